# Optimizing an MI355X kernel written in HIP

```python
import jax
import jax.numpy as jnp
from jax import lax
import numpy as np


D_MODEL = 2048
BATCH = 8
SEQ = 2048
DEPTH = 2

CTX_LEN = 256
GRID_W = 64
CHUNK = 64
Q_BLOCK = 128
EPS = 1e-6
N_BRANCH = 4
BR_W = 512

ML_HEADS = 4
ML_DH = 128
ML_W = ML_HEADS * ML_DH
HG_HEADS = 4
HG_DK = 128
HG_DV = 128
HG_W = HG_HEADS * HG_DV
MLA_HEADS = 4
MLA_Q_RANK = 512
MLA_KV_RANK = 256
MLA_NOPE = 128
MLA_ROPE = 64
MLA_DV = 128
MLA_SCALE = (MLA_NOPE + MLA_ROPE) ** -0.5
ROPE_BASE = 10000.0
SSD_HEADS = 8
SSD_P = 64
SSD_W = SSD_HEADS * SSD_P
SSD_GROUPS = 2
SSD_N = 128
SSD_GN = SSD_GROUPS * SSD_N
SSD_XBC = SSD_W + 2 * SSD_GN
SSD_CONV = 3
N_GROUPS = 4
EXP_PER_GROUP = 8
N_EXPERTS = N_GROUPS * EXP_PER_GROUP
TOP_K = 2
D_EXPERT = 512

IN_SIZES = (ML_W, ML_W, ML_W, ML_W, 4 * ML_HEADS,
            HG_W, HG_W, HG_W, 2 * HG_W,
            MLA_Q_RANK, MLA_KV_RANK, MLA_ROPE,
            SSD_W, SSD_XBC, 2 * SSD_HEADS)
D_IN = sum(IN_SIZES)

F32 = jnp.float32

kernel_name = 'hybrid_mlstm_hgrn2_mla_ssd_hmoe_dit'


def rmsnorm(x, g):
    x32 = x.astype(F32)
    y = x32 * lax.rsqrt(jnp.mean(x32 * x32, axis=-1, keepdims=True) + EPS)
    return (y * g.astype(F32)).astype(x.dtype)


def modulate(x, shift, scale):
    return x * (1.0 + scale) + shift


def split_cols(u, sizes):
    idx, acc = [], 0
    for s in sizes[:-1]:
        acc += s
        idx.append(acc)
    return jnp.split(u, idx, axis=-1)


def split_heads(t, n_heads):
    b, l, _ = t.shape
    return t.reshape(b, l, n_heads, -1).transpose(0, 2, 1, 3)


def merge_heads(t):
    b, n, l, d = t.shape
    return t.transpose(0, 2, 1, 3).reshape(b, l, n * d)


def chunk_tril():
    return jnp.tril(jnp.ones((CHUNK, CHUNK), dtype=bool))


def to_chunks(t):
    b, h, l = t.shape[:3]
    t = t.reshape((b, h, l // CHUNK, CHUNK) + t.shape[3:])
    return jnp.moveaxis(t, 2, 0)


def from_chunks(t):
    t = jnp.moveaxis(t, 0, 2)
    return t.reshape(t.shape[:2] + (t.shape[2] * t.shape[3],) + t.shape[4:])


def chunk_scan(body, inputs, state):
    xs = tuple(to_chunks(t) for t in inputs)
    state, ys = lax.scan(body, state, xs)
    return from_chunks(ys), state


def run_direction(body, ctx_in, lat_in, init, reverse):
    def flip(t):
        return jnp.flip(t, axis=2) if reverse else t
    y_ctx, state = chunk_scan(body, tuple(flip(t) for t in ctx_in), init)
    y_lat, _ = chunk_scan(body, tuple(flip(t) for t in lat_in), state)
    return flip(y_ctx), flip(y_lat)


def mlstm_chunk(carry, inp):
    c_mat, n_vec, m_sc = carry
    q, k, v, i_log, f_log = inp
    tril = chunk_tril()
    f_cum = jnp.cumsum(f_log, axis=-1)
    d_mat = jnp.where(tril, f_cum[..., :, None] - f_cum[..., None, :] + i_log[..., None, :], -jnp.inf)
    from_state = f_cum + m_sc[..., None]
    m_t = jnp.maximum(from_state, jnp.max(d_mat, axis=-1))
    s = jnp.einsum('bhtd,bhsd->bhts', q, k) * jnp.exp(d_mat - m_t[..., None])
    w_state = jnp.exp(from_state - m_t)
    num = jnp.einsum('bhts,bhsv->bhtv', s, v) + w_state[..., None] * jnp.einsum('bhtk,bhkv->bhtv', q, c_mat)
    den = jnp.sum(s, axis=-1) + w_state * jnp.einsum('bhtk,bhk->bht', q, n_vec)
    h = num / jnp.maximum(jnp.abs(den), jnp.exp(-m_t))[..., None]
    f_tot = f_cum[..., -1]
    w_log = f_tot[..., None] - f_cum + i_log
    m_new = jnp.maximum(f_tot + m_sc, jnp.max(w_log, axis=-1))
    decay = jnp.exp(f_tot + m_sc - m_new)
    w_in = jnp.exp(w_log - m_new[..., None])
    c_new = decay[..., None, None] * c_mat + jnp.einsum('bhs,bhsk,bhsv->bhkv', w_in, k, v)
    n_new = decay[..., None] * n_vec + jnp.einsum('bhs,bhsk->bhk', w_in, k)
    return (c_new, n_new, m_new), h


def mlstm_branch(parts_c, parts_l, f_bias):
    def prep(q, k, v, o, gates):
        b, l, _ = q.shape
        qh = split_heads(q.astype(F32), ML_HEADS) * (ML_DH ** -0.5)
        kh = split_heads(k.astype(F32), ML_HEADS)
        vh = split_heads(v.astype(F32), ML_HEADS)
        g = gates.astype(F32).reshape(b, l, 2, 2, ML_HEADS).transpose(2, 3, 0, 4, 1)
        f_log = jax.nn.log_sigmoid(g[:, 1] + f_bias.astype(F32)[:, None, :, None])
        return (qh, kh, vh, g[0, 0], f_log[0]), (qh, kh, vh, g[1, 0], f_log[1]), o
    fc, bc, oc = prep(*parts_c)
    fl, bl, ol = prep(*parts_l)
    b = parts_l[0].shape[0]
    init = (jnp.zeros((b, ML_HEADS, ML_DH, ML_DH), F32), jnp.zeros((b, ML_HEADS, ML_DH), F32),
            jnp.full((b, ML_HEADS), -jnp.inf, F32))
    yc_f, yl_f = run_direction(mlstm_chunk, fc, fl, init, False)
    yc_b, yl_b = run_direction(mlstm_chunk, bc, bl, init, True)

    def finish(y_f, y_b, o):
        return (merge_heads(y_f + y_b) * jax.nn.sigmoid(o.astype(F32))).astype(o.dtype)
    return finish(yc_f, yc_b, oc), finish(yl_f, yl_b, ol)


def hgrn2_chunk(s_state, inp):
    q, k, v, lf = inp
    tril = chunk_tril()
    g_cum = jnp.cumsum(lf, axis=2)
    rel = jnp.where(tril[:, :, None], g_cum[:, :, :, None, :] - g_cum[:, :, None, :, :], -jnp.inf)
    a = jnp.einsum('bhtd,bhsd,bhtsd->bhts', q, k, jnp.exp(rel))
    o = jnp.einsum('bhts,bhsv->bhtv', a, v) + jnp.einsum('bhtd,bhdv->bhtv', q * jnp.exp(g_cum), s_state)
    g_tot = g_cum[:, :, -1]
    k_dec = k * jnp.exp(g_tot[:, :, None, :] - g_cum)
    s_new = jnp.exp(g_tot)[..., None] * s_state + jnp.einsum('bhsd,bhsv->bhdv', k_dec, v)
    return s_new, o


def hgrn2_branch(parts_c, parts_l, lb, norm_g):
    def prep(q, i, g, f_raw):
        b, l, _ = q.shape
        qh = split_heads(jax.nn.silu(q.astype(F32)), HG_HEADS)
        vh = split_heads(i.astype(F32), HG_HEADS)
        f = lb + (1.0 - lb) * jax.nn.sigmoid(f_raw.astype(F32).reshape(b, l, 2, HG_W))
        dirs = []
        for d in range(2):
            fd = split_heads(f[:, :, d], HG_HEADS)
            dirs.append((qh, 1.0 - fd, vh, jnp.log(fd)))
        return dirs[0], dirs[1], g
    fc, bc, gc = prep(*parts_c)
    fl, bl, gl = prep(*parts_l)
    b = parts_l[0].shape[0]
    init = jnp.zeros((b, HG_HEADS, HG_DK, HG_DV), F32)
    yc_f, yl_f = run_direction(hgrn2_chunk, fc, fl, init, False)
    yc_b, yl_b = run_direction(hgrn2_chunk, bc, bl, init, True)

    def finish(y_f, y_b, g):
        bb, h, l, dv = y_f.shape
        o = (y_f + y_b).transpose(0, 2, 1, 3)
        o = rmsnorm(o, norm_g.reshape(HG_HEADS, HG_DV)).reshape(bb, l, HG_W)
        return (o * jax.nn.sigmoid(g.astype(F32))).astype(g.dtype)
    return finish(yc_f, yc_b, gc), finish(yl_f, yl_b, gl)


def axial_rope(x, pos_row, pos_col):
    half = MLA_ROPE // 2
    quarter = half // 2
    inv_freq = ROPE_BASE ** (-jnp.arange(quarter, dtype=F32) / quarter)

    def rot(xa, pos):
        ang = pos.astype(F32)[:, None] * inv_freq
        shape = (ang.shape[0],) + (1,) * (xa.ndim - 3) + (quarter,)
        cos, sin = jnp.cos(ang).reshape(shape), jnp.sin(ang).reshape(shape)
        x1, x2 = xa[..., :quarter], xa[..., quarter:]
        return jnp.concatenate([x1 * cos - x2 * sin, x1 * sin + x2 * cos], axis=-1)
    x32 = x.astype(F32)
    return jnp.concatenate([rot(x32[..., :half], pos_row), rot(x32[..., half:], pos_col)], axis=-1).astype(x.dtype)


def softmax_attend(q, k, v):
    s = jnp.einsum('bhqd,bhkd->bhqk', q, k).astype(F32) * MLA_SCALE
    p = jax.nn.softmax(s, axis=-1)
    return jnp.einsum('bhqk,bhkv->bhqv', p.astype(v.dtype), v)


def mla_branch(parts_c, parts_l, pos, g_q, g_kv, w_uq, w_ukv, emit_ctx):
    def project(cq, ckv, k_rope, rope_pos):
        b, l, _ = cq.shape
        q = (rmsnorm(cq, g_q) @ w_uq).reshape(b, l, MLA_HEADS, MLA_NOPE + MLA_ROPE)
        kv = (rmsnorm(ckv, g_kv) @ w_ukv).reshape(b, l, MLA_HEADS, MLA_NOPE + MLA_DV)
        q_nope, q_rope = q[..., :MLA_NOPE], q[..., MLA_NOPE:]
        k_nope, v = kv[..., :MLA_NOPE], kv[..., MLA_NOPE:]
        if rope_pos is not None:
            q_rope = axial_rope(q_rope, *rope_pos)
            k_rope = axial_rope(k_rope, *rope_pos)
        k_rope = jnp.broadcast_to(k_rope[:, :, None, :], (b, l, MLA_HEADS, MLA_ROPE))
        q = jnp.concatenate([q_nope, q_rope], axis=-1).transpose(0, 2, 1, 3)
        k = jnp.concatenate([k_nope, k_rope], axis=-1).transpose(0, 2, 1, 3)
        return q, k, v.transpose(0, 2, 1, 3)
    qc, kc, vc = project(*parts_c, None)
    ql, kl, vl = project(*parts_l, pos)
    k_all = jnp.concatenate([kc, kl], axis=2)
    v_all = jnp.concatenate([vc, vl], axis=2)
    b, h, s, dh = ql.shape
    n_blk = s // Q_BLOCK
    q_blocks = ql.reshape(b, h, n_blk, Q_BLOCK, dh).transpose(2, 0, 1, 3, 4)

    def attend(q_blk):
        return softmax_attend(q_blk, k_all, v_all)
    ol = lax.map(attend, q_blocks)
    ol = ol.transpose(1, 0, 3, 2, 4).reshape(b, s, h * MLA_DV)
    oc = merge_heads(softmax_attend(qc, kc, vc)) if emit_ctx else None
    return oc, ol


def centred_dwconv(x, w, b):
    pad = (SSD_CONV - 1) // 2
    y = lax.conv_general_dilated(x, w[:, None, :].astype(x.dtype), window_strides=(1,),
                                 padding=[(pad, pad)], dimension_numbers=('NWC', 'WIO', 'NWC'),
                                 feature_group_count=x.shape[-1])
    return y + b.astype(x.dtype)


def ssd_chunk(h_state, inp):
    x, bm, cm, da, dt = inp
    tril = chunk_tril()
    a_cum = jnp.cumsum(da, axis=-1)
    decay = jnp.exp(jnp.where(tril, a_cum[..., :, None] - a_cum[..., None, :], -jnp.inf))
    xdt = x * dt[..., None]
    s = jnp.einsum('bhtn,bhsn->bhts', cm, bm) * decay
    y = jnp.einsum('bhts,bhsp->bhtp', s, xdt) + jnp.exp(a_cum)[..., None] * jnp.einsum('bhtn,bhpn->bhtp', cm, h_state)
    a_tot = a_cum[..., -1]
    w = jnp.exp(a_tot[..., None] - a_cum)
    h_new = jnp.exp(a_tot)[..., None, None] * h_state + jnp.einsum('bhs,bhsp,bhsn->bhpn', w, xdt, bm)
    return h_new, y


def ssd_branch(parts_c, parts_l, conv_w, conv_b, a_log, dt_bias, d_skip, norm_g):
    a_neg = -jnp.exp(a_log.astype(F32))

    def prep(z, xbc, dt_raw):
        b, l, _ = xbc.shape
        xbc = jax.nn.silu(centred_dwconv(xbc, conv_w, conv_b)).astype(F32)
        xs, bm, cm = xbc[..., :SSD_W], xbc[..., SSD_W:SSD_W + SSD_GN], xbc[..., SSD_W + SSD_GN:]
        xh = split_heads(xs, SSD_HEADS)

        def group_to_heads(t):
            t = t.reshape(b, l, SSD_GROUPS, SSD_N)
            return jnp.repeat(t, SSD_HEADS // SSD_GROUPS, axis=2).transpose(0, 2, 1, 3)
        bh, ch = group_to_heads(bm), group_to_heads(cm)
        dt = jax.nn.softplus(dt_raw.astype(F32).reshape(b, l, 2, SSD_HEADS) + dt_bias.astype(F32))
        dt = dt.transpose(2, 0, 3, 1)
        da = dt * a_neg[:, None, :, None]
        return (xh, bh, ch, da[0], dt[0]), (xh, bh, ch, da[1], dt[1]), xh, z
    fc, bc, xc, zc = prep(*parts_c)
    fl, bl, xl, zl = prep(*parts_l)
    b = parts_l[0].shape[0]
    init = jnp.zeros((b, SSD_HEADS, SSD_P, SSD_N), F32)
    yc_f, yl_f = run_direction(ssd_chunk, fc, fl, init, False)
    yc_b, yl_b = run_direction(ssd_chunk, bc, bl, init, True)

    def finish(y_f, y_b, xh, z):
        y = y_f + y_b + d_skip.astype(F32)[None, :, None, None] * xh
        y = merge_heads(y) * jax.nn.silu(z.astype(F32))
        return rmsnorm(y, norm_g).astype(z.dtype)
    return finish(yc_f, yc_b, xc, zc), finish(yl_f, yl_b, xl, zl)


def merge_branches(h, branches, w_gate, w_br, w_out):
    acc = None
    for k in range(N_BRANCH):
        gate = jax.nn.sigmoid((h @ w_gate[k]).astype(F32))
        term = gate * (branches[k] @ w_br[k]).astype(F32)
        acc = term if acc is None else acc + term
    return acc.astype(h.dtype) @ w_out


def mixer_sublayer(hc, hl, pos, lb, w_in, ml_f_bias, hg_norm_g, mla_g_q, mla_g_kv, mla_w_uq, mla_w_ukv,
                   ssd_conv_w, ssd_conv_b, ssd_a_log, ssd_dt_bias, ssd_d, ssd_norm_g,
                   w_gate, w_br, w_out, emit_ctx):
    n_ctx = hc.shape[1]
    h = jnp.concatenate([hc, hl], axis=1)
    parts = split_cols(h @ w_in, IN_SIZES)
    pc = [t[:, :n_ctx] for t in parts]
    pl = [t[:, n_ctx:] for t in parts]
    ml = mlstm_branch(pc[0:5], pl[0:5], ml_f_bias)
    hg = hgrn2_branch(pc[5:9], pl[5:9], lb, hg_norm_g)
    mla = mla_branch(pc[9:12], pl[9:12], pos, mla_g_q, mla_g_kv, mla_w_uq, mla_w_ukv, emit_ctx)
    ssd = ssd_branch(pc[12:15], pl[12:15], ssd_conv_w, ssd_conv_b, ssd_a_log, ssd_dt_bias, ssd_d, ssd_norm_g)
    outs = (ml, hg, mla, ssd)
    if emit_ctx:
        y = merge_branches(h, [jnp.concatenate([o[0], o[1]], axis=1) for o in outs], w_gate, w_br, w_out)
        return y[:, :n_ctx], y[:, n_ctx:]
    return None, merge_branches(hl, [o[1] for o in outs], w_gate, w_br, w_out)


def moe_ffn(h, w_grp, w_exp, w1, w3, w2):
    b, l, _ = h.shape
    grp_prob = jax.nn.softmax((h @ w_grp).astype(F32), axis=-1)
    grp_p, grp_idx = lax.top_k(grp_prob, 1)
    exp_logits = (h @ w_exp).astype(F32).reshape(b, l, N_GROUPS, EXP_PER_GROUP)
    sel = jnp.take_along_axis(exp_logits, grp_idx[..., None], axis=2)[..., 0, :]
    top_v, top_i = lax.top_k(sel, TOP_K)
    w_top = jax.nn.softmax(top_v, axis=-1) * grp_p
    expert_id = grp_idx * EXP_PER_GROUP + top_i
    combine = jnp.sum(jax.nn.one_hot(expert_id, N_EXPERTS, dtype=F32) * w_top[..., None], axis=-2)
    out = None
    for e in range(N_EXPERTS):
        y = (jax.nn.silu(h @ w1[e]) * (h @ w3[e])) @ w2[e]
        term = combine[..., e:e + 1] * y.astype(F32)
        out = term if out is None else out + term
    return out.astype(h.dtype)


def setup_inputs(seed: int = 0) -> dict:
    key = jax.random.key(seed)
    ks = jax.random.split(key, 29)

    def nrm(k, shape, scale):
        return scale * jax.random.normal(k, shape, F32)
    d = D_MODEL
    dt0 = jnp.exp(jax.random.uniform(ks[18], (DEPTH, 2, SSD_HEADS), F32, np.log(1e-3), np.log(1e-1)))
    return {
        'x': nrm(ks[0], (BATCH, SEQ, d), 1.0),
        'c': nrm(ks[1], (BATCH, d), 1.0),
        'ctx': nrm(ks[2], (BATCH, CTX_LEN, d), 1.0),
        'c_ctx': nrm(ks[3], (d,), 1.0),
        'w_ada': nrm(ks[4], (DEPTH, d, 6 * d), 0.2 * d ** -0.5),
        'b_ada': nrm(ks[5], (DEPTH, 6 * d), 0.01),
        'norm_g': 1.0 + nrm(ks[6], (DEPTH, 4, d), 0.05),
        'w_in': nrm(ks[7], (DEPTH, d, D_IN), d ** -0.5),
        'ml_f_bias': jax.random.uniform(ks[8], (DEPTH, 2, ML_HEADS), F32, 3.0, 6.0),
        'hg_lb_logits': nrm(ks[9], (DEPTH + 1, HG_W), 0.5),
        'hg_norm_g': 1.0 + nrm(ks[10], (DEPTH, HG_W), 0.05),
        'mla_g_q': 1.0 + nrm(ks[11], (DEPTH, MLA_Q_RANK), 0.05),
        'mla_g_kv': 1.0 + nrm(ks[12], (DEPTH, MLA_KV_RANK), 0.05),
        'mla_w_uq': nrm(ks[13], (DEPTH, MLA_Q_RANK, MLA_HEADS * (MLA_NOPE + MLA_ROPE)), MLA_Q_RANK ** -0.5),
        'mla_w_ukv': nrm(ks[14], (DEPTH, MLA_KV_RANK, MLA_HEADS * (MLA_NOPE + MLA_DV)), MLA_KV_RANK ** -0.5),
        'ssd_conv_w': nrm(ks[15], (DEPTH, SSD_CONV, SSD_XBC), SSD_CONV ** -0.5),
        'ssd_conv_b': nrm(ks[16], (DEPTH, SSD_XBC), 0.01),
        'ssd_a_log': jnp.log(jax.random.uniform(ks[17], (DEPTH, 2, SSD_HEADS), F32, 1.0, 16.0)),
        'ssd_dt_bias': dt0 + jnp.log(-jnp.expm1(-dt0)),
        'ssd_d': 1.0 + nrm(ks[19], (DEPTH, SSD_HEADS), 0.1),
        'ssd_norm_g': 1.0 + nrm(ks[20], (DEPTH, SSD_W), 0.05),
        'w_gate': nrm(ks[21], (DEPTH, N_BRANCH, d, d), d ** -0.5),
        'w_br': nrm(ks[22], (DEPTH, N_BRANCH, BR_W, d), BR_W ** -0.5),
        'w_out': nrm(ks[23], (DEPTH, d, d), d ** -0.5),
        'moe_w_grp': nrm(ks[24], (DEPTH, d, N_GROUPS), d ** -0.5),
        'moe_w_exp': nrm(ks[25], (DEPTH, d, N_EXPERTS), d ** -0.5),
        'moe_w1': nrm(ks[26], (DEPTH, N_EXPERTS, d, D_EXPERT), d ** -0.5),
        'moe_w3': nrm(ks[27], (DEPTH, N_EXPERTS, d, D_EXPERT), d ** -0.5),
        'moe_w2': nrm(ks[28], (DEPTH, N_EXPERTS, D_EXPERT, d), D_EXPERT ** -0.5),
    }


def reference(x, c, ctx, c_ctx, w_ada, b_ada, norm_g, w_in, ml_f_bias, hg_lb_logits, hg_norm_g,
              mla_g_q, mla_g_kv, mla_w_uq, mla_w_ukv, ssd_conv_w, ssd_conv_b, ssd_a_log, ssd_dt_bias,
              ssd_d, ssd_norm_g, w_gate, w_br, w_out, moe_w_grp, moe_w_exp, moe_w1, moe_w3, moe_w2):
    n_ctx = ctx.shape[1]
    rows = x.shape[1] // GRID_W
    tok = jnp.arange(rows * GRID_W)
    pos = (tok // GRID_W, tok % GRID_W)
    lb_all = jnp.cumsum(jax.nn.softmax(hg_lb_logits.astype(F32), axis=0), axis=0)
    s_c = jax.nn.silu(c)
    s_ctx = jax.nn.silu(c_ctx)
    xl, xc = x, ctx
    for l in range(DEPTH):
        emit_ctx = l < DEPTH - 1
        mod_l = [t[:, None, :] for t in jnp.split(s_c @ w_ada[l] + b_ada[l], 6, axis=-1)]
        mod_c = jnp.split(s_ctx @ w_ada[l] + b_ada[l], 6, axis=-1)
        hl = modulate(rmsnorm(xl, norm_g[l, 0]), mod_l[0], mod_l[1])
        hc = modulate(rmsnorm(xc, norm_g[l, 0]), mod_c[0], mod_c[1])
        yc, yl = mixer_sublayer(hc, hl, pos, lb_all[l], w_in[l], ml_f_bias[l], hg_norm_g[l],
                                mla_g_q[l], mla_g_kv[l], mla_w_uq[l], mla_w_ukv[l],
                                ssd_conv_w[l], ssd_conv_b[l], ssd_a_log[l], ssd_dt_bias[l], ssd_d[l],
                                ssd_norm_g[l], w_gate[l], w_br[l], w_out[l], emit_ctx)
        xl = xl + mod_l[2] * rmsnorm(yl, norm_g[l, 1])
        hl2 = modulate(rmsnorm(xl, norm_g[l, 2]), mod_l[3], mod_l[4])
        if emit_ctx:
            xc = xc + mod_c[2] * rmsnorm(yc, norm_g[l, 1])
            hc2 = modulate(rmsnorm(xc, norm_g[l, 2]), mod_c[3], mod_c[4])
            y2 = moe_ffn(jnp.concatenate([hc2, hl2], axis=1), moe_w_grp[l], moe_w_exp[l], moe_w1[l], moe_w3[l], moe_w2[l])
            xc = xc + mod_c[5] * rmsnorm(y2[:, :n_ctx], norm_g[l, 3])
            yl2 = y2[:, n_ctx:]
        else:
            yl2 = moe_ffn(hl2, moe_w_grp[l], moe_w_exp[l], moe_w1[l], moe_w3[l], moe_w2[l])
        xl = xl + mod_l[5] * rmsnorm(yl2, norm_g[l, 3])
    return xl
```

```cpp
#include <hip/hip_runtime.h>
#include <cstdio>
#include <cstdint>

#ifndef MK_SINGLE
#define MK_SINGLE 1
#endif

constexpr int DM = 2048, NBATCH = 8, SEQ = 2048, CTXL = 256, DEPTH = 2;
constexpr int ML = NBATCH * SEQ;
constexpr int MC = NBATCH * CTXL;
constexpr int MT = ML + MC;
constexpr int DIN = 7008, NU = 7168;
constexpr int U_MLQ = 0, U_MLK = 512, U_MLV = 1024, U_MLO = 1536, U_HGQ = 2048, U_HGI = 2560, U_HGG = 3072, U_HGF = 3584,
              U_CQ = 4608, U_CKV = 5120, U_KR = 5376, U_MLG = 5440, U_DT = 5456, U_Z = 5632, U_XBC = 6144;
constexpr float EPS = 1e-6f;
constexpr int NEXP = 32, DEXP = 512;
constexpr int MOE_ROWS = 2 * MT + NEXP * 256;

enum { I_X = 0, I_C, I_CTX, I_CCTX, I_WADA, I_BADA, I_NORMG, I_WIN, I_MLFB, I_HGLB, I_HGNG, I_MLAGQ, I_MLAGKV, I_WUQ, I_WUKV,
       I_CONVW, I_CONVB, I_ALOG, I_DTB, I_SSDD, I_SSDNG, I_WGATE, I_WBR, I_WOUT, I_WGRP, I_WEXP, I_W1, I_W3, I_W2, N_IN };

constexpr size_t al256(size_t x) { return (x + 255) / 256 * 256; }
constexpr size_t WS_CTL = 0, CTL_BYTES = 1u << 20;
constexpr size_t WS_WIN = WS_CTL + CTL_BYTES;
constexpr size_t WS_WUQ = WS_WIN + (size_t)2 * NU * DM * 2;
constexpr size_t WS_WUKV = WS_WUQ + (size_t)2 * 768 * 512 * 2;
constexpr size_t WS_WG = WS_WUKV + (size_t)2 * 1024 * 256 * 2;
constexpr size_t WS_WBR = WS_WG + (size_t)2 * 8192 * DM * 2;
constexpr size_t WS_WOUT = WS_WBR + (size_t)2 * 4 * DM * 512 * 2;
constexpr size_t WS_WR = WS_WOUT + (size_t)2 * DM * DM * 2;
constexpr size_t WS_W13 = WS_WR + (size_t)2 * 256 * DM * 2;
constexpr size_t WS_W2 = WS_W13 + (size_t)NEXP * 1024 * DM * 2;
constexpr size_t WS_MODP = WS_W2 + (size_t)NEXP * DM * 512 * 2;
constexpr size_t WS_MOD = WS_MODP + (size_t)2 * 16 * 9 * 12288 * 4;
constexpr size_t WS_TAB = WS_MOD + (size_t)2 * 9 * 12288 * 4;
constexpr size_t WS_XC = WS_TAB + 16384;
constexpr size_t WS_H = WS_XC + (size_t)MC * DM * 4;
constexpr size_t WS_QB = WS_H + (size_t)MT * DM * 2;
constexpr size_t WS_KVB = WS_QB + (size_t)MT * 768 * 2;
constexpr size_t WS_SSQ = WS_KVB + (size_t)MT * 1024 * 2;
constexpr size_t WS_BR = WS_SSQ + (size_t)MT * 12 * 4;
constexpr size_t WS_YFB = WS_BR + (size_t)MT * DM * 2;
constexpr size_t WS_RSSD = WS_YFB + (size_t)6 * MT * 512 * 2;
constexpr size_t WS_LOG = WS_RSSD + al256((size_t)MT * 4);
constexpr size_t WS_LIST = WS_LOG + (size_t)4 * MT * 64 * 4;
constexpr size_t WS_WL = WS_LIST + (size_t)NEXP * MT * 4;
constexpr size_t WS_XBC = WS_WL + (size_t)NEXP * MT * 4;
constexpr size_t HGP_ITEM = 8192 + 8192 + 1024;
constexpr size_t WS_HGP = WS_XBC + (size_t)MT * 1024 * 2;
constexpr size_t WS_MLS = WS_HGP + (size_t)64 * 72 * HGP_ITEM;
constexpr size_t WS_SSDS = WS_MLS + (size_t)64 * 2304 * 32;
constexpr size_t WS_MLC = WS_SSDS + (size_t)128 * 2304 * 32;
constexpr size_t WS_RA = WS_MLC + (size_t)32 * 2304 * 384 * 2;
constexpr size_t RA_BYTES = (size_t)MT * NU * 2;
constexpr size_t WS_RB = WS_RA + RA_BYTES;
constexpr size_t RB_BYTES = ((size_t)80 << 20) + (size_t)2 * MT * DM * 2;
constexpr size_t WS_END = WS_RB + RB_BYTES;
constexpr size_t RA_ACC = 0, RA_PART = (size_t)80 << 20, RA_H1 = (size_t)150 << 20;
constexpr size_t RB_Y = 0, RB_Y2 = (size_t)80 << 20;
static_assert(RA_PART >= (size_t)MT * DM * 2 && RA_H1 >= RA_PART + (size_t)256 * 65536 * 4 && RA_H1 + (size_t)MOE_ROWS * 512 * 2 <= RA_BYTES, "region A");
static_assert(RB_Y2 >= (size_t)MT * DM * 2 && RB_Y2 + (size_t)2 * MT * DM * 2 <= RB_BYTES && (size_t)MT * 8192 <= RB_BYTES, "region B");
constexpr int CW_CNT = 64;
constexpr int CW_BAR = 4096;

constexpr int RING_BYTES = 131072, MISC_OFF = RING_BYTES, LDS_BYTES = 147456;

#define GAS __attribute__((address_space(1)))
#define LAS __attribute__((address_space(3)))
typedef unsigned short bf16_t;
typedef short bf16x8 __attribute__((ext_vector_type(8)));
typedef short s16x4 __attribute__((ext_vector_type(4)));
typedef float f32x4 __attribute__((ext_vector_type(4)));
typedef float f32x2 __attribute__((ext_vector_type(2)));
typedef float f32x16 __attribute__((ext_vector_type(16)));
typedef unsigned u32x4 __attribute__((ext_vector_type(4)));
typedef unsigned u32x2 __attribute__((ext_vector_type(2)));
#define LDS_WAIT() asm volatile("s_waitcnt lgkmcnt(0)" ::: "memory")
#define VM_WAIT() asm volatile("s_waitcnt vmcnt(0)" ::: "memory")
typedef __bf16 bf16x2_t __attribute__((ext_vector_type(2)));
__device__ __forceinline__ unsigned cvt_pk_bf16(float lo, float hi) { const f32x2 v = {lo, hi}; return __builtin_bit_cast(unsigned, __builtin_convertvector(v, bf16x2_t)); }
__device__ __forceinline__ bf16_t f2bf(float f) { return (bf16_t)(cvt_pk_bf16(f, 0.f) & 0xffffu); }
__device__ __forceinline__ float bf2f(bf16_t b) { return __uint_as_float(((unsigned)b) << 16); }
__device__ __forceinline__ float bflo(unsigned w) { return __uint_as_float(w << 16); }
__device__ __forceinline__ float bfhi(unsigned w) { return __uint_as_float(w & 0xffff0000u); }
__device__ __forceinline__ float sigmoidf_(float x) { return 1.f / (1.f + __expf(-x)); }
__device__ __forceinline__ float siluf_(float x) { return x / (1.f + __expf(-x)); }
__device__ __forceinline__ int opaque_tid() { int t = threadIdx.x; asm volatile("" : "+v"(t)); return t; }
__device__ __forceinline__ const void* opaque_ptr(const void* p) {
    unsigned lo = (unsigned)(uintptr_t)p, hi = (unsigned)((uintptr_t)p >> 32); asm volatile("" : "+v"(lo), "+v"(hi));
    lo = __builtin_amdgcn_readfirstlane(lo); hi = __builtin_amdgcn_readfirstlane(hi); return (const void*)(((uintptr_t)hi << 32) | lo); }
__device__ __forceinline__ float wave_sum(float v) {
#pragma unroll
    for (int o = 1; o < 64; o <<= 1) v += __shfl_xor(v, o);
    return v;
}

__device__ __forceinline__ int prow(int b, int dir, int p) { if (p < CTXL) return ML + b * CTXL + (dir ? CTXL - 1 - p : p); const int q = p - CTXL; return b * SEQ + (dir ? SEQ - 1 - q : q); }
namespace scn {
__device__ __forceinline__ int rowl(int row, int colB) { return row * 256 + (colB ^ ((row & 7) << 4)); }
__device__ __forceinline__ float scan_add32(float v, int r32) {
#pragma unroll
    for (int d = 1; d < 32; d <<= 1) { const float o = __shfl_up(v, d, 32); if (r32 >= d) v += o; }
    return v;
}
__device__ __forceinline__ float scan_max32(float v, int r32) {
#pragma unroll
    for (int d = 1; d < 32; d <<= 1) { const float o = __shfl_up(v, d, 32); if (r32 >= d) v = fmaxf(v, o); }
    return v;
}
}

#define XB_TMO      128
#define XB_XCNT(j)  (256  + 64 * (j))
#define XB_XSUB(j)  (1280 + 64 * (j))
#define XB_XGEN(j)  (2304 + 64 * (j))
#define XB_TOP      3328
#define XB_TOPGEN   3392
#define XCD_BAR_WORDS 3456
#define XB_SPIN_CAP (1u << 18)
__device__ __forceinline__ unsigned xb_ld(unsigned* p)              { return __hip_atomic_load(p, __ATOMIC_RELAXED, __HIP_MEMORY_SCOPE_AGENT); }
__device__ __forceinline__ unsigned xb_add(unsigned* p, unsigned v) { return __hip_atomic_fetch_add(p, v, __ATOMIC_RELAXED, __HIP_MEMORY_SCOPE_AGENT); }
__device__ __forceinline__ unsigned xb_xcc_id() { return (unsigned)__builtin_amdgcn_s_getreg((3 << 11) | 20) & 0xFu; }
#define XB_SPIN(cond, bar) do { unsigned _sp = 0; while (cond) { __builtin_amdgcn_s_sleep(1); \
    if ((++_sp & 255u) == 0u) { if (xb_ld(&(bar)[XB_TMO])) break; if (_sp > XB_SPIN_CAP) { atomicAdd(&(bar)[XB_TMO], 1u); break; } } } } while (0)
struct XcdBarrier { unsigned* bar; unsigned x; volatile LAS unsigned* st; };
__device__ __forceinline__ XcdBarrier xcd_barrier_post(unsigned* bar, volatile LAS unsigned* st) {
    XcdBarrier b; b.bar = bar; b.x = xb_xcc_id(); b.st = st;
    if (threadIdx.x == 0) (void)xb_add(&bar[XB_XCNT(b.x)], 1u);
    return b;
}
__device__ __forceinline__ void xcd_barrier_complete(unsigned* bar, unsigned x, unsigned& nloc, unsigned& nx) {
    const unsigned G = gridDim.x * gridDim.y * gridDim.z;
    unsigned sum, cnt, mine, sp = 0u;
    for (;;) {
        sum = 0u; cnt = 0u; mine = 0u;
#pragma unroll
        for (unsigned j = 0; j < 16; ++j) { const unsigned c = xb_ld(&bar[XB_XCNT(j)]); sum += c; cnt += (c > 0u) ? 1u : 0u; mine = (j == x) ? c : mine; }
        if (sum == G) break;
        __builtin_amdgcn_s_sleep(1);
        if ((++sp & 255u) == 0u) { if (xb_ld(&bar[XB_TMO])) break; if (sp > XB_SPIN_CAP) { atomicAdd(&bar[XB_TMO], 1u); break; } }
    }
    nloc = mine > 0u ? mine : 1u; nx = cnt > 0u ? cnt : 1u;
}
__device__ __forceinline__ void xcd_barrier(const XcdBarrier& b) {
    asm volatile("s_waitcnt vmcnt(0)" ::: "memory");
    __syncthreads();
    if (threadIdx.x == 0) {
        unsigned* bar = b.bar;
        __builtin_amdgcn_s_waitcnt(0);
        unsigned nloc = b.st[0], nx = b.st[1];
        if (nloc == 0u) { xcd_barrier_complete(bar, b.x, nloc, nx); b.st[0] = nloc; b.st[1] = nx; }
        const unsigned old = xb_add(&bar[XB_XSUB(b.x)], 1u);
        const unsigned gen = old / nloc;
        if (old + 1u == (gen + 1u) * nloc) {
            __builtin_amdgcn_fence(__ATOMIC_RELEASE, "agent");
            asm volatile("s_waitcnt vmcnt(0)" ::: "memory");
            const unsigned og = xb_add(&bar[XB_TOP], 1u);
            const unsigned tg = og / nx;
            if (og + 1u == (tg + 1u) * nx) xb_add(&bar[XB_TOPGEN], 1u);
            else XB_SPIN(xb_ld(&bar[XB_TOPGEN]) == tg, bar);
            __builtin_amdgcn_fence(__ATOMIC_ACQUIRE, "agent");
            xb_add(&bar[XB_XGEN(b.x)], 1u);
            asm volatile("s_waitcnt vmcnt(0)" ::: "memory");
        } else {
            XB_SPIN(xb_ld(&bar[XB_XGEN(b.x)]) == gen, bar);
            __builtin_amdgcn_fence(__ATOMIC_ACQUIRE, "agent");
            asm volatile("s_waitcnt vmcnt(0)" ::: "memory");
        }
    }
    __syncthreads();
}

struct Frame {
    LAS unsigned char* lds;
    volatile LAS unsigned* MISC;
    unsigned* ctl;
    int tid, lane, wave, vcu, G;
    const float* const* inp;
    GAS float* out;
    GAS unsigned char* ws;
};
#define WSP(T, off) ((GAS T*)(F.ws + (off)))
#define INP(i) ((const GAS float*)F.inp[i])

namespace pg8 {
constexpr int BM = 256, BK = 64, HALF = 128, HTB = HALF * BK * 2, STAGE_BYTES = 8 * HTB, NXCD = 8, WGM = 8;
__host__ __device__ __forceinline__ int lds_byte(int r, int c) { const int st = (r >> 4) * 2 + (c >> 5), rr = r & 15, cc = c & 31, ob = rr * 64 + cc * 2; return st * 1024 + (ob ^ (((ob >> 9) & 1) << 5)); }
__host__ __device__ __forceinline__ void stage_rc(int b, int& R, int& C) { const int st = b / 1024, sb = b % 1024, swz = sb ^ (((sb >> 9) & 1) << 5); R = (st >> 1) * 16 + swz / 64; C = (st & 1) * 32 + (swz % 64) / 2; }

struct Unit { int pm, pn, aux, aux2; size_t aoff, boff; };
struct Gemm { const GAS bf16_t* A; const GAS bf16_t* Bt; int lda, ldb, K; };

struct GridSched {
    int nM, nN, nwg, G, c; size_t a_tile, b_tile, a0, b0;
    __device__ __forceinline__ void init(int nM_, int nN_, int G_, int c_, size_t a_tile_, size_t b_tile_, size_t a0_, size_t b0_) { nM = nM_; nN = nN_; nwg = nM * nN; G = G_; c = c_; a_tile = a_tile_; b_tile = b_tile_; a0 = a0_; b0 = b0_; }
    __device__ __forceinline__ void map(int L, int& pm, int& pn) const {
        int wgid = L; { const int q = nwg / NXCD, r = nwg % NXCD, xcd = wgid % NXCD, off = wgid / NXCD; wgid = (xcd < r ? xcd * (q + 1) : r * (q + 1) + (xcd - r) * q) + off; }
        const int nig = WGM * nN, gid = wgid / nig, fm = gid * WGM, gsz = (nM - fm) < WGM ? (nM - fm) : WGM;
        pm = fm + ((wgid % nig) % gsz); pn = (wgid % nig) / gsz;
    }
    __device__ __forceinline__ bool next(int i, Unit& u) const {
        const long L = (long)i * G + c; if (L >= nwg) return false;
        map((int)L, u.pm, u.pn); u.aux = 0; u.aux2 = 0; u.aoff = a0 + (size_t)u.pm * a_tile; u.boff = b0 + (size_t)u.pn * b_tile; return true;
    }
    __device__ __forceinline__ int arow(const Unit&, int) const { return 0; }
};

template <class Epi, class Sched, bool GATHER>
__device__ __forceinline__ void gemm_phase(LAS unsigned char* lds, const Gemm g, const Sched& S, const Epi& E) {
    const int tid = opaque_tid(), wid = __builtin_amdgcn_readfirstlane(tid >> 6), lane = tid & 63, wr = wid >> 2, wc = wid & 3, fr = lane & 15, fq = lane >> 4;
    int nt = g.K / BK; asm volatile("" : "+s"(nt));
    unsigned voffA[2], voffB[2];
#pragma unroll
    for (int i = 0; i < 2; ++i) { int R, C; stage_rc(tid * 16 + i * 8192, R, C);
        voffA[i] = (unsigned)(R * g.lda + C) * 2u; voffB[i] = (unsigned)(R * g.ldb + C) * 2u; }
    const size_t kstep = (size_t)(BK * 2);
    const size_t hstepA = (size_t)HALF * g.lda * 2, hstepB = (size_t)HALF * g.ldb * 2;
    const unsigned ldsw = (unsigned)wid * 1024u;
    const int aoff = lds_byte(wr * 64 + fr, fq * 8), boff = lds_byte(wc * 32 + fr, fq * 8);
#define PG8_SA(b, h) (((b) * 2 + (h)) * HTB)
#define PG8_SB(b, h) ((4 + (b) * 2 + (h)) * HTB)
#define PG8_STAGE(bufoff, gbase, voff) do { _Pragma("unroll") for (int _i = 0; _i < 2; ++_i) \
        __builtin_amdgcn_global_load_lds((const unsigned*)((const char*)(gbase) + (voff)[_i]), (LAS unsigned*)(lds + (bufoff) + ldsw + _i * 8192), 16, 0, 0); } while (0)
#define PG8_LDA(dst, b, h) do { _Pragma("unroll") for (int m = 0; m < 4; ++m) _Pragma("unroll") for (int k = 0; k < 2; ++k) dst[m][k] = *(const LAS bf16x8*)(lds + PG8_SA(b, h) + aoff + m * 2048 + k * 1024); } while (0)
#define PG8_LDB(dst, b, h) do { _Pragma("unroll") for (int n = 0; n < 2; ++n) _Pragma("unroll") for (int k = 0; k < 2; ++k) dst[n][k] = *(const LAS bf16x8*)(lds + PG8_SB(b, h) + boff + n * 2048 + k * 1024); } while (0)
#define PG8_MMA(ai, bj, At, Bt) do { __builtin_amdgcn_s_setprio(1); _Pragma("unroll") for (int m = 0; m < 4; ++m) _Pragma("unroll") for (int n = 0; n < 2; ++n) _Pragma("unroll") for (int k = 0; k < 2; ++k) \
        acc[ai][bj][m][n] = __builtin_amdgcn_mfma_f32_16x16x32_bf16(Bt[n][k], At[m][k], acc[ai][bj][m][n], 0, 0, 0); __builtin_amdgcn_s_setprio(0); } while (0)
#if GEMM_SAFE
#define PG8_WAIT_V(n) asm volatile("s_waitcnt vmcnt(0)" ::: "memory")
#else
#define PG8_WAIT_V(n) asm volatile("s_waitcnt vmcnt(" #n ")" ::: "memory")
#endif
#define PG8_WAIT_L(n) asm volatile("s_waitcnt lgkmcnt(" #n ")" ::: "memory")
#define PG8_BAR __builtin_amdgcn_s_barrier()
#define PG8_SCHED __builtin_amdgcn_sched_barrier(0)
    unsigned cvA[2][2], nvA[2][2];
#define PG8_GOFF(dst, u) do { if constexpr (GATHER) { _Pragma("unroll") for (int _i = 0; _i < 2; ++_i) { int R_, C_; stage_rc(tid * 16 + _i * 8192, R_, C_); _Pragma("unroll") for (int _h = 0; _h < 2; ++_h) \
        dst[_h][_i] = (unsigned)(((size_t)S.arow(u, _h * HALF + R_) * (size_t)g.lda + (size_t)C_) * 2u); } } } while (0)
#define PG8_STAGE_A(bufoff, base, half, vh) do { if constexpr (GATHER) { PG8_STAGE(bufoff, base, (vh)[half]); } else { PG8_STAGE(bufoff, (base) + (half) * hstepA, voffA); } } while (0)
    Unit cur, nxt; int ui = 0;
    if (!S.next(0, cur)) return;
    f32x4 acc[2][2][4][2];
#pragma unroll
    for (int a = 0; a < 2; ++a)
#pragma unroll
        for (int b = 0; b < 2; ++b)
#pragma unroll
            for (int m = 0; m < 4; ++m)
#pragma unroll
                for (int n = 0; n < 2; ++n) acc[a][b][m][n] = (f32x4){0.f, 0.f, 0.f, 0.f};
    bf16x8 At[4][2], B0[2][2], B1[2][2];
    const char* cA = (const char*)g.A + cur.aoff; const char* cB = (const char*)g.Bt + cur.boff;
    PG8_GOFF(cvA, cur);
#pragma unroll
    for (int _h = 0; _h < 2; ++_h)
#pragma unroll
        for (int _i = 0; _i < 2; ++_i) nvA[_h][_i] = cvA[_h][_i];
    PG8_STAGE(PG8_SB(0, 0), cB, voffB); PG8_STAGE_A(PG8_SA(0, 0), cA, 0, cvA); PG8_STAGE(PG8_SB(0, 1), cB + hstepB, voffB); PG8_STAGE_A(PG8_SA(0, 1), cA, 1, cvA);
    if (wr == 1) PG8_BAR;
    PG8_WAIT_V(4); PG8_BAR;
    PG8_STAGE(PG8_SB(1, 0), cB + kstep, voffB); PG8_STAGE_A(PG8_SA(1, 0), cA + kstep, 0, cvA); PG8_STAGE(PG8_SB(1, 1), cB + hstepB + kstep, voffB);
    PG8_WAIT_V(6); PG8_BAR;
    for (;;) {
        const bool has_next = S.next(ui + 1, nxt);
        const char* nA = has_next ? (const char*)g.A + nxt.aoff : cA; const char* nB = has_next ? (const char*)g.Bt + nxt.boff : cB;
        for (int t = 0; t < nt; t += 2) {
            const bool last = (t == nt - 2);
            const char* a1 = cA + (size_t)(t + 1) * kstep;
            const char* a2 = last ? nA : cA + (size_t)(t + 2) * kstep; const char* b2 = last ? nB : cB + (size_t)(t + 2) * kstep;
            const char* a3 = a2 + kstep; const char* b3 = b2 + kstep;
            if constexpr (GATHER) { if (last && has_next) { PG8_GOFF(nvA, nxt); } }
            PG8_LDB(B0, 0, 0); PG8_SCHED; PG8_LDA(At, 0, 0); PG8_STAGE_A(PG8_SA(1, 1), a1, 1, cvA);
            PG8_WAIT_L(8); PG8_BAR; PG8_WAIT_L(0); PG8_MMA(0, 0, At, B0); PG8_BAR; PG8_SCHED;
            PG8_LDB(B1, 0, 1); PG8_STAGE(PG8_SB(0, 0), b2, voffB);
            PG8_BAR; PG8_WAIT_L(0); PG8_MMA(0, 1, At, B1); PG8_BAR;
            PG8_LDA(At, 0, 1); PG8_STAGE_A(PG8_SA(0, 0), a2, 0, nvA);
            PG8_BAR; PG8_WAIT_L(0); PG8_MMA(1, 0, At, B0); PG8_BAR; PG8_SCHED;
            PG8_STAGE(PG8_SB(0, 1), b2 + hstepB, voffB);
            PG8_WAIT_V(6); PG8_BAR; PG8_MMA(1, 1, At, B1); PG8_BAR;
            PG8_LDB(B0, 1, 0); PG8_SCHED; PG8_LDA(At, 1, 0); PG8_STAGE_A(PG8_SA(0, 1), a2, 1, nvA);
            PG8_WAIT_L(8); PG8_BAR; PG8_WAIT_L(0); PG8_MMA(0, 0, At, B0); PG8_BAR; PG8_SCHED;
            PG8_LDB(B1, 1, 1); PG8_STAGE(PG8_SB(1, 0), b3, voffB);
            PG8_BAR; PG8_WAIT_L(0); PG8_MMA(0, 1, At, B1); PG8_BAR;
            PG8_LDA(At, 1, 1); PG8_STAGE_A(PG8_SA(1, 0), a3, 0, nvA);
            PG8_BAR; PG8_WAIT_L(0); PG8_MMA(1, 0, At, B0); PG8_BAR; PG8_SCHED;
            PG8_STAGE(PG8_SB(1, 1), b3 + hstepB, voffB);
            PG8_WAIT_V(6); PG8_BAR; PG8_MMA(1, 1, At, B1); PG8_BAR;
        }
        E(acc, cur, wr, wc, fr, fq);
        if (!has_next) break;
#pragma unroll
        for (int a = 0; a < 2; ++a)
#pragma unroll
            for (int b = 0; b < 2; ++b)
#pragma unroll
                for (int m = 0; m < 4; ++m)
#pragma unroll
                    for (int n = 0; n < 2; ++n) acc[a][b][m][n] = (f32x4){0.f, 0.f, 0.f, 0.f};
        cur = nxt; cA = nA; cB = nB; ++ui;
        if constexpr (GATHER) {
#pragma unroll
            for (int _h = 0; _h < 2; ++_h)
#pragma unroll
                for (int _i = 0; _i < 2; ++_i) cvA[_h][_i] = nvA[_h][_i];
        }
    }
    PG8_WAIT_V(0);
    if (wr == 0) PG8_BAR;
    PG8_BAR;
#undef PG8_SA
#undef PG8_SB
#undef PG8_STAGE
#undef PG8_STAGE_A
#undef PG8_GOFF
#undef PG8_LDA
#undef PG8_LDB
#undef PG8_MMA
#undef PG8_WAIT_V
#undef PG8_WAIT_L
#undef PG8_BAR
#undef PG8_SCHED
}
}
using pg8::Unit;
using pg8::Gemm;
using pg8::GridSched;
#define EPI_ARGS f32x4 (&acc)[2][2][4][2], const Unit& u, int wr, int wc, int fr, int fq
#define EPI_FOR_ROWS for (int ai = 0; ai < 2; ++ai) for (int m = 0; m < 4; ++m)
#define EPI_FOR_COLS for (int bj = 0; bj < 2; ++bj) for (int n = 0; n < 2; ++n)
__device__ __forceinline__ void st_bf16x4(GAS bf16_t* p, f32x4 v) { u32x2 w; w.x = cvt_pk_bf16(v[0], v[1]); w.y = cvt_pk_bf16(v[2], v[3]); *(GAS u32x2*)p = w; }

struct EpiWin {
    GAS bf16_t* U; GAS float* ssq; const GAS float* rope;
    __device__ __forceinline__ void operator()(EPI_ARGS) const {
        const int row0 = u.pm * 256 + wr * 64 + fr, col0 = u.pn * 256 + wc * 32 + 4 * fq;
        if (u.pn == 21 && wc < 2 && u.pm < ML / 256) {
#pragma unroll
            for (int ai = 0; ai < 2; ++ai)
#pragma unroll
                for (int m = 0; m < 4; ++m) {
                    const int r = row0 + ai * 128 + m * 16, tok = r & (SEQ - 1), pos = wc == 0 ? (tok >> 6) : (tok & 63);
                    const f32x4 cs = *(const GAS f32x4*)(rope + pos * 16 + 4 * fq), sn = *(const GAS f32x4*)(rope + 1024 + pos * 16 + 4 * fq);
                    const f32x4 x1 = acc[ai][0][m][0], x2 = acc[ai][0][m][1];
                    acc[ai][0][m][0] = x1 * cs - x2 * sn; acc[ai][0][m][1] = x1 * sn + x2 * cs;
                }
        }
        if (u.pn >= 18 && u.pn <= 20) {
            const int slot = (u.pn - 18) * 4 + wc;
#pragma unroll
            for (int ai = 0; ai < 2; ++ai)
#pragma unroll
                for (int m = 0; m < 4; ++m) {
                    float s = 0.f;
#pragma unroll
                    for (int bj = 0; bj < 2; ++bj)
#pragma unroll
                        for (int n = 0; n < 2; ++n) { const f32x4 x = acc[ai][bj][m][n]; s += (x[0] * x[0] + x[1] * x[1]) + (x[2] * x[2] + x[3] * x[3]); }
                    s += __shfl_xor(s, 16); s += __shfl_xor(s, 32);
                    if (fq == 0) ssq[(size_t)(row0 + ai * 128 + m * 16) * 12 + slot] = s;
                }
        }
#pragma unroll
        for (int ai = 0; ai < 2; ++ai)
#pragma unroll
            for (int m = 0; m < 4; ++m) { GAS bf16_t* rowp = U + (size_t)(row0 + ai * 128 + m * 16) * NU + col0;
#pragma unroll
                for (int bj = 0; bj < 2; ++bj)
#pragma unroll
                    for (int n = 0; n < 2; ++n) st_bf16x4(rowp + bj * 128 + n * 16, acc[ai][bj][m][n]); }
    }
};
struct EpiMlaQ {
    GAS bf16_t* Q; const GAS float* ssq; const GAS float* rope;
    __device__ __forceinline__ void operator()(EPI_ARGS) const {
        const int row0 = u.pm * 256 + wr * 64 + fr, col0 = u.pn * 256 + wc * 32 + 4 * fq;
        f32x4 p0[8], p1[8];
#pragma unroll
        for (int i = 0; i < 8; ++i) { const int r = row0 + (i >> 2) * 128 + (i & 3) * 16; p0[i] = *(const GAS f32x4*)(ssq + (size_t)r * 12); p1[i] = *(const GAS f32x4*)(ssq + (size_t)r * 12 + 4); }
#pragma unroll
        for (int ai = 0; ai < 2; ++ai)
#pragma unroll
            for (int m = 0; m < 4; ++m) {
                const int r = row0 + ai * 128 + m * 16, i = ai * 4 + m;
                const float rstd = rsqrtf(((p0[i][0] + p0[i][1]) + (p0[i][2] + p0[i][3]) + (p1[i][0] + p1[i][1]) + (p1[i][2] + p1[i][3])) * (1.f / 512.f) + EPS);
#pragma unroll
                for (int bj = 0; bj < 2; ++bj) {
                    f32x4 a = acc[ai][bj][m][0] * rstd, b = acc[ai][bj][m][1] * rstd;
                    if (u.pn == 2 && u.pm < ML / 256) {
                        const int tok = r & (SEQ - 1), pos = (wc & 1) == 0 ? (tok >> 6) : (tok & 63);
                        const f32x4 cs = *(const GAS f32x4*)(rope + pos * 16 + 4 * fq), sn = *(const GAS f32x4*)(rope + 1024 + pos * 16 + 4 * fq);
                        const f32x4 x1 = a, x2 = b; a = x1 * cs - x2 * sn; b = x1 * sn + x2 * cs;
                    }
                    GAS bf16_t* rowp = Q + (size_t)r * 768 + col0 + bj * 128;
                    st_bf16x4(rowp, a); st_bf16x4(rowp + 16, b);
                }
            }
    }
};
struct EpiMlaKV {
    GAS bf16_t* KV; const GAS float* ssq;
    __device__ __forceinline__ void operator()(EPI_ARGS) const {
        const int row0 = u.pm * 256 + wr * 64 + fr, col0 = u.pn * 256 + wc * 32 + 4 * fq;
        f32x4 p0[8];
#pragma unroll
        for (int i = 0; i < 8; ++i) { const int r = row0 + (i >> 2) * 128 + (i & 3) * 16; p0[i] = *(const GAS f32x4*)(ssq + (size_t)r * 12 + 8); }
#pragma unroll
        for (int ai = 0; ai < 2; ++ai)
#pragma unroll
            for (int m = 0; m < 4; ++m) {
                const int r = row0 + ai * 128 + m * 16, i = ai * 4 + m;
                const float rstd = rsqrtf(((p0[i][0] + p0[i][1]) + (p0[i][2] + p0[i][3])) * (1.f / 256.f) + EPS);
                GAS bf16_t* rowp = KV + (size_t)r * 1024 + col0;
#pragma unroll
                for (int bj = 0; bj < 2; ++bj)
#pragma unroll
                    for (int n = 0; n < 2; ++n) st_bf16x4(rowp + bj * 128 + n * 16, acc[ai][bj][m][n] * rstd);
            }
    }
};
struct EpiGate {
    GAS unsigned char* G;
    __device__ __forceinline__ void operator()(EPI_ARGS) const {
        const __amdgpu_buffer_rsrc_t rsrc = __builtin_amdgcn_make_buffer_rsrc((void*)G, 0, 0x7fffffff, 0x00020000);
        const int voff = threadIdx.x * 8; const int tbase = (u.pm * 32 + u.pn) * 65536;
#pragma unroll
        for (int ai = 0; ai < 2; ++ai)
#pragma unroll
            for (int bj = 0; bj < 2; ++bj)
#pragma unroll
                for (int m = 0; m < 4; ++m) {
                    u32x2 w;
#pragma unroll
                    for (int n = 0; n < 2; ++n) { const f32x4 v = acc[ai][bj][m][n]; unsigned d = 0;
#pragma unroll
                        for (int j = 0; j < 4; ++j) { const float g = 255.f * __builtin_amdgcn_rcpf(1.f + __builtin_amdgcn_exp2f(-1.4426950409f * v[j])); d = __builtin_amdgcn_cvt_pk_u8_f32(g, j, d); }
                        if (n == 0) w.x = d; else w.y = d; }
                    __builtin_amdgcn_raw_buffer_store_b64(w, rsrc, voff, tbase + ((ai * 2 + bj) * 4 + m) * 4096, 0);
                }
    }
};
struct EpiMerge {
    const GAS unsigned char* G; GAS bf16_t* ACC; GAS unsigned char* part; const GAS float* rssd;
    __device__ __forceinline__ void operator()(EPI_ARGS) const {
        const int row0 = u.pm * 256 + wr * 64 + fr, col0 = u.pn * 256 + wc * 32 + 4 * fq, k = u.aux;
        const __amdgpu_buffer_rsrc_t rg = __builtin_amdgcn_make_buffer_rsrc((void*)G, 0, 0x7fffffff, 0x00020000);
        const __amdgpu_buffer_rsrc_t rp = __builtin_amdgcn_make_buffer_rsrc((void*)part, 0, 131072, 0x00020000);
        const int vg = threadIdx.x * 8, vp = threadIdx.x * 16; const int tbase = (u.pm * 32 + k * 8 + u.pn) * 65536;
#pragma unroll
        for (int ai = 0; ai < 2; ++ai) {
            u32x2 gw[2][4]; u32x4 pw[2][4]; float rsv[4];
#pragma unroll
            for (int m = 0; m < 4; ++m) { rsv[m] = (k == 3) ? rssd[row0 + ai * 128 + m * 16] : 1.f;
#pragma unroll
                for (int bj = 0; bj < 2; ++bj) { const int idx2 = (ai * 2 + bj) * 4 + m; gw[bj][m] = __builtin_amdgcn_raw_buffer_load_b64(rg, vg, tbase + idx2 * 4096, 0);
                    if (k > 0) pw[bj][m] = __builtin_amdgcn_raw_buffer_load_b128(rp, vp, idx2 * 8192, 16); } }
#pragma unroll
            for (int m = 0; m < 4; ++m) {
                const int r = row0 + ai * 128 + m * 16; const float rs = rsv[m] * (1.f / 255.f);
#pragma unroll
                for (int bj = 0; bj < 2; ++bj) {
                    const int idx2 = (ai * 2 + bj) * 4 + m; const u32x2 g2 = gw[bj][m];
                    f32x4 v0, v1;
                    v0[0] = (float)(g2.x & 0xffu); v0[1] = (float)((g2.x >> 8) & 0xffu); v0[2] = (float)((g2.x >> 16) & 0xffu); v0[3] = (float)(g2.x >> 24);
                    v1[0] = (float)(g2.y & 0xffu); v1[1] = (float)((g2.y >> 8) & 0xffu); v1[2] = (float)((g2.y >> 16) & 0xffu); v1[3] = (float)(g2.y >> 24);
                    v0 = v0 * acc[ai][bj][m][0] * rs; v1 = v1 * acc[ai][bj][m][1] * rs;
                    if (k > 0) { const u32x4 p4 = pw[bj][m];
                        v0 += (f32x4){bflo(p4.x), bfhi(p4.x), bflo(p4.y), bfhi(p4.y)}; v1 += (f32x4){bflo(p4.z), bfhi(p4.z), bflo(p4.w), bfhi(p4.w)}; }
                    if (k < 3) { u32x4 ow; ow.x = cvt_pk_bf16(v0[0], v0[1]); ow.y = cvt_pk_bf16(v0[2], v0[3]); ow.z = cvt_pk_bf16(v1[0], v1[1]); ow.w = cvt_pk_bf16(v1[2], v1[3]);
                        __builtin_amdgcn_raw_buffer_store_b128(ow, rp, vp, idx2 * 8192, 16); }
                    else { GAS bf16_t* op = ACC + (size_t)r * DM + col0 + bj * 128; st_bf16x4(op, v0); st_bf16x4(op + 16, v1); }
                }
            }
            asm volatile("" ::: "memory");
        }
    }
};
struct EpiBf16 {
    GAS bf16_t* O; int ld;
    __device__ __forceinline__ void operator()(EPI_ARGS) const {
        const int row0 = u.pm * 256 + wr * 64 + fr, col0 = u.pn * 256 + wc * 32 + 4 * fq;
#pragma unroll
        for (int ai = 0; ai < 2; ++ai)
#pragma unroll
            for (int m = 0; m < 4; ++m) { GAS bf16_t* rowp = O + (size_t)(row0 + ai * 128 + m * 16) * ld + col0;
#pragma unroll
                for (int bj = 0; bj < 2; ++bj)
#pragma unroll
                    for (int n = 0; n < 2; ++n) st_bf16x4(rowp + bj * 128 + n * 16, acc[ai][bj][m][n]); }
    }
};
struct EpiRouter {
    GAS float* LOG;
    __device__ __forceinline__ void operator()(EPI_ARGS) const {
        if (wc >= 2) return;
        const int row0 = u.pm * 256 + wr * 64 + fr, col0 = wc * 32 + 4 * fq;
#pragma unroll
        for (int ai = 0; ai < 2; ++ai)
#pragma unroll
            for (int m = 0; m < 4; ++m) { GAS float* rowp = LOG + ((size_t)u.aux * MT + (row0 + ai * 128 + m * 16)) * 64 + col0;
#pragma unroll
                for (int n = 0; n < 2; ++n) *(GAS f32x4*)(rowp + n * 16) = acc[ai][0][m][n]; }
    }
};
struct RouterSched {
    int nM, G, c;
    __device__ __forceinline__ bool next(int i, Unit& u) const {
        const long L = (long)i * G + c; if (L >= (long)nM * 4) return false;
        u.pm = (int)(L >> 2); u.pn = 0; u.aux = (int)(L & 3); u.aux2 = 0;
        u.aoff = ((size_t)u.pm * 256 * DM + (size_t)u.aux * 512) * 2; u.boff = (size_t)u.aux * 512 * 2; return true;
    }
    __device__ __forceinline__ int arow(const Unit&, int) const { return 0; }
};
struct MoeSched {
    const volatile LAS int* tb; const volatile LAS int* cnt; const GAS int* list; int nN, G, c, mode;
    __device__ __forceinline__ bool next(int i, Unit& u) const {
        const long L = (long)i * G + c; const int NT = tb[32];
        const int ti = (int)(L / nN); if (ti >= NT) return false;
        u.pn = (int)(L % nN); int e = 0;
        while (e < 31 && ti >= tb[e + 1]) ++e;
        u.aux = e; u.aux2 = ti - tb[e]; u.pm = ti;
        if (mode == 1) { u.aoff = 0; u.boff = ((size_t)e * 1024 + (size_t)u.pn * 256) * DM * 2; }
        else { u.aoff = (size_t)ti * 256 * DEXP * 2; u.boff = ((size_t)e * DM + (size_t)u.pn * 256) * DEXP * 2; }
        return true;
    }
    __device__ __forceinline__ int arow(const Unit& u, int r) const {
        const int pos = u.aux2 * 256 + r; const int e = u.aux;
        return pos < cnt[e] ? (list[(size_t)e * MT + pos] >> 1) : 0;
    }
};
struct EpiMoe1 {
    GAS bf16_t* H1;
    __device__ __forceinline__ void operator()(EPI_ARGS) const {
        const int row0 = u.pm * 256 + wr * 64 + fr, col0 = u.pn * 128 + wc * 32 + 4 * fq;
#pragma unroll
        for (int ai = 0; ai < 2; ++ai)
#pragma unroll
            for (int m = 0; m < 4; ++m) { GAS bf16_t* rowp = H1 + (size_t)(row0 + ai * 128 + m * 16) * DEXP + col0;
#pragma unroll
                for (int n = 0; n < 2; ++n) { const f32x4 a = acc[ai][0][m][n], b = acc[ai][1][m][n]; f32x4 v;
#pragma unroll
                    for (int j = 0; j < 4; ++j) v[j] = a[j] * __builtin_amdgcn_rcpf(1.f + __builtin_amdgcn_exp2f(-1.4426950409f * a[j])) * b[j];
                    st_bf16x4(rowp + n * 16, v); } }
    }
};
struct EpiMoe2 {
    GAS bf16_t* Y2; const GAS int* list; const GAS float* wl; const volatile LAS int* cnt;
    __device__ __forceinline__ void operator()(EPI_ARGS) const {
        const int e = u.aux, n_e = cnt[e], col0 = u.pn * 256 + wc * 32 + 4 * fq;
        int ts[8]; float w[8];
#pragma unroll
        for (int i = 0; i < 8; ++i) { const int pos = u.aux2 * 256 + (i >> 2) * 128 + wr * 64 + (i & 3) * 16 + fr; const bool ok = pos < n_e;
            ts[i] = ok ? list[(size_t)e * MT + pos] : -1; w[i] = ok ? wl[(size_t)e * MT + pos] : 0.f; }
#pragma unroll
        for (int ai = 0; ai < 2; ++ai)
#pragma unroll
            for (int m = 0; m < 4; ++m) { const int i = ai * 4 + m;
                if (ts[i] >= 0) {
                    GAS bf16_t* rowp = Y2 + (size_t)ts[i] * DM + col0;
#pragma unroll
                    for (int bj = 0; bj < 2; ++bj)
#pragma unroll
                        for (int n = 0; n < 2; ++n) st_bf16x4(rowp + bj * 128 + n * 16, acc[ai][bj][m][n] * w[i]);
                }
            }
    }
};
struct MergeSched {
    GridSched gs;
    __device__ __forceinline__ bool next(int i, Unit& u) const {
        const long L = (long)(i >> 2) * gs.G + gs.c; if (L >= gs.nwg) return false;
        gs.map((int)L, u.pm, u.pn); const int k = i & 3; u.aux = k; u.aux2 = 0;
        u.aoff = ((size_t)u.pm * 256 * DM + (size_t)k * 512) * 2; u.boff = ((size_t)k * DM + (size_t)u.pn * 256) * 512 * 2; return true;
    }
    __device__ __forceinline__ int arow(const Unit&, int) const { return 0; }
};

__device__ __forceinline__ void tr_block(const GAS float* colp, int ldw, float nscale, const GAS float* kscale, int k0, GAS bf16_t* WT, int K, int n0, LAS float* scr, int lane) {
    float v[32];
#pragma unroll
    for (int i = 0; i < 32; ++i) { const int kk = 2 * i + (lane >> 5); v[i] = colp ? colp[(size_t)(k0 + kk) * ldw] : 0.f; }
    if (kscale) {
#pragma unroll
        for (int i = 0; i < 32; ++i) { const int kk = 2 * i + (lane >> 5); v[i] *= kscale[k0 + kk]; }
    }
#pragma unroll
    for (int i = 0; i < 32; ++i) { const int kk = 2 * i + (lane >> 5); scr[kk * 33 + (lane & 31)] = v[i] * nscale; }
    LDS_WAIT(); asm volatile("" ::: "memory");
    const int c = lane & 7;
#pragma unroll
    for (int j = 0; j < 4; ++j) { const int n = (lane >> 3) + 8 * j; const LAS float* s = scr + (8 * c) * 33 + n;
        u32x4 o; o.x = cvt_pk_bf16(s[0 * 33], s[1 * 33]); o.y = cvt_pk_bf16(s[2 * 33], s[3 * 33]); o.z = cvt_pk_bf16(s[4 * 33], s[5 * 33]); o.w = cvt_pk_bf16(s[6 * 33], s[7 * 33]);
        *(GAS u32x4*)(WT + (size_t)(n0 + n) * K + k0 + 8 * c) = o; }
    LDS_WAIT(); asm volatile("" ::: "memory");
}
__device__ __forceinline__ int win_src(int n) {
    if (n < 2048) return n;
    if (n < 5440) return n + 16;
    if (n < 5456) return 2048 + (n - 5440);
    if (n < 5472) return 6992 + (n - 5456);
    if (n < 5632) return -1;
    if (n < 6144) return 5456 + (n - 5632);
    return 5968 + (n - 6144);
}
constexpr int IT_WIN = 32 * 224, IT_WUQ = 8 * 24, IT_WUKV = 4 * 32, IT_WG = 32 * 64, IT_WBR = 8 * 64, IT_WOUT = 32 * 64, IT_WR = 32 * 8, IT_W13 = 32 * 32, IT_W2 = 8 * 64;
constexpr int IT_LAYER = IT_WIN + IT_WUQ + IT_WUKV + 4 * IT_WG + 4 * IT_WBR + IT_WOUT + IT_WR;
constexpr int IT_MOE = NEXP * (IT_W13 + IT_W2);
__device__ __forceinline__ void cvt_layer_item(Frame& F, int l, int r, LAS float* scr) {
    const int lane = F.lane, nl = lane & 31;
    if (r < IT_WIN) { const int nb = r % 224, kb = r / 224, n = nb * 32 + nl, sc = win_src(n);
        tr_block(sc >= 0 ? INP(I_WIN) + (size_t)l * DM * DIN + sc : nullptr, DIN, n < 512 ? 0.08838834764831845f : 1.f, nullptr, kb * 64, WSP(bf16_t, WS_WIN) + (size_t)l * NU * DM, DM, nb * 32, scr, lane); return; }
    r -= IT_WIN;
    if (r < IT_WUQ) { const int nb = r % 24, kb = r / 24, n = nb * 32 + nl; const int sc = n < 512 ? (n >> 7) * 192 + (n & 127) : ((n - 512) >> 6) * 192 + 128 + ((n - 512) & 63);
        tr_block(INP(I_WUQ) + (size_t)l * 512 * 768 + sc, 768, 0.07216878364870323f * 1.4426950408889634f, INP(I_MLAGQ) + l * 512, kb * 64, WSP(bf16_t, WS_WUQ) + (size_t)l * 768 * 512, 512, nb * 32, scr, lane); return; }
    r -= IT_WUQ;
    if (r < IT_WUKV) { const int nb = r % 32, kb = r / 32, n = nb * 32 + nl; const int sc = n < 512 ? (n >> 7) * 256 + (n & 127) : ((n - 512) >> 7) * 256 + 128 + ((n - 512) & 127);
        tr_block(INP(I_WUKV) + (size_t)l * 256 * 1024 + sc, 1024, 1.f, INP(I_MLAGKV) + l * 256, kb * 64, WSP(bf16_t, WS_WUKV) + (size_t)l * 1024 * 256, 256, nb * 32, scr, lane); return; }
    r -= IT_WUKV;
    if (r < 4 * IT_WG) { const int k = r / IT_WG, q = r % IT_WG, nb = q % 64, kb = q / 64;
        tr_block(INP(I_WGATE) + (size_t)(l * 4 + k) * DM * DM + nb * 32 + nl, DM, 1.f, nullptr, kb * 64, WSP(bf16_t, WS_WG) + ((size_t)l * 8192 + (size_t)k * 2048) * DM, DM, nb * 32, scr, lane); return; }
    r -= 4 * IT_WG;
    if (r < 4 * IT_WBR) { const int k = r / IT_WBR, q = r % IT_WBR, nb = q % 64, kb = q / 64;
        const GAS float* ks = k == 1 ? INP(I_HGNG) + l * 512 : (k == 3 ? INP(I_SSDNG) + l * 512 : nullptr);
        tr_block(INP(I_WBR) + (size_t)(l * 4 + k) * 512 * DM + nb * 32 + nl, DM, 1.f, ks, kb * 64, WSP(bf16_t, WS_WBR) + (size_t)(l * 4 + k) * DM * 512, 512, nb * 32, scr, lane); return; }
    r -= 4 * IT_WBR;
    if (r < IT_WOUT) { const int nb = r % 64, kb = r / 64;
        tr_block(INP(I_WOUT) + (size_t)l * DM * DM + nb * 32 + nl, DM, 1.f, nullptr, kb * 64, WSP(bf16_t, WS_WOUT) + (size_t)l * DM * DM, DM, nb * 32, scr, lane); return; }
    r -= IT_WOUT;
    { const int nb = r % 8, kb = r / 8, n = nb * 32 + nl; const GAS float* cp = nullptr; int ld = 4;
      if (n < 4) { cp = INP(I_WGRP) + (size_t)l * DM * 4 + n; ld = 4; } else if (n < 36) { cp = INP(I_WEXP) + (size_t)l * DM * 32 + (n - 4); ld = 32; }
      tr_block(cp, ld, 1.f, nullptr, kb * 64, WSP(bf16_t, WS_WR) + (size_t)l * 256 * DM, DM, nb * 32, scr, lane); }
}
__device__ __forceinline__ void cvt_moe_item(Frame& F, int l, int r, LAS float* scr) {
    const int lane = F.lane, nl = lane & 31;
    if (r < NEXP * IT_W13) { const int e = r / IT_W13, q = r % IT_W13, nb = q % 32, kb = q / 32, n = nb * 32 + nl;
        const int c = (n >> 8) * 128 + (n & 127); const GAS float* src = ((n >> 7) & 1) ? INP(I_W3) : INP(I_W1);
        tr_block(src + (size_t)(l * NEXP + e) * DM * DEXP + c, DEXP, 1.f, nullptr, kb * 64, WSP(bf16_t, WS_W13) + (size_t)e * 1024 * DM, DM, nb * 32, scr, lane); return; }
    r -= NEXP * IT_W13;
    { const int e = r / IT_W2, q = r % IT_W2, nb = q % 64, kb = q / 64;
      tr_block(INP(I_W2) + (size_t)(l * NEXP + e) * DEXP * DM + nb * 32 + nl, DM, 1.f, nullptr, kb * 64, WSP(bf16_t, WS_W2) + (size_t)e * DM * DEXP, DEXP, nb * 32, scr, lane); }
}
__device__ __forceinline__ void ada_task(Frame& F, int task) {
    const int ks = task & 15, cg = (task >> 4) % 48, l = task / (16 * 48); const int col = cg * 256 + F.lane * 4;
    f32x4 a[9];
#pragma unroll
    for (int r = 0; r < 9; ++r) a[r] = (f32x4){0.f, 0.f, 0.f, 0.f};
    const GAS float* W = INP(I_WADA) + ((size_t)l * DM + ks * 128) * 12288 + col;
    for (int k = 0; k < 128; k += 4) {
        f32x4 w[4];
#pragma unroll
        for (int q = 0; q < 4; ++q) w[q] = *(const GAS f32x4*)(W + (size_t)(k + q) * 12288);
#pragma unroll
        for (int q = 0; q < 4; ++q) {
            const int kk = ks * 128 + k + q;
#pragma unroll
            for (int r = 0; r < 9; ++r) { const float c = r < 8 ? INP(I_C)[r * DM + kk] : INP(I_CCTX)[kk]; a[r] += siluf_(c) * w[q]; }
        }
    }
    GAS float* P = WSP(float, WS_MODP) + ((size_t)(l * 16 + ks) * 9) * 12288 + col;
#pragma unroll
    for (int r = 0; r < 9; ++r) *(GAS f32x4*)(P + (size_t)r * 12288) = a[r];
}
__device__ __forceinline__ void tables_task(Frame& F) {
    GAS float* T = WSP(float, WS_TAB); const int lane = F.lane;
    for (int i = 0; i < 16; ++i) { const float inv = expf(-(float)i * (9.210340371976184f / 16.f)); const float ang = (float)lane * inv; T[lane * 16 + i] = cosf(ang); T[1024 + lane * 16 + i] = sinf(ang); }
    for (int j = lane; j < 512; j += 64) { const float a0 = INP(I_HGLB)[j], a1 = INP(I_HGLB)[512 + j], a2 = INP(I_HGLB)[1024 + j];
        const float mx = fmaxf(a0, fmaxf(a1, a2)), e0 = expf(a0 - mx), e1 = expf(a1 - mx), e2 = expf(a2 - mx), s = e0 + e1 + e2;
        T[2048 + j] = e0 / s; T[2048 + 512 + j] = (e0 + e1) / s; }
}
constexpr int N_ADA = 2 * 48 * 16;
__device__ __forceinline__ void phase_prologue(Frame& F) {
    LAS float* scr = (LAS float*)(F.lds + F.wave * 16384);
    const int gw = F.vcu * 8 + F.wave, NGW = F.G * 8;
    constexpr int TOTAL = N_ADA + 1 + 2 * IT_LAYER;
    for (int it = gw; it < TOTAL; it += NGW) {
        int r = it;
        if (r < N_ADA) { ada_task(F, r); continue; } r -= N_ADA;
        if (r == 0) { tables_task(F); continue; } r -= 1;
        cvt_layer_item(F, r / IT_LAYER, r % IT_LAYER, scr);
    }
}
__device__ __forceinline__ void phase_modfin(Frame& F) {
    const int gt = F.vcu * 512 + F.tid, NT_ = F.G * 512;
    for (int i = gt; i < 2 * 9 * 12288; i += NT_) { const int l = i / (9 * 12288), rc = i % (9 * 12288), col = rc % 12288;
        float s = INP(I_BADA)[l * 12288 + col];
#pragma unroll
        for (int ks = 0; ks < 16; ++ks) s += WSP(float, WS_MODP)[((size_t)(l * 16 + ks) * 9) * 12288 + rc];
        WSP(float, WS_MOD)[i] = s; }
}

struct Row8 { f32x4 v[8]; };
__device__ __forceinline__ void ld_row_f32(Row8& R, const GAS float* p, int lane) {
#pragma unroll
    for (int j = 0; j < 8; ++j) R.v[j] = ((const GAS f32x4*)p)[64 * j + lane];
}
__device__ __forceinline__ void st_row_f32(const Row8& R, GAS float* p, int lane) {
#pragma unroll
    for (int j = 0; j < 8; ++j) ((GAS f32x4*)p)[64 * j + lane] = R.v[j];
}
__device__ __forceinline__ void ld_row_bf16(Row8& R, const GAS bf16_t* p, int lane) {
#pragma unroll
    for (int j = 0; j < 8; ++j) { const u32x2 w = ((const GAS u32x2*)p)[64 * j + lane]; R.v[j] = (f32x4){bflo(w.x), bfhi(w.x), bflo(w.y), bfhi(w.y)}; }
}
__device__ __forceinline__ void st_row_bf16(const Row8& R, GAS bf16_t* p, int lane) {
#pragma unroll
    for (int j = 0; j < 8; ++j) { u32x2 w; w.x = cvt_pk_bf16(R.v[j][0], R.v[j][1]); w.y = cvt_pk_bf16(R.v[j][2], R.v[j][3]); ((GAS u32x2*)p)[64 * j + lane] = w; }
}
__device__ __forceinline__ float row_rstd(const Row8& R) {
    float s = 0.f;
#pragma unroll
    for (int j = 0; j < 8; ++j) s += (R.v[j][0] * R.v[j][0] + R.v[j][1] * R.v[j][1]) + (R.v[j][2] * R.v[j][2] + R.v[j][3] * R.v[j][3]);
    return rsqrtf(wave_sum(s) * (1.f / DM) + EPS);
}
__device__ __forceinline__ void st_modnorm(const Row8& R, float rstd, const GAS float* g, const GAS float* shift, const GAS float* scale, GAS bf16_t* o, int lane) {
#pragma unroll
    for (int j = 0; j < 8; ++j) { const int c = 64 * j + lane; const f32x4 gg = ((const GAS f32x4*)g)[c], sh = ((const GAS f32x4*)shift)[c], sc = ((const GAS f32x4*)scale)[c];
        const f32x4 h = (R.v[j] * rstd * gg) * (sc + 1.f) + sh; u32x2 w; w.x = cvt_pk_bf16(h[0], h[1]); w.y = cvt_pk_bf16(h[2], h[3]); ((GAS u32x2*)o)[c] = w; }
}
__device__ __forceinline__ const GAS float* mod_row(Frame& F, int l, int r) { return WSP(float, WS_MOD) + (size_t)(l * 9 + (r < ML ? (r >> 11) : 8)) * 12288; }
__device__ __forceinline__ void phase_rwA(Frame& F, int l) {
    const int gw = F.vcu * 8 + F.wave, NGW = F.G * 8; const GAS float* g0 = INP(I_NORMG) + (size_t)(l * 4 + 0) * DM;
    for (int r = gw; r < MT; r += NGW) {
        Row8 R; ld_row_f32(R, r < ML ? INP(I_X) + (size_t)r * DM : INP(I_CTX) + (size_t)(r - ML) * DM, F.lane);
        const float rstd = row_rstd(R); const GAS float* md = mod_row(F, l, r);
        st_modnorm(R, rstd, g0, md, md + DM, WSP(bf16_t, WS_H) + (size_t)r * DM, F.lane);
    }
}
__device__ __forceinline__ void phase_rwB(Frame& F, int l, int mrows) {
    const int gw = F.vcu * 8 + F.wave, NGW = F.G * 8; const GAS float* g1 = INP(I_NORMG) + (size_t)(l * 4 + 1) * DM; const GAS float* g2 = INP(I_NORMG) + (size_t)(l * 4 + 2) * DM;
    for (int r = gw; r < mrows; r += NGW) {
        Row8 Y; ld_row_bf16(Y, WSP(bf16_t, WS_RB + RB_Y) + (size_t)r * DM, F.lane);
        const float ry = row_rstd(Y); const GAS float* md = mod_row(F, l, r);
        Row8 X;
        if (r < ML) { if (l == 0) ld_row_f32(X, INP(I_X) + (size_t)r * DM, F.lane); else ld_row_bf16(X, (const GAS bf16_t*)(F.out + (size_t)r * DM), F.lane); }
        else ld_row_f32(X, l == 0 ? INP(I_CTX) + (size_t)(r - ML) * DM : WSP(float, WS_XC) + (size_t)(r - ML) * DM, F.lane);
#pragma unroll
        for (int j = 0; j < 8; ++j) { const int c = 64 * j + F.lane; X.v[j] += ((const GAS f32x4*)(md + 2 * DM))[c] * (Y.v[j] * ry * ((const GAS f32x4*)g1)[c]); }
        if (r < ML) st_row_bf16(X, (GAS bf16_t*)(F.out + (size_t)r * DM), F.lane); else st_row_f32(X, WSP(float, WS_XC) + (size_t)(r - ML) * DM, F.lane);
        const float rx = row_rstd(X);
        st_modnorm(X, rx, g2, md + 3 * DM, md + 4 * DM, WSP(bf16_t, WS_H) + (size_t)r * DM, F.lane);
    }
}
__device__ __forceinline__ void phase_rwC(Frame& F, int l, int mrows) {
    const int gw = F.vcu * 8 + F.wave, NGW = F.G * 8; const GAS float* g3 = INP(I_NORMG) + (size_t)(l * 4 + 3) * DM;
    for (int r = gw; r < mrows; r += NGW) {
        Row8 A, B; ld_row_bf16(A, WSP(bf16_t, WS_RB + RB_Y2) + (size_t)(2 * r) * DM, F.lane); ld_row_bf16(B, WSP(bf16_t, WS_RB + RB_Y2) + (size_t)(2 * r + 1) * DM, F.lane);
#pragma unroll
        for (int j = 0; j < 8; ++j) A.v[j] += B.v[j];
        const float ry = row_rstd(A); const GAS float* md = mod_row(F, l, r);
        Row8 X;
        if (r < ML) ld_row_bf16(X, (const GAS bf16_t*)(F.out + (size_t)r * DM), F.lane); else ld_row_f32(X, WSP(float, WS_XC) + (size_t)(r - ML) * DM, F.lane);
#pragma unroll
        for (int j = 0; j < 8; ++j) { const int c = 64 * j + F.lane; X.v[j] += ((const GAS f32x4*)(md + 5 * DM))[c] * (A.v[j] * ry * ((const GAS f32x4*)g3)[c]); }
        if (r >= ML) st_row_f32(X, WSP(float, WS_XC) + (size_t)(r - ML) * DM, F.lane);
        else if (l + 1 < DEPTH) st_row_bf16(X, (GAS bf16_t*)(F.out + (size_t)r * DM), F.lane);
        else st_row_f32(X, F.out + (size_t)r * DM, F.lane);
        if (l + 1 < DEPTH) { const float rx = row_rstd(X); const GAS float* m1 = mod_row(F, l + 1, r);
            st_modnorm(X, rx, INP(I_NORMG) + (size_t)((l + 1) * 4 + 0) * DM, m1, m1 + DM, WSP(bf16_t, WS_H) + (size_t)r * DM, F.lane); }
    }
    if (l + 1 < DEPTH) {
        LAS float* scr = (LAS float*)(F.lds + F.wave * 16384);
        for (int it = gw; it < IT_MOE; it += NGW) cvt_moe_item(F, l + 1, it, scr);
    }
}
__device__ __forceinline__ void ld8bf(float (&o)[8], const GAS bf16_t* p) { const u32x4 w = *(const GAS u32x4*)p; o[0] = bflo(w.x); o[1] = bfhi(w.x); o[2] = bflo(w.y); o[3] = bfhi(w.y); o[4] = bflo(w.z); o[5] = bfhi(w.z); o[6] = bflo(w.w); o[7] = bfhi(w.w); }
__device__ __forceinline__ void st8bf(GAS bf16_t* p, const float (&v)[8]) { u32x4 w; w.x = cvt_pk_bf16(v[0], v[1]); w.y = cvt_pk_bf16(v[2], v[3]); w.z = cvt_pk_bf16(v[4], v[5]); w.w = cvt_pk_bf16(v[6], v[7]); *(GAS u32x4*)p = w; }
__device__ __forceinline__ void phase_finish(Frame& F, int l, int mrows) {
    const int gw = F.vcu * 8 + F.wave, NGW = F.G * 8, c8 = F.lane * 8;
    const GAS bf16_t* Y = WSP(bf16_t, WS_YFB); const GAS bf16_t* U = WSP(bf16_t, WS_RA); GAS bf16_t* BR = WSP(bf16_t, WS_BR); const GAS float* dskip = INP(I_SSDD) + l * 8;
    for (int r = gw; r < mrows; r += NGW) {
        float a[8], b[8], g[8], o[8];
        ld8bf(a, Y + ((size_t)0 * MT + r) * 512 + c8); ld8bf(b, Y + ((size_t)1 * MT + r) * 512 + c8); ld8bf(g, U + (size_t)r * NU + U_MLO + c8);
#pragma unroll
        for (int j = 0; j < 8; ++j) o[j] = (a[j] + b[j]) * sigmoidf_(g[j]);
        st8bf(BR + (size_t)r * DM + c8, o);
        ld8bf(a, Y + ((size_t)2 * MT + r) * 512 + c8); ld8bf(b, Y + ((size_t)3 * MT + r) * 512 + c8); ld8bf(g, U + (size_t)r * NU + U_HGG + c8);
        float ss = 0.f;
#pragma unroll
        for (int j = 0; j < 8; ++j) { a[j] += b[j]; ss += a[j] * a[j]; }
        ss += __shfl_xor(ss, 1); ss += __shfl_xor(ss, 2); ss += __shfl_xor(ss, 4); ss += __shfl_xor(ss, 8);
        const float rh = rsqrtf(ss * (1.f / 128.f) + EPS);
#pragma unroll
        for (int j = 0; j < 8; ++j) o[j] = a[j] * rh * sigmoidf_(g[j]);
        st8bf(BR + (size_t)r * DM + 512 + c8, o);
        ld8bf(a, Y + ((size_t)4 * MT + r) * 512 + c8); ld8bf(b, Y + ((size_t)5 * MT + r) * 512 + c8); ld8bf(g, U + (size_t)r * NU + U_Z + c8);
        float s2 = 0.f, xh[8]; ld8bf(xh, WSP(bf16_t, WS_XBC) + (size_t)r * 1024 + c8); const float dsk = dskip[F.lane >> 3];
#pragma unroll
        for (int j = 0; j < 8; ++j) { o[j] = (a[j] + b[j] + dsk * xh[j]) * siluf_(g[j]); s2 += o[j] * o[j]; }
        s2 = wave_sum(s2);
        if (F.lane == 0) WSP(float, WS_RSSD)[r] = rsqrtf(s2 * (1.f / 512.f) + EPS);
        st8bf(BR + (size_t)r * DM + 1536 + c8, o);
    }
}

__device__ __forceinline__ void phase_ssdconv(Frame& F, int l) {
    const int gw = F.vcu * 8 + F.wave, NGW = F.G * 8, c16 = F.lane * 16;
    const GAS bf16_t* U = WSP(bf16_t, WS_RA); GAS bf16_t* X2 = WSP(bf16_t, WS_XBC);
    float w0[16], w1[16], w2[16], cb[16];
    { const GAS float* cw = INP(I_CONVW) + (size_t)l * 3 * 1024 + c16; const GAS float* bb = INP(I_CONVB) + l * 1024 + c16;
#pragma unroll
      for (int j = 0; j < 16; ++j) { w0[j] = cw[j]; w1[j] = cw[1024 + j]; w2[j] = cw[2048 + j]; cb[j] = bb[j]; } }
    for (int r = gw; r < MT; r += NGW) {
        const int t = r < ML ? (r & (SEQ - 1)) : ((r - ML) & (CTXL - 1)), tn = r < ML ? SEQ : CTXL;
        const GAS bf16_t* up = U + (size_t)r * NU + U_XBC + c16;
        float a[16], p_[16], n_[16];
        { float t8[8]; ld8bf(t8, up);
#pragma unroll
          for (int j = 0; j < 8; ++j) a[j] = t8[j]; ld8bf(t8, up + 8);
#pragma unroll
          for (int j = 0; j < 8; ++j) a[8 + j] = t8[j]; }
        if (t > 0) { float t8[8]; ld8bf(t8, up - NU);
#pragma unroll
          for (int j = 0; j < 8; ++j) p_[j] = t8[j]; ld8bf(t8, up - NU + 8);
#pragma unroll
          for (int j = 0; j < 8; ++j) p_[8 + j] = t8[j]; } else {
#pragma unroll
          for (int j = 0; j < 16; ++j) p_[j] = 0.f; }
        if (t + 1 < tn) { float t8[8]; ld8bf(t8, up + NU);
#pragma unroll
          for (int j = 0; j < 8; ++j) n_[j] = t8[j]; ld8bf(t8, up + NU + 8);
#pragma unroll
          for (int j = 0; j < 8; ++j) n_[8 + j] = t8[j]; } else {
#pragma unroll
          for (int j = 0; j < 16; ++j) n_[j] = 0.f; }
        float o[8];
#pragma unroll
        for (int j = 0; j < 8; ++j) o[j] = siluf_(w0[j] * p_[j] + w1[j] * a[j] + w2[j] * n_[j] + cb[j]);
        st8bf(X2 + (size_t)r * 1024 + c16, o);
#pragma unroll
        for (int j = 0; j < 8; ++j) o[j] = siluf_(w0[8 + j] * p_[8 + j] + w1[8 + j] * a[8 + j] + w2[8 + j] * n_[8 + j] + cb[8 + j]);
        st8bf(X2 + (size_t)r * 1024 + c16 + 8, o);
    }
}

__device__ __forceinline__ void phase_scanprep(Frame& F, int l) {
    const int gw = F.vcu * 8 + F.wave, NGW = F.G * 8, lane = F.lane, r32 = lane & 31, hi = lane >> 5;
    const GAS bf16_t* U = WSP(bf16_t, WS_RA);
    constexpr int N_ML = 64, N_SSD = 64 * 72, N_HG = 64 * 72 * 2, N_MLC = 32 * 72;
    for (int it = gw; it < N_ML + N_SSD + N_HG + N_MLC; it += NGW) {
        if (it >= N_ML + N_SSD + N_HG) {
            const int q = it - (N_ML + N_SSD + N_HG), cg = q % 72, bh = q / 72, b = bh >> 2, h = bh & 3;
            GAS bf16_t* dst = WSP(bf16_t, WS_MLC) + ((size_t)bh * 2304 + 32 * cg) * 384;
#pragma unroll 1
            for (int ib = 0; ib < 3; ++ib) { u32x4 v[8];
#pragma unroll
                for (int i = 0; i < 8; ++i) { const int piece = (ib * 8 + i) * 64 + lane, rr = piece / 48, pc = piece % 48, ci = 32 * cg + rr;
                    const int trow = ci < CTXL ? ML + b * CTXL + ci : b * SEQ + (ci - CTXL);
                    v[i] = *(const GAS u32x4*)(U + (size_t)trow * NU + (pc >> 4) * 512 + h * 128 + (pc & 15) * 8); }
#pragma unroll
                for (int i = 0; i < 8; ++i) { const int piece = (ib * 8 + i) * 64 + lane; *(GAS u32x4*)(dst + (size_t)piece * 8) = v[i]; } }
            continue;
        }
        if (it < N_ML) {
            const int task = it, b = task >> 3, h = (task >> 1) & 3, dir = task & 1, cg = U_MLG + dir * 8 + h;
            const float fbias = INP(I_MLFB)[l * 8 + dir * 4 + h];
            GAS float* rec = WSP(float, WS_MLS) + (size_t)task * 2304 * 8;
            float Fp = 0.f, Bp = -INFINITY;
            const GAS bf16_t* gp = U + (size_t)prow(b, dir, r32) * NU + cg; float gi = bf2f(gp[0]), gf = bf2f(gp[4]);
            for (int c = 0; c < 72; ++c) {
                float ni = 0.f, nf = 0.f;
                if (c + 1 < 72) { const GAS bf16_t* np_ = U + (size_t)prow(b, dir, 32 * (c + 1) + r32) * NU + cg; ni = bf2f(np_[0]); nf = bf2f(np_[4]); }
                const float x_ = gf + fbias, flog = fminf(x_, 0.f) - log1pf(__expf(-fabsf(x_)));
                const float Ft = Fp + scn::scan_add32(flog, r32), bt = gi - Ft, Bt = fmaxf(Bp, scn::scan_max32(bt, r32));
                const float Be = __shfl(Bt, 31, 32), Fe = __shfl(Ft, 31, 32);
                if (hi == 0) { GAS float* rp = rec + (size_t)(32 * c + r32) * 8;
                    *(GAS f32x4*)rp = (f32x4){bt, Bt, __expf(Bp - Bt), __expf(-(Ft + Bt))}; *(GAS f32x4*)(rp + 4) = (f32x4){__expf(bt - Be), __expf(Bp - Be), 0.f, 0.f}; }
                Fp = Fe; Bp = Be; gi = ni; gf = nf;
            }
        } else if (it < N_ML + N_SSD) {
            const int q = it - N_ML, c = q % 72, t3 = q / 72, b = t3 >> 3, hp = (t3 >> 1) & 3, dir = t3 & 1, hd = 2 * hp + hi;
            const float dtb = INP(I_DTB)[l * 16 + dir * 8 + hd], aneg = -__expf(INP(I_ALOG)[l * 16 + dir * 8 + hd]);
            const float xr_ = bf2f(U[(size_t)prow(b, dir, 32 * c + r32) * NU + U_DT + dir * 8 + hd]) + dtb;
            const float dt_ = fmaxf(xr_, 0.f) + log1pf(__expf(-fabsf(xr_))), at = scn::scan_add32(dt_ * aneg, r32), ae = __shfl(at, 31, 32);
            GAS float* rp = WSP(float, WS_SSDS) + ((size_t)((b * 2 + dir) * 8 + hd) * 2304 + 32 * c + r32) * 8;
            *(GAS f32x4*)rp = (f32x4){dt_, at, __expf(at), __expf(ae - at)}; *(GAS f32x4*)(rp + 4) = (f32x4){__expf(ae), 0.f, 0.f, 0.f};
        } else {
            const int q = it - N_ML - N_SSD, half = q & 1, c = (q >> 1) % 72, task = (q >> 1) / 72, b = task >> 3, h = (task >> 1) & 3, dir = task & 1, r16 = lane >> 2, ch0 = half * 64 + 16 * (lane & 3);
            GAS unsigned char* item = F.ws + WS_HGP + (size_t)(task * 72 + c) * HGP_ITEM;
            const GAS float* lbp = WSP(float, WS_TAB) + 2048 + l * 512 + h * 128 + ch0;
            float lb[16], cc[16], ee[16];
#pragma unroll
            for (int j = 0; j < 16; ++j) { lb[j] = lbp[j]; cc[j] = 0.f; ee[j] = 0.f; }
#pragma unroll
            for (int rb = 0; rb < 2; ++rb) {
                const int rloc = rb * 16 + r16; const GAS bf16_t* up = U + (size_t)prow(b, dir, 32 * c + rloc) * NU;
                float fa[8], fb[8], qa[8], qb[8], q1[16], k1[16];
                ld8bf(fa, up + U_HGF + dir * 512 + h * 128 + ch0); ld8bf(fb, up + U_HGF + dir * 512 + h * 128 + ch0 + 8);
                ld8bf(qa, up + U_HGQ + h * 128 + ch0); ld8bf(qb, up + U_HGQ + h * 128 + ch0 + 8);
#pragma unroll
                for (int j = 0; j < 16; ++j) {
                    const float fr_ = j < 8 ? fa[j & 7] : fb[j & 7], qr_ = j < 8 ? qa[j & 7] : qb[j & 7];
                    const float f_ = lb[j] + (1.f - lb[j]) * __builtin_amdgcn_rcpf(1.f + __expf(-fr_)); float x_ = __logf(f_);
                    { const float o = __shfl_up(x_, 4); if (lane >= 4) x_ += o; } { const float o = __shfl_up(x_, 8); if (lane >= 8) x_ += o; }
                    { const float o = __shfl_up(x_, 16); if (lane >= 16) x_ += o; } { const float o = __shfl_up(x_, 32); if (lane >= 32) x_ += o; }
                    const float tot = __shfl(x_, 60 + (lane & 3));
                    float g_;
                    if (rb == 0) { cc[j] = tot; g_ = x_; } else { g_ = cc[j] + x_; ee[j] = cc[j] + tot; }
                    const float e1 = __expf(g_ - cc[j]);
                    q1[j] = qr_ * __builtin_amdgcn_rcpf(1.f + __expf(-qr_)) * e1; k1[j] = (1.f - f_) * __builtin_amdgcn_rcpf(e1);
                }
                float t8[8];
#pragma unroll
                for (int j = 0; j < 8; ++j) t8[j] = q1[j]; st8bf((GAS bf16_t*)(item + scn::rowl(rloc, ch0 * 2)), t8);
#pragma unroll
                for (int j = 0; j < 8; ++j) t8[j] = q1[8 + j]; st8bf((GAS bf16_t*)(item + scn::rowl(rloc, ch0 * 2 + 16)), t8);
#pragma unroll
                for (int j = 0; j < 8; ++j) t8[j] = k1[j]; st8bf((GAS bf16_t*)(item + 8192 + scn::rowl(rloc, ch0 * 2)), t8);
#pragma unroll
                for (int j = 0; j < 8; ++j) t8[j] = k1[8 + j]; st8bf((GAS bf16_t*)(item + 8192 + scn::rowl(rloc, ch0 * 2 + 16)), t8);
            }
            if (r16 == 0) { GAS float* vv = (GAS float*)(item + 16384) + ch0;
#pragma unroll
                for (int j = 0; j < 16; ++j) { vv[j] = __expf(cc[j]); vv[128 + j] = __expf(ee[j] - cc[j]); } }
        }
    }
}
__device__ __forceinline__ void phase_route(Frame& F, int l, int mrows) {
    const int gt = F.vcu * 512 + F.tid, NT_ = F.G * 512; unsigned* cnt = F.ctl + CW_CNT + l * 64;
    GAS int* list = WSP(int, WS_LIST); GAS float* wl = WSP(float, WS_WL);
    for (int r = gt; r < mrows; r += NT_) {
        const GAS float* lg0 = WSP(float, WS_LOG) + (size_t)r * 64;
        f32x4 lgv[9];
#pragma unroll
        for (int q = 0; q < 9; ++q) { lgv[q] = *(const GAS f32x4*)(lg0 + 4 * q);
#pragma unroll
            for (int ks = 1; ks < 4; ++ks) lgv[q] += *(const GAS f32x4*)(lg0 + (size_t)ks * MT * 64 + 4 * q); }
        const f32x4 g = lgv[0]; int gi = 0; float gm = g[0];
#pragma unroll
        for (int i = 1; i < 4; ++i) if (g[i] > gm) { gm = g[i]; gi = i; }
        float gs = 0.f;
#pragma unroll
        for (int i = 0; i < 4; ++i) gs += __expf(g[i] - gm);
        const float gp = 1.f / gs;
        f32x4 e0 = lgv[1], e1 = lgv[2];
        if (gi == 1) { e0 = lgv[3]; e1 = lgv[4]; } else if (gi == 2) { e0 = lgv[5]; e1 = lgv[6]; } else if (gi == 3) { e0 = lgv[7]; e1 = lgv[8]; }
        float ev[8] = {e0[0], e0[1], e0[2], e0[3], e1[0], e1[1], e1[2], e1[3]};
        int i1 = 0; float v1 = ev[0];
#pragma unroll
        for (int i = 1; i < 8; ++i) if (ev[i] > v1) { v1 = ev[i]; i1 = i; }
        int i2 = -1; float v2 = -3.4e38f;
#pragma unroll
        for (int i = 0; i < 8; ++i) if (i != i1 && ev[i] > v2) { v2 = ev[i]; i2 = i; }
        const float w1 = 1.f / (1.f + __expf(v2 - v1)), w2 = 1.f - w1;
        const int ea = gi * 8 + i1, eb = gi * 8 + i2;
        const unsigned pa = atomicAdd(cnt + ea, 1u), pb = atomicAdd(cnt + eb, 1u);
        list[(size_t)ea * MT + pa] = r * 2; wl[(size_t)ea * MT + pa] = w1 * gp;
        list[(size_t)eb * MT + pb] = r * 2 + 1; wl[(size_t)eb * MT + pb] = w2 * gp;
    }
}
__device__ __forceinline__ void moe_tables(Frame& F, int l) {
    __syncthreads();
    if (F.tid < 32) F.MISC[64 + F.tid] = __hip_atomic_load(F.ctl + CW_CNT + l * 64 + F.tid, __ATOMIC_RELAXED, __HIP_MEMORY_SCOPE_AGENT);
    __syncthreads();
    if (F.tid == 0) { int s = 0; for (int e = 0; e < 32; ++e) { F.MISC[16 + e] = s; s += ((int)F.MISC[64 + e] + 255) >> 8; } F.MISC[48] = s; }
    __syncthreads();
}

constexpr int NSTEP = CTXL + SEQ;
namespace scn {
enum { K_ML = 0, K_HG = 1, K_SSD = 2 };
constexpr int GRP_BYTES = 65536, O_QT = 0, O_KT = 8192, O_QH = 16384, O_KH = 24576, O_VT = 34816, O_VH = 45056, O_SC = 55296, O_N = 59392, O_TOT = 60416;
constexpr int NCH = (CTXL + SEQ) / 32;
__device__ __forceinline__ int crow(int r, int hi) { return (r & 3) + 8 * (r >> 2) + 4 * hi; }
template <int OFF> __device__ __forceinline__ s16x4 trr(int base) { s16x4 r; asm volatile("ds_read_b64_tr_b16 %0, %1 offset:%2" : "=&v"(r) : "v"(base), "i"(OFF) : "memory"); return r; }
#define SCN_PK(L, H) (bf16x8){L[0], L[1], L[2], L[3], H[0], H[1], H[2], H[3]}
template <int S1, int CB> __device__ __forceinline__ bf16x8 trfrag(int base) { const s16x4 lo = trr<S1 * 5120 + CB * 2>(base), hi_ = trr<S1 * 5120 + 2560 + CB * 2>(base); return SCN_PK(lo, hi_); }
__device__ __forceinline__ void unpack8(float (&o)[8], u32x4 w) { o[0] = bflo(w.x); o[1] = bfhi(w.x); o[2] = bflo(w.y); o[3] = bfhi(w.y); o[4] = bflo(w.z); o[5] = bfhi(w.z); o[6] = bflo(w.w); o[7] = bfhi(w.w); }
__device__ __forceinline__ u32x4 pack8(const float (&v)[8]) { u32x4 w; w.x = cvt_pk_bf16(v[0], v[1]); w.y = cvt_pk_bf16(v[2], v[3]); w.z = cvt_pk_bf16(v[4], v[5]); w.w = cvt_pk_bf16(v[6], v[7]); return w; }

template <int KIND>
__device__ __forceinline__ void scan_block(Frame& F, int l, int bu) {
    const int tid = F.tid, wave = F.wave, lane = tid & 63, grp = wave >> 2, vb = wave & 3, gt = tid & 255, r32 = lane & 31, hi = lane >> 5;
    LAS char* L = (LAS char*)F.lds + grp * GRP_BYTES;
    const int Lb = (int)(uintptr_t)L;
    const int task = bu * 2 + grp, b = task >> 3, hx = (task >> 1) & 3, dir = task & 1;
    const int srow = gt >> 3, sp = gt & 7;
    const GAS bf16_t* U = WSP(bf16_t, WS_RA); const GAS bf16_t* X2 = WSP(bf16_t, WS_XBC);
    GAS bf16_t* YO = WSP(bf16_t, WS_YFB) + (size_t)(KIND * 2 + dir) * MT * 512;
    LAS float* SC = (LAS float*)(L + O_SC);
    int cq = 0, ck = 0, cv = 0;
    const GAS float* recA = nullptr; const GAS float* recB = nullptr; const GAS unsigned char* hgp = nullptr; const GAS bf16_t* mlc = nullptr;
    if constexpr (KIND == K_ML) { cq = U_MLQ + hx * 128 + 16 * sp; ck = U_MLK + hx * 128 + 16 * sp; cv = U_MLV + hx * 128 + 16 * sp;
        recA = WSP(float, WS_MLS) + (size_t)task * 2304 * 8; recB = recA; mlc = WSP(bf16_t, WS_MLC) + (size_t)(b * 4 + hx) * 2304 * 384; }
    if constexpr (KIND == K_HG) { cv = U_HGI + hx * 128 + 16 * sp; hgp = F.ws + WS_HGP + (size_t)task * 72 * HGP_ITEM; }
    if constexpr (KIND == K_SSD) { const int g = hx >> 1; cq = 768 + g * 128 + 16 * sp; ck = 512 + g * 128 + 16 * sp; cv = hx * 128 + 16 * sp;
        recA = WSP(float, WS_SSDS) + (size_t)((b * 2 + dir) * 8 + 2 * hx + (sp >> 2)) * 2304 * 8;
        recB = WSP(float, WS_SSDS) + (size_t)((b * 2 + dir) * 8 + 2 * hx + hi) * 2304 * 8; }
    f32x16 S[4];
#pragma unroll
    for (int k = 0; k < 4; ++k)
#pragma unroll
        for (int r = 0; r < 16; ++r) S[k][r] = 0.f;
    if (KIND == K_ML) { LAS float* nn = (LAS float*)(L + O_N); nn[gt] = 0.f; }
    const int i16 = lane & 15, g4 = lane >> 4;
    const int trb = Lb + (4 * hi + (i16 >> 2)) * 320 + (16 * (g4 & 1) + 4 * (i16 & 3)) * 2;
    struct Pre { u32x4 a0, a1, b0, b1, c0, c1; f32x4 sA, sB; float g1; }; Pre P0, P1;
#define SCN_LOAD(P, c_) do { const int c__ = (c_); const int row_ = prow(b, dir, 32 * c__ + srow); \
        if constexpr (KIND == K_SSD) { const GAS bf16_t* xp = X2 + (size_t)row_ * 1024; P.a0 = *(const GAS u32x4*)(xp + cq); P.a1 = *(const GAS u32x4*)(xp + cq + 8); P.b0 = *(const GAS u32x4*)(xp + ck); P.b1 = *(const GAS u32x4*)(xp + ck + 8); P.c0 = *(const GAS u32x4*)(xp + cv); P.c1 = *(const GAS u32x4*)(xp + cv + 8); \
            P.sA = *(const GAS f32x4*)(recA + (size_t)(32 * c__ + srow) * 8); P.sB = *(const GAS f32x4*)(recB + (size_t)(32 * c__ + r32) * 8); P.g1 = recB[(size_t)(32 * c__ + r32) * 8 + 4]; } \
        else if constexpr (KIND == K_ML) { const int p__ = 32 * c__ + srow; const int ci_ = p__ < CTXL ? (dir ? CTXL - 1 - p__ : p__) : CTXL + (dir ? SEQ - 1 - (p__ - CTXL) : p__ - CTXL); \
            const GAS bf16_t* up = mlc + (size_t)ci_ * 384 + 16 * sp; P.a0 = *(const GAS u32x4*)(up); P.a1 = *(const GAS u32x4*)(up + 8); P.b0 = *(const GAS u32x4*)(up + 128); P.b1 = *(const GAS u32x4*)(up + 136); P.c0 = *(const GAS u32x4*)(up + 256); P.c1 = *(const GAS u32x4*)(up + 264); \
            P.sA = *(const GAS f32x4*)(recA + (size_t)(32 * c__ + srow) * 8 + 4); P.sB = *(const GAS f32x4*)(recB + (size_t)(32 * c__ + r32) * 8); P.g1 = recB[(size_t)(32 * c__ + r32) * 8 + 5]; } \
        else { const GAS unsigned char* it_ = hgp + (size_t)c__ * HGP_ITEM; const int ra_ = rowl(srow, 32 * sp), rb_ = rowl(srow, 32 * sp + 16); \
            P.a0 = *(const GAS u32x4*)(it_ + ra_); P.a1 = *(const GAS u32x4*)(it_ + rb_); P.b0 = *(const GAS u32x4*)(it_ + 8192 + ra_); P.b1 = *(const GAS u32x4*)(it_ + 8192 + rb_); \
            const GAS bf16_t* up = U + (size_t)row_ * NU; P.c0 = *(const GAS u32x4*)(up + cv); P.c1 = *(const GAS u32x4*)(up + cv + 8); \
            if (gt < 64) P.sA = *(const GAS f32x4*)((const GAS float*)(it_ + 16384) + 4 * gt); } } while (0)
#define SCN_STAGE(P) do { \
        const int ra = rowl(srow, 32 * sp), rb = rowl(srow, 32 * sp + 16), ta = srow * 320 + 32 * sp; \
        *(LAS u32x4*)(L + O_QT + ra) = P.a0; *(LAS u32x4*)(L + O_QT + rb) = P.a1; *(LAS u32x4*)(L + O_KT + ra) = P.b0; *(LAS u32x4*)(L + O_KT + rb) = P.b1; \
        if constexpr (KIND == K_ML) { \
            if (vb == 0 && hi == 0) { SC[r32] = P.sB[0]; SC[32 + r32] = P.sB[1]; SC[64 + r32] = P.sB[2]; SC[96 + r32] = P.sB[3]; if (r32 == 0) SC[128] = P.g1; } \
            const float win = P.sA[0]; float ka[8], kb_[8]; unpack8(ka, P.b0); unpack8(kb_, P.b1); \
            _Pragma("unroll") for (int j = 0; j < 8; ++j) { ka[j] *= win; kb_[j] *= win; } \
            *(LAS u32x4*)(L + O_KH + ta) = pack8(ka); *(LAS u32x4*)(L + O_KH + ta + 16) = pack8(kb_); *(LAS u32x4*)(L + O_VT + ta) = P.c0; *(LAS u32x4*)(L + O_VT + ta + 16) = P.c1; \
        } else if constexpr (KIND == K_SSD) { \
            if (vb == 0) { SC[hi * 32 + r32] = P.sB[1]; SC[64 + hi * 32 + r32] = P.sB[2]; if (r32 == 0) SC[128 + hi] = P.g1; } \
            const float dts = P.sA[0], vsc = P.sA[3]; float va[8], vb_[8]; unpack8(va, P.c0); unpack8(vb_, P.c1); \
            *(LAS u32x4*)(L + O_KH + ta) = P.b0; *(LAS u32x4*)(L + O_KH + ta + 16) = P.b1; \
            _Pragma("unroll") for (int j = 0; j < 8; ++j) { va[j] *= dts; vb_[j] *= dts; } \
            *(LAS u32x4*)(L + O_VT + ta) = pack8(va); *(LAS u32x4*)(L + O_VT + ta + 16) = pack8(vb_); \
            _Pragma("unroll") for (int j = 0; j < 8; ++j) { va[j] *= vsc; vb_[j] *= vsc; } \
            *(LAS u32x4*)(L + O_VH + ta) = pack8(va); *(LAS u32x4*)(L + O_VH + ta + 16) = pack8(vb_); \
        } else { \
            *(LAS u32x4*)(L + O_KH + ta) = P.b0; *(LAS u32x4*)(L + O_KH + ta + 16) = P.b1; *(LAS u32x4*)(L + O_VT + ta) = P.c0; *(LAS u32x4*)(L + O_VT + ta + 16) = P.c1; \
            if (gt < 64) *(LAS f32x4*)(SC + 4 * gt) = P.sA; \
        } } while (0)
    constexpr int OQH = O_QT, OVH = (KIND == K_SSD) ? O_VH : O_VT;
    auto compute = [&](const int c) __attribute__((always_inline)) {
        const int hh = vb >> 1;
        if constexpr (KIND == K_HG) {
#pragma unroll
            for (int kb = 0; kb < 4; ++kb)
#pragma unroll
                for (int r = 0; r < 16; ++r) S[kb][r] *= SC[32 * kb + crow(r, hi)];
        }
        f32x16 acc;
#pragma unroll
        for (int r = 0; r < 16; ++r) acc[r] = 0.f;
        if (c > 0) {
#pragma unroll
            for (int kb = 0; kb < 4; ++kb)
#pragma unroll
                for (int s1 = 0; s1 < 2; ++s1) {
                    u32x4 aw; aw.x = cvt_pk_bf16(S[kb][8 * s1 + 0], S[kb][8 * s1 + 1]); aw.y = cvt_pk_bf16(S[kb][8 * s1 + 2], S[kb][8 * s1 + 3]); aw.z = cvt_pk_bf16(S[kb][8 * s1 + 4], S[kb][8 * s1 + 5]); aw.w = cvt_pk_bf16(S[kb][8 * s1 + 6], S[kb][8 * s1 + 7]);
                    const int cb0 = (32 * kb + 16 * s1 + 4 * hi) * 2;
                    const u32x2 lo = *(const LAS u32x2*)(L + OQH + rowl(r32, cb0)), hi2 = *(const LAS u32x2*)(L + OQH + rowl(r32, cb0 + 16));
                    const u32x4 bw = {lo.x, lo.y, hi2.x, hi2.y};
                    acc = __builtin_amdgcn_mfma_f32_32x32x16_bf16(__builtin_bit_cast(bf16x8, aw), __builtin_bit_cast(bf16x8, bw), acc, 0, 0, 0);
                }
            if constexpr (KIND == K_ML) { const float w = SC[64 + r32];
#pragma unroll
                for (int r = 0; r < 16; ++r) acc[r] *= w; }
            if constexpr (KIND == K_SSD) { const float w = SC[64 + hh * 32 + r32];
#pragma unroll
                for (int r = 0; r < 16; ++r) acc[r] *= w; }
        }
        f32x16 p;
#pragma unroll
        for (int r = 0; r < 16; ++r) p[r] = 0.f;
#pragma unroll
        for (int kk = 0; kk < 8; ++kk) { const int cb0 = (16 * kk + 8 * hi) * 2;
            const bf16x8 a = *(const LAS bf16x8*)(L + O_KT + rowl(r32, cb0)), bq = *(const LAS bf16x8*)(L + O_QT + rowl(r32, cb0));
            p = __builtin_amdgcn_mfma_f32_32x32x16_bf16(a, bq, p, 0, 0, 0); }
        float den = 0.f;
        if constexpr (KIND == K_ML) { const float Bt = SC[32 + r32];
#pragma unroll
            for (int q = 0; q < 4; ++q) {
                const f32x4 bs = *(const LAS f32x4*)(SC + 8 * q + 4 * hi);
#pragma unroll
                for (int j = 0; j < 4; ++j) { const int r = 4 * q + j, s_ = crow(r, hi); float w = __expf(fminf(bs[j] - Bt, 0.f)); w = s_ <= r32 ? w : 0.f; p[r] *= w; den += p[r]; }
                __builtin_amdgcn_sched_barrier(0);
            }
            { auto rr = __builtin_amdgcn_permlane32_swap(__float_as_uint(den), __float_as_uint(den), false, false); den = __uint_as_float(rr[0]) + __uint_as_float(rr[1]); }
        } else if constexpr (KIND == K_SSD) { const float at = SC[hh * 32 + r32];
            f32x4 as_[4];
#pragma unroll
            for (int q = 0; q < 4; ++q) as_[q] = *(const LAS f32x4*)(SC + hh * 32 + 8 * q + 4 * hi);
#pragma unroll
            for (int r = 0; r < 16; ++r) { const int s_ = crow(r, hi); float w = __expf(fminf(at - as_[r >> 2][r & 3], 0.f)); p[r] *= s_ <= r32 ? w : 0.f; }
        } else {
#pragma unroll
            for (int r = 0; r < 16; ++r) { if (crow(r, hi) > r32) p[r] = 0.f; }
        }
        {
            u32x4 w0, w1; w0.x = cvt_pk_bf16(p[0], p[1]); w0.y = cvt_pk_bf16(p[2], p[3]); w0.z = cvt_pk_bf16(p[4], p[5]); w0.w = cvt_pk_bf16(p[6], p[7]);
            w1.x = cvt_pk_bf16(p[8], p[9]); w1.y = cvt_pk_bf16(p[10], p[11]); w1.z = cvt_pk_bf16(p[12], p[13]); w1.w = cvt_pk_bf16(p[14], p[15]);
            const int vbase = trb + O_VT + vb * 64;
            const bf16x8 v0 = trfrag<0, 0>(vbase), v1 = trfrag<1, 0>(vbase);
            asm volatile("s_waitcnt lgkmcnt(0)" ::: "memory"); __builtin_amdgcn_sched_barrier(0);
            acc = __builtin_amdgcn_mfma_f32_32x32x16_bf16(v0, __builtin_bit_cast(bf16x8, w0), acc, 0, 0, 0);
            acc = __builtin_amdgcn_mfma_f32_32x32x16_bf16(v1, __builtin_bit_cast(bf16x8, w1), acc, 0, 0, 0);
        }
        float oscale = 1.f;
        if constexpr (KIND == K_ML) {
            LAS const float* nn = (LAS const float*)(L + O_N) + (c & 1) * 128;
            float ds = 0.f;
            if (c > 0) {
#pragma unroll
                for (int j = 0; j < 8; ++j) { const u32x4 qw = *(const LAS u32x4*)(L + O_QT + rowl(r32, (64 * hi + 8 * j) * 2)); float q8[8]; unpack8(q8, qw);
                    const f32x4 n0 = *(const LAS f32x4*)(nn + 64 * hi + 8 * j), n1 = *(const LAS f32x4*)(nn + 64 * hi + 8 * j + 4);
                    ds += (q8[0] * n0[0] + q8[1] * n0[1]) + (q8[2] * n0[2] + q8[3] * n0[3]) + (q8[4] * n1[0] + q8[5] * n1[1]) + (q8[6] * n1[2] + q8[7] * n1[3]); }
                { auto rr = __builtin_amdgcn_permlane32_swap(__float_as_uint(ds), __float_as_uint(ds), false, false); ds = __uint_as_float(rr[0]) + __uint_as_float(rr[1]); }
                ds *= SC[64 + r32];
            }
            oscale = __builtin_amdgcn_rcpf(fmaxf(fabsf(den + ds), SC[96 + r32]));
            { const int k = 32 * vb + r32; float sm = 0.f;
#pragma unroll
              for (int s_ = 0; s_ < 16; ++s_) sm += bf2f(*(const LAS bf16_t*)(L + O_KH + (16 * hi + s_) * 320 + k * 2));
              { auto rr = __builtin_amdgcn_permlane32_swap(__float_as_uint(sm), __float_as_uint(sm), false, false); sm = __uint_as_float(rr[0]) + __uint_as_float(rr[1]); }
              LAS float* n2 = (LAS float*)(L + O_N) + ((c + 1) & 1) * 128;
              if (hi == 0) n2[k] = SC[128] * nn[k] + sm; }
        }
        { const int orow = prow(b, dir, 32 * c + r32); GAS bf16_t* yp = YO + (size_t)orow * 512 + hx * 128 + 32 * vb + 4 * hi;
#pragma unroll
          for (int q = 0; q < 4; ++q) { u32x2 w; w.x = cvt_pk_bf16(acc[4 * q] * oscale, acc[4 * q + 1] * oscale); w.y = cvt_pk_bf16(acc[4 * q + 2] * oscale, acc[4 * q + 3] * oscale); *(GAS u32x2*)(yp + 8 * q) = w; } }
        {
            const int kbase = trb + O_KH, vbase = trb + OVH + vb * 64;
            const bf16x8 vh0 = trfrag<0, 0>(vbase), vh1 = trfrag<1, 0>(vbase);
            const bf16x8 k00 = trfrag<0, 0>(kbase), k01 = trfrag<1, 0>(kbase), k10 = trfrag<0, 32>(kbase), k11 = trfrag<1, 32>(kbase);
            const bf16x8 k20 = trfrag<0, 64>(kbase), k21 = trfrag<1, 64>(kbase), k30 = trfrag<0, 96>(kbase), k31 = trfrag<1, 96>(kbase);
            if constexpr (KIND != K_HG) { const float rd = KIND == K_ML ? SC[128] : SC[128 + hh];
#pragma unroll
                for (int kb = 0; kb < 4; ++kb)
#pragma unroll
                    for (int r = 0; r < 16; ++r) S[kb][r] *= rd; }
            asm volatile("s_waitcnt lgkmcnt(0)" ::: "memory"); __builtin_amdgcn_sched_barrier(0);
            S[0] = __builtin_amdgcn_mfma_f32_32x32x16_bf16(k00, vh0, S[0], 0, 0, 0); S[0] = __builtin_amdgcn_mfma_f32_32x32x16_bf16(k01, vh1, S[0], 0, 0, 0);
            S[1] = __builtin_amdgcn_mfma_f32_32x32x16_bf16(k10, vh0, S[1], 0, 0, 0); S[1] = __builtin_amdgcn_mfma_f32_32x32x16_bf16(k11, vh1, S[1], 0, 0, 0);
            S[2] = __builtin_amdgcn_mfma_f32_32x32x16_bf16(k20, vh0, S[2], 0, 0, 0); S[2] = __builtin_amdgcn_mfma_f32_32x32x16_bf16(k21, vh1, S[2], 0, 0, 0);
            S[3] = __builtin_amdgcn_mfma_f32_32x32x16_bf16(k30, vh0, S[3], 0, 0, 0); S[3] = __builtin_amdgcn_mfma_f32_32x32x16_bf16(k31, vh1, S[3], 0, 0, 0);
            if constexpr (KIND == K_HG) {
#pragma unroll
                for (int kb = 0; kb < 4; ++kb)
#pragma unroll
                    for (int r = 0; r < 16; ++r) S[kb][r] *= SC[128 + 32 * kb + crow(r, hi)];
            }
        }
    };
    if constexpr (KIND == K_ML) {
        SCN_LOAD(P0, 0); SCN_LOAD(P1, 1);
        __syncthreads();
        SCN_STAGE(P0);
        __syncthreads();
        for (int c = 0; c < NCH; c += 2) {
            if (c + 2 < NCH) SCN_LOAD(P0, c + 2);
            compute(c);
            __syncthreads();
            SCN_STAGE(P1);
            __syncthreads();
            if (c + 3 < NCH) SCN_LOAD(P1, c + 3);
            compute(c + 1);
            __syncthreads();
            if (c + 2 < NCH) { SCN_STAGE(P0); }
            __syncthreads();
        }
    } else {
        SCN_LOAD(P0, 0);
        __syncthreads();
        SCN_STAGE(P0);
        __syncthreads();
        for (int c = 0; c < NCH; ++c) {
            if (c + 1 < NCH) SCN_LOAD(P0, c + 1);
            compute(c);
            __syncthreads();
            if (c + 1 < NCH) { SCN_STAGE(P0); }
            __syncthreads();
        }
    }
#undef SCN_LOAD
#undef SCN_STAGE
}
}

namespace att {
constexpr int KVBLK = 64, SHM_V = 64 * 128 * 2, SHM_K = 64 * 192 * 2;
constexpr float THRL = 11.5f;
#define AKSWZ(row, colB) ((row) * 384 + ((colB) ^ (((row) & 7) << 4)))
#define ASBAR() __builtin_amdgcn_sched_barrier(0)
__device__ __forceinline__ int crow(int r, int hi) { return (r & 3) + 8 * (r >> 2) + 4 * hi; }
__device__ __forceinline__ void partialSM(f32x16& p0, f32x16& p1, float& m_reg, float& mn, float& alpha) {
    float pmax = p0[0];
#pragma unroll
    for (int r = 1; r < 16; ++r) pmax = fmaxf(pmax, p0[r]);
#pragma unroll
    for (int r = 0; r < 16; ++r) pmax = fmaxf(pmax, p1[r]);
    { auto rr = __builtin_amdgcn_permlane32_swap(__float_as_uint(pmax), __float_as_uint(pmax), false, false); pmax = fmaxf(__uint_as_float(rr[0]), __uint_as_float(rr[1])); }
    if (__builtin_expect(__all(pmax - m_reg <= THRL), 1)) { mn = m_reg; alpha = 1.f; }
    else { mn = fmaxf(m_reg, pmax); alpha = __builtin_amdgcn_exp2f(m_reg - mn); m_reg = mn; }
#pragma unroll
    for (int r = 0; r < 16; ++r) p0[r] = __builtin_amdgcn_exp2f(p0[r] - mn);
#pragma unroll
    for (int r = 0; r < 16; ++r) p1[r] = p1[r] - mn;
}
__device__ __forceinline__ void finishSM(f32x16& p0, f32x16& p1, float alpha, float& l_reg, bf16x8& pa0, bf16x8& pa1, bf16x8& pa2, bf16x8& pa3) {
#pragma unroll
    for (int r = 0; r < 16; ++r) p1[r] = __builtin_amdgcn_exp2f(p1[r]);
    float ps = 0;
#pragma unroll
    for (int r = 0; r < 16; ++r) ps += p0[r];
#pragma unroll
    for (int r = 0; r < 16; ++r) ps += p1[r];
    { auto rr = __builtin_amdgcn_permlane32_swap(__float_as_uint(ps), __float_as_uint(ps), false, false); ps = __uint_as_float(rr[0]) + __uint_as_float(rr[1]); }
    l_reg = l_reg * alpha + ps;
#define APK4(P, BASE, OUT) do { unsigned a0 = cvt_pk_bf16(P[BASE + 0], P[BASE + 1]), a1 = cvt_pk_bf16(P[BASE + 2], P[BASE + 3]);   \
    unsigned b0 = cvt_pk_bf16(P[BASE + 4], P[BASE + 5]), b1 = cvt_pk_bf16(P[BASE + 6], P[BASE + 7]);                              \
    auto r0 = __builtin_amdgcn_permlane32_swap(a0, b0, false, false); auto r1 = __builtin_amdgcn_permlane32_swap(a1, b1, false, false); \
    u32x4 w = {r0[0], r1[0], r0[1], r1[1]}; OUT = __builtin_bit_cast(bf16x8, w); } while (0)
    APK4(p0, 0, pa0); APK4(p0, 8, pa1); APK4(p1, 0, pa2); APK4(p1, 8, pa3);
#undef APK4
}
__device__ __forceinline__ void qkt(f32x16& p0, f32x16& p1, const LAS char* Ks, const bf16x8* qr, int r32, int hi) {
    p0 = f32x16{}; p1 = f32x16{};
#pragma unroll
    for (int d0 = 0; d0 < 12; ++d0) { const int cb = (d0 * 16 + hi * 8) * 2;
        const bf16x8 b0 = *(const LAS bf16x8*)(Ks + AKSWZ(r32, cb));
        const bf16x8 b1 = *(const LAS bf16x8*)(Ks + AKSWZ(32 + r32, cb));
        p0 = __builtin_amdgcn_mfma_f32_32x32x16_bf16(b0, qr[d0], p0, 0, 0, 0);
        p1 = __builtin_amdgcn_mfma_f32_32x32x16_bf16(b1, qr[d0], p1, 0, 0, 0); }
}
__device__ __forceinline__ int v_st(int k, int c) { const int kk = (k & ~0xC) | ((k & 4) << 1) | ((k & 8) >> 1); return ((kk >> 3) * 4 + (c >> 5)) * 512 + ((kk & 7) * 32 + (c & 31)) * 2; }
__device__ __forceinline__ int v_rd_base(int lane) { return ((lane & 3) << 3) | (((lane >> 2) & 3) << 6) | (((lane >> 4) & 1) << 5) | (((lane >> 5) & 1) << 8); }
constexpr int v_rd_off(int d0, int ks, int half) { return d0 * 512 + ks * 4096 + half * 2048; }
template <int OFF> __device__ __forceinline__ s16x4 tr_read(int vb) { s16x4 r; asm volatile("ds_read_b64_tr_b16 %0, %1 offset:%2" : "=&v"(r) : "v"(vb), "i"(OFF) : "memory"); return r; }
template <int D0> __device__ __forceinline__ void pv_one(f32x16& od, int vb, bf16x8 pa0, bf16x8 pa1, bf16x8 pa2, bf16x8 pa3) {
    const s16x4 l0 = tr_read<v_rd_off(D0, 0, 0)>(vb), h0 = tr_read<v_rd_off(D0, 0, 1)>(vb), l1 = tr_read<v_rd_off(D0, 1, 0)>(vb), h1 = tr_read<v_rd_off(D0, 1, 1)>(vb);
    const s16x4 l2 = tr_read<v_rd_off(D0, 2, 0)>(vb), h2 = tr_read<v_rd_off(D0, 2, 1)>(vb), l3 = tr_read<v_rd_off(D0, 3, 0)>(vb), h3 = tr_read<v_rd_off(D0, 3, 1)>(vb);
    asm volatile("s_waitcnt lgkmcnt(0)" ::: "memory"); ASBAR();
#define APK(L, H) (bf16x8){L[0], L[1], L[2], L[3], H[0], H[1], H[2], H[3]}
    od = __builtin_amdgcn_mfma_f32_32x32x16_bf16(pa0, APK(l0, h0), od, 0, 0, 0);
    od = __builtin_amdgcn_mfma_f32_32x32x16_bf16(pa1, APK(l1, h1), od, 0, 0, 0);
    od = __builtin_amdgcn_mfma_f32_32x32x16_bf16(pa2, APK(l2, h2), od, 0, 0, 0);
    od = __builtin_amdgcn_mfma_f32_32x32x16_bf16(pa3, APK(l3, h3), od, 0, 0, 0);
#undef APK
}
__device__ __forceinline__ void pv_d0(f32x16* o, int vb, bf16x8 pa0, bf16x8 pa1, bf16x8 pa2, bf16x8 pa3) {
    pv_one<0>(o[0], vb, pa0, pa1, pa2, pa3); pv_one<1>(o[1], vb, pa0, pa1, pa2, pa3); pv_one<2>(o[2], vb, pa0, pa1, pa2, pa3); pv_one<3>(o[3], vb, pa0, pa1, pa2, pa3);
}
__device__ __forceinline__ void attn_unit(const GAS bf16_t* __restrict__ QB, const GAS bf16_t* __restrict__ KVB, const GAS bf16_t* __restrict__ U, GAS bf16_t* __restrict__ BR,
                                          int qrow0, int h, int kctx0, int klat0, int nct, int NT, LAS char* lds) {
    const int tid = opaque_tid(), wid = tid >> 6, lane = tid & 63, r32 = lane & 31, hi = lane >> 5;
    LAS char* V_lds = lds; LAS char* K_lds = lds + 2 * SHM_V;
    LAS float* ws = (LAS float*)(lds + 2 * SHM_V + 2 * SHM_K) + wid * 64; LAS float* li_l = ws; LAS float* al_l = ws + 32;
    float m_reg = -1e30f, l_reg = 0; f32x16 o[4] = {}; bf16x8 qr[12];
    const GAS bf16_t* Qw = QB + (size_t)(qrow0 + wid * 32 + r32) * 768;
#pragma unroll
    for (int d0 = 0; d0 < 8; ++d0) qr[d0] = *(const GAS bf16x8*)(Qw + h * 128 + d0 * 16 + hi * 8);
#pragma unroll
    for (int d0 = 8; d0 < 12; ++d0) qr[d0] = *(const GAS bf16x8*)(Qw + 512 + h * 64 + (d0 - 8) * 16 + hi * 8);
    const int sr = tid >> 4, sc = (tid & 15) * 8, vst0 = v_st(sr, sc), vst1 = v_st(32 + sr, sc), rr_ = tid >> 3, rc_ = (tid & 7) * 8;
    const int vb0 = (int)(uintptr_t)V_lds + v_rd_base(lane);
    struct { bf16x8 vs0, vs1, ks0, ks1, kr; } sr_[1];
#define ASLOAD(i, j_) do { const int j__ = (j_); const int k0 = j__ < nct ? kctx0 + 64 * j__ : klat0 + 64 * (j__ - nct); \
    sr_[i].vs0 = *(const GAS bf16x8*)(KVB + (size_t)(k0 + sr) * 1024 + 512 + h * 128 + sc); sr_[i].vs1 = *(const GAS bf16x8*)(KVB + (size_t)(k0 + 32 + sr) * 1024 + 512 + h * 128 + sc); \
    sr_[i].ks0 = *(const GAS bf16x8*)(KVB + (size_t)(k0 + sr) * 1024 + h * 128 + sc); sr_[i].ks1 = *(const GAS bf16x8*)(KVB + (size_t)(k0 + 32 + sr) * 1024 + h * 128 + sc); \
    sr_[i].kr = *(const GAS bf16x8*)(U + (size_t)(k0 + rr_) * NU + U_KR + rc_); } while (0)
#define ASWRITE(b, i) do { *(LAS bf16x8*)(V_lds + (b) * SHM_V + vst0) = sr_[i].vs0; *(LAS bf16x8*)(V_lds + (b) * SHM_V + vst1) = sr_[i].vs1; \
    *(LAS bf16x8*)(K_lds + (b) * SHM_K + AKSWZ(sr, sc * 2)) = sr_[i].ks0; *(LAS bf16x8*)(K_lds + (b) * SHM_K + AKSWZ(32 + sr, sc * 2)) = sr_[i].ks1; \
    *(LAS bf16x8*)(K_lds + (b) * SHM_K + AKSWZ(rr_, 256 + rc_ * 2)) = sr_[i].kr; } while (0)
#define ASWAIT() asm volatile("s_waitcnt vmcnt(0)" ::: "memory")
#define ARESC(a) do { if (__any((a) < 1.f)) { if (hi == 0) al_l[r32] = (a); asm volatile("s_waitcnt lgkmcnt(0)" ::: "memory"); \
    _Pragma("unroll") for (int d = 0; d < 4; ++d) _Pragma("unroll") for (int r = 0; r < 16; ++r) o[d][r] *= al_l[crow(r, hi)]; } } while (0)
    f32x16 pA0, pA1; float mnA, alA; bf16x8 pa0, pa1, pa2, pa3;
    ASLOAD(0, 0); asm volatile("s_waitcnt vmcnt(0)" ::: "memory"); ASWRITE(0, 0); __syncthreads();
    for (int j = 0; j < NT; ++j) {
        const int bsel = j & 1;
        if (j + 1 < NT) ASLOAD(0, j + 1);
        ASBAR(); qkt(pA0, pA1, K_lds + bsel * SHM_K, qr, r32, hi);
        partialSM(pA0, pA1, m_reg, mnA, alA);
        ARESC(alA);
        finishSM(pA0, pA1, alA, l_reg, pa0, pa1, pa2, pa3); ASBAR();
        pv_d0(o, vb0 + bsel * SHM_V, pa0, pa1, pa2, pa3);
        if (j + 1 < NT) { ASWAIT(); ASWRITE(bsel ^ 1, 0); }
        __syncthreads();
    }
    if (hi == 0) li_l[r32] = l_reg; asm volatile("s_waitcnt lgkmcnt(0)" ::: "memory");
    GAS bf16_t* Ow = BR + (size_t)(qrow0 + wid * 32) * DM + 1024 + h * 128;
#pragma unroll
    for (int r = 0; r < 16; ++r) { const int orow = crow(r, hi); const float rl = __builtin_amdgcn_rcpf(li_l[orow]);
#pragma unroll
        for (int d0 = 0; d0 < 4; ++d0) Ow[(size_t)orow * DM + d0 * 32 + r32] = f2bf(o[d0][r] * rl); }
    __syncthreads();
#undef ASLOAD
#undef ASWRITE
#undef ASWAIT
#undef ARESC
}
}

constexpr int PH_PER_LAYER = 13, NPHASE = 2 + DEPTH * PH_PER_LAYER;
struct Args { const float* in[N_IN]; float* out; unsigned char* ws; int ph_lo, ph_hi; };
static_assert(sizeof(Args) == N_IN * 8 + 8 + 8 + 8, "Args has no padding");

#ifndef REP_G1
#define REP_G1 1
#endif
#ifndef REP_G2
#define REP_G2 1
#endif
#ifndef REP_G5
#define REP_G5 1
#endif
#ifndef REP_G6
#define REP_G6 1
#endif
#ifndef REP_G8
#define REP_G8 1
#endif
#ifndef REP_G10
#define REP_G10 1
#endif
#ifndef REP_G11
#define REP_G11 1
#endif
#ifndef REP_R4
#define REP_R4 1
#endif
#ifndef PH_MASK
#define PH_MASK 0xffffffffu
#endif
#define IN(k) (lo <= (k) && (k) < hi)
#define EN(j) ((PH_MASK >> (j)) & 1u)
#ifndef SUBMASK
#define SUBMASK 7
#endif
#define REFRESH() do { F.tid = opaque_tid(); F.lane = F.tid & 63; F.wave = __builtin_amdgcn_readfirstlane(F.tid >> 6); \
    F.ws = (GAS unsigned char*)opaque_ptr(args.ws); F.ctl = (unsigned*)opaque_ptr(args.ws + WS_CTL); F.out = (GAS float*)opaque_ptr(args.out); } while (0)
#define SEAM(k) do { if (IN(k) && IN((k) + 1)) xcd_barrier(bar); } while (0)
template <int l> __device__ __forceinline__ void layer_phases(Frame& F, const Args& args, const XcdBarrier& bar, const int lo, const int hi, char* ldsg) {
        const int pb = 2 + l * PH_PER_LAYER;
        const int mrows = (l + 1 < DEPTH) ? MT : ML;
        GAS bf16_t* const Hb = WSP(bf16_t, WS_H); GAS bf16_t* const Ub = WSP(bf16_t, WS_RA);
        if (IN(pb + 0) && EN(0) && l == 0) { REFRESH(); phase_rwA(F, l); }
        if (l == 0) SEAM(pb + 0);
        if (IN(pb + 1) && EN(1)) for (int rp_ = 0; rp_ < REP_G1; ++rp_) { REFRESH();
            Gemm g{Hb, WSP(bf16_t, WS_WIN) + (size_t)l * NU * DM, DM, DM, DM};
            GridSched S; S.init(MT / 256, NU / 256, F.G, (int)blockIdx.x, (size_t)256 * DM * 2, (size_t)256 * DM * 2, 0, 0);
            EpiWin E{Ub, WSP(float, WS_SSQ), WSP(float, WS_TAB)};
            pg8::gemm_phase<EpiWin, GridSched, false>(F.lds, g, S, E);
        }
        SEAM(pb + 1);
        if (IN(pb + 2) && EN(2)) for (int rp_ = 0; rp_ < REP_G2; ++rp_) { REFRESH();
            if (SUBMASK & 1) { Gemm g{Ub, WSP(bf16_t, WS_WUQ) + (size_t)l * 768 * 512, NU, 512, 512};
              GridSched S; S.init(MT / 256, 3, F.G, (int)blockIdx.x, (size_t)256 * NU * 2, (size_t)256 * 512 * 2, (size_t)U_CQ * 2, 0);
              EpiMlaQ E{WSP(bf16_t, WS_QB), WSP(float, WS_SSQ), WSP(float, WS_TAB)};
              pg8::gemm_phase<EpiMlaQ, GridSched, false>(F.lds, g, S, E); }
            if (SUBMASK & 2) { Gemm g{Ub, WSP(bf16_t, WS_WUKV) + (size_t)l * 1024 * 256, NU, 256, 256};
              GridSched S; S.init(MT / 256, 4, F.G, (int)blockIdx.x, (size_t)256 * NU * 2, (size_t)256 * 256 * 2, (size_t)U_CKV * 2, 0);
              EpiMlaKV E{WSP(bf16_t, WS_KVB), WSP(float, WS_SSQ)};
              pg8::gemm_phase<EpiMlaKV, GridSched, false>(F.lds, g, S, E); }
            if (SUBMASK & 4) { Gemm g{Hb, WSP(bf16_t, WS_WG) + (size_t)l * 8192 * DM, DM, DM, DM};
              GridSched S; S.init(mrows / 256, 32, F.G, (int)blockIdx.x, (size_t)256 * DM * 2, (size_t)256 * DM * 2, 0, 0);
              EpiGate E{WSP(unsigned char, WS_RB)};
              pg8::gemm_phase<EpiGate, GridSched, false>(F.lds, g, S, E); }
            phase_ssdconv(F, l);
            phase_scanprep(F, l);
        }
        SEAM(pb + 2);
#ifndef REP_MIX
#define REP_MIX 1
#endif
        if (IN(pb + 3) && EN(3)) for (int rep_ = 0; rep_ < REP_MIX; ++rep_) { REFRESH();
            const int bx = blockIdx.x;
#ifndef REPMASK
#define REPMASK 15
#endif
#ifdef ONLYK
            const int SCANMASK = ONLYK;
#else
            const int SCANMASK = rep_ == 0 ? 15 : REPMASK;
#endif
            if (bx < 32) { if (SCANMASK & 1) scn::scan_block<scn::K_ML>(F, l, bx); }
            else if (bx < 64) { if (SCANMASK & 2) scn::scan_block<scn::K_HG>(F, l, bx - 32); }
            else if (bx < 96) { if (SCANMASK & 4) scn::scan_block<scn::K_SSD>(F, l, bx - 64); }
            else if (SCANMASK & 8) {
                const int natt = 256 + (l + 1 < DEPTH ? 32 : 0), nab = F.G - 96;
                for (int ua = bx - 96; ua < natt; ua += nab) {
                    if (ua < 256) { const int b = ua >> 5, h = (ua >> 3) & 3, qb = ua & 7;
                        att::attn_unit(WSP(bf16_t, WS_QB), WSP(bf16_t, WS_KVB), Ub, WSP(bf16_t, WS_BR), b * SEQ + qb * 256, h, ML + b * CTXL, b * SEQ, 4, 36, (LAS char*)F.lds); }
                    else { const int uc = ua - 256, b = uc >> 2, h = uc & 3;
                        att::attn_unit(WSP(bf16_t, WS_QB), WSP(bf16_t, WS_KVB), Ub, WSP(bf16_t, WS_BR), ML + b * CTXL, h, ML + b * CTXL, 0, 4, 4, (LAS char*)F.lds); }
                }
            }
        }
        SEAM(pb + 3);
        if (IN(pb + 4) && EN(4)) for (int rp_ = 0; rp_ < REP_R4; ++rp_) { REFRESH(); phase_finish(F, l, mrows); }
        SEAM(pb + 4);
        if (IN(pb + 5) && EN(5)) for (int rp_ = 0; rp_ < REP_G5; ++rp_) { REFRESH();
            Gemm g{WSP(bf16_t, WS_BR), WSP(bf16_t, WS_WBR) + (size_t)l * 4 * DM * 512, DM, 512, 512};
            MergeSched S; S.gs.init(mrows / 256, 8, F.G, (int)blockIdx.x, 0, 0, 0, 0);
            EpiMerge E{WSP(unsigned char, WS_RB), WSP(bf16_t, WS_RA + RA_ACC), F.ws + WS_RA + RA_PART + (size_t)blockIdx.x * 131072, WSP(float, WS_RSSD)};
            pg8::gemm_phase<EpiMerge, MergeSched, false>(F.lds, g, S, E);
            if (l == 0 && blockIdx.x >= 64) {
                LAS float* scr = (LAS float*)(F.lds + F.wave * 16384);
                for (int it = ((int)blockIdx.x - 64) * 8 + F.wave; it < IT_MOE / 2; it += 192 * 8) cvt_moe_item(F, 0, it, scr);
            }
        }
        SEAM(pb + 5);
        if (IN(pb + 6) && EN(6)) for (int rp_ = 0; rp_ < REP_G6; ++rp_) { REFRESH();
            Gemm g{WSP(bf16_t, WS_RA + RA_ACC), WSP(bf16_t, WS_WOUT) + (size_t)l * DM * DM, DM, DM, DM};
            GridSched S; S.init(mrows / 256, 8, F.G, (int)blockIdx.x, (size_t)256 * DM * 2, (size_t)256 * DM * 2, 0, 0);
            EpiBf16 E{WSP(bf16_t, WS_RB + RB_Y), DM};
            pg8::gemm_phase<EpiBf16, GridSched, false>(F.lds, g, S, E);
            if (l == 0 && blockIdx.x >= 64) {
                LAS float* scr = (LAS float*)(F.lds + F.wave * 16384);
                for (int it = IT_MOE / 2 + ((int)blockIdx.x - 64) * 8 + F.wave; it < IT_MOE; it += 192 * 8) cvt_moe_item(F, 0, it, scr);
            }
        }
        SEAM(pb + 6);
        if (IN(pb + 7) && EN(7)) { REFRESH(); phase_rwB(F, l, mrows); }
        SEAM(pb + 7);
        if (IN(pb + 8) && EN(8)) for (int rp_ = 0; rp_ < REP_G8; ++rp_) { REFRESH();
            Gemm g{Hb, WSP(bf16_t, WS_WR) + (size_t)l * 256 * DM, DM, DM, 512};
            RouterSched S{mrows / 256, F.G, (int)blockIdx.x};
            EpiRouter E{WSP(float, WS_LOG)};
            pg8::gemm_phase<EpiRouter, RouterSched, false>(F.lds, g, S, E);
        }
        SEAM(pb + 8);
        if (IN(pb + 9) && EN(9)) { REFRESH(); phase_route(F, l, mrows); }
        SEAM(pb + 9);
        if (IN(pb + 10) && EN(10)) for (int rp_ = 0; rp_ < REP_G10; ++rp_) { REFRESH();
            moe_tables(F, l);
            Gemm g{Hb, WSP(bf16_t, WS_W13), DM, DM, DM};
            MoeSched S{(const volatile LAS int*)(F.MISC + 16), (const volatile LAS int*)(F.MISC + 64), WSP(int, WS_LIST), 4, F.G, (int)blockIdx.x, 1};
            EpiMoe1 E{WSP(bf16_t, WS_RA + RA_H1)};
            pg8::gemm_phase<EpiMoe1, MoeSched, true>(F.lds, g, S, E);
        }
        SEAM(pb + 10);
        if (IN(pb + 11) && EN(11)) for (int rp_ = 0; rp_ < REP_G11; ++rp_) { REFRESH();
            moe_tables(F, l);
            Gemm g{WSP(bf16_t, WS_RA + RA_H1), WSP(bf16_t, WS_W2), DEXP, DEXP, DEXP};
            MoeSched S{(const volatile LAS int*)(F.MISC + 16), (const volatile LAS int*)(F.MISC + 64), WSP(int, WS_LIST), 8, F.G, (int)blockIdx.x, 2};
            EpiMoe2 E{WSP(bf16_t, WS_RB + RB_Y2), WSP(int, WS_LIST), WSP(float, WS_WL), (const volatile LAS int*)(F.MISC + 64)};
            pg8::gemm_phase<EpiMoe2, MoeSched, false>(F.lds, g, S, E);
        }
        SEAM(pb + 11);
        if (IN(pb + 12) && EN(12)) { REFRESH(); phase_rwC(F, l, mrows); }
        SEAM(pb + 12);
    }

__global__ void __launch_bounds__(512, 2) fwd_kernel(Args args) {
    extern __shared__ __attribute__((aligned(16))) unsigned char lds_raw[];
    Frame F;
    F.lds = (LAS unsigned char*)lds_raw;
    F.MISC = (volatile LAS unsigned*)(F.lds + MISC_OFF);
    F.tid = threadIdx.x; F.lane = F.tid & 63; F.wave = __builtin_amdgcn_readfirstlane(F.tid >> 6);
    F.G = gridDim.x; { const int bx = blockIdx.x; F.vcu = (F.G % 8 == 0) ? (bx % 8) * (F.G / 8) + bx / 8 : bx; }
    F.ws = (GAS unsigned char*)args.ws; F.ctl = (unsigned*)(args.ws + WS_CTL); F.out = (GAS float*)args.out;
    F.inp = args.in;
    for (int u = F.tid; u < (LDS_BYTES - MISC_OFF) / 4; u += 512) F.MISC[u] = 0u;
    __syncthreads();
    const int lo = args.ph_lo, hi = args.ph_hi;
    XcdBarrier bar; bar.bar = F.ctl + CW_BAR; bar.x = 0; bar.st = nullptr;
    if (hi - lo > 1) bar = xcd_barrier_post(F.ctl + CW_BAR, F.MISC + 8);
    char* ldsg = (char*)lds_raw;

#ifndef REP_PRO
#define REP_PRO 1
#endif
    if (IN(0) && EN(13)) for (int rep_ = 0; rep_ < REP_PRO; ++rep_) { phase_prologue(F); } SEAM(0);
    if (IN(1) && EN(14)) { phase_modfin(F); } SEAM(1);

    layer_phases<0>(F, args, bar, lo, hi, ldsg);
    layer_phases<1>(F, args, bar, lo, hi, ldsg);
#undef IN
#undef SEAM
}


#ifdef DUMP_OFF
__global__ void dump_kernel(GAS float* out, const unsigned char* ws) {
    const size_t OUTN = (size_t)ML * DM; const size_t i0 = (size_t)blockIdx.x * blockDim.x + threadIdx.x, st = (size_t)gridDim.x * blockDim.x;
    for (size_t i = i0; i < OUTN; i += st) { float a = 0.f;
#if DUMP_F32
        const GAS float* src = (const GAS float*)(ws + (size_t)DUMP_OFF); for (size_t j = i; j < (size_t)DUMP_ELEMS; j += OUTN) a += src[j];
#else
        const GAS bf16_t* src = (const GAS bf16_t*)(ws + (size_t)DUMP_OFF); for (size_t j = i; j < (size_t)DUMP_ELEMS; j += OUTN) a += bf2f(src[j]);
#endif
        out[i] = a; }
}
#endif
extern "C" void kernel_launch(void* const* d_in, const int* in_sizes, int n_in, void* d_out, int out_size, void* d_ws, size_t ws_size, hipStream_t stream) {
    static int grid = 0;
    if (grid == 0) {
        if (n_in != N_IN || out_size != ML * DM || ws_size < WS_END) { fprintf(stderr, "kernel_launch: unexpected shapes: n_in %d out %d ws %zu (need %zu)\n", n_in, out_size, ws_size, (size_t)WS_END); grid = -1; return; }
        int dev = 0, cus = 0, per_cu = 0;
        if (hipGetDevice(&dev) != hipSuccess || hipDeviceGetAttribute(&cus, hipDeviceAttributeMultiprocessorCount, dev) != hipSuccess) { grid = -1; return; }
        if (hipFuncSetAttribute((const void*)fwd_kernel, hipFuncAttributeMaxDynamicSharedMemorySize, LDS_BYTES) != hipSuccess) { fprintf(stderr, "kernel_launch: hipFuncSetAttribute failed\n"); grid = -1; return; }
        if (hipOccupancyMaxActiveBlocksPerMultiprocessor(&per_cu, (const void*)fwd_kernel, 512, LDS_BYTES) != hipSuccess || per_cu < 1) { fprintf(stderr, "kernel_launch: occupancy query says %d\n", per_cu); }
        (void)hipGetLastError();
        grid = cus;
    }
    if (grid < 0) return;
    if (hipMemsetAsync((char*)d_ws + WS_CTL, 0, CTL_BYTES, stream) != hipSuccess) return;
    Args a{};
    for (int i = 0; i < N_IN; ++i) a.in[i] = (const float*)d_in[i];
    a.out = (float*)d_out; a.ws = (unsigned char*)d_ws;
#if MK_SINGLE
    a.ph_lo = 0; a.ph_hi = NPHASE;
    hipLaunchKernelGGL(fwd_kernel, dim3(grid), dim3(512), LDS_BYTES, stream, a);
#else
#ifndef MK_STOP
#define MK_STOP NPHASE
#endif
    for (int ph = 0; ph < MK_STOP; ++ph) {
        if (ph == 2 + PH_PER_LAYER) continue;
        a.ph_lo = ph; a.ph_hi = ph + 1;
        hipLaunchKernelGGL(fwd_kernel, dim3(grid), dim3(512), LDS_BYTES, stream, a);
    }
#endif
#ifdef DUMP_OFF
    hipLaunchKernelGGL(dump_kernel, dim3(2048), dim3(256), 0, stream, (float*)d_out, (const unsigned char*)d_ws);
#endif
    const hipError_t le = hipPeekAtLastError();
    if (le != hipSuccess) fprintf(stderr, "kernel_launch: launch failed: %s\n", hipGetErrorName(le));
}
```

```cpp
#include <hip/hip_runtime.h>
#include <cstdio>
#include <cstdint>

#ifndef MK_SINGLE
#define MK_SINGLE 1
#endif

constexpr int DM = 2048, NBATCH = 8, SEQ = 2048, CTXL = 256, DEPTH = 2;
constexpr int ML = NBATCH * SEQ;
constexpr int MC = NBATCH * CTXL;
constexpr int MT = ML + MC;
constexpr int DIN = 7008, NU = 7168;
constexpr int U_MLQ = 0, U_MLK = 512, U_MLV = 1024, U_MLO = 1536, U_HGQ = 2048, U_HGI = 2560, U_HGG = 3072, U_HGF = 3584,
              U_CQ = 4608, U_CKV = 5120, U_KR = 5376, U_MLG = 5440, U_DT = 5456, U_Z = 5632, U_XBC = 6144;
constexpr float EPS = 1e-6f;
constexpr int NEXP = 32, DEXP = 512;
constexpr int MOE_ROWS = 2 * MT + NEXP * 256;

enum { I_X = 0, I_C, I_CTX, I_CCTX, I_WADA, I_BADA, I_NORMG, I_WIN, I_MLFB, I_HGLB, I_HGNG, I_MLAGQ, I_MLAGKV, I_WUQ, I_WUKV,
       I_CONVW, I_CONVB, I_ALOG, I_DTB, I_SSDD, I_SSDNG, I_WGATE, I_WBR, I_WOUT, I_WGRP, I_WEXP, I_W1, I_W3, I_W2, N_IN };

constexpr size_t al256(size_t x) { return (x + 255) / 256 * 256; }
constexpr size_t WS_CTL = 0, CTL_BYTES = 1u << 20;
constexpr size_t WS_WIN = WS_CTL + CTL_BYTES;
constexpr size_t WS_WUQ = WS_WIN + (size_t)2 * NU * DM * 2;
constexpr size_t WS_WUKV = WS_WUQ + (size_t)2 * 768 * 512 * 2;
constexpr size_t WS_WG = WS_WUKV + (size_t)2 * 1024 * 256 * 2;
constexpr size_t WS_WBR = WS_WG + (size_t)2 * 8192 * DM;
constexpr size_t WS_WOUT = WS_WBR + (size_t)2 * 4 * DM * 512 * 2;
constexpr size_t WS_WR = WS_WOUT + (size_t)2 * DM * DM;
constexpr size_t WS_WIN8 = WS_WR + (size_t)2 * 256 * DM * 2;
constexpr size_t WS_W13 = WS_WIN8 + (size_t)2 * NU * DM;
constexpr size_t WS_W2 = WS_W13 + (size_t)NEXP * 1024 * DM * 2;
constexpr size_t WS_MODP = WS_W2 + (size_t)NEXP * DM * 512 * 2;
constexpr size_t WS_MOD = WS_MODP + (size_t)2 * 16 * 9 * 12288 * 4;
constexpr size_t WS_TAB = WS_MOD + (size_t)2 * 9 * 12288 * 4;
constexpr size_t WS_XC = WS_TAB + 16384;
constexpr size_t WS_H8 = WS_XC + (size_t)MC * DM * 4;
constexpr size_t WS_H = WS_H8 + (size_t)MT * DM;
constexpr size_t WS_HIN = WS_H;
constexpr size_t WS_QB = WS_H + (size_t)MT * DM * 2;
constexpr size_t WS_KVB = WS_QB + (size_t)MT * 768 * 2;
constexpr size_t WS_SSQ = WS_KVB + (size_t)MT * 1024 * 2;
constexpr size_t WS_BR = WS_SSQ + (size_t)MT * 12 * 4;
constexpr size_t WS_YFB = WS_BR + (size_t)MT * DM * 2;
constexpr size_t WS_RSSD = WS_YFB + (size_t)6 * MT * 512 * 2;
constexpr size_t WS_LOG = WS_RSSD + al256((size_t)MT * 4);
constexpr size_t WS_LIST = WS_LOG + (size_t)4 * MT * 64 * 4;
constexpr size_t WS_WL = WS_LIST + (size_t)NEXP * MT * 4;
constexpr size_t WS_XBC = WS_WL + (size_t)NEXP * MT * 4;
constexpr size_t HGP_ITEM = 8192 + 8192 + 1024;
constexpr size_t WS_HGP = WS_XBC + (size_t)MT * 1024 * 2;
constexpr size_t WS_MLS = WS_HGP + (size_t)64 * 72 * HGP_ITEM;
constexpr size_t WS_SSDS = WS_MLS + (size_t)64 * 2304 * 32;
constexpr size_t WS_MLC = WS_SSDS + (size_t)128 * 2304 * 32;
constexpr size_t WS_RA = WS_MLC + (size_t)32 * 2304 * 384 * 2;
constexpr size_t RA_BYTES = (size_t)MT * NU * 2;
constexpr size_t WS_RB = WS_RA + RA_BYTES;
constexpr size_t RB_BYTES = ((size_t)80 << 20) + (size_t)2 * MT * DM * 2;
constexpr size_t WS_END = WS_RB + RB_BYTES;
constexpr size_t RA_ACC = 0, RA_PART = (size_t)80 << 20, RA_H1 = (size_t)150 << 20;
constexpr size_t RB_Y = 0, RB_Y2 = (size_t)80 << 20;
static_assert(RA_PART >= (size_t)MT * DM * 2 && RA_H1 >= RA_PART + (size_t)256 * 65536 * 4 && RA_H1 + (size_t)MOE_ROWS * 512 * 2 <= RA_BYTES, "region A");
static_assert(RB_Y2 >= (size_t)MT * DM * 2 && RB_Y2 + (size_t)2 * MT * DM * 2 <= RB_BYTES && (size_t)MT * 8192 <= RB_BYTES, "region B");
constexpr int CW_CNT = 64;
constexpr int CW_BAR = 4096;

constexpr int RING_BYTES = 131072, MISC_OFF = RING_BYTES, LDS_BYTES = 147456;

#define GAS __attribute__((address_space(1)))
#define LAS __attribute__((address_space(3)))
typedef unsigned short bf16_t;
typedef short bf16x8 __attribute__((ext_vector_type(8)));
typedef short s16x4 __attribute__((ext_vector_type(4)));
typedef float f32x4 __attribute__((ext_vector_type(4)));
typedef float f32x2 __attribute__((ext_vector_type(2)));
typedef float f32x16 __attribute__((ext_vector_type(16)));
typedef unsigned u32x4 __attribute__((ext_vector_type(4)));
typedef unsigned u32x2 __attribute__((ext_vector_type(2)));
#define LDS_WAIT() asm volatile("s_waitcnt lgkmcnt(0)" ::: "memory")
#define VM_WAIT() asm volatile("s_waitcnt vmcnt(0)" ::: "memory")
typedef __bf16 bf16x2_t __attribute__((ext_vector_type(2)));
__device__ __forceinline__ unsigned cvt_pk_bf16(float lo, float hi) { const f32x2 v = {lo, hi}; return __builtin_bit_cast(unsigned, __builtin_convertvector(v, bf16x2_t)); }
__device__ __forceinline__ bf16_t f2bf(float f) { return (bf16_t)(cvt_pk_bf16(f, 0.f) & 0xffffu); }
__device__ __forceinline__ float bf2f(bf16_t b) { return __uint_as_float(((unsigned)b) << 16); }
__device__ __forceinline__ float bflo(unsigned w) { return __uint_as_float(w << 16); }
__device__ __forceinline__ float bfhi(unsigned w) { return __uint_as_float(w & 0xffff0000u); }
__device__ __forceinline__ float sigmoidf_(float x) { return 1.f / (1.f + __expf(-x)); }
__device__ __forceinline__ float siluf_(float x) { return x / (1.f + __expf(-x)); }
__device__ __forceinline__ int opaque_tid() { int t = threadIdx.x; asm volatile("" : "+v"(t)); return t; }
__device__ __forceinline__ const void* opaque_ptr(const void* p) {
    unsigned lo = (unsigned)(uintptr_t)p, hi = (unsigned)((uintptr_t)p >> 32); asm volatile("" : "+v"(lo), "+v"(hi));
    lo = __builtin_amdgcn_readfirstlane(lo); hi = __builtin_amdgcn_readfirstlane(hi); return (const void*)(((uintptr_t)hi << 32) | lo); }
__device__ __forceinline__ float wave_sum(float v) {
#pragma unroll
    for (int o = 1; o < 64; o <<= 1) v += __shfl_xor(v, o);
    return v;
}

__device__ __forceinline__ int prow(int b, int dir, int p) { if (p < CTXL) return ML + b * CTXL + (dir ? CTXL - 1 - p : p); const int q = p - CTXL; return b * SEQ + (dir ? SEQ - 1 - q : q); }
namespace scn {
__device__ __forceinline__ int rowl(int row, int colB) { return row * 256 + (colB ^ ((row & 7) << 4)); }
__device__ __forceinline__ float scan_add32(float v, int r32) {
#pragma unroll
    for (int d = 1; d < 32; d <<= 1) { const float o = __shfl_up(v, d, 32); if (r32 >= d) v += o; }
    return v;
}
__device__ __forceinline__ float scan_max32(float v, int r32) {
#pragma unroll
    for (int d = 1; d < 32; d <<= 1) { const float o = __shfl_up(v, d, 32); if (r32 >= d) v = fmaxf(v, o); }
    return v;
}
}

#define XB_TMO      128
#define XB_XCNT(j)  (256  + 64 * (j))
#define XB_XSUB(j)  (1280 + 64 * (j))
#define XB_XGEN(j)  (2304 + 64 * (j))
#define XB_TOP      3328
#define XB_TOPGEN   3392
#define XCD_BAR_WORDS 3456
#define XB_SPIN_CAP (1u << 18)
__device__ __forceinline__ unsigned xb_ld(unsigned* p)              { return __hip_atomic_load(p, __ATOMIC_RELAXED, __HIP_MEMORY_SCOPE_AGENT); }
__device__ __forceinline__ unsigned xb_add(unsigned* p, unsigned v) { return __hip_atomic_fetch_add(p, v, __ATOMIC_RELAXED, __HIP_MEMORY_SCOPE_AGENT); }
__device__ __forceinline__ unsigned xb_xcc_id() { return (unsigned)__builtin_amdgcn_s_getreg((3 << 11) | 20) & 0xFu; }
#define XB_SPIN(cond, bar) do { unsigned _sp = 0; while (cond) { __builtin_amdgcn_s_sleep(1); \
    if ((++_sp & 255u) == 0u) { if (xb_ld(&(bar)[XB_TMO])) break; if (_sp > XB_SPIN_CAP) { atomicAdd(&(bar)[XB_TMO], 1u); break; } } } } while (0)
struct XcdBarrier { unsigned* bar; unsigned x; volatile LAS unsigned* st; };
__device__ __forceinline__ XcdBarrier xcd_barrier_post(unsigned* bar, volatile LAS unsigned* st) {
    XcdBarrier b; b.bar = bar; b.x = xb_xcc_id(); b.st = st;
    if (threadIdx.x == 0) (void)xb_add(&bar[XB_XCNT(b.x)], 1u);
    return b;
}
__device__ __forceinline__ void xcd_barrier_complete(unsigned* bar, unsigned x, unsigned& nloc, unsigned& nx) {
    const unsigned G = gridDim.x * gridDim.y * gridDim.z;
    unsigned sum, cnt, mine, sp = 0u;
    for (;;) {
        sum = 0u; cnt = 0u; mine = 0u;
#pragma unroll
        for (unsigned j = 0; j < 16; ++j) { const unsigned c = xb_ld(&bar[XB_XCNT(j)]); sum += c; cnt += (c > 0u) ? 1u : 0u; mine = (j == x) ? c : mine; }
        if (sum == G) break;
        __builtin_amdgcn_s_sleep(1);
        if ((++sp & 255u) == 0u) { if (xb_ld(&bar[XB_TMO])) break; if (sp > XB_SPIN_CAP) { atomicAdd(&bar[XB_TMO], 1u); break; } }
    }
    nloc = mine > 0u ? mine : 1u; nx = cnt > 0u ? cnt : 1u;
}
__device__ __forceinline__ void xcd_barrier(const XcdBarrier& b) {
    asm volatile("s_waitcnt vmcnt(0)" ::: "memory");
    __syncthreads();
    if (threadIdx.x == 0) {
        unsigned* bar = b.bar;
        __builtin_amdgcn_s_waitcnt(0);
        unsigned nloc = b.st[0], nx = b.st[1];
        if (nloc == 0u) { xcd_barrier_complete(bar, b.x, nloc, nx); b.st[0] = nloc; b.st[1] = nx; }
        const unsigned old = xb_add(&bar[XB_XSUB(b.x)], 1u);
        const unsigned gen = old / nloc;
        if (old + 1u == (gen + 1u) * nloc) {
            __builtin_amdgcn_fence(__ATOMIC_RELEASE, "agent");
            asm volatile("s_waitcnt vmcnt(0)" ::: "memory");
            const unsigned og = xb_add(&bar[XB_TOP], 1u);
            const unsigned tg = og / nx;
            if (og + 1u == (tg + 1u) * nx) xb_add(&bar[XB_TOPGEN], 1u);
            else XB_SPIN(xb_ld(&bar[XB_TOPGEN]) == tg, bar);
            __builtin_amdgcn_fence(__ATOMIC_ACQUIRE, "agent");
            xb_add(&bar[XB_XGEN(b.x)], 1u);
            asm volatile("s_waitcnt vmcnt(0)" ::: "memory");
        } else {
            XB_SPIN(xb_ld(&bar[XB_XGEN(b.x)]) == gen, bar);
            __builtin_amdgcn_fence(__ATOMIC_ACQUIRE, "agent");
            asm volatile("s_waitcnt vmcnt(0)" ::: "memory");
        }
    }
    __syncthreads();
}

struct Frame {
    LAS unsigned char* lds;
    volatile LAS unsigned* MISC;
    unsigned* ctl;
    int tid, lane, wave, vcu, G;
    const float* const* inp;
    GAS float* out;
    GAS unsigned char* ws;
};
#define WSP(T, off) ((GAS T*)(F.ws + (off)))
#define INP(i) ((const GAS float*)F.inp[i])

namespace pg8 {
constexpr int BM = 256, BK = 64, HALF = 128, HTB = HALF * BK * 2, STAGE_BYTES = 8 * HTB, NXCD = 8, WGM = 8;
__host__ __device__ __forceinline__ int lds_byte(int r, int c) { const int st = (r >> 4) * 2 + (c >> 5), rr = r & 15, cc = c & 31, ob = rr * 64 + cc * 2; return st * 1024 + (ob ^ (((ob >> 9) & 1) << 5)); }
__host__ __device__ __forceinline__ void stage_rc(int b, int& R, int& C) { const int st = b / 1024, sb = b % 1024, swz = sb ^ (((sb >> 9) & 1) << 5); R = (st >> 1) * 16 + swz / 64; C = (st & 1) * 32 + (swz % 64) / 2; }

struct Unit { int pm, pn, aux, aux2; size_t aoff, boff; };
struct Gemm { const GAS bf16_t* A; const GAS bf16_t* Bt; int lda, ldb, K; };

struct GridSched {
    int nM, nN, nwg, G, c; size_t a_tile, b_tile, a0, b0;
    __device__ __forceinline__ void init(int nM_, int nN_, int G_, int c_, size_t a_tile_, size_t b_tile_, size_t a0_, size_t b0_) { nM = nM_; nN = nN_; nwg = nM * nN; G = G_; c = c_; a_tile = a_tile_; b_tile = b_tile_; a0 = a0_; b0 = b0_; }
    __device__ __forceinline__ void map(int L, int& pm, int& pn) const {
        int wgid = L; { const int q = nwg / NXCD, r = nwg % NXCD, xcd = wgid % NXCD, off = wgid / NXCD; wgid = (xcd < r ? xcd * (q + 1) : r * (q + 1) + (xcd - r) * q) + off; }
        const int nig = WGM * nN, gid = wgid / nig, fm = gid * WGM, gsz = (nM - fm) < WGM ? (nM - fm) : WGM;
        pm = fm + ((wgid % nig) % gsz); pn = (wgid % nig) / gsz;
    }
    __device__ __forceinline__ bool next(int i, Unit& u) const {
        const long L = (long)i * G + c; if (L >= nwg) return false;
        map((int)L, u.pm, u.pn); u.aux = 0; u.aux2 = 0; u.aoff = a0 + (size_t)u.pm * a_tile; u.boff = b0 + (size_t)u.pn * b_tile; return true;
    }
    __device__ __forceinline__ int arow(const Unit&, int) const { return 0; }
};

template <class Epi, class Sched, bool GATHER, bool FP8 = false>
__device__ __forceinline__ void gemm_phase(LAS unsigned char* lds, const Gemm g, const Sched& S, const Epi& E) {
    const int tid = opaque_tid(), wid = __builtin_amdgcn_readfirstlane(tid >> 6), lane = tid & 63, wr = wid >> 2, wc = wid & 3, fr = lane & 15, fq = lane >> 4;
    int nt = g.K / BK; asm volatile("" : "+s"(nt));
    unsigned voffA[2], voffB[2];
#pragma unroll
    for (int i = 0; i < 2; ++i) { int R, C; stage_rc(tid * 16 + i * 8192, R, C);
        voffA[i] = (unsigned)(R * g.lda + C) * 2u; voffB[i] = (unsigned)(R * g.ldb + C) * 2u; }
    const size_t kstep = (size_t)(BK * 2);
    const size_t hstepA = (size_t)HALF * g.lda * 2, hstepB = (size_t)HALF * g.ldb * 2;
    const unsigned ldsw = (unsigned)wid * 1024u;
    const int aoff = lds_byte(wr * 64 + fr, fq * 8), boff = lds_byte(wc * 32 + fr, fq * 8);
#define PG8_SA(b, h) (((b) * 2 + (h)) * HTB)
#define PG8_SB(b, h) ((4 + (b) * 2 + (h)) * HTB)
#define PG8_STAGE(bufoff, gbase, voff) do { _Pragma("unroll") for (int _i = 0; _i < 2; ++_i) \
        __builtin_amdgcn_global_load_lds((const unsigned*)((const char*)(gbase) + (voff)[_i]), (LAS unsigned*)(lds + (bufoff) + ldsw + _i * 8192), 16, 0, 0); } while (0)
#define PG8_LDA(dst, b, h) do { _Pragma("unroll") for (int m = 0; m < 4; ++m) { dst[m].lo = *(const LAS v4i_t*)(lds + PG8_SA(b, h) + aoff + m * 2048); dst[m].hi = *(const LAS v4i_t*)(lds + PG8_SA(b, h) + aoff + m * 2048 + 1024); } } while (0)
#define PG8_LDB(dst, b, h) do { _Pragma("unroll") for (int n = 0; n < 2; ++n) { dst[n].lo = *(const LAS v4i_t*)(lds + PG8_SB(b, h) + boff + n * 2048); dst[n].hi = *(const LAS v4i_t*)(lds + PG8_SB(b, h) + boff + n * 2048 + 1024); } } while (0)
typedef int v8i_t __attribute__((ext_vector_type(8))); typedef int v4i_t __attribute__((ext_vector_type(4)));
#define PG8_MMA(ai, bj, At, Bt) do { __builtin_amdgcn_s_setprio(1); _Pragma("unroll") for (int m = 0; m < 4; ++m) _Pragma("unroll") for (int n = 0; n < 2; ++n) { \
        if constexpr (FP8) { asm volatile("v_mfma_scale_f32_16x16x128_f8f6f4 %0, %1, %2, %0, %3, %4 op_sel_hi:[0,0,0]" : "+v"(acc[ai][bj][m][n]) : "v"(Bt[n]), "v"(At[m]), "v"(scW), "v"(scA)); } \
        else { acc[ai][bj][m][n] = __builtin_amdgcn_mfma_f32_16x16x32_bf16(__builtin_bit_cast(bf16x8, (v4i_t)Bt[n].lo), __builtin_bit_cast(bf16x8, (v4i_t)At[m].lo), acc[ai][bj][m][n], 0, 0, 0); \
               acc[ai][bj][m][n] = __builtin_amdgcn_mfma_f32_16x16x32_bf16(__builtin_bit_cast(bf16x8, (v4i_t)Bt[n].hi), __builtin_bit_cast(bf16x8, (v4i_t)At[m].hi), acc[ai][bj][m][n], 0, 0, 0); } } \
        __builtin_amdgcn_s_setprio(0); } while (0)
#if GEMM_SAFE
#define PG8_WAIT_V(n) asm volatile("s_waitcnt vmcnt(0)" ::: "memory")
#else
#define PG8_WAIT_V(n) asm volatile("s_waitcnt vmcnt(" #n ")" ::: "memory")
#endif
#define PG8_WAIT_L(n) asm volatile("s_waitcnt lgkmcnt(" #n ")" ::: "memory")
#define PG8_BAR __builtin_amdgcn_s_barrier()
#define PG8_SCHED __builtin_amdgcn_sched_barrier(0)
    unsigned cvA[2][2], nvA[2][2];
#define PG8_GOFF(dst, u) do { if constexpr (GATHER) { _Pragma("unroll") for (int _i = 0; _i < 2; ++_i) { int R_, C_; stage_rc(tid * 16 + _i * 8192, R_, C_); _Pragma("unroll") for (int _h = 0; _h < 2; ++_h) \
        dst[_h][_i] = (unsigned)(((size_t)S.arow(u, _h * HALF + R_) * (size_t)g.lda + (size_t)C_) * 2u); } } } while (0)
#define PG8_STAGE_A(bufoff, base, half, vh) do { if constexpr (GATHER) { PG8_STAGE(bufoff, base, (vh)[half]); } else { PG8_STAGE(bufoff, (base) + (half) * hstepA, voffA); } } while (0)
    Unit cur, nxt; int ui = 0;
    if (!S.next(0, cur)) return;
    f32x4 acc[2][2][4][2];
#pragma unroll
    for (int a = 0; a < 2; ++a)
#pragma unroll
        for (int b = 0; b < 2; ++b)
#pragma unroll
            for (int m = 0; m < 4; ++m)
#pragma unroll
                for (int n = 0; n < 2; ++n) acc[a][b][m][n] = (f32x4){0.f, 0.f, 0.f, 0.f};
    int scW = 0x79797979, scA = 0x7f7f7f7f; asm volatile("" : "+v"(scW), "+v"(scA));
    v8i_t At[4], B0[2], B1[2];
    const char* cA = (const char*)g.A + cur.aoff; const char* cB = (const char*)g.Bt + cur.boff;
    PG8_GOFF(cvA, cur);
#pragma unroll
    for (int _h = 0; _h < 2; ++_h)
#pragma unroll
        for (int _i = 0; _i < 2; ++_i) nvA[_h][_i] = cvA[_h][_i];
    PG8_STAGE(PG8_SB(0, 0), cB, voffB); PG8_STAGE_A(PG8_SA(0, 0), cA, 0, cvA); PG8_STAGE(PG8_SB(0, 1), cB + hstepB, voffB); PG8_STAGE_A(PG8_SA(0, 1), cA, 1, cvA);
    if (wr == 1) PG8_BAR;
    PG8_WAIT_V(4); PG8_BAR;
    PG8_STAGE(PG8_SB(1, 0), cB + kstep, voffB); PG8_STAGE_A(PG8_SA(1, 0), cA + kstep, 0, cvA); PG8_STAGE(PG8_SB(1, 1), cB + hstepB + kstep, voffB);
    PG8_WAIT_V(6); PG8_BAR;
    for (;;) {
        const bool has_next = S.next(ui + 1, nxt);
        const char* nA = has_next ? (const char*)g.A + nxt.aoff : cA; const char* nB = has_next ? (const char*)g.Bt + nxt.boff : cB;
        for (int t = 0; t < nt; t += 2) {
            const bool last = (t == nt - 2);
            const char* a1 = cA + (size_t)(t + 1) * kstep;
            const char* a2 = last ? nA : cA + (size_t)(t + 2) * kstep; const char* b2 = last ? nB : cB + (size_t)(t + 2) * kstep;
            const char* a3 = a2 + kstep; const char* b3 = b2 + kstep;
            if constexpr (GATHER) { if (last && has_next) { PG8_GOFF(nvA, nxt); } }
            PG8_LDB(B0, 0, 0); PG8_SCHED; PG8_LDA(At, 0, 0); PG8_STAGE_A(PG8_SA(1, 1), a1, 1, cvA);
            PG8_WAIT_L(8); PG8_BAR; PG8_WAIT_L(0); PG8_MMA(0, 0, At, B0); PG8_BAR; PG8_SCHED;
            PG8_LDB(B1, 0, 1); PG8_STAGE(PG8_SB(0, 0), b2, voffB);
            PG8_BAR; PG8_WAIT_L(0); PG8_MMA(0, 1, At, B1); PG8_BAR;
            PG8_LDA(At, 0, 1); PG8_STAGE_A(PG8_SA(0, 0), a2, 0, nvA);
            PG8_BAR; PG8_WAIT_L(0); PG8_MMA(1, 0, At, B0); PG8_BAR; PG8_SCHED;
            PG8_STAGE(PG8_SB(0, 1), b2 + hstepB, voffB);
            PG8_WAIT_V(6); PG8_BAR; PG8_MMA(1, 1, At, B1); PG8_BAR;
            PG8_LDB(B0, 1, 0); PG8_SCHED; PG8_LDA(At, 1, 0); PG8_STAGE_A(PG8_SA(0, 1), a2, 1, nvA);
            PG8_WAIT_L(8); PG8_BAR; PG8_WAIT_L(0); PG8_MMA(0, 0, At, B0); PG8_BAR; PG8_SCHED;
            PG8_LDB(B1, 1, 1); PG8_STAGE(PG8_SB(1, 0), b3, voffB);
            PG8_BAR; PG8_WAIT_L(0); PG8_MMA(0, 1, At, B1); PG8_BAR;
            PG8_LDA(At, 1, 1); PG8_STAGE_A(PG8_SA(1, 0), a3, 0, nvA);
            PG8_BAR; PG8_WAIT_L(0); PG8_MMA(1, 0, At, B0); PG8_BAR; PG8_SCHED;
            PG8_STAGE(PG8_SB(1, 1), b3 + hstepB, voffB);
            PG8_WAIT_V(6); PG8_BAR; PG8_MMA(1, 1, At, B1); PG8_BAR;
        }
        if constexpr (FP8) { asm volatile("s_nop 15\n\ts_nop 15" ::: "memory"); }
        E(acc, cur, wr, wc, fr, fq);
        if (!has_next) break;
#pragma unroll
        for (int a = 0; a < 2; ++a)
#pragma unroll
            for (int b = 0; b < 2; ++b)
#pragma unroll
                for (int m = 0; m < 4; ++m)
#pragma unroll
                    for (int n = 0; n < 2; ++n) acc[a][b][m][n] = (f32x4){0.f, 0.f, 0.f, 0.f};
        cur = nxt; cA = nA; cB = nB; ++ui;
        if constexpr (GATHER) {
#pragma unroll
            for (int _h = 0; _h < 2; ++_h)
#pragma unroll
                for (int _i = 0; _i < 2; ++_i) cvA[_h][_i] = nvA[_h][_i];
        }
    }
    PG8_WAIT_V(0);
    if (wr == 0) PG8_BAR;
    PG8_BAR;
#undef PG8_SA
#undef PG8_SB
#undef PG8_STAGE
#undef PG8_STAGE_A
#undef PG8_GOFF
#undef PG8_LDA
#undef PG8_LDB
#undef PG8_MMA
#undef PG8_WAIT_V
#undef PG8_WAIT_L
#undef PG8_BAR
#undef PG8_SCHED
}
}
using pg8::Unit;
using pg8::Gemm;
using pg8::GridSched;
#define EPI_ARGS f32x4 (&acc)[2][2][4][2], const Unit& u, int wr, int wc, int fr, int fq
#define EPI_FOR_ROWS for (int ai = 0; ai < 2; ++ai) for (int m = 0; m < 4; ++m)
#define EPI_FOR_COLS for (int bj = 0; bj < 2; ++bj) for (int n = 0; n < 2; ++n)
__device__ __forceinline__ void st_bf16x4(GAS bf16_t* p, f32x4 v) { u32x2 w; w.x = cvt_pk_bf16(v[0], v[1]); w.y = cvt_pk_bf16(v[2], v[3]); *(GAS u32x2*)p = w; }

struct EpiWin {
    GAS bf16_t* U; GAS float* ssq; const GAS float* rope;
    __device__ __forceinline__ void operator()(EPI_ARGS) const {
        const int row0 = u.pm * 256 + wr * 64 + fr, col0 = u.pn * 256 + wc * 32 + 4 * fq;
        if (u.pn == 21 && wc < 2 && u.pm < ML / 256) {
#pragma unroll
            for (int ai = 0; ai < 2; ++ai)
#pragma unroll
                for (int m = 0; m < 4; ++m) {
                    const int r = row0 + ai * 128 + m * 16, tok = r & (SEQ - 1), pos = wc == 0 ? (tok >> 6) : (tok & 63);
                    const f32x4 cs = *(const GAS f32x4*)(rope + pos * 16 + 4 * fq), sn = *(const GAS f32x4*)(rope + 1024 + pos * 16 + 4 * fq);
                    const f32x4 x1 = acc[ai][0][m][0], x2 = acc[ai][0][m][1];
                    acc[ai][0][m][0] = x1 * cs - x2 * sn; acc[ai][0][m][1] = x1 * sn + x2 * cs;
                }
        }
        if (u.pn >= 18 && u.pn <= 20) {
            const int slot = (u.pn - 18) * 4 + wc;
#pragma unroll
            for (int ai = 0; ai < 2; ++ai)
#pragma unroll
                for (int m = 0; m < 4; ++m) {
                    float s = 0.f;
#pragma unroll
                    for (int bj = 0; bj < 2; ++bj)
#pragma unroll
                        for (int n = 0; n < 2; ++n) { const f32x4 x = acc[ai][bj][m][n]; s += (x[0] * x[0] + x[1] * x[1]) + (x[2] * x[2] + x[3] * x[3]); }
                    s += __shfl_xor(s, 16); s += __shfl_xor(s, 32);
                    if (fq == 0) ssq[(size_t)(row0 + ai * 128 + m * 16) * 12 + slot] = s;
                }
        }
#pragma unroll
        for (int ai = 0; ai < 2; ++ai)
#pragma unroll
            for (int m = 0; m < 4; ++m) { GAS bf16_t* rowp = U + (size_t)(row0 + ai * 128 + m * 16) * NU + col0;
#pragma unroll
                for (int bj = 0; bj < 2; ++bj)
#pragma unroll
                    for (int n = 0; n < 2; ++n) st_bf16x4(rowp + bj * 128 + n * 16, acc[ai][bj][m][n]); }
    }
};
struct EpiMlaQ {
    GAS bf16_t* Q; const GAS float* ssq; const GAS float* rope;
    __device__ __forceinline__ void operator()(EPI_ARGS) const {
        const int row0 = u.pm * 256 + wr * 64 + fr, col0 = u.pn * 256 + wc * 32 + 4 * fq;
        f32x4 p0[8], p1[8];
#pragma unroll
        for (int i = 0; i < 8; ++i) { const int r = row0 + (i >> 2) * 128 + (i & 3) * 16; p0[i] = *(const GAS f32x4*)(ssq + (size_t)r * 12); p1[i] = *(const GAS f32x4*)(ssq + (size_t)r * 12 + 4); }
#pragma unroll
        for (int ai = 0; ai < 2; ++ai)
#pragma unroll
            for (int m = 0; m < 4; ++m) {
                const int r = row0 + ai * 128 + m * 16, i = ai * 4 + m;
                const float rstd = rsqrtf(((p0[i][0] + p0[i][1]) + (p0[i][2] + p0[i][3]) + (p1[i][0] + p1[i][1]) + (p1[i][2] + p1[i][3])) * (1.f / 512.f) + EPS);
#pragma unroll
                for (int bj = 0; bj < 2; ++bj) {
                    f32x4 a = acc[ai][bj][m][0] * rstd, b = acc[ai][bj][m][1] * rstd;
                    if (u.pn == 2 && u.pm < ML / 256) {
                        const int tok = r & (SEQ - 1), pos = (wc & 1) == 0 ? (tok >> 6) : (tok & 63);
                        const f32x4 cs = *(const GAS f32x4*)(rope + pos * 16 + 4 * fq), sn = *(const GAS f32x4*)(rope + 1024 + pos * 16 + 4 * fq);
                        const f32x4 x1 = a, x2 = b; a = x1 * cs - x2 * sn; b = x1 * sn + x2 * cs;
                    }
                    GAS bf16_t* rowp = Q + (size_t)r * 768 + col0 + bj * 128;
                    st_bf16x4(rowp, a); st_bf16x4(rowp + 16, b);
                }
            }
    }
};
struct EpiMlaKV {
    GAS bf16_t* KV; const GAS float* ssq;
    __device__ __forceinline__ void operator()(EPI_ARGS) const {
        const int row0 = u.pm * 256 + wr * 64 + fr, col0 = u.pn * 256 + wc * 32 + 4 * fq;
        f32x4 p0[8];
#pragma unroll
        for (int i = 0; i < 8; ++i) { const int r = row0 + (i >> 2) * 128 + (i & 3) * 16; p0[i] = *(const GAS f32x4*)(ssq + (size_t)r * 12 + 8); }
#pragma unroll
        for (int ai = 0; ai < 2; ++ai)
#pragma unroll
            for (int m = 0; m < 4; ++m) {
                const int r = row0 + ai * 128 + m * 16, i = ai * 4 + m;
                const float rstd = rsqrtf(((p0[i][0] + p0[i][1]) + (p0[i][2] + p0[i][3])) * (1.f / 256.f) + EPS);
                GAS bf16_t* rowp = KV + (size_t)r * 1024 + col0;
#pragma unroll
                for (int bj = 0; bj < 2; ++bj)
#pragma unroll
                    for (int n = 0; n < 2; ++n) st_bf16x4(rowp + bj * 128 + n * 16, acc[ai][bj][m][n] * rstd);
            }
    }
};
struct EpiGate {
    GAS unsigned char* G;
    __device__ __forceinline__ void operator()(EPI_ARGS) const {
        const __amdgpu_buffer_rsrc_t rsrc = __builtin_amdgcn_make_buffer_rsrc((void*)G, 0, 0x7fffffff, 0x00020000);
        const int voff = threadIdx.x * 8; const int tbase = (u.pm * 32 + u.pn) * 65536;
#pragma unroll
        for (int ai = 0; ai < 2; ++ai)
#pragma unroll
            for (int bj = 0; bj < 2; ++bj)
#pragma unroll
                for (int m = 0; m < 4; ++m) {
                    u32x2 w;
#pragma unroll
                    for (int n = 0; n < 2; ++n) { const f32x4 v = acc[ai][bj][m][n]; unsigned d = 0;
#pragma unroll
                        for (int j = 0; j < 4; ++j) { const float g = 255.f * __builtin_amdgcn_rcpf(1.f + __builtin_amdgcn_exp2f(-1.4426950409f * v[j])); d = __builtin_amdgcn_cvt_pk_u8_f32(g, j, d); }
                        if (n == 0) w.x = d; else w.y = d; }
                    __builtin_amdgcn_raw_buffer_store_b64(w, rsrc, voff, tbase + ((ai * 2 + bj) * 4 + m) * 4096, 0);
                }
    }
};
struct EpiMerge {
    const GAS unsigned char* G; GAS unsigned char* ACC; GAS unsigned char* part; const GAS float* rssd;
    __device__ __forceinline__ void operator()(EPI_ARGS) const {
        const int row0 = u.pm * 256 + wr * 64 + fr, col0 = u.pn * 256 + wc * 32 + 4 * fq, k = u.aux;
        const __amdgpu_buffer_rsrc_t rg = __builtin_amdgcn_make_buffer_rsrc((void*)G, 0, 0x7fffffff, 0x00020000);
        const __amdgpu_buffer_rsrc_t rp = __builtin_amdgcn_make_buffer_rsrc((void*)part, 0, 131072, 0x00020000);
        const int vg = threadIdx.x * 8, vp = threadIdx.x * 16; const int tbase = (u.pm * 32 + k * 8 + u.pn) * 65536;
#pragma unroll
        for (int ai = 0; ai < 2; ++ai) {
            u32x2 gw[2][4]; u32x4 pw[2][4]; float rsv[4];
#pragma unroll
            for (int m = 0; m < 4; ++m) { rsv[m] = (k == 3) ? rssd[row0 + ai * 128 + m * 16] : 1.f;
#pragma unroll
                for (int bj = 0; bj < 2; ++bj) { const int idx2 = (ai * 2 + bj) * 4 + m; gw[bj][m] = __builtin_amdgcn_raw_buffer_load_b64(rg, vg, tbase + idx2 * 4096, 0);
                    if (k > 0) pw[bj][m] = __builtin_amdgcn_raw_buffer_load_b128(rp, vp, idx2 * 8192, 16); } }
#pragma unroll
            for (int m = 0; m < 4; ++m) {
                const int r = row0 + ai * 128 + m * 16; const float rs = rsv[m] * (1.f / 255.f);
#pragma unroll
                for (int bj = 0; bj < 2; ++bj) {
                    const int idx2 = (ai * 2 + bj) * 4 + m; const u32x2 g2 = gw[bj][m];
                    f32x4 v0, v1;
                    v0[0] = (float)(g2.x & 0xffu); v0[1] = (float)((g2.x >> 8) & 0xffu); v0[2] = (float)((g2.x >> 16) & 0xffu); v0[3] = (float)(g2.x >> 24);
                    v1[0] = (float)(g2.y & 0xffu); v1[1] = (float)((g2.y >> 8) & 0xffu); v1[2] = (float)((g2.y >> 16) & 0xffu); v1[3] = (float)(g2.y >> 24);
                    v0 = v0 * acc[ai][bj][m][0] * rs; v1 = v1 * acc[ai][bj][m][1] * rs;
                    if (k > 0) { const u32x4 p4 = pw[bj][m];
                        v0 += (f32x4){bflo(p4.x), bfhi(p4.x), bflo(p4.y), bfhi(p4.y)}; v1 += (f32x4){bflo(p4.z), bfhi(p4.z), bflo(p4.w), bfhi(p4.w)}; }
                    if (k < 3) { u32x4 ow; ow.x = cvt_pk_bf16(v0[0], v0[1]); ow.y = cvt_pk_bf16(v0[2], v0[3]); ow.z = cvt_pk_bf16(v1[0], v1[1]); ow.w = cvt_pk_bf16(v1[2], v1[3]);
                        __builtin_amdgcn_raw_buffer_store_b128(ow, rp, vp, idx2 * 8192, 16); }
                    else { GAS unsigned char* op = ACC + (size_t)r * DM + col0 + bj * 128;
                        unsigned w0 = 0, w1 = 0; w0 = __builtin_amdgcn_cvt_pk_fp8_f32(v0[0], v0[1], w0, false); w0 = __builtin_amdgcn_cvt_pk_fp8_f32(v0[2], v0[3], w0, true);
                        w1 = __builtin_amdgcn_cvt_pk_fp8_f32(v1[0], v1[1], w1, false); w1 = __builtin_amdgcn_cvt_pk_fp8_f32(v1[2], v1[3], w1, true);
                        *(GAS unsigned*)op = w0; *(GAS unsigned*)(op + 16) = w1; }
                }
            }
            asm volatile("" ::: "memory");
        }
    }
};
struct EpiBf16 {
    GAS bf16_t* O; int ld;
    __device__ __forceinline__ void operator()(EPI_ARGS) const {
        const int row0 = u.pm * 256 + wr * 64 + fr, col0 = u.pn * 256 + wc * 32 + 4 * fq;
#pragma unroll
        for (int ai = 0; ai < 2; ++ai)
#pragma unroll
            for (int m = 0; m < 4; ++m) { GAS bf16_t* rowp = O + (size_t)(row0 + ai * 128 + m * 16) * ld + col0;
#pragma unroll
                for (int bj = 0; bj < 2; ++bj)
#pragma unroll
                    for (int n = 0; n < 2; ++n) st_bf16x4(rowp + bj * 128 + n * 16, acc[ai][bj][m][n]); }
    }
};
struct EpiRouter {
    GAS float* LOG;
    __device__ __forceinline__ void operator()(EPI_ARGS) const {
        if (wc >= 2) return;
        const int row0 = u.pm * 256 + wr * 64 + fr, col0 = wc * 32 + 4 * fq;
#pragma unroll
        for (int ai = 0; ai < 2; ++ai)
#pragma unroll
            for (int m = 0; m < 4; ++m) { GAS float* rowp = LOG + ((size_t)u.aux * MT + (row0 + ai * 128 + m * 16)) * 64 + col0;
#pragma unroll
                for (int n = 0; n < 2; ++n) *(GAS f32x4*)(rowp + n * 16) = acc[ai][0][m][n]; }
    }
};
struct RouterSched {
    int nM, G, c;
    __device__ __forceinline__ bool next(int i, Unit& u) const {
        const long L = (long)i * G + c; if (L >= (long)nM * 4) return false;
        u.pm = (int)(L >> 2); u.pn = 0; u.aux = (int)(L & 3); u.aux2 = 0;
        u.aoff = ((size_t)u.pm * 256 * DM + (size_t)u.aux * 512) * 2; u.boff = (size_t)u.aux * 512 * 2; return true;
    }
    __device__ __forceinline__ int arow(const Unit&, int) const { return 0; }
};
struct MoeSched {
    const volatile LAS int* tb; const volatile LAS int* cnt; const GAS int* list; int nN, G, c, mode;
    __device__ __forceinline__ bool next(int i, Unit& u) const {
        const long L = (long)i * G + c; const int NT = tb[32];
        const int ti = (int)(L / nN); if (ti >= NT) return false;
        u.pn = (int)(L % nN); int e = 0;
        while (e < 31 && ti >= tb[e + 1]) ++e;
        u.aux = e; u.aux2 = ti - tb[e]; u.pm = ti;
        if (mode == 1) { u.aoff = 0; u.boff = ((size_t)e * 1024 + (size_t)u.pn * 256) * DM * 2; }
        else { u.aoff = (size_t)ti * 256 * DEXP * 2; u.boff = ((size_t)e * DM + (size_t)u.pn * 256) * DEXP * 2; }
        return true;
    }
    __device__ __forceinline__ int arow(const Unit& u, int r) const {
        const int pos = u.aux2 * 256 + r; const int e = u.aux;
        return pos < cnt[e] ? (list[(size_t)e * MT + pos] >> 1) : 0;
    }
};
struct EpiMoe1 {
    GAS bf16_t* H1;
    __device__ __forceinline__ void operator()(EPI_ARGS) const {
        const int row0 = u.pm * 256 + wr * 64 + fr, col0 = u.pn * 128 + wc * 32 + 4 * fq;
#pragma unroll
        for (int ai = 0; ai < 2; ++ai)
#pragma unroll
            for (int m = 0; m < 4; ++m) { GAS bf16_t* rowp = H1 + (size_t)(row0 + ai * 128 + m * 16) * DEXP + col0;
#pragma unroll
                for (int n = 0; n < 2; ++n) { const f32x4 a = acc[ai][0][m][n], b = acc[ai][1][m][n]; f32x4 v;
#pragma unroll
                    for (int j = 0; j < 4; ++j) v[j] = a[j] * __builtin_amdgcn_rcpf(1.f + __builtin_amdgcn_exp2f(-1.4426950409f * a[j])) * b[j];
                    st_bf16x4(rowp + n * 16, v); } }
    }
};
struct EpiMoe2 {
    GAS bf16_t* Y2; const GAS int* list; const GAS float* wl; const volatile LAS int* cnt;
    __device__ __forceinline__ void operator()(EPI_ARGS) const {
        const int e = u.aux, n_e = cnt[e], col0 = u.pn * 256 + wc * 32 + 4 * fq;
        int ts[8]; float w[8];
#pragma unroll
        for (int i = 0; i < 8; ++i) { const int pos = u.aux2 * 256 + (i >> 2) * 128 + wr * 64 + (i & 3) * 16 + fr; const bool ok = pos < n_e;
            ts[i] = ok ? list[(size_t)e * MT + pos] : -1; w[i] = ok ? wl[(size_t)e * MT + pos] : 0.f; }
#pragma unroll
        for (int ai = 0; ai < 2; ++ai)
#pragma unroll
            for (int m = 0; m < 4; ++m) { const int i = ai * 4 + m;
                if (ts[i] >= 0) {
                    GAS bf16_t* rowp = Y2 + (size_t)ts[i] * DM + col0;
#pragma unroll
                    for (int bj = 0; bj < 2; ++bj)
#pragma unroll
                        for (int n = 0; n < 2; ++n) st_bf16x4(rowp + bj * 128 + n * 16, acc[ai][bj][m][n] * w[i]);
                }
            }
    }
};

struct WinSched {
    GridSched gs; int mode;
    __device__ __forceinline__ bool next(int i, Unit& u) const {
        const long L = (long)i * gs.G + gs.c; if (L >= gs.nwg) return false;
        int j; gs.map((int)L, u.pm, j);
        u.pn = mode == 0 ? (j < 10 ? 4 + j : 12 + j) : (j < 4 ? j : 10 + j);
        u.aux = 0; u.aux2 = 0; u.aoff = gs.a0 + (size_t)u.pm * gs.a_tile; u.boff = gs.b0 + (size_t)u.pn * gs.b_tile; return true;
    }
    __device__ __forceinline__ int arow(const Unit&, int) const { return 0; }
};
struct MergeSched {
    GridSched gs;
    __device__ __forceinline__ bool next(int i, Unit& u) const {
        const long L = (long)(i >> 2) * gs.G + gs.c; if (L >= gs.nwg) return false;
        gs.map((int)L, u.pm, u.pn); const int k = i & 3; u.aux = k; u.aux2 = 0;
        u.aoff = ((size_t)u.pm * 256 * DM + (size_t)k * 512) * 2; u.boff = ((size_t)k * DM + (size_t)u.pn * 256) * 512 * 2; return true;
    }
    __device__ __forceinline__ int arow(const Unit&, int) const { return 0; }
};

__device__ __forceinline__ void tr_block(const GAS float* colp, int ldw, float nscale, const GAS float* kscale, int k0, GAS bf16_t* WT, int K, int n0, LAS float* scr, int lane) {
    float v[32];
#pragma unroll
    for (int i = 0; i < 32; ++i) { const int kk = 2 * i + (lane >> 5); v[i] = colp ? colp[(size_t)(k0 + kk) * ldw] : 0.f; }
    if (kscale) {
#pragma unroll
        for (int i = 0; i < 32; ++i) { const int kk = 2 * i + (lane >> 5); v[i] *= kscale[k0 + kk]; }
    }
#pragma unroll
    for (int i = 0; i < 32; ++i) { const int kk = 2 * i + (lane >> 5); scr[kk * 33 + (lane & 31)] = v[i] * nscale; }
    LDS_WAIT(); asm volatile("" ::: "memory");
    const int c = lane & 7;
#pragma unroll
    for (int j = 0; j < 4; ++j) { const int n = (lane >> 3) + 8 * j; const LAS float* s = scr + (8 * c) * 33 + n;
        u32x4 o; o.x = cvt_pk_bf16(s[0 * 33], s[1 * 33]); o.y = cvt_pk_bf16(s[2 * 33], s[3 * 33]); o.z = cvt_pk_bf16(s[4 * 33], s[5 * 33]); o.w = cvt_pk_bf16(s[6 * 33], s[7 * 33]);
        *(GAS u32x4*)(WT + (size_t)(n0 + n) * K + k0 + 8 * c) = o; }
    LDS_WAIT(); asm volatile("" ::: "memory");
}

__device__ __forceinline__ void tr_block8(const GAS float* colp, int ldw, float nscale, int k0, GAS unsigned char* WT, int K, int n0, LAS float* scr, int lane) {
    float v[32];
#pragma unroll
    for (int i = 0; i < 32; ++i) { const int kk = 2 * i + (lane >> 5); v[i] = colp ? colp[(size_t)(k0 + kk) * ldw] : 0.f; }
#pragma unroll
    for (int i = 0; i < 32; ++i) { const int kk = 2 * i + (lane >> 5); scr[kk * 33 + (lane & 31)] = v[i] * nscale; }
    LDS_WAIT(); asm volatile("" ::: "memory");
    const int c = lane & 7;
#pragma unroll
    for (int j = 0; j < 4; ++j) { const int n = (lane >> 3) + 8 * j; const LAS float* s = scr + (8 * c) * 33 + n;
        u32x2 o; unsigned w = 0; w = __builtin_amdgcn_cvt_pk_fp8_f32(s[0 * 33], s[1 * 33], w, false); w = __builtin_amdgcn_cvt_pk_fp8_f32(s[2 * 33], s[3 * 33], w, true); o.x = w;
        w = 0; w = __builtin_amdgcn_cvt_pk_fp8_f32(s[4 * 33], s[5 * 33], w, false); w = __builtin_amdgcn_cvt_pk_fp8_f32(s[6 * 33], s[7 * 33], w, true); o.y = w;
        *(GAS u32x2*)(WT + (size_t)(n0 + n) * K + k0 + 8 * c) = o; }
    LDS_WAIT(); asm volatile("" ::: "memory");
}
__device__ __forceinline__ int win_src(int n) {
    if (n < 2048) return n;
    if (n < 5440) return n + 16;
    if (n < 5456) return 2048 + (n - 5440);
    if (n < 5472) return 6992 + (n - 5456);
    if (n < 5632) return -1;
    if (n < 6144) return 5456 + (n - 5632);
    return 5968 + (n - 6144);
}
constexpr int IT_WIN = 32 * 224, IT_WUQ = 8 * 24, IT_WUKV = 4 * 32, IT_WG = 32 * 64, IT_WBR = 8 * 64, IT_WOUT = 32 * 64, IT_WR = 32 * 8, IT_W13 = 32 * 32, IT_W2 = 8 * 64;
constexpr int IT_LAYER = IT_WIN + IT_WUQ + IT_WUKV + 4 * IT_WG + 4 * IT_WBR + IT_WOUT + IT_WR;
constexpr int IT_MOE = NEXP * (IT_W13 + IT_W2);
__device__ __forceinline__ void cvt_layer_item(Frame& F, int l, int r, LAS float* scr) {
    const int lane = F.lane, nl = lane & 31;
    if (r < IT_WIN) { const int nb = r % 224, kb = r / 224, n = nb * 32 + nl, sc = win_src(n);
        const int ct = nb >> 3;
        if ((ct >= 4 && ct <= 13) || ct >= 22) tr_block8(sc >= 0 ? INP(I_WIN) + (size_t)l * DM * DIN + sc : nullptr, DIN, 64.f, kb * 64, WSP(unsigned char, WS_WIN8) + (size_t)l * NU * DM, DM, nb * 32, scr, lane);
        else tr_block(sc >= 0 ? INP(I_WIN) + (size_t)l * DM * DIN + sc : nullptr, DIN, n < 512 ? 0.08838834764831845f : 1.f, nullptr, kb * 64, WSP(bf16_t, WS_WIN) + (size_t)l * NU * DM, DM, nb * 32, scr, lane);
        return; }
    r -= IT_WIN;
    if (r < IT_WUQ) { const int nb = r % 24, kb = r / 24, n = nb * 32 + nl; const int sc = n < 512 ? (n >> 7) * 192 + (n & 127) : ((n - 512) >> 6) * 192 + 128 + ((n - 512) & 63);
        tr_block(INP(I_WUQ) + (size_t)l * 512 * 768 + sc, 768, 0.07216878364870323f * 1.4426950408889634f, INP(I_MLAGQ) + l * 512, kb * 64, WSP(bf16_t, WS_WUQ) + (size_t)l * 768 * 512, 512, nb * 32, scr, lane); return; }
    r -= IT_WUQ;
    if (r < IT_WUKV) { const int nb = r % 32, kb = r / 32, n = nb * 32 + nl; const int sc = n < 512 ? (n >> 7) * 256 + (n & 127) : ((n - 512) >> 7) * 256 + 128 + ((n - 512) & 127);
        tr_block(INP(I_WUKV) + (size_t)l * 256 * 1024 + sc, 1024, 1.f, INP(I_MLAGKV) + l * 256, kb * 64, WSP(bf16_t, WS_WUKV) + (size_t)l * 1024 * 256, 256, nb * 32, scr, lane); return; }
    r -= IT_WUKV;
    if (r < 4 * IT_WG) { const int k = r / IT_WG, q = r % IT_WG, nb = q % 64, kb = q / 64;
        tr_block8(INP(I_WGATE) + (size_t)(l * 4 + k) * DM * DM + nb * 32 + nl, DM, 64.f, kb * 64, WSP(unsigned char, WS_WG) + ((size_t)l * 8192 + (size_t)k * 2048) * DM, DM, nb * 32, scr, lane); return; }
    r -= 4 * IT_WG;
    if (r < 4 * IT_WBR) { const int k = r / IT_WBR, q = r % IT_WBR, nb = q % 64, kb = q / 64;
        const GAS float* ks = k == 1 ? INP(I_HGNG) + l * 512 : (k == 3 ? INP(I_SSDNG) + l * 512 : nullptr);
        tr_block(INP(I_WBR) + (size_t)(l * 4 + k) * 512 * DM + nb * 32 + nl, DM, 1.f, ks, kb * 64, WSP(bf16_t, WS_WBR) + (size_t)(l * 4 + k) * DM * 512, 512, nb * 32, scr, lane); return; }
    r -= 4 * IT_WBR;
    if (r < IT_WOUT) { const int nb = r % 64, kb = r / 64;
        tr_block8(INP(I_WOUT) + (size_t)l * DM * DM + nb * 32 + nl, DM, 64.f, kb * 64, WSP(unsigned char, WS_WOUT) + (size_t)l * DM * DM, DM, nb * 32, scr, lane); return; }
    r -= IT_WOUT;
    { const int nb = r % 8, kb = r / 8, n = nb * 32 + nl; const GAS float* cp = nullptr; int ld = 4;
      if (n < 4) { cp = INP(I_WGRP) + (size_t)l * DM * 4 + n; ld = 4; } else if (n < 36) { cp = INP(I_WEXP) + (size_t)l * DM * 32 + (n - 4); ld = 32; }
      tr_block(cp, ld, 1.f, nullptr, kb * 64, WSP(bf16_t, WS_WR) + (size_t)l * 256 * DM, DM, nb * 32, scr, lane); }
}
__device__ __forceinline__ void cvt_moe_item(Frame& F, int l, int r, LAS float* scr) {
    const int lane = F.lane, nl = lane & 31;
    if (r < NEXP * IT_W13) { const int e = r / IT_W13, q = r % IT_W13, nb = q % 32, kb = q / 32, n = nb * 32 + nl;
        const int c = (n >> 8) * 128 + (n & 127); const GAS float* src = ((n >> 7) & 1) ? INP(I_W3) : INP(I_W1);
        tr_block(src + (size_t)(l * NEXP + e) * DM * DEXP + c, DEXP, 1.f, nullptr, kb * 64, WSP(bf16_t, WS_W13) + (size_t)e * 1024 * DM, DM, nb * 32, scr, lane); return; }
    r -= NEXP * IT_W13;
    { const int e = r / IT_W2, q = r % IT_W2, nb = q % 64, kb = q / 64;
      tr_block(INP(I_W2) + (size_t)(l * NEXP + e) * DEXP * DM + nb * 32 + nl, DM, 1.f, nullptr, kb * 64, WSP(bf16_t, WS_W2) + (size_t)e * DM * DEXP, DEXP, nb * 32, scr, lane); }
}
__device__ __forceinline__ void ada_task(Frame& F, int task) {
    const int ks = task & 15, cg = (task >> 4) % 48, l = task / (16 * 48); const int col = cg * 256 + F.lane * 4;
    f32x4 a[9];
#pragma unroll
    for (int r = 0; r < 9; ++r) a[r] = (f32x4){0.f, 0.f, 0.f, 0.f};
    const GAS float* W = INP(I_WADA) + ((size_t)l * DM + ks * 128) * 12288 + col;
    for (int k = 0; k < 128; k += 4) {
        f32x4 w[4];
#pragma unroll
        for (int q = 0; q < 4; ++q) w[q] = *(const GAS f32x4*)(W + (size_t)(k + q) * 12288);
#pragma unroll
        for (int q = 0; q < 4; ++q) {
            const int kk = ks * 128 + k + q;
#pragma unroll
            for (int r = 0; r < 9; ++r) { const float c = r < 8 ? INP(I_C)[r * DM + kk] : INP(I_CCTX)[kk]; a[r] += siluf_(c) * w[q]; }
        }
    }
    GAS float* P = WSP(float, WS_MODP) + ((size_t)(l * 16 + ks) * 9) * 12288 + col;
#pragma unroll
    for (int r = 0; r < 9; ++r) *(GAS f32x4*)(P + (size_t)r * 12288) = a[r];
}
__device__ __forceinline__ void tables_task(Frame& F) {
    GAS float* T = WSP(float, WS_TAB); const int lane = F.lane;
    for (int i = 0; i < 16; ++i) { const float inv = expf(-(float)i * (9.210340371976184f / 16.f)); const float ang = (float)lane * inv; T[lane * 16 + i] = cosf(ang); T[1024 + lane * 16 + i] = sinf(ang); }
    for (int j = lane; j < 512; j += 64) { const float a0 = INP(I_HGLB)[j], a1 = INP(I_HGLB)[512 + j], a2 = INP(I_HGLB)[1024 + j];
        const float mx = fmaxf(a0, fmaxf(a1, a2)), e0 = expf(a0 - mx), e1 = expf(a1 - mx), e2 = expf(a2 - mx), s = e0 + e1 + e2;
        T[2048 + j] = e0 / s; T[2048 + 512 + j] = (e0 + e1) / s; }
}
constexpr int N_ADA = 2 * 48 * 16;
__device__ __forceinline__ void phase_prologue(Frame& F) {
    LAS float* scr = (LAS float*)(F.lds + F.wave * 16384);
    const int gw = F.vcu * 8 + F.wave, NGW = F.G * 8;
    constexpr int TOTAL = N_ADA + 1 + 2 * IT_LAYER;
    for (int it = gw; it < TOTAL; it += NGW) {
        int r = it;
        if (r < N_ADA) { ada_task(F, r); continue; } r -= N_ADA;
        if (r == 0) { tables_task(F); continue; } r -= 1;
        cvt_layer_item(F, r / IT_LAYER, r % IT_LAYER, scr);
    }
}
__device__ __forceinline__ void phase_modfin(Frame& F) {
    const int gt = F.vcu * 512 + F.tid, NT_ = F.G * 512;
    for (int i = gt; i < 2 * 9 * 12288; i += NT_) { const int l = i / (9 * 12288), rc = i % (9 * 12288), col = rc % 12288;
        float s = INP(I_BADA)[l * 12288 + col];
#pragma unroll
        for (int ks = 0; ks < 16; ++ks) s += WSP(float, WS_MODP)[((size_t)(l * 16 + ks) * 9) * 12288 + rc];
        WSP(float, WS_MOD)[i] = s; }
}

struct Row8 { f32x4 v[8]; };
__device__ __forceinline__ void ld_row_f32(Row8& R, const GAS float* p, int lane) {
#pragma unroll
    for (int j = 0; j < 8; ++j) R.v[j] = ((const GAS f32x4*)p)[64 * j + lane];
}
__device__ __forceinline__ void st_row_f32(const Row8& R, GAS float* p, int lane) {
#pragma unroll
    for (int j = 0; j < 8; ++j) ((GAS f32x4*)p)[64 * j + lane] = R.v[j];
}
__device__ __forceinline__ void ld_row_bf16(Row8& R, const GAS bf16_t* p, int lane) {
#pragma unroll
    for (int j = 0; j < 8; ++j) { const u32x2 w = ((const GAS u32x2*)p)[64 * j + lane]; R.v[j] = (f32x4){bflo(w.x), bfhi(w.x), bflo(w.y), bfhi(w.y)}; }
}
__device__ __forceinline__ void st_row_bf16(const Row8& R, GAS bf16_t* p, int lane) {
#pragma unroll
    for (int j = 0; j < 8; ++j) { u32x2 w; w.x = cvt_pk_bf16(R.v[j][0], R.v[j][1]); w.y = cvt_pk_bf16(R.v[j][2], R.v[j][3]); ((GAS u32x2*)p)[64 * j + lane] = w; }
}
__device__ __forceinline__ float row_rstd(const Row8& R) {
    float s = 0.f;
#pragma unroll
    for (int j = 0; j < 8; ++j) s += (R.v[j][0] * R.v[j][0] + R.v[j][1] * R.v[j][1]) + (R.v[j][2] * R.v[j][2] + R.v[j][3] * R.v[j][3]);
    return rsqrtf(wave_sum(s) * (1.f / DM) + EPS);
}
__device__ __forceinline__ void st_modnorm(const Row8& R, float rstd, const GAS float* g, const GAS float* shift, const GAS float* scale, GAS bf16_t* o, int lane) {
#pragma unroll
    for (int j = 0; j < 8; ++j) { const int c = 64 * j + lane; const f32x4 gg = ((const GAS f32x4*)g)[c], sh = ((const GAS f32x4*)shift)[c], sc = ((const GAS f32x4*)scale)[c];
        const f32x4 h = (R.v[j] * rstd * gg) * (sc + 1.f) + sh; u32x2 w; w.x = cvt_pk_bf16(h[0], h[1]); w.y = cvt_pk_bf16(h[2], h[3]); ((GAS u32x2*)o)[c] = w; }
}
__device__ __forceinline__ void st_modnorm8(const Row8& R, float rstd, const GAS float* g, const GAS float* shift, const GAS float* scale, GAS unsigned char* o, int lane) {
#pragma unroll
    for (int j = 0; j < 8; ++j) { const int c = 64 * j + lane; const f32x4 gg = ((const GAS f32x4*)g)[c], sh = ((const GAS f32x4*)shift)[c], sc = ((const GAS f32x4*)scale)[c];
        const f32x4 h = (R.v[j] * rstd * gg) * (sc + 1.f) + sh; unsigned w = 0; w = __builtin_amdgcn_cvt_pk_fp8_f32(h[0], h[1], w, false); w = __builtin_amdgcn_cvt_pk_fp8_f32(h[2], h[3], w, true); ((GAS unsigned*)o)[c] = w; }
}
__device__ __forceinline__ const GAS float* mod_row(Frame& F, int l, int r) { return WSP(float, WS_MOD) + (size_t)(l * 9 + (r < ML ? (r >> 11) : 8)) * 12288; }
__device__ __forceinline__ void phase_rwA(Frame& F, int l) {
    const int gw = F.vcu * 8 + F.wave, NGW = F.G * 8; const GAS float* g0 = INP(I_NORMG) + (size_t)(l * 4 + 0) * DM;
    for (int r = gw; r < MT; r += NGW) {
        Row8 R; ld_row_f32(R, r < ML ? INP(I_X) + (size_t)r * DM : INP(I_CTX) + (size_t)(r - ML) * DM, F.lane);
        const float rstd = row_rstd(R); const GAS float* md = mod_row(F, l, r);
        st_modnorm8(R, rstd, g0, md, md + DM, WSP(unsigned char, WS_H8) + (size_t)r * DM, F.lane);
        st_modnorm(R, rstd, g0, md, md + DM, WSP(bf16_t, WS_HIN) + (size_t)r * DM, F.lane);
    }
}
__device__ __forceinline__ void phase_rwB(Frame& F, int l, int mrows) {
    const int gw = F.vcu * 8 + F.wave, NGW = F.G * 8; const GAS float* g1 = INP(I_NORMG) + (size_t)(l * 4 + 1) * DM; const GAS float* g2 = INP(I_NORMG) + (size_t)(l * 4 + 2) * DM;
    for (int r = gw; r < mrows; r += NGW) {
        Row8 Y; ld_row_bf16(Y, WSP(bf16_t, WS_RB + RB_Y) + (size_t)r * DM, F.lane);
        const float ry = row_rstd(Y); const GAS float* md = mod_row(F, l, r);
        Row8 X;
        if (r < ML) { if (l == 0) ld_row_f32(X, INP(I_X) + (size_t)r * DM, F.lane); else ld_row_bf16(X, (const GAS bf16_t*)(F.out + (size_t)r * DM), F.lane); }
        else ld_row_f32(X, l == 0 ? INP(I_CTX) + (size_t)(r - ML) * DM : WSP(float, WS_XC) + (size_t)(r - ML) * DM, F.lane);
#pragma unroll
        for (int j = 0; j < 8; ++j) { const int c = 64 * j + F.lane; X.v[j] += ((const GAS f32x4*)(md + 2 * DM))[c] * (Y.v[j] * ry * ((const GAS f32x4*)g1)[c]); }
        if (r < ML) st_row_bf16(X, (GAS bf16_t*)(F.out + (size_t)r * DM), F.lane); else st_row_f32(X, WSP(float, WS_XC) + (size_t)(r - ML) * DM, F.lane);
        const float rx = row_rstd(X);
        st_modnorm(X, rx, g2, md + 3 * DM, md + 4 * DM, WSP(bf16_t, WS_H) + (size_t)r * DM, F.lane);
    }
}
__device__ __forceinline__ void phase_rwC(Frame& F, int l, int mrows) {
    const int gw = F.vcu * 8 + F.wave, NGW = F.G * 8; const GAS float* g3 = INP(I_NORMG) + (size_t)(l * 4 + 3) * DM;
    for (int r = gw; r < mrows; r += NGW) {
        Row8 A, B; ld_row_bf16(A, WSP(bf16_t, WS_RB + RB_Y2) + (size_t)(2 * r) * DM, F.lane); ld_row_bf16(B, WSP(bf16_t, WS_RB + RB_Y2) + (size_t)(2 * r + 1) * DM, F.lane);
#pragma unroll
        for (int j = 0; j < 8; ++j) A.v[j] += B.v[j];
        const float ry = row_rstd(A); const GAS float* md = mod_row(F, l, r);
        Row8 X;
        if (r < ML) ld_row_bf16(X, (const GAS bf16_t*)(F.out + (size_t)r * DM), F.lane); else ld_row_f32(X, WSP(float, WS_XC) + (size_t)(r - ML) * DM, F.lane);
#pragma unroll
        for (int j = 0; j < 8; ++j) { const int c = 64 * j + F.lane; X.v[j] += ((const GAS f32x4*)(md + 5 * DM))[c] * (A.v[j] * ry * ((const GAS f32x4*)g3)[c]); }
        if (r >= ML) st_row_f32(X, WSP(float, WS_XC) + (size_t)(r - ML) * DM, F.lane);
        else if (l + 1 < DEPTH) st_row_bf16(X, (GAS bf16_t*)(F.out + (size_t)r * DM), F.lane);
        else st_row_f32(X, F.out + (size_t)r * DM, F.lane);
        if (l + 1 < DEPTH) { const float rx = row_rstd(X); const GAS float* m1 = mod_row(F, l + 1, r);
            st_modnorm8(X, rx, INP(I_NORMG) + (size_t)((l + 1) * 4 + 0) * DM, m1, m1 + DM, WSP(unsigned char, WS_H8) + (size_t)r * DM, F.lane);
            st_modnorm(X, rx, INP(I_NORMG) + (size_t)((l + 1) * 4 + 0) * DM, m1, m1 + DM, WSP(bf16_t, WS_HIN) + (size_t)r * DM, F.lane); }
    }
    if (l + 1 < DEPTH) {
        LAS float* scr = (LAS float*)(F.lds + F.wave * 16384);
        for (int it = gw; it < IT_MOE; it += NGW) cvt_moe_item(F, l + 1, it, scr);
    }
}
__device__ __forceinline__ void ld8bf(float (&o)[8], const GAS bf16_t* p) { const u32x4 w = *(const GAS u32x4*)p; o[0] = bflo(w.x); o[1] = bfhi(w.x); o[2] = bflo(w.y); o[3] = bfhi(w.y); o[4] = bflo(w.z); o[5] = bfhi(w.z); o[6] = bflo(w.w); o[7] = bfhi(w.w); }
__device__ __forceinline__ void st8bf(GAS bf16_t* p, const float (&v)[8]) { u32x4 w; w.x = cvt_pk_bf16(v[0], v[1]); w.y = cvt_pk_bf16(v[2], v[3]); w.z = cvt_pk_bf16(v[4], v[5]); w.w = cvt_pk_bf16(v[6], v[7]); *(GAS u32x4*)p = w; }
__device__ __forceinline__ void phase_finish(Frame& F, int l, int mrows) {
    const int gw = F.vcu * 8 + F.wave, NGW = F.G * 8, c8 = F.lane * 8;
    const GAS bf16_t* Y = WSP(bf16_t, WS_YFB); const GAS bf16_t* U = WSP(bf16_t, WS_RA); GAS bf16_t* BR = WSP(bf16_t, WS_BR); const GAS float* dskip = INP(I_SSDD) + l * 8;
    for (int r = gw; r < mrows; r += NGW) {
        float a[8], b[8], g[8], o[8];
        ld8bf(a, Y + ((size_t)0 * MT + r) * 512 + c8); ld8bf(b, Y + ((size_t)1 * MT + r) * 512 + c8); ld8bf(g, U + (size_t)r * NU + U_MLO + c8);
#pragma unroll
        for (int j = 0; j < 8; ++j) o[j] = (a[j] + b[j]) * sigmoidf_(g[j]);
        st8bf(BR + (size_t)r * DM + c8, o);
        ld8bf(a, Y + ((size_t)2 * MT + r) * 512 + c8); ld8bf(b, Y + ((size_t)3 * MT + r) * 512 + c8); ld8bf(g, U + (size_t)r * NU + U_HGG + c8);
        float ss = 0.f;
#pragma unroll
        for (int j = 0; j < 8; ++j) { a[j] += b[j]; ss += a[j] * a[j]; }
        ss += __shfl_xor(ss, 1); ss += __shfl_xor(ss, 2); ss += __shfl_xor(ss, 4); ss += __shfl_xor(ss, 8);
        const float rh = rsqrtf(ss * (1.f / 128.f) + EPS);
#pragma unroll
        for (int j = 0; j < 8; ++j) o[j] = a[j] * rh * sigmoidf_(g[j]);
        st8bf(BR + (size_t)r * DM + 512 + c8, o);
        ld8bf(a, Y + ((size_t)4 * MT + r) * 512 + c8); ld8bf(b, Y + ((size_t)5 * MT + r) * 512 + c8); ld8bf(g, U + (size_t)r * NU + U_Z + c8);
        float s2 = 0.f, xh[8]; ld8bf(xh, WSP(bf16_t, WS_XBC) + (size_t)r * 1024 + c8); const float dsk = dskip[F.lane >> 3];
#pragma unroll
        for (int j = 0; j < 8; ++j) { o[j] = (a[j] + b[j] + dsk * xh[j]) * siluf_(g[j]); s2 += o[j] * o[j]; }
        s2 = wave_sum(s2);
        if (F.lane == 0) WSP(float, WS_RSSD)[r] = rsqrtf(s2 * (1.f / 512.f) + EPS);
        st8bf(BR + (size_t)r * DM + 1536 + c8, o);
    }
}

__device__ __forceinline__ void phase_ssdconv(Frame& F, int l) {
    const int gw = F.vcu * 8 + F.wave, NGW = F.G * 8, c16 = F.lane * 16;
    const GAS bf16_t* U = WSP(bf16_t, WS_RA); GAS bf16_t* X2 = WSP(bf16_t, WS_XBC);
    float w0[16], w1[16], w2[16], cb[16];
    { const GAS float* cw = INP(I_CONVW) + (size_t)l * 3 * 1024 + c16; const GAS float* bb = INP(I_CONVB) + l * 1024 + c16;
#pragma unroll
      for (int j = 0; j < 16; ++j) { w0[j] = cw[j]; w1[j] = cw[1024 + j]; w2[j] = cw[2048 + j]; cb[j] = bb[j]; } }
    for (int r = gw; r < MT; r += NGW) {
        const int t = r < ML ? (r & (SEQ - 1)) : ((r - ML) & (CTXL - 1)), tn = r < ML ? SEQ : CTXL;
        const GAS bf16_t* up = U + (size_t)r * NU + U_XBC + c16;
        float a[16], p_[16], n_[16];
        { float t8[8]; ld8bf(t8, up);
#pragma unroll
          for (int j = 0; j < 8; ++j) a[j] = t8[j]; ld8bf(t8, up + 8);
#pragma unroll
          for (int j = 0; j < 8; ++j) a[8 + j] = t8[j]; }
        if (t > 0) { float t8[8]; ld8bf(t8, up - NU);
#pragma unroll
          for (int j = 0; j < 8; ++j) p_[j] = t8[j]; ld8bf(t8, up - NU + 8);
#pragma unroll
          for (int j = 0; j < 8; ++j) p_[8 + j] = t8[j]; } else {
#pragma unroll
          for (int j = 0; j < 16; ++j) p_[j] = 0.f; }
        if (t + 1 < tn) { float t8[8]; ld8bf(t8, up + NU);
#pragma unroll
          for (int j = 0; j < 8; ++j) n_[j] = t8[j]; ld8bf(t8, up + NU + 8);
#pragma unroll
          for (int j = 0; j < 8; ++j) n_[8 + j] = t8[j]; } else {
#pragma unroll
          for (int j = 0; j < 16; ++j) n_[j] = 0.f; }
        float o[8];
#pragma unroll
        for (int j = 0; j < 8; ++j) o[j] = siluf_(w0[j] * p_[j] + w1[j] * a[j] + w2[j] * n_[j] + cb[j]);
        st8bf(X2 + (size_t)r * 1024 + c16, o);
#pragma unroll
        for (int j = 0; j < 8; ++j) o[j] = siluf_(w0[8 + j] * p_[8 + j] + w1[8 + j] * a[8 + j] + w2[8 + j] * n_[8 + j] + cb[8 + j]);
        st8bf(X2 + (size_t)r * 1024 + c16 + 8, o);
    }
}

__device__ __forceinline__ void phase_scanprep(Frame& F, int l) {
    const int gw = F.vcu * 8 + F.wave, NGW = F.G * 8, lane = F.lane, r32 = lane & 31, hi = lane >> 5;
    const GAS bf16_t* U = WSP(bf16_t, WS_RA);
    constexpr int N_ML = 64, N_SSD = 64 * 72, N_HG = 64 * 72 * 2, N_MLC = 32 * 72;
    for (int it = gw; it < N_ML + N_SSD + N_HG + N_MLC; it += NGW) {
        if (it >= N_ML + N_SSD + N_HG) {
            const int q = it - (N_ML + N_SSD + N_HG), cg = q % 72, bh = q / 72, b = bh >> 2, h = bh & 3;
            GAS bf16_t* dst = WSP(bf16_t, WS_MLC) + ((size_t)bh * 2304 + 32 * cg) * 384;
#pragma unroll 1
            for (int ib = 0; ib < 3; ++ib) { u32x4 v[8];
#pragma unroll
                for (int i = 0; i < 8; ++i) { const int piece = (ib * 8 + i) * 64 + lane, rr = piece / 48, pc = piece % 48, ci = 32 * cg + rr;
                    const int trow = ci < CTXL ? ML + b * CTXL + ci : b * SEQ + (ci - CTXL);
                    v[i] = *(const GAS u32x4*)(U + (size_t)trow * NU + (pc >> 4) * 512 + h * 128 + (pc & 15) * 8); }
#pragma unroll
                for (int i = 0; i < 8; ++i) { const int piece = (ib * 8 + i) * 64 + lane; *(GAS u32x4*)(dst + (size_t)piece * 8) = v[i]; } }
            continue;
        }
        if (it < N_ML) {
            const int task = it, b = task >> 3, h = (task >> 1) & 3, dir = task & 1, cg = U_MLG + dir * 8 + h;
            const float fbias = INP(I_MLFB)[l * 8 + dir * 4 + h];
            GAS float* rec = WSP(float, WS_MLS) + (size_t)task * 2304 * 8;
            float Fp = 0.f, Bp = -INFINITY;
            const GAS bf16_t* gp = U + (size_t)prow(b, dir, r32) * NU + cg; float gi = bf2f(gp[0]), gf = bf2f(gp[4]);
            for (int c = 0; c < 72; ++c) {
                float ni = 0.f, nf = 0.f;
                if (c + 1 < 72) { const GAS bf16_t* np_ = U + (size_t)prow(b, dir, 32 * (c + 1) + r32) * NU + cg; ni = bf2f(np_[0]); nf = bf2f(np_[4]); }
                const float x_ = gf + fbias, flog = fminf(x_, 0.f) - log1pf(__expf(-fabsf(x_)));
                const float Ft = Fp + scn::scan_add32(flog, r32), bt = gi - Ft, Bt = fmaxf(Bp, scn::scan_max32(bt, r32));
                const float Be = __shfl(Bt, 31, 32), Fe = __shfl(Ft, 31, 32);
                if (hi == 0) { GAS float* rp = rec + (size_t)(32 * c + r32) * 8;
                    *(GAS f32x4*)rp = (f32x4){bt, Bt, __expf(Bp - Bt), __expf(-(Ft + Bt))}; *(GAS f32x4*)(rp + 4) = (f32x4){__expf(bt - Be), __expf(Bp - Be), 0.f, 0.f}; }
                Fp = Fe; Bp = Be; gi = ni; gf = nf;
            }
        } else if (it < N_ML + N_SSD) {
            const int q = it - N_ML, c = q % 72, t3 = q / 72, b = t3 >> 3, hp = (t3 >> 1) & 3, dir = t3 & 1, hd = 2 * hp + hi;
            const float dtb = INP(I_DTB)[l * 16 + dir * 8 + hd], aneg = -__expf(INP(I_ALOG)[l * 16 + dir * 8 + hd]);
            const float xr_ = bf2f(U[(size_t)prow(b, dir, 32 * c + r32) * NU + U_DT + dir * 8 + hd]) + dtb;
            const float dt_ = fmaxf(xr_, 0.f) + log1pf(__expf(-fabsf(xr_))), at = scn::scan_add32(dt_ * aneg, r32), ae = __shfl(at, 31, 32);
            GAS float* rp = WSP(float, WS_SSDS) + ((size_t)((b * 2 + dir) * 8 + hd) * 2304 + 32 * c + r32) * 8;
            *(GAS f32x4*)rp = (f32x4){dt_, at, __expf(at), __expf(ae - at)}; *(GAS f32x4*)(rp + 4) = (f32x4){__expf(ae), 0.f, 0.f, 0.f};
        } else {
            const int q = it - N_ML - N_SSD, half = q & 1, c = (q >> 1) % 72, task = (q >> 1) / 72, b = task >> 3, h = (task >> 1) & 3, dir = task & 1, r16 = lane >> 2, ch0 = half * 64 + 16 * (lane & 3);
            GAS unsigned char* item = F.ws + WS_HGP + (size_t)(task * 72 + c) * HGP_ITEM;
            const GAS float* lbp = WSP(float, WS_TAB) + 2048 + l * 512 + h * 128 + ch0;
            float lb[16], cc[16], ee[16];
#pragma unroll
            for (int j = 0; j < 16; ++j) { lb[j] = lbp[j]; cc[j] = 0.f; ee[j] = 0.f; }
#pragma unroll
            for (int rb = 0; rb < 2; ++rb) {
                const int rloc = rb * 16 + r16; const GAS bf16_t* up = U + (size_t)prow(b, dir, 32 * c + rloc) * NU;
                float fa[8], fb[8], qa[8], qb[8], q1[16], k1[16];
                ld8bf(fa, up + U_HGF + dir * 512 + h * 128 + ch0); ld8bf(fb, up + U_HGF + dir * 512 + h * 128 + ch0 + 8);
                ld8bf(qa, up + U_HGQ + h * 128 + ch0); ld8bf(qb, up + U_HGQ + h * 128 + ch0 + 8);
#pragma unroll
                for (int j = 0; j < 16; ++j) {
                    const float fr_ = j < 8 ? fa[j & 7] : fb[j & 7], qr_ = j < 8 ? qa[j & 7] : qb[j & 7];
                    const float f_ = lb[j] + (1.f - lb[j]) * __builtin_amdgcn_rcpf(1.f + __expf(-fr_)); float x_ = __logf(f_);
                    { const float o = __shfl_up(x_, 4); if (lane >= 4) x_ += o; } { const float o = __shfl_up(x_, 8); if (lane >= 8) x_ += o; }
                    { const float o = __shfl_up(x_, 16); if (lane >= 16) x_ += o; } { const float o = __shfl_up(x_, 32); if (lane >= 32) x_ += o; }
                    const float tot = __shfl(x_, 60 + (lane & 3));
                    float g_;
                    if (rb == 0) { cc[j] = tot; g_ = x_; } else { g_ = cc[j] + x_; ee[j] = cc[j] + tot; }
                    const float e1 = __expf(g_ - cc[j]);
                    q1[j] = qr_ * __builtin_amdgcn_rcpf(1.f + __expf(-qr_)) * e1; k1[j] = (1.f - f_) * __builtin_amdgcn_rcpf(e1);
                }
                float t8[8];
#pragma unroll
                for (int j = 0; j < 8; ++j) t8[j] = q1[j]; st8bf((GAS bf16_t*)(item + scn::rowl(rloc, ch0 * 2)), t8);
#pragma unroll
                for (int j = 0; j < 8; ++j) t8[j] = q1[8 + j]; st8bf((GAS bf16_t*)(item + scn::rowl(rloc, ch0 * 2 + 16)), t8);
#pragma unroll
                for (int j = 0; j < 8; ++j) t8[j] = k1[j]; st8bf((GAS bf16_t*)(item + 8192 + scn::rowl(rloc, ch0 * 2)), t8);
#pragma unroll
                for (int j = 0; j < 8; ++j) t8[j] = k1[8 + j]; st8bf((GAS bf16_t*)(item + 8192 + scn::rowl(rloc, ch0 * 2 + 16)), t8);
            }
            if (r16 == 0) { GAS float* vv = (GAS float*)(item + 16384) + ch0;
#pragma unroll
                for (int j = 0; j < 16; ++j) { vv[j] = __expf(cc[j]); vv[128 + j] = __expf(ee[j] - cc[j]); } }
        }
    }
}
__device__ __forceinline__ void phase_route(Frame& F, int l, int mrows) {
    const int gt = F.vcu * 512 + F.tid, NT_ = F.G * 512; unsigned* cnt = F.ctl + CW_CNT + l * 64;
    GAS int* list = WSP(int, WS_LIST); GAS float* wl = WSP(float, WS_WL);
    for (int r = gt; r < mrows; r += NT_) {
        const GAS float* lg0 = WSP(float, WS_LOG) + (size_t)r * 64;
        f32x4 lgv[9];
#pragma unroll
        for (int q = 0; q < 9; ++q) { lgv[q] = *(const GAS f32x4*)(lg0 + 4 * q);
#pragma unroll
            for (int ks = 1; ks < 4; ++ks) lgv[q] += *(const GAS f32x4*)(lg0 + (size_t)ks * MT * 64 + 4 * q); }
        const f32x4 g = lgv[0]; int gi = 0; float gm = g[0];
#pragma unroll
        for (int i = 1; i < 4; ++i) if (g[i] > gm) { gm = g[i]; gi = i; }
        float gs = 0.f;
#pragma unroll
        for (int i = 0; i < 4; ++i) gs += __expf(g[i] - gm);
        const float gp = 1.f / gs;
        f32x4 e0 = lgv[1], e1 = lgv[2];
        if (gi == 1) { e0 = lgv[3]; e1 = lgv[4]; } else if (gi == 2) { e0 = lgv[5]; e1 = lgv[6]; } else if (gi == 3) { e0 = lgv[7]; e1 = lgv[8]; }
        float ev[8] = {e0[0], e0[1], e0[2], e0[3], e1[0], e1[1], e1[2], e1[3]};
        int i1 = 0; float v1 = ev[0];
#pragma unroll
        for (int i = 1; i < 8; ++i) if (ev[i] > v1) { v1 = ev[i]; i1 = i; }
        int i2 = -1; float v2 = -3.4e38f;
#pragma unroll
        for (int i = 0; i < 8; ++i) if (i != i1 && ev[i] > v2) { v2 = ev[i]; i2 = i; }
        const float w1 = 1.f / (1.f + __expf(v2 - v1)), w2 = 1.f - w1;
        const int ea = gi * 8 + i1, eb = gi * 8 + i2;
        const unsigned pa = atomicAdd(cnt + ea, 1u), pb = atomicAdd(cnt + eb, 1u);
        list[(size_t)ea * MT + pa] = r * 2; wl[(size_t)ea * MT + pa] = w1 * gp;
        list[(size_t)eb * MT + pb] = r * 2 + 1; wl[(size_t)eb * MT + pb] = w2 * gp;
    }
}
__device__ __forceinline__ void moe_tables(Frame& F, int l) {
    __syncthreads();
    if (F.tid < 32) F.MISC[64 + F.tid] = __hip_atomic_load(F.ctl + CW_CNT + l * 64 + F.tid, __ATOMIC_RELAXED, __HIP_MEMORY_SCOPE_AGENT);
    __syncthreads();
    if (F.tid == 0) { int s = 0; for (int e = 0; e < 32; ++e) { F.MISC[16 + e] = s; s += ((int)F.MISC[64 + e] + 255) >> 8; } F.MISC[48] = s; }
    __syncthreads();
}

constexpr int NSTEP = CTXL + SEQ;
namespace scn {
enum { K_ML = 0, K_HG = 1, K_SSD = 2 };
constexpr int GRP_BYTES = 65536, O_QT = 0, O_KT = 8192, O_QH = 16384, O_KH = 24576, O_VT = 34816, O_VH = 45056, O_SC = 55296, O_N = 59392, O_TOT = 60416;
constexpr int NCH = (CTXL + SEQ) / 32;
__device__ __forceinline__ int crow(int r, int hi) { return (r & 3) + 8 * (r >> 2) + 4 * hi; }
template <int OFF> __device__ __forceinline__ s16x4 trr(int base) { s16x4 r; asm volatile("ds_read_b64_tr_b16 %0, %1 offset:%2" : "=&v"(r) : "v"(base), "i"(OFF) : "memory"); return r; }
#define SCN_PK(L, H) (bf16x8){L[0], L[1], L[2], L[3], H[0], H[1], H[2], H[3]}
template <int S1, int CB> __device__ __forceinline__ bf16x8 trfrag(int base) { const s16x4 lo = trr<S1 * 5120 + CB * 2>(base), hi_ = trr<S1 * 5120 + 2560 + CB * 2>(base); return SCN_PK(lo, hi_); }
__device__ __forceinline__ void unpack8(float (&o)[8], u32x4 w) { o[0] = bflo(w.x); o[1] = bfhi(w.x); o[2] = bflo(w.y); o[3] = bfhi(w.y); o[4] = bflo(w.z); o[5] = bfhi(w.z); o[6] = bflo(w.w); o[7] = bfhi(w.w); }
__device__ __forceinline__ u32x4 pack8(const float (&v)[8]) { u32x4 w; w.x = cvt_pk_bf16(v[0], v[1]); w.y = cvt_pk_bf16(v[2], v[3]); w.z = cvt_pk_bf16(v[4], v[5]); w.w = cvt_pk_bf16(v[6], v[7]); return w; }

template <int KIND>
__device__ __forceinline__ void scan_block(Frame& F, int l, int bu) {
    const int tid = F.tid, wave = F.wave, lane = tid & 63, grp = wave >> 2, vb = wave & 3, gt = tid & 255, r32 = lane & 31, hi = lane >> 5;
    LAS char* L = (LAS char*)F.lds + grp * GRP_BYTES;
    const int Lb = (int)(uintptr_t)L;
    const int task = bu * 2 + grp, b = task >> 3, hx = (task >> 1) & 3, dir = task & 1;
    const int srow = gt >> 3, sp = gt & 7;
    const GAS bf16_t* U = WSP(bf16_t, WS_RA); const GAS bf16_t* X2 = WSP(bf16_t, WS_XBC);
    GAS bf16_t* YO = WSP(bf16_t, WS_YFB) + (size_t)(KIND * 2 + dir) * MT * 512;
    LAS float* SC = (LAS float*)(L + O_SC);
    int cq = 0, ck = 0, cv = 0;
    const GAS float* recA = nullptr; const GAS float* recB = nullptr; const GAS unsigned char* hgp = nullptr; const GAS bf16_t* mlc = nullptr;
    if constexpr (KIND == K_ML) { cq = U_MLQ + hx * 128 + 16 * sp; ck = U_MLK + hx * 128 + 16 * sp; cv = U_MLV + hx * 128 + 16 * sp;
        recA = WSP(float, WS_MLS) + (size_t)task * 2304 * 8; recB = recA; mlc = WSP(bf16_t, WS_MLC) + (size_t)(b * 4 + hx) * 2304 * 384; }
    if constexpr (KIND == K_HG) { cv = U_HGI + hx * 128 + 16 * sp; hgp = F.ws + WS_HGP + (size_t)task * 72 * HGP_ITEM; }
    if constexpr (KIND == K_SSD) { const int g = hx >> 1; cq = 768 + g * 128 + 16 * sp; ck = 512 + g * 128 + 16 * sp; cv = hx * 128 + 16 * sp;
        recA = WSP(float, WS_SSDS) + (size_t)((b * 2 + dir) * 8 + 2 * hx + (sp >> 2)) * 2304 * 8;
        recB = WSP(float, WS_SSDS) + (size_t)((b * 2 + dir) * 8 + 2 * hx + hi) * 2304 * 8; }
    f32x16 S[4];
#pragma unroll
    for (int k = 0; k < 4; ++k)
#pragma unroll
        for (int r = 0; r < 16; ++r) S[k][r] = 0.f;
    if (KIND == K_ML) { LAS float* nn = (LAS float*)(L + O_N); nn[gt] = 0.f; }
    const int i16 = lane & 15, g4 = lane >> 4;
    const int trb = Lb + (4 * hi + (i16 >> 2)) * 320 + (16 * (g4 & 1) + 4 * (i16 & 3)) * 2;
    struct Pre { u32x4 a0, a1, b0, b1, c0, c1; f32x4 sA, sB; float g1; }; Pre P0, P1;
#define SCN_LOAD(P, c_) do { const int c__ = (c_); const int row_ = prow(b, dir, 32 * c__ + srow); \
        if constexpr (KIND == K_SSD) { const GAS bf16_t* xp = X2 + (size_t)row_ * 1024; P.a0 = *(const GAS u32x4*)(xp + cq); P.a1 = *(const GAS u32x4*)(xp + cq + 8); P.b0 = *(const GAS u32x4*)(xp + ck); P.b1 = *(const GAS u32x4*)(xp + ck + 8); P.c0 = *(const GAS u32x4*)(xp + cv); P.c1 = *(const GAS u32x4*)(xp + cv + 8); \
            P.sA = *(const GAS f32x4*)(recA + (size_t)(32 * c__ + srow) * 8); P.sB = *(const GAS f32x4*)(recB + (size_t)(32 * c__ + r32) * 8); P.g1 = recB[(size_t)(32 * c__ + r32) * 8 + 4]; } \
        else if constexpr (KIND == K_ML) { const int p__ = 32 * c__ + srow; const int ci_ = p__ < CTXL ? (dir ? CTXL - 1 - p__ : p__) : CTXL + (dir ? SEQ - 1 - (p__ - CTXL) : p__ - CTXL); \
            const GAS bf16_t* up = mlc + (size_t)ci_ * 384 + 16 * sp; P.a0 = *(const GAS u32x4*)(up); P.a1 = *(const GAS u32x4*)(up + 8); P.b0 = *(const GAS u32x4*)(up + 128); P.b1 = *(const GAS u32x4*)(up + 136); P.c0 = *(const GAS u32x4*)(up + 256); P.c1 = *(const GAS u32x4*)(up + 264); \
            P.sA = *(const GAS f32x4*)(recA + (size_t)(32 * c__ + srow) * 8 + 4); P.sB = *(const GAS f32x4*)(recB + (size_t)(32 * c__ + r32) * 8); P.g1 = recB[(size_t)(32 * c__ + r32) * 8 + 5]; } \
        else { const GAS unsigned char* it_ = hgp + (size_t)c__ * HGP_ITEM; const int ra_ = rowl(srow, 32 * sp), rb_ = rowl(srow, 32 * sp + 16); \
            P.a0 = *(const GAS u32x4*)(it_ + ra_); P.a1 = *(const GAS u32x4*)(it_ + rb_); P.b0 = *(const GAS u32x4*)(it_ + 8192 + ra_); P.b1 = *(const GAS u32x4*)(it_ + 8192 + rb_); \
            const GAS bf16_t* up = U + (size_t)row_ * NU; P.c0 = *(const GAS u32x4*)(up + cv); P.c1 = *(const GAS u32x4*)(up + cv + 8); \
            if (gt < 64) P.sA = *(const GAS f32x4*)((const GAS float*)(it_ + 16384) + 4 * gt); } } while (0)
#define SCN_STAGE(P) do { \
        const int ra = rowl(srow, 32 * sp), rb = rowl(srow, 32 * sp + 16), ta = srow * 320 + 32 * sp; \
        *(LAS u32x4*)(L + O_QT + ra) = P.a0; *(LAS u32x4*)(L + O_QT + rb) = P.a1; *(LAS u32x4*)(L + O_KT + ra) = P.b0; *(LAS u32x4*)(L + O_KT + rb) = P.b1; \
        if constexpr (KIND == K_ML) { \
            if (vb == 0 && hi == 0) { SC[r32] = P.sB[0]; SC[32 + r32] = P.sB[1]; SC[64 + r32] = P.sB[2]; SC[96 + r32] = P.sB[3]; if (r32 == 0) SC[128] = P.g1; } \
            const float win = P.sA[0]; float ka[8], kb_[8]; unpack8(ka, P.b0); unpack8(kb_, P.b1); \
            _Pragma("unroll") for (int j = 0; j < 8; ++j) { ka[j] *= win; kb_[j] *= win; } \
            *(LAS u32x4*)(L + O_KH + ta) = pack8(ka); *(LAS u32x4*)(L + O_KH + ta + 16) = pack8(kb_); *(LAS u32x4*)(L + O_VT + ta) = P.c0; *(LAS u32x4*)(L + O_VT + ta + 16) = P.c1; \
        } else if constexpr (KIND == K_SSD) { \
            if (vb == 0) { SC[hi * 32 + r32] = P.sB[1]; SC[64 + hi * 32 + r32] = P.sB[2]; if (r32 == 0) SC[128 + hi] = P.g1; } \
            const float dts = P.sA[0], vsc = P.sA[3]; float va[8], vb_[8]; unpack8(va, P.c0); unpack8(vb_, P.c1); \
            *(LAS u32x4*)(L + O_KH + ta) = P.b0; *(LAS u32x4*)(L + O_KH + ta + 16) = P.b1; \
            _Pragma("unroll") for (int j = 0; j < 8; ++j) { va[j] *= dts; vb_[j] *= dts; } \
            *(LAS u32x4*)(L + O_VT + ta) = pack8(va); *(LAS u32x4*)(L + O_VT + ta + 16) = pack8(vb_); \
            _Pragma("unroll") for (int j = 0; j < 8; ++j) { va[j] *= vsc; vb_[j] *= vsc; } \
            *(LAS u32x4*)(L + O_VH + ta) = pack8(va); *(LAS u32x4*)(L + O_VH + ta + 16) = pack8(vb_); \
        } else { \
            *(LAS u32x4*)(L + O_KH + ta) = P.b0; *(LAS u32x4*)(L + O_KH + ta + 16) = P.b1; *(LAS u32x4*)(L + O_VT + ta) = P.c0; *(LAS u32x4*)(L + O_VT + ta + 16) = P.c1; \
            if (gt < 64) *(LAS f32x4*)(SC + 4 * gt) = P.sA; \
        } } while (0)
    constexpr int OQH = O_QT, OVH = (KIND == K_SSD) ? O_VH : O_VT;
    auto compute = [&](const int c) __attribute__((always_inline)) {
        const int hh = vb >> 1;
        if constexpr (KIND == K_HG) {
#pragma unroll
            for (int kb = 0; kb < 4; ++kb)
#pragma unroll
                for (int r = 0; r < 16; ++r) S[kb][r] *= SC[32 * kb + crow(r, hi)];
        }
        f32x16 acc;
#pragma unroll
        for (int r = 0; r < 16; ++r) acc[r] = 0.f;
        if (c > 0) {
#pragma unroll
            for (int kb = 0; kb < 4; ++kb)
#pragma unroll
                for (int s1 = 0; s1 < 2; ++s1) {
                    u32x4 aw; aw.x = cvt_pk_bf16(S[kb][8 * s1 + 0], S[kb][8 * s1 + 1]); aw.y = cvt_pk_bf16(S[kb][8 * s1 + 2], S[kb][8 * s1 + 3]); aw.z = cvt_pk_bf16(S[kb][8 * s1 + 4], S[kb][8 * s1 + 5]); aw.w = cvt_pk_bf16(S[kb][8 * s1 + 6], S[kb][8 * s1 + 7]);
                    const int cb0 = (32 * kb + 16 * s1 + 4 * hi) * 2;
                    const u32x2 lo = *(const LAS u32x2*)(L + OQH + rowl(r32, cb0)), hi2 = *(const LAS u32x2*)(L + OQH + rowl(r32, cb0 + 16));
                    const u32x4 bw = {lo.x, lo.y, hi2.x, hi2.y};
                    acc = __builtin_amdgcn_mfma_f32_32x32x16_bf16(__builtin_bit_cast(bf16x8, aw), __builtin_bit_cast(bf16x8, bw), acc, 0, 0, 0);
                }
            if constexpr (KIND == K_ML) { const float w = SC[64 + r32];
#pragma unroll
                for (int r = 0; r < 16; ++r) acc[r] *= w; }
            if constexpr (KIND == K_SSD) { const float w = SC[64 + hh * 32 + r32];
#pragma unroll
                for (int r = 0; r < 16; ++r) acc[r] *= w; }
        }
        f32x16 p;
#pragma unroll
        for (int r = 0; r < 16; ++r) p[r] = 0.f;
#pragma unroll
        for (int kk = 0; kk < 8; ++kk) { const int cb0 = (16 * kk + 8 * hi) * 2;
            const bf16x8 a = *(const LAS bf16x8*)(L + O_KT + rowl(r32, cb0)), bq = *(const LAS bf16x8*)(L + O_QT + rowl(r32, cb0));
            p = __builtin_amdgcn_mfma_f32_32x32x16_bf16(a, bq, p, 0, 0, 0); }
        float den = 0.f;
        if constexpr (KIND == K_ML) { const float Bt = SC[32 + r32];
#pragma unroll
            for (int q = 0; q < 4; ++q) {
                const f32x4 bs = *(const LAS f32x4*)(SC + 8 * q + 4 * hi);
#pragma unroll
                for (int j = 0; j < 4; ++j) { const int r = 4 * q + j, s_ = crow(r, hi); float w = __expf(fminf(bs[j] - Bt, 0.f)); w = s_ <= r32 ? w : 0.f; p[r] *= w; den += p[r]; }
                __builtin_amdgcn_sched_barrier(0);
            }
            { auto rr = __builtin_amdgcn_permlane32_swap(__float_as_uint(den), __float_as_uint(den), false, false); den = __uint_as_float(rr[0]) + __uint_as_float(rr[1]); }
        } else if constexpr (KIND == K_SSD) { const float at = SC[hh * 32 + r32];
            f32x4 as_[4];
#pragma unroll
            for (int q = 0; q < 4; ++q) as_[q] = *(const LAS f32x4*)(SC + hh * 32 + 8 * q + 4 * hi);
#pragma unroll
            for (int r = 0; r < 16; ++r) { const int s_ = crow(r, hi); float w = __expf(fminf(at - as_[r >> 2][r & 3], 0.f)); p[r] *= s_ <= r32 ? w : 0.f; }
        } else {
#pragma unroll
            for (int r = 0; r < 16; ++r) { if (crow(r, hi) > r32) p[r] = 0.f; }
        }
        {
            u32x4 w0, w1; w0.x = cvt_pk_bf16(p[0], p[1]); w0.y = cvt_pk_bf16(p[2], p[3]); w0.z = cvt_pk_bf16(p[4], p[5]); w0.w = cvt_pk_bf16(p[6], p[7]);
            w1.x = cvt_pk_bf16(p[8], p[9]); w1.y = cvt_pk_bf16(p[10], p[11]); w1.z = cvt_pk_bf16(p[12], p[13]); w1.w = cvt_pk_bf16(p[14], p[15]);
            const int vbase = trb + O_VT + vb * 64;
            const bf16x8 v0 = trfrag<0, 0>(vbase), v1 = trfrag<1, 0>(vbase);
            asm volatile("s_waitcnt lgkmcnt(0)" ::: "memory"); __builtin_amdgcn_sched_barrier(0);
            acc = __builtin_amdgcn_mfma_f32_32x32x16_bf16(v0, __builtin_bit_cast(bf16x8, w0), acc, 0, 0, 0);
            acc = __builtin_amdgcn_mfma_f32_32x32x16_bf16(v1, __builtin_bit_cast(bf16x8, w1), acc, 0, 0, 0);
        }
        float oscale = 1.f;
        if constexpr (KIND == K_ML) {
            LAS const float* nn = (LAS const float*)(L + O_N) + (c & 1) * 128;
            float ds = 0.f;
            if (c > 0) {
#pragma unroll
                for (int j = 0; j < 8; ++j) { const u32x4 qw = *(const LAS u32x4*)(L + O_QT + rowl(r32, (64 * hi + 8 * j) * 2)); float q8[8]; unpack8(q8, qw);
                    const f32x4 n0 = *(const LAS f32x4*)(nn + 64 * hi + 8 * j), n1 = *(const LAS f32x4*)(nn + 64 * hi + 8 * j + 4);
                    ds += (q8[0] * n0[0] + q8[1] * n0[1]) + (q8[2] * n0[2] + q8[3] * n0[3]) + (q8[4] * n1[0] + q8[5] * n1[1]) + (q8[6] * n1[2] + q8[7] * n1[3]); }
                { auto rr = __builtin_amdgcn_permlane32_swap(__float_as_uint(ds), __float_as_uint(ds), false, false); ds = __uint_as_float(rr[0]) + __uint_as_float(rr[1]); }
                ds *= SC[64 + r32];
            }
            oscale = __builtin_amdgcn_rcpf(fmaxf(fabsf(den + ds), SC[96 + r32]));
            { const int k = 32 * vb + r32; float sm = 0.f;
#pragma unroll
              for (int s_ = 0; s_ < 16; ++s_) sm += bf2f(*(const LAS bf16_t*)(L + O_KH + (16 * hi + s_) * 320 + k * 2));
              { auto rr = __builtin_amdgcn_permlane32_swap(__float_as_uint(sm), __float_as_uint(sm), false, false); sm = __uint_as_float(rr[0]) + __uint_as_float(rr[1]); }
              LAS float* n2 = (LAS float*)(L + O_N) + ((c + 1) & 1) * 128;
              if (hi == 0) n2[k] = SC[128] * nn[k] + sm; }
        }
        { const int orow = prow(b, dir, 32 * c + r32); GAS bf16_t* yp = YO + (size_t)orow * 512 + hx * 128 + 32 * vb + 4 * hi;
#pragma unroll
          for (int q = 0; q < 4; ++q) { u32x2 w; w.x = cvt_pk_bf16(acc[4 * q] * oscale, acc[4 * q + 1] * oscale); w.y = cvt_pk_bf16(acc[4 * q + 2] * oscale, acc[4 * q + 3] * oscale); *(GAS u32x2*)(yp + 8 * q) = w; } }
        {
            const int kbase = trb + O_KH, vbase = trb + OVH + vb * 64;
            const bf16x8 vh0 = trfrag<0, 0>(vbase), vh1 = trfrag<1, 0>(vbase);
            const bf16x8 k00 = trfrag<0, 0>(kbase), k01 = trfrag<1, 0>(kbase), k10 = trfrag<0, 32>(kbase), k11 = trfrag<1, 32>(kbase);
            const bf16x8 k20 = trfrag<0, 64>(kbase), k21 = trfrag<1, 64>(kbase), k30 = trfrag<0, 96>(kbase), k31 = trfrag<1, 96>(kbase);
            if constexpr (KIND != K_HG) { const float rd = KIND == K_ML ? SC[128] : SC[128 + hh];
#pragma unroll
                for (int kb = 0; kb < 4; ++kb)
#pragma unroll
                    for (int r = 0; r < 16; ++r) S[kb][r] *= rd; }
            asm volatile("s_waitcnt lgkmcnt(0)" ::: "memory"); __builtin_amdgcn_sched_barrier(0);
            S[0] = __builtin_amdgcn_mfma_f32_32x32x16_bf16(k00, vh0, S[0], 0, 0, 0); S[0] = __builtin_amdgcn_mfma_f32_32x32x16_bf16(k01, vh1, S[0], 0, 0, 0);
            S[1] = __builtin_amdgcn_mfma_f32_32x32x16_bf16(k10, vh0, S[1], 0, 0, 0); S[1] = __builtin_amdgcn_mfma_f32_32x32x16_bf16(k11, vh1, S[1], 0, 0, 0);
            S[2] = __builtin_amdgcn_mfma_f32_32x32x16_bf16(k20, vh0, S[2], 0, 0, 0); S[2] = __builtin_amdgcn_mfma_f32_32x32x16_bf16(k21, vh1, S[2], 0, 0, 0);
            S[3] = __builtin_amdgcn_mfma_f32_32x32x16_bf16(k30, vh0, S[3], 0, 0, 0); S[3] = __builtin_amdgcn_mfma_f32_32x32x16_bf16(k31, vh1, S[3], 0, 0, 0);
            if constexpr (KIND == K_HG) {
#pragma unroll
                for (int kb = 0; kb < 4; ++kb)
#pragma unroll
                    for (int r = 0; r < 16; ++r) S[kb][r] *= SC[128 + 32 * kb + crow(r, hi)];
            }
        }
    };
    if constexpr (KIND == K_ML) {
        SCN_LOAD(P0, 0); SCN_LOAD(P1, 1);
        __syncthreads();
        SCN_STAGE(P0);
        __syncthreads();
        for (int c = 0; c < NCH; c += 2) {
            if (c + 2 < NCH) SCN_LOAD(P0, c + 2);
            compute(c);
            __syncthreads();
            SCN_STAGE(P1);
            __syncthreads();
            if (c + 3 < NCH) SCN_LOAD(P1, c + 3);
            compute(c + 1);
            __syncthreads();
            if (c + 2 < NCH) { SCN_STAGE(P0); }
            __syncthreads();
        }
    } else {
        SCN_LOAD(P0, 0);
        __syncthreads();
        SCN_STAGE(P0);
        __syncthreads();
        for (int c = 0; c < NCH; ++c) {
            if (c + 1 < NCH) SCN_LOAD(P0, c + 1);
            compute(c);
            __syncthreads();
            if (c + 1 < NCH) { SCN_STAGE(P0); }
            __syncthreads();
        }
    }
#undef SCN_LOAD
#undef SCN_STAGE
}
}

namespace att {
constexpr int KVBLK = 64, SHM_V = 64 * 128 * 2, SHM_K = 64 * 192 * 2;
constexpr float THRL = 11.5f;
#define AKSWZ(row, colB) ((row) * 384 + ((colB) ^ (((row) & 7) << 4)))
#define ASBAR() __builtin_amdgcn_sched_barrier(0)
__device__ __forceinline__ int crow(int r, int hi) { return (r & 3) + 8 * (r >> 2) + 4 * hi; }
__device__ __forceinline__ void partialSM(f32x16& p0, f32x16& p1, float& m_reg, float& mn, float& alpha) {
    float pmax = p0[0];
#pragma unroll
    for (int r = 1; r < 16; ++r) pmax = fmaxf(pmax, p0[r]);
#pragma unroll
    for (int r = 0; r < 16; ++r) pmax = fmaxf(pmax, p1[r]);
    { auto rr = __builtin_amdgcn_permlane32_swap(__float_as_uint(pmax), __float_as_uint(pmax), false, false); pmax = fmaxf(__uint_as_float(rr[0]), __uint_as_float(rr[1])); }
    if (__builtin_expect(__all(pmax - m_reg <= THRL), 1)) { mn = m_reg; alpha = 1.f; }
    else { mn = fmaxf(m_reg, pmax); alpha = __builtin_amdgcn_exp2f(m_reg - mn); m_reg = mn; }
#pragma unroll
    for (int r = 0; r < 16; ++r) p0[r] = __builtin_amdgcn_exp2f(p0[r] - mn);
#pragma unroll
    for (int r = 0; r < 16; ++r) p1[r] = p1[r] - mn;
}
__device__ __forceinline__ void finishSM(f32x16& p0, f32x16& p1, float alpha, float& l_reg, bf16x8& pa0, bf16x8& pa1, bf16x8& pa2, bf16x8& pa3) {
#pragma unroll
    for (int r = 0; r < 16; ++r) p1[r] = __builtin_amdgcn_exp2f(p1[r]);
    float ps = 0;
#pragma unroll
    for (int r = 0; r < 16; ++r) ps += p0[r];
#pragma unroll
    for (int r = 0; r < 16; ++r) ps += p1[r];
    { auto rr = __builtin_amdgcn_permlane32_swap(__float_as_uint(ps), __float_as_uint(ps), false, false); ps = __uint_as_float(rr[0]) + __uint_as_float(rr[1]); }
    l_reg = l_reg * alpha + ps;
#define APK4(P, BASE, OUT) do { unsigned a0 = cvt_pk_bf16(P[BASE + 0], P[BASE + 1]), a1 = cvt_pk_bf16(P[BASE + 2], P[BASE + 3]);   \
    unsigned b0 = cvt_pk_bf16(P[BASE + 4], P[BASE + 5]), b1 = cvt_pk_bf16(P[BASE + 6], P[BASE + 7]);                              \
    auto r0 = __builtin_amdgcn_permlane32_swap(a0, b0, false, false); auto r1 = __builtin_amdgcn_permlane32_swap(a1, b1, false, false); \
    u32x4 w = {r0[0], r1[0], r0[1], r1[1]}; OUT = __builtin_bit_cast(bf16x8, w); } while (0)
    APK4(p0, 0, pa0); APK4(p0, 8, pa1); APK4(p1, 0, pa2); APK4(p1, 8, pa3);
#undef APK4
}
__device__ __forceinline__ void qkt(f32x16& p0, f32x16& p1, const LAS char* Ks, const bf16x8* qr, int r32, int hi) {
    p0 = f32x16{}; p1 = f32x16{};
#pragma unroll
    for (int d0 = 0; d0 < 12; ++d0) { const int cb = (d0 * 16 + hi * 8) * 2;
        const bf16x8 b0 = *(const LAS bf16x8*)(Ks + AKSWZ(r32, cb));
        const bf16x8 b1 = *(const LAS bf16x8*)(Ks + AKSWZ(32 + r32, cb));
        p0 = __builtin_amdgcn_mfma_f32_32x32x16_bf16(b0, qr[d0], p0, 0, 0, 0);
        p1 = __builtin_amdgcn_mfma_f32_32x32x16_bf16(b1, qr[d0], p1, 0, 0, 0); }
}
__device__ __forceinline__ int v_st(int k, int c) { const int kk = (k & ~0xC) | ((k & 4) << 1) | ((k & 8) >> 1); return ((kk >> 3) * 4 + (c >> 5)) * 512 + ((kk & 7) * 32 + (c & 31)) * 2; }
__device__ __forceinline__ int v_rd_base(int lane) { return ((lane & 3) << 3) | (((lane >> 2) & 3) << 6) | (((lane >> 4) & 1) << 5) | (((lane >> 5) & 1) << 8); }
constexpr int v_rd_off(int d0, int ks, int half) { return d0 * 512 + ks * 4096 + half * 2048; }
template <int OFF> __device__ __forceinline__ s16x4 tr_read(int vb) { s16x4 r; asm volatile("ds_read_b64_tr_b16 %0, %1 offset:%2" : "=&v"(r) : "v"(vb), "i"(OFF) : "memory"); return r; }
template <int D0> __device__ __forceinline__ void pv_one(f32x16& od, int vb, bf16x8 pa0, bf16x8 pa1, bf16x8 pa2, bf16x8 pa3) {
    const s16x4 l0 = tr_read<v_rd_off(D0, 0, 0)>(vb), h0 = tr_read<v_rd_off(D0, 0, 1)>(vb), l1 = tr_read<v_rd_off(D0, 1, 0)>(vb), h1 = tr_read<v_rd_off(D0, 1, 1)>(vb);
    const s16x4 l2 = tr_read<v_rd_off(D0, 2, 0)>(vb), h2 = tr_read<v_rd_off(D0, 2, 1)>(vb), l3 = tr_read<v_rd_off(D0, 3, 0)>(vb), h3 = tr_read<v_rd_off(D0, 3, 1)>(vb);
    asm volatile("s_waitcnt lgkmcnt(0)" ::: "memory"); ASBAR();
#define APK(L, H) (bf16x8){L[0], L[1], L[2], L[3], H[0], H[1], H[2], H[3]}
    od = __builtin_amdgcn_mfma_f32_32x32x16_bf16(pa0, APK(l0, h0), od, 0, 0, 0);
    od = __builtin_amdgcn_mfma_f32_32x32x16_bf16(pa1, APK(l1, h1), od, 0, 0, 0);
    od = __builtin_amdgcn_mfma_f32_32x32x16_bf16(pa2, APK(l2, h2), od, 0, 0, 0);
    od = __builtin_amdgcn_mfma_f32_32x32x16_bf16(pa3, APK(l3, h3), od, 0, 0, 0);
#undef APK
}
__device__ __forceinline__ void pv_d0(f32x16* o, int vb, bf16x8 pa0, bf16x8 pa1, bf16x8 pa2, bf16x8 pa3) {
    pv_one<0>(o[0], vb, pa0, pa1, pa2, pa3); pv_one<1>(o[1], vb, pa0, pa1, pa2, pa3); pv_one<2>(o[2], vb, pa0, pa1, pa2, pa3); pv_one<3>(o[3], vb, pa0, pa1, pa2, pa3);
}
__device__ __forceinline__ void attn_unit(const GAS bf16_t* __restrict__ QB, const GAS bf16_t* __restrict__ KVB, const GAS bf16_t* __restrict__ U, GAS bf16_t* __restrict__ BR,
                                          int qrow0, int h, int kctx0, int klat0, int nct, int NT, LAS char* lds) {
    const int tid = opaque_tid(), wid = tid >> 6, lane = tid & 63, r32 = lane & 31, hi = lane >> 5;
    LAS char* V_lds = lds; LAS char* K_lds = lds + 2 * SHM_V;
    LAS float* ws = (LAS float*)(lds + 2 * SHM_V + 2 * SHM_K) + wid * 64; LAS float* li_l = ws; LAS float* al_l = ws + 32;
    float m_reg = -1e30f, l_reg = 0; f32x16 o[4] = {}; bf16x8 qr[12];
    const GAS bf16_t* Qw = QB + (size_t)(qrow0 + wid * 32 + r32) * 768;
#pragma unroll
    for (int d0 = 0; d0 < 8; ++d0) qr[d0] = *(const GAS bf16x8*)(Qw + h * 128 + d0 * 16 + hi * 8);
#pragma unroll
    for (int d0 = 8; d0 < 12; ++d0) qr[d0] = *(const GAS bf16x8*)(Qw + 512 + h * 64 + (d0 - 8) * 16 + hi * 8);
    const int sr = tid >> 4, sc = (tid & 15) * 8, vst0 = v_st(sr, sc), vst1 = v_st(32 + sr, sc), rr_ = tid >> 3, rc_ = (tid & 7) * 8;
    const int vb0 = (int)(uintptr_t)V_lds + v_rd_base(lane);
    struct { bf16x8 vs0, vs1, ks0, ks1, kr; } sr_[1];
#define ASLOAD(i, j_) do { const int j__ = (j_); const int k0 = j__ < nct ? kctx0 + 64 * j__ : klat0 + 64 * (j__ - nct); \
    sr_[i].vs0 = *(const GAS bf16x8*)(KVB + (size_t)(k0 + sr) * 1024 + 512 + h * 128 + sc); sr_[i].vs1 = *(const GAS bf16x8*)(KVB + (size_t)(k0 + 32 + sr) * 1024 + 512 + h * 128 + sc); \
    sr_[i].ks0 = *(const GAS bf16x8*)(KVB + (size_t)(k0 + sr) * 1024 + h * 128 + sc); sr_[i].ks1 = *(const GAS bf16x8*)(KVB + (size_t)(k0 + 32 + sr) * 1024 + h * 128 + sc); \
    sr_[i].kr = *(const GAS bf16x8*)(U + (size_t)(k0 + rr_) * NU + U_KR + rc_); } while (0)
#define ASWRITE(b, i) do { *(LAS bf16x8*)(V_lds + (b) * SHM_V + vst0) = sr_[i].vs0; *(LAS bf16x8*)(V_lds + (b) * SHM_V + vst1) = sr_[i].vs1; \
    *(LAS bf16x8*)(K_lds + (b) * SHM_K + AKSWZ(sr, sc * 2)) = sr_[i].ks0; *(LAS bf16x8*)(K_lds + (b) * SHM_K + AKSWZ(32 + sr, sc * 2)) = sr_[i].ks1; \
    *(LAS bf16x8*)(K_lds + (b) * SHM_K + AKSWZ(rr_, 256 + rc_ * 2)) = sr_[i].kr; } while (0)
#define ASWAIT() asm volatile("s_waitcnt vmcnt(0)" ::: "memory")
#define ARESC(a) do { if (__any((a) < 1.f)) { if (hi == 0) al_l[r32] = (a); asm volatile("s_waitcnt lgkmcnt(0)" ::: "memory"); \
    _Pragma("unroll") for (int d = 0; d < 4; ++d) _Pragma("unroll") for (int r = 0; r < 16; ++r) o[d][r] *= al_l[crow(r, hi)]; } } while (0)
    f32x16 pA0, pA1; float mnA, alA; bf16x8 pa0, pa1, pa2, pa3;
    ASLOAD(0, 0); asm volatile("s_waitcnt vmcnt(0)" ::: "memory"); ASWRITE(0, 0); __syncthreads();
    for (int j = 0; j < NT; ++j) {
        const int bsel = j & 1;
        if (j + 1 < NT) ASLOAD(0, j + 1);
        ASBAR(); qkt(pA0, pA1, K_lds + bsel * SHM_K, qr, r32, hi);
        partialSM(pA0, pA1, m_reg, mnA, alA);
        ARESC(alA);
        finishSM(pA0, pA1, alA, l_reg, pa0, pa1, pa2, pa3); ASBAR();
        pv_d0(o, vb0 + bsel * SHM_V, pa0, pa1, pa2, pa3);
        if (j + 1 < NT) { ASWAIT(); ASWRITE(bsel ^ 1, 0); }
        __syncthreads();
    }
    if (hi == 0) li_l[r32] = l_reg; asm volatile("s_waitcnt lgkmcnt(0)" ::: "memory");
    GAS bf16_t* Ow = BR + (size_t)(qrow0 + wid * 32) * DM + 1024 + h * 128;
#pragma unroll
    for (int r = 0; r < 16; ++r) { const int orow = crow(r, hi); const float rl = __builtin_amdgcn_rcpf(li_l[orow]);
#pragma unroll
        for (int d0 = 0; d0 < 4; ++d0) Ow[(size_t)orow * DM + d0 * 32 + r32] = f2bf(o[d0][r] * rl); }
    __syncthreads();
#undef ASLOAD
#undef ASWRITE
#undef ASWAIT
#undef ARESC
}
}

constexpr int PH_PER_LAYER = 13, NPHASE = 2 + DEPTH * PH_PER_LAYER;
struct Args { const float* in[N_IN]; float* out; unsigned char* ws; int ph_lo, ph_hi; };
static_assert(sizeof(Args) == N_IN * 8 + 8 + 8 + 8, "Args has no padding");

#ifndef REP_G1
#define REP_G1 1
#endif
#ifndef REP_G2
#define REP_G2 1
#endif
#ifndef REP_G5
#define REP_G5 1
#endif
#ifndef REP_G6
#define REP_G6 1
#endif
#ifndef REP_G8
#define REP_G8 1
#endif
#ifndef REP_G10
#define REP_G10 1
#endif
#ifndef REP_G11
#define REP_G11 1
#endif
#ifndef REP_R4
#define REP_R4 1
#endif
#ifndef PH_MASK
#define PH_MASK 0xffffffffu
#endif
#define IN(k) (lo <= (k) && (k) < hi)
#define EN(j) ((PH_MASK >> (j)) & 1u)
#ifndef SUBMASK
#define SUBMASK 7
#endif
#define REFRESH() do { F.tid = opaque_tid(); F.lane = F.tid & 63; F.wave = __builtin_amdgcn_readfirstlane(F.tid >> 6); \
    F.ws = (GAS unsigned char*)opaque_ptr(args.ws); F.ctl = (unsigned*)opaque_ptr(args.ws + WS_CTL); F.out = (GAS float*)opaque_ptr(args.out); } while (0)
#define SEAM(k) do { if (IN(k) && IN((k) + 1)) xcd_barrier(bar); } while (0)
template <int l> __device__ __forceinline__ void layer_phases(Frame& F, const Args& args, const XcdBarrier& bar, const int lo, const int hi, char* ldsg) {
        const int pb = 2 + l * PH_PER_LAYER;
        const int mrows = (l + 1 < DEPTH) ? MT : ML;
        GAS bf16_t* const Hb = WSP(bf16_t, WS_H); GAS bf16_t* const Ub = WSP(bf16_t, WS_RA);
        if (IN(pb + 0) && EN(0) && l == 0) { REFRESH(); phase_rwA(F, l); }
        if (l == 0) SEAM(pb + 0);
        if (IN(pb + 1) && EN(1)) for (int rp_ = 0; rp_ < REP_G1; ++rp_) { REFRESH();
            EpiWin E{Ub, WSP(float, WS_SSQ), WSP(float, WS_TAB)};
            { Gemm g{WSP(bf16_t, WS_HIN), WSP(bf16_t, WS_WIN) + (size_t)l * NU * DM, DM, DM, DM};
              WinSched S; S.gs.init(MT / 256, 12, F.G, (int)blockIdx.x, (size_t)256 * DM * 2, (size_t)256 * DM * 2, 0, 0); S.mode = 1;
              pg8::gemm_phase<EpiWin, WinSched, false>(F.lds, g, S, E); }
            { Gemm g{(const GAS bf16_t*)WSP(unsigned char, WS_H8), (const GAS bf16_t*)(WSP(unsigned char, WS_WIN8) + (size_t)l * NU * DM), DM / 2, DM / 2, DM / 2};
              WinSched S; S.gs.init(MT / 256, 16, F.G, (int)((blockIdx.x + 160) & 255), (size_t)256 * DM, (size_t)256 * DM, 0, 0); S.mode = 0;
              pg8::gemm_phase<EpiWin, WinSched, false, true>(F.lds, g, S, E); }
        }
        SEAM(pb + 1);
        if (IN(pb + 2) && EN(2)) for (int rp_ = 0; rp_ < REP_G2; ++rp_) { REFRESH();
            if (SUBMASK & 1) { Gemm g{Ub, WSP(bf16_t, WS_WUQ) + (size_t)l * 768 * 512, NU, 512, 512};
              GridSched S; S.init(MT / 256, 3, F.G, (int)blockIdx.x, (size_t)256 * NU * 2, (size_t)256 * 512 * 2, (size_t)U_CQ * 2, 0);
              EpiMlaQ E{WSP(bf16_t, WS_QB), WSP(float, WS_SSQ), WSP(float, WS_TAB)};
              pg8::gemm_phase<EpiMlaQ, GridSched, false>(F.lds, g, S, E); }
            if (SUBMASK & 2) { Gemm g{Ub, WSP(bf16_t, WS_WUKV) + (size_t)l * 1024 * 256, NU, 256, 256};
              GridSched S; S.init(MT / 256, 4, F.G, (int)blockIdx.x, (size_t)256 * NU * 2, (size_t)256 * 256 * 2, (size_t)U_CKV * 2, 0);
              EpiMlaKV E{WSP(bf16_t, WS_KVB), WSP(float, WS_SSQ)};
              pg8::gemm_phase<EpiMlaKV, GridSched, false>(F.lds, g, S, E); }
            if (SUBMASK & 4) { Gemm g{(const GAS bf16_t*)WSP(unsigned char, WS_H8), (const GAS bf16_t*)(WSP(unsigned char, WS_WG) + (size_t)l * 8192 * DM), DM / 2, DM / 2, DM / 2};
              GridSched S; S.init(mrows / 256, 32, F.G, (int)blockIdx.x, (size_t)256 * DM, (size_t)256 * DM, 0, 0);
              EpiGate E{WSP(unsigned char, WS_RB)};
              pg8::gemm_phase<EpiGate, GridSched, false, true>(F.lds, g, S, E); }
            phase_ssdconv(F, l);
            phase_scanprep(F, l);
        }
        SEAM(pb + 2);
#ifndef REP_MIX
#define REP_MIX 1
#endif
        if (IN(pb + 3) && EN(3)) for (int rep_ = 0; rep_ < REP_MIX; ++rep_) { REFRESH();
            const int bx = blockIdx.x;
#ifndef REPMASK
#define REPMASK 15
#endif
#ifdef ONLYK
            const int SCANMASK = ONLYK;
#else
            const int SCANMASK = rep_ == 0 ? 15 : REPMASK;
#endif
            if (bx < 32) { if (SCANMASK & 1) scn::scan_block<scn::K_ML>(F, l, bx); }
            else if (bx < 64) { if (SCANMASK & 2) scn::scan_block<scn::K_HG>(F, l, bx - 32); }
            else if (bx < 96) { if (SCANMASK & 4) scn::scan_block<scn::K_SSD>(F, l, bx - 64); }
            else if (SCANMASK & 8) {
                const int natt = 256 + (l + 1 < DEPTH ? 32 : 0), nab = F.G - 96;
                for (int ua = bx - 96; ua < natt; ua += nab) {
                    if (ua < 256) { const int b = ua >> 5, h = (ua >> 3) & 3, qb = ua & 7;
                        att::attn_unit(WSP(bf16_t, WS_QB), WSP(bf16_t, WS_KVB), Ub, WSP(bf16_t, WS_BR), b * SEQ + qb * 256, h, ML + b * CTXL, b * SEQ, 4, 36, (LAS char*)F.lds); }
                    else { const int uc = ua - 256, b = uc >> 2, h = uc & 3;
                        att::attn_unit(WSP(bf16_t, WS_QB), WSP(bf16_t, WS_KVB), Ub, WSP(bf16_t, WS_BR), ML + b * CTXL, h, ML + b * CTXL, 0, 4, 4, (LAS char*)F.lds); }
                }
            }
        }
        SEAM(pb + 3);
        if (IN(pb + 4) && EN(4)) for (int rp_ = 0; rp_ < REP_R4; ++rp_) { REFRESH(); phase_finish(F, l, mrows); }
        SEAM(pb + 4);
        if (IN(pb + 5) && EN(5)) for (int rp_ = 0; rp_ < REP_G5; ++rp_) { REFRESH();
            Gemm g{WSP(bf16_t, WS_BR), WSP(bf16_t, WS_WBR) + (size_t)l * 4 * DM * 512, DM, 512, 512};
            MergeSched S; S.gs.init(mrows / 256, 8, F.G, (int)blockIdx.x, 0, 0, 0, 0);
            EpiMerge E{WSP(unsigned char, WS_RB), WSP(unsigned char, WS_RA + RA_ACC), F.ws + WS_RA + RA_PART + (size_t)blockIdx.x * 131072, WSP(float, WS_RSSD)};
            pg8::gemm_phase<EpiMerge, MergeSched, false>(F.lds, g, S, E);
            if (l == 0 && blockIdx.x >= 64) {
                LAS float* scr = (LAS float*)(F.lds + F.wave * 16384);
                for (int it = ((int)blockIdx.x - 64) * 8 + F.wave; it < IT_MOE / 2; it += 192 * 8) cvt_moe_item(F, 0, it, scr);
            }
        }
        SEAM(pb + 5);
        if (IN(pb + 6) && EN(6)) for (int rp_ = 0; rp_ < REP_G6; ++rp_) { REFRESH();
            Gemm g{(const GAS bf16_t*)WSP(unsigned char, WS_RA + RA_ACC), (const GAS bf16_t*)(WSP(unsigned char, WS_WOUT) + (size_t)l * DM * DM), DM / 2, DM / 2, DM / 2};
            GridSched S; S.init(mrows / 256, 8, F.G, (int)blockIdx.x, (size_t)256 * DM, (size_t)256 * DM, 0, 0);
            EpiBf16 E{WSP(bf16_t, WS_RB + RB_Y), DM};
            pg8::gemm_phase<EpiBf16, GridSched, false, true>(F.lds, g, S, E);
            if (l == 0 && blockIdx.x >= 64) {
                LAS float* scr = (LAS float*)(F.lds + F.wave * 16384);
                for (int it = IT_MOE / 2 + ((int)blockIdx.x - 64) * 8 + F.wave; it < IT_MOE; it += 192 * 8) cvt_moe_item(F, 0, it, scr);
            }
        }
        SEAM(pb + 6);
        if (IN(pb + 7) && EN(7)) { REFRESH(); phase_rwB(F, l, mrows); }
        SEAM(pb + 7);
        if (IN(pb + 8) && EN(8)) for (int rp_ = 0; rp_ < REP_G8; ++rp_) { REFRESH();
            Gemm g{Hb, WSP(bf16_t, WS_WR) + (size_t)l * 256 * DM, DM, DM, 512};
            RouterSched S{mrows / 256, F.G, (int)blockIdx.x};
            EpiRouter E{WSP(float, WS_LOG)};
            pg8::gemm_phase<EpiRouter, RouterSched, false>(F.lds, g, S, E);
        }
        SEAM(pb + 8);
        if (IN(pb + 9) && EN(9)) { REFRESH(); phase_route(F, l, mrows); }
        SEAM(pb + 9);
        if (IN(pb + 10) && EN(10)) for (int rp_ = 0; rp_ < REP_G10; ++rp_) { REFRESH();
            moe_tables(F, l);
            Gemm g{Hb, WSP(bf16_t, WS_W13), DM, DM, DM};
            MoeSched S{(const volatile LAS int*)(F.MISC + 16), (const volatile LAS int*)(F.MISC + 64), WSP(int, WS_LIST), 4, F.G, (int)blockIdx.x, 1};
            EpiMoe1 E{WSP(bf16_t, WS_RA + RA_H1)};
            pg8::gemm_phase<EpiMoe1, MoeSched, true>(F.lds, g, S, E);
        }
        SEAM(pb + 10);
        if (IN(pb + 11) && EN(11)) for (int rp_ = 0; rp_ < REP_G11; ++rp_) { REFRESH();
            moe_tables(F, l);
            Gemm g{WSP(bf16_t, WS_RA + RA_H1), WSP(bf16_t, WS_W2), DEXP, DEXP, DEXP};
            MoeSched S{(const volatile LAS int*)(F.MISC + 16), (const volatile LAS int*)(F.MISC + 64), WSP(int, WS_LIST), 8, F.G, (int)blockIdx.x, 2};
            EpiMoe2 E{WSP(bf16_t, WS_RB + RB_Y2), WSP(int, WS_LIST), WSP(float, WS_WL), (const volatile LAS int*)(F.MISC + 64)};
            pg8::gemm_phase<EpiMoe2, MoeSched, false>(F.lds, g, S, E);
        }
        SEAM(pb + 11);
        if (IN(pb + 12) && EN(12)) { REFRESH(); phase_rwC(F, l, mrows); }
        SEAM(pb + 12);
    }

__global__ void __launch_bounds__(512, 2) fwd_kernel(Args args) {
    extern __shared__ __attribute__((aligned(16))) unsigned char lds_raw[];
    Frame F;
    F.lds = (LAS unsigned char*)lds_raw;
    F.MISC = (volatile LAS unsigned*)(F.lds + MISC_OFF);
    F.tid = threadIdx.x; F.lane = F.tid & 63; F.wave = __builtin_amdgcn_readfirstlane(F.tid >> 6);
    F.G = gridDim.x; { const int bx = blockIdx.x; F.vcu = (F.G % 8 == 0) ? (bx % 8) * (F.G / 8) + bx / 8 : bx; }
    F.ws = (GAS unsigned char*)args.ws; F.ctl = (unsigned*)(args.ws + WS_CTL); F.out = (GAS float*)args.out;
    F.inp = args.in;
    for (int u = F.tid; u < (LDS_BYTES - MISC_OFF) / 4; u += 512) F.MISC[u] = 0u;
    __syncthreads();
    const int lo = args.ph_lo, hi = args.ph_hi;
    XcdBarrier bar; bar.bar = F.ctl + CW_BAR; bar.x = 0; bar.st = nullptr;
    if (hi - lo > 1) bar = xcd_barrier_post(F.ctl + CW_BAR, F.MISC + 8);
    char* ldsg = (char*)lds_raw;

#ifndef REP_PRO
#define REP_PRO 1
#endif
    if (IN(0) && EN(13)) for (int rep_ = 0; rep_ < REP_PRO; ++rep_) { phase_prologue(F); } SEAM(0);
    if (IN(1) && EN(14)) { phase_modfin(F); } SEAM(1);

    layer_phases<0>(F, args, bar, lo, hi, ldsg);
    layer_phases<1>(F, args, bar, lo, hi, ldsg);
#undef IN
#undef SEAM
}


#ifdef DUMP_OFF
__global__ void dump_kernel(GAS float* out, const unsigned char* ws) {
    const size_t OUTN = (size_t)ML * DM; const size_t i0 = (size_t)blockIdx.x * blockDim.x + threadIdx.x, st = (size_t)gridDim.x * blockDim.x;
    for (size_t i = i0; i < OUTN; i += st) { float a = 0.f;
#if DUMP_F32
        const GAS float* src = (const GAS float*)(ws + (size_t)DUMP_OFF); for (size_t j = i; j < (size_t)DUMP_ELEMS; j += OUTN) a += src[j];
#else
        const GAS bf16_t* src = (const GAS bf16_t*)(ws + (size_t)DUMP_OFF); for (size_t j = i; j < (size_t)DUMP_ELEMS; j += OUTN) a += bf2f(src[j]);
#endif
        out[i] = a; }
}
#endif
extern "C" void kernel_launch(void* const* d_in, const int* in_sizes, int n_in, void* d_out, int out_size, void* d_ws, size_t ws_size, hipStream_t stream) {
    static int grid = 0;
    if (grid == 0) {
        if (n_in != N_IN || out_size != ML * DM || ws_size < WS_END) { fprintf(stderr, "kernel_launch: unexpected shapes: n_in %d out %d ws %zu (need %zu)\n", n_in, out_size, ws_size, (size_t)WS_END); grid = -1; return; }
        int dev = 0, cus = 0, per_cu = 0;
        if (hipGetDevice(&dev) != hipSuccess || hipDeviceGetAttribute(&cus, hipDeviceAttributeMultiprocessorCount, dev) != hipSuccess) { grid = -1; return; }
        if (hipFuncSetAttribute((const void*)fwd_kernel, hipFuncAttributeMaxDynamicSharedMemorySize, LDS_BYTES) != hipSuccess) { fprintf(stderr, "kernel_launch: hipFuncSetAttribute failed\n"); grid = -1; return; }
        if (hipOccupancyMaxActiveBlocksPerMultiprocessor(&per_cu, (const void*)fwd_kernel, 512, LDS_BYTES) != hipSuccess || per_cu < 1) { fprintf(stderr, "kernel_launch: occupancy query says %d\n", per_cu); }
        (void)hipGetLastError();
        grid = cus;
    }
    if (grid < 0) return;
    if (hipMemsetAsync((char*)d_ws + WS_CTL, 0, CTL_BYTES, stream) != hipSuccess) return;
    Args a{};
    for (int i = 0; i < N_IN; ++i) a.in[i] = (const float*)d_in[i];
    a.out = (float*)d_out; a.ws = (unsigned char*)d_ws;
#if MK_SINGLE
    a.ph_lo = 0; a.ph_hi = NPHASE;
    hipLaunchKernelGGL(fwd_kernel, dim3(grid), dim3(512), LDS_BYTES, stream, a);
#else
#ifndef MK_STOP
#define MK_STOP NPHASE
#endif
    for (int ph = 0; ph < MK_STOP; ++ph) {
        if (ph == 2 + PH_PER_LAYER) continue;
        a.ph_lo = ph; a.ph_hi = ph + 1;
        hipLaunchKernelGGL(fwd_kernel, dim3(grid), dim3(512), LDS_BYTES, stream, a);
    }
#endif
#ifdef DUMP_OFF
    hipLaunchKernelGGL(dump_kernel, dim3(2048), dim3(256), 0, stream, (float*)d_out, (const unsigned char*)d_ws);
#endif
    const hipError_t le = hipPeekAtLastError();
    if (le != hipSuccess) fprintf(stderr, "kernel_launch: launch failed: %s\n", hipGetErrorName(le));
}
```

```cpp
#include <hip/hip_runtime.h>
#include <cstdio>
#include <cstdint>

#ifndef MK_SINGLE
#define MK_SINGLE 1
#endif

constexpr int DM = 2048, NBATCH = 8, SEQ = 2048, CTXL = 256, DEPTH = 2;
constexpr int ML = NBATCH * SEQ;
constexpr int MC = NBATCH * CTXL;
constexpr int MT = ML + MC;
constexpr int DIN = 7008, NU = 7168;
constexpr int U_MLQ = 0, U_MLK = 512, U_MLV = 1024, U_MLO = 1536, U_HGQ = 2048, U_HGI = 2560, U_HGG = 3072, U_HGF = 3584,
              U_CQ = 4608, U_CKV = 5120, U_KR = 5376, U_MLG = 5440, U_DT = 5456, U_Z = 5632, U_XBC = 6144;
constexpr float EPS = 1e-6f;
constexpr int NEXP = 32, DEXP = 512;
constexpr int MOE_ROWS = 2 * MT + NEXP * 256;

enum { I_X = 0, I_C, I_CTX, I_CCTX, I_WADA, I_BADA, I_NORMG, I_WIN, I_MLFB, I_HGLB, I_HGNG, I_MLAGQ, I_MLAGKV, I_WUQ, I_WUKV,
       I_CONVW, I_CONVB, I_ALOG, I_DTB, I_SSDD, I_SSDNG, I_WGATE, I_WBR, I_WOUT, I_WGRP, I_WEXP, I_W1, I_W3, I_W2, N_IN };

constexpr size_t al256(size_t x) { return (x + 255) / 256 * 256; }
constexpr size_t WS_CTL = 0, CTL_BYTES = 1u << 20;
constexpr size_t WS_WIN = WS_CTL + CTL_BYTES;
constexpr size_t WS_WUQ = WS_WIN + (size_t)2 * NU * DM * 2;
constexpr size_t WS_WUKV = WS_WUQ + (size_t)2 * 768 * 512 * 2;
constexpr size_t WS_WG = WS_WUKV + (size_t)2 * 1024 * 256 * 2;
constexpr size_t WS_WBR = WS_WG + (size_t)2 * 8192 * DM;
constexpr size_t WS_WOUT = WS_WBR + (size_t)2 * 4 * DM * 512 * 2;
constexpr size_t WS_WR = WS_WOUT + (size_t)2 * DM * DM;
constexpr size_t WS_WIN8 = WS_WR + (size_t)2 * 256 * DM * 2;
constexpr size_t WS_W13 = WS_WIN8 + (size_t)2 * NU * DM;
constexpr size_t WS_W2 = WS_W13 + (size_t)NEXP * 1024 * DM * 2;
constexpr size_t WS_MODP = WS_W2 + (size_t)NEXP * DM * 512 * 2;
constexpr size_t WS_MOD = WS_MODP + (size_t)2 * 16 * 9 * 12288 * 4;
constexpr size_t WS_TAB = WS_MOD + (size_t)2 * 9 * 12288 * 4;
constexpr size_t WS_XC = WS_TAB + 16384;
constexpr size_t WS_H8 = WS_XC + (size_t)MC * DM * 4;
constexpr size_t WS_H = WS_H8 + (size_t)MT * DM;
constexpr size_t WS_HIN = WS_H;
constexpr size_t WS_QB = WS_H + (size_t)MT * DM * 2;
constexpr size_t WS_KVB = WS_QB + (size_t)MT * 768 * 2;
constexpr size_t WS_SSQ = WS_KVB + (size_t)MT * 1024 * 2;
constexpr size_t WS_BR = WS_SSQ + (size_t)MT * 12 * 4;
constexpr size_t WS_YFB = WS_BR + (size_t)MT * DM * 2;
constexpr size_t WS_RSSD = WS_YFB + (size_t)6 * MT * 512 * 2;
constexpr size_t WS_LOG = WS_RSSD + al256((size_t)MT * 4);
constexpr size_t WS_LIST = WS_LOG + (size_t)4 * MT * 64 * 4;
constexpr size_t WS_WL = WS_LIST + (size_t)NEXP * MT * 4;
constexpr size_t WS_XBC = WS_WL + (size_t)NEXP * MT * 4;
constexpr size_t HGP_ITEM = 8192 + 8192 + 1024;
constexpr size_t WS_HGP = WS_XBC + (size_t)MT * 1024 * 2;
constexpr size_t WS_MLS = WS_HGP + (size_t)64 * 72 * HGP_ITEM;
constexpr size_t WS_SSDS = WS_MLS + (size_t)64 * 2304 * 32;
constexpr size_t WS_MLC = WS_SSDS + (size_t)128 * 2304 * 32;
constexpr size_t WS_RA = WS_MLC + (size_t)32 * 2304 * 384 * 2;
constexpr size_t RA_BYTES = (size_t)MT * NU * 2;
constexpr size_t WS_RB = WS_RA + RA_BYTES;
constexpr size_t RB_BYTES = ((size_t)80 << 20) + (size_t)2 * MT * DM * 2;
constexpr size_t WS_END = WS_RB + RB_BYTES;
constexpr size_t RA_ACC = 0, RA_PART = (size_t)80 << 20, RA_H1 = (size_t)150 << 20;
constexpr size_t RB_Y = 0, RB_Y2 = (size_t)80 << 20;
static_assert(RA_PART >= (size_t)MT * DM * 2 && RA_H1 >= RA_PART + (size_t)256 * 65536 * 4 && RA_H1 + (size_t)MOE_ROWS * 512 * 2 <= RA_BYTES, "region A");
static_assert(RB_Y2 >= (size_t)MT * DM * 2 && RB_Y2 + (size_t)2 * MT * DM * 2 <= RB_BYTES && (size_t)MT * 8192 <= RB_BYTES, "region B");
constexpr int CW_CNT = 64;
constexpr int CW_BAR = 4096;

constexpr int RING_BYTES = 131072, MISC_OFF = RING_BYTES, LDS_BYTES = 147456;

#define GAS __attribute__((address_space(1)))
#define LAS __attribute__((address_space(3)))
typedef unsigned short bf16_t;
typedef short bf16x8 __attribute__((ext_vector_type(8)));
typedef short s16x4 __attribute__((ext_vector_type(4)));
typedef float f32x4 __attribute__((ext_vector_type(4)));
typedef float f32x2 __attribute__((ext_vector_type(2)));
typedef float f32x16 __attribute__((ext_vector_type(16)));
typedef unsigned u32x4 __attribute__((ext_vector_type(4)));
typedef unsigned u32x2 __attribute__((ext_vector_type(2)));
#define LDS_WAIT() asm volatile("s_waitcnt lgkmcnt(0)" ::: "memory")
#define VM_WAIT() asm volatile("s_waitcnt vmcnt(0)" ::: "memory")
typedef __bf16 bf16x2_t __attribute__((ext_vector_type(2)));
__device__ __forceinline__ unsigned cvt_pk_bf16(float lo, float hi) { const f32x2 v = {lo, hi}; return __builtin_bit_cast(unsigned, __builtin_convertvector(v, bf16x2_t)); }
__device__ __forceinline__ bf16_t f2bf(float f) { return (bf16_t)(cvt_pk_bf16(f, 0.f) & 0xffffu); }
__device__ __forceinline__ float bf2f(bf16_t b) { return __uint_as_float(((unsigned)b) << 16); }
__device__ __forceinline__ float bflo(unsigned w) { return __uint_as_float(w << 16); }
__device__ __forceinline__ float bfhi(unsigned w) { return __uint_as_float(w & 0xffff0000u); }
__device__ __forceinline__ float sigmoidf_(float x) { return 1.f / (1.f + __expf(-x)); }
__device__ __forceinline__ float siluf_(float x) { return x / (1.f + __expf(-x)); }
__device__ __forceinline__ int opaque_tid() { int t = threadIdx.x; asm volatile("" : "+v"(t)); return t; }
__device__ __forceinline__ const void* opaque_ptr(const void* p) {
    unsigned lo = (unsigned)(uintptr_t)p, hi = (unsigned)((uintptr_t)p >> 32); asm volatile("" : "+v"(lo), "+v"(hi));
    lo = __builtin_amdgcn_readfirstlane(lo); hi = __builtin_amdgcn_readfirstlane(hi); return (const void*)(((uintptr_t)hi << 32) | lo); }
__device__ __forceinline__ float wave_sum(float v) {
#pragma unroll
    for (int o = 1; o < 64; o <<= 1) v += __shfl_xor(v, o);
    return v;
}

__device__ __forceinline__ int prow(int b, int dir, int p) { if (p < CTXL) return ML + b * CTXL + (dir ? CTXL - 1 - p : p); const int q = p - CTXL; return b * SEQ + (dir ? SEQ - 1 - q : q); }
namespace scn {
__device__ __forceinline__ int rowl(int row, int colB) { return row * 256 + (colB ^ ((row & 7) << 4)); }
__device__ __forceinline__ float scan_add32(float v, int r32) {
#pragma unroll
    for (int d = 1; d < 32; d <<= 1) { const float o = __shfl_up(v, d, 32); if (r32 >= d) v += o; }
    return v;
}
__device__ __forceinline__ float scan_max32(float v, int r32) {
#pragma unroll
    for (int d = 1; d < 32; d <<= 1) { const float o = __shfl_up(v, d, 32); if (r32 >= d) v = fmaxf(v, o); }
    return v;
}
}

#define XB_TMO      128
#define XB_XCNT(j)  (256  + 64 * (j))
#define XB_XSUB(j)  (1280 + 64 * (j))
#define XB_XGEN(j)  (2304 + 64 * (j))
#define XB_TOP      3328
#define XB_TOPGEN   3392
#define XCD_BAR_WORDS 3456
#define XB_SPIN_CAP (1u << 18)
__device__ __forceinline__ unsigned xb_ld(unsigned* p)              { return __hip_atomic_load(p, __ATOMIC_RELAXED, __HIP_MEMORY_SCOPE_AGENT); }
__device__ __forceinline__ unsigned xb_add(unsigned* p, unsigned v) { return __hip_atomic_fetch_add(p, v, __ATOMIC_RELAXED, __HIP_MEMORY_SCOPE_AGENT); }
__device__ __forceinline__ unsigned xb_xcc_id() { return (unsigned)__builtin_amdgcn_s_getreg((3 << 11) | 20) & 0xFu; }
#define XB_SPIN(cond, bar) do { unsigned _sp = 0; while (cond) { __builtin_amdgcn_s_sleep(1); \
    if ((++_sp & 255u) == 0u) { if (xb_ld(&(bar)[XB_TMO])) break; if (_sp > XB_SPIN_CAP) { atomicAdd(&(bar)[XB_TMO], 1u); break; } } } } while (0)
struct XcdBarrier { unsigned* bar; unsigned x; volatile LAS unsigned* st; };
__device__ __forceinline__ XcdBarrier xcd_barrier_post(unsigned* bar, volatile LAS unsigned* st) {
    XcdBarrier b; b.bar = bar; b.x = xb_xcc_id(); b.st = st;
    if (threadIdx.x == 0) (void)xb_add(&bar[XB_XCNT(b.x)], 1u);
    return b;
}
__device__ __forceinline__ void xcd_barrier_complete(unsigned* bar, unsigned x, unsigned& nloc, unsigned& nx) {
    const unsigned G = gridDim.x * gridDim.y * gridDim.z;
    unsigned sum, cnt, mine, sp = 0u;
    for (;;) {
        sum = 0u; cnt = 0u; mine = 0u;
#pragma unroll
        for (unsigned j = 0; j < 16; ++j) { const unsigned c = xb_ld(&bar[XB_XCNT(j)]); sum += c; cnt += (c > 0u) ? 1u : 0u; mine = (j == x) ? c : mine; }
        if (sum == G) break;
        __builtin_amdgcn_s_sleep(1);
        if ((++sp & 255u) == 0u) { if (xb_ld(&bar[XB_TMO])) break; if (sp > XB_SPIN_CAP) { atomicAdd(&bar[XB_TMO], 1u); break; } }
    }
    nloc = mine > 0u ? mine : 1u; nx = cnt > 0u ? cnt : 1u;
}
__device__ __forceinline__ void xcd_barrier(const XcdBarrier& b) {
    asm volatile("s_waitcnt vmcnt(0)" ::: "memory");
    __syncthreads();
    if (threadIdx.x == 0) {
        unsigned* bar = b.bar;
        __builtin_amdgcn_s_waitcnt(0);
        unsigned nloc = b.st[0], nx = b.st[1];
        if (nloc == 0u) { xcd_barrier_complete(bar, b.x, nloc, nx); b.st[0] = nloc; b.st[1] = nx; }
        const unsigned old = xb_add(&bar[XB_XSUB(b.x)], 1u);
        const unsigned gen = old / nloc;
        if (old + 1u == (gen + 1u) * nloc) {
            __builtin_amdgcn_fence(__ATOMIC_RELEASE, "agent");
            asm volatile("s_waitcnt vmcnt(0)" ::: "memory");
            const unsigned og = xb_add(&bar[XB_TOP], 1u);
            const unsigned tg = og / nx;
            if (og + 1u == (tg + 1u) * nx) xb_add(&bar[XB_TOPGEN], 1u);
            else XB_SPIN(xb_ld(&bar[XB_TOPGEN]) == tg, bar);
            __builtin_amdgcn_fence(__ATOMIC_ACQUIRE, "agent");
            xb_add(&bar[XB_XGEN(b.x)], 1u);
            asm volatile("s_waitcnt vmcnt(0)" ::: "memory");
        } else {
            XB_SPIN(xb_ld(&bar[XB_XGEN(b.x)]) == gen, bar);
            __builtin_amdgcn_fence(__ATOMIC_ACQUIRE, "agent");
            asm volatile("s_waitcnt vmcnt(0)" ::: "memory");
        }
    }
    __syncthreads();
}

struct Frame {
    LAS unsigned char* lds;
    volatile LAS unsigned* MISC;
    unsigned* ctl;
    int tid, lane, wave, vcu, G;
    const float* const* inp;
    GAS float* out;
    GAS unsigned char* ws;
};
#define WSP(T, off) ((GAS T*)(F.ws + (off)))
#define INP(i) ((const GAS float*)F.inp[i])

namespace pg8 {
constexpr int BM = 256, BK = 64, HALF = 128, HTB = HALF * BK * 2, STAGE_BYTES = 8 * HTB, NXCD = 8, WGM = 8;
__host__ __device__ __forceinline__ int lds_byte(int r, int c) { const int st = (r >> 4) * 2 + (c >> 5), rr = r & 15, cc = c & 31, ob = rr * 64 + cc * 2; return st * 1024 + (ob ^ (((ob >> 9) & 1) << 5)); }
__host__ __device__ __forceinline__ void stage_rc(int b, int& R, int& C) { const int st = b / 1024, sb = b % 1024, swz = sb ^ (((sb >> 9) & 1) << 5); R = (st >> 1) * 16 + swz / 64; C = (st & 1) * 32 + (swz % 64) / 2; }

struct Unit { int pm, pn, aux, aux2; size_t aoff, boff; };
struct Gemm { const GAS bf16_t* A; const GAS bf16_t* Bt; int lda, ldb, K; };

struct GridSched {
    int nM, nN, nwg, G, c; size_t a_tile, b_tile, a0, b0;
    __device__ __forceinline__ void init(int nM_, int nN_, int G_, int c_, size_t a_tile_, size_t b_tile_, size_t a0_, size_t b0_) { nM = nM_; nN = nN_; nwg = nM * nN; G = G_; c = c_; a_tile = a_tile_; b_tile = b_tile_; a0 = a0_; b0 = b0_; }
    __device__ __forceinline__ void map(int L, int& pm, int& pn) const {
        int wgid = L; { const int q = nwg / NXCD, r = nwg % NXCD, xcd = wgid % NXCD, off = wgid / NXCD; wgid = (xcd < r ? xcd * (q + 1) : r * (q + 1) + (xcd - r) * q) + off; }
        const int nig = WGM * nN, gid = wgid / nig, fm = gid * WGM, gsz = (nM - fm) < WGM ? (nM - fm) : WGM;
        pm = fm + ((wgid % nig) % gsz); pn = (wgid % nig) / gsz;
    }
    __device__ __forceinline__ bool next(int i, Unit& u) const {
        const long L = (long)i * G + c; if (L >= nwg) return false;
        map((int)L, u.pm, u.pn); u.aux = 0; u.aux2 = 0; u.aoff = a0 + (size_t)u.pm * a_tile; u.boff = b0 + (size_t)u.pn * b_tile; return true;
    }
    __device__ __forceinline__ int arow(const Unit&, int) const { return 0; }
};

template <class Epi, class Sched, bool GATHER, bool FP8 = false>
__device__ __forceinline__ void gemm_phase(LAS unsigned char* lds, const Gemm g, const Sched& S, const Epi& E) {
    const int tid = opaque_tid(), wid = __builtin_amdgcn_readfirstlane(tid >> 6), lane = tid & 63, wr = wid >> 2, wc = wid & 3, fr = lane & 15, fq = lane >> 4;
    int nt = g.K / BK; asm volatile("" : "+s"(nt));
    unsigned voffA[2], voffB[2];
#pragma unroll
    for (int i = 0; i < 2; ++i) { int R, C; stage_rc(tid * 16 + i * 8192, R, C);
        voffA[i] = (unsigned)(R * g.lda + C) * 2u; voffB[i] = (unsigned)(R * g.ldb + C) * 2u; }
    const size_t kstep = (size_t)(BK * 2);
    const size_t hstepA = (size_t)HALF * g.lda * 2, hstepB = (size_t)HALF * g.ldb * 2;
    const unsigned ldsw = (unsigned)wid * 1024u;
    const int aoff = lds_byte(wr * 64 + fr, fq * 8), boff = lds_byte(wc * 32 + fr, fq * 8);
#define PG8_SA(b, h) (((b) * 2 + (h)) * HTB)
#define PG8_SB(b, h) ((4 + (b) * 2 + (h)) * HTB)
#define PG8_STAGE(bufoff, gbase, voff) do { _Pragma("unroll") for (int _i = 0; _i < 2; ++_i) \
        __builtin_amdgcn_global_load_lds((const unsigned*)((const char*)(gbase) + (voff)[_i]), (LAS unsigned*)(lds + (bufoff) + ldsw + _i * 8192), 16, 0, 0); } while (0)
#define PG8_LDA(dst, b, h) do { _Pragma("unroll") for (int m = 0; m < 4; ++m) { dst[m].lo = *(const LAS v4i_t*)(lds + PG8_SA(b, h) + aoff + m * 2048); dst[m].hi = *(const LAS v4i_t*)(lds + PG8_SA(b, h) + aoff + m * 2048 + 1024); } } while (0)
#define PG8_LDB(dst, b, h) do { _Pragma("unroll") for (int n = 0; n < 2; ++n) { dst[n].lo = *(const LAS v4i_t*)(lds + PG8_SB(b, h) + boff + n * 2048); dst[n].hi = *(const LAS v4i_t*)(lds + PG8_SB(b, h) + boff + n * 2048 + 1024); } } while (0)
typedef int v8i_t __attribute__((ext_vector_type(8))); typedef int v4i_t __attribute__((ext_vector_type(4)));
#define PG8_MMA(ai, bj, At, Bt) do { __builtin_amdgcn_s_setprio(1); _Pragma("unroll") for (int m = 0; m < 4; ++m) _Pragma("unroll") for (int n = 0; n < 2; ++n) { \
        if constexpr (FP8) { asm volatile("v_mfma_scale_f32_16x16x128_f8f6f4 %0, %1, %2, %0, %3, %4 op_sel_hi:[0,0,0]" : "+v"(acc[ai][bj][m][n]) : "v"(Bt[n]), "v"(At[m]), "v"(scW), "v"(scA)); } \
        else { acc[ai][bj][m][n] = __builtin_amdgcn_mfma_f32_16x16x32_bf16(__builtin_bit_cast(bf16x8, (v4i_t)Bt[n].lo), __builtin_bit_cast(bf16x8, (v4i_t)At[m].lo), acc[ai][bj][m][n], 0, 0, 0); \
               acc[ai][bj][m][n] = __builtin_amdgcn_mfma_f32_16x16x32_bf16(__builtin_bit_cast(bf16x8, (v4i_t)Bt[n].hi), __builtin_bit_cast(bf16x8, (v4i_t)At[m].hi), acc[ai][bj][m][n], 0, 0, 0); } } \
        __builtin_amdgcn_s_setprio(0); } while (0)
#if GEMM_SAFE
#define PG8_WAIT_V(n) asm volatile("s_waitcnt vmcnt(0)" ::: "memory")
#else
#define PG8_WAIT_V(n) asm volatile("s_waitcnt vmcnt(" #n ")" ::: "memory")
#endif
#define PG8_WAIT_L(n) asm volatile("s_waitcnt lgkmcnt(" #n ")" ::: "memory")
#define PG8_BAR __builtin_amdgcn_s_barrier()
#define PG8_SCHED __builtin_amdgcn_sched_barrier(0)
    unsigned cvA[2][2], nvA[2][2];
#define PG8_GOFF(dst, u) do { if constexpr (GATHER) { const int ne_ = S.acnt(u); int gr_[2][2], gc_[2];        \
        _Pragma("unroll") for (int _i = 0; _i < 2; ++_i) { int R_; stage_rc(tid * 16 + _i * 8192, R_, gc_[_i]); _Pragma("unroll") for (int _h = 0; _h < 2; ++_h) gr_[_h][_i] = S.arow(u, _h * HALF + R_, ne_); } \
        _Pragma("unroll") for (int _i = 0; _i < 2; ++_i) _Pragma("unroll") for (int _h = 0; _h < 2; ++_h) dst[_h][_i] = (unsigned)(((size_t)gr_[_h][_i] * (size_t)g.lda + (size_t)gc_[_i]) * 2u); } } while (0)
#define PG8_STAGE_A(bufoff, base, half, vh) do { if constexpr (GATHER) { PG8_STAGE(bufoff, base, (vh)[half]); } else { PG8_STAGE(bufoff, (base) + (half) * hstepA, voffA); } } while (0)
    Unit cur, nxt; int ui = 0;
    if (!S.next(0, cur)) return;
    f32x4 acc[2][2][4][2];
#pragma unroll
    for (int a = 0; a < 2; ++a)
#pragma unroll
        for (int b = 0; b < 2; ++b)
#pragma unroll
            for (int m = 0; m < 4; ++m)
#pragma unroll
                for (int n = 0; n < 2; ++n) acc[a][b][m][n] = (f32x4){0.f, 0.f, 0.f, 0.f};
    int scW = 0x79797979, scA = 0x7f7f7f7f; asm volatile("" : "+v"(scW), "+v"(scA));
    v8i_t At[4], B0[2], B1[2];
    const char* cA = (const char*)g.A + cur.aoff; const char* cB = (const char*)g.Bt + cur.boff;
    PG8_GOFF(cvA, cur);
#pragma unroll
    for (int _h = 0; _h < 2; ++_h)
#pragma unroll
        for (int _i = 0; _i < 2; ++_i) nvA[_h][_i] = cvA[_h][_i];
    PG8_STAGE(PG8_SB(0, 0), cB, voffB); PG8_STAGE_A(PG8_SA(0, 0), cA, 0, cvA); PG8_STAGE(PG8_SB(0, 1), cB + hstepB, voffB); PG8_STAGE_A(PG8_SA(0, 1), cA, 1, cvA);
    if (wr == 1) PG8_BAR;
    PG8_WAIT_V(4); PG8_BAR;
    PG8_STAGE(PG8_SB(1, 0), cB + kstep, voffB); PG8_STAGE_A(PG8_SA(1, 0), cA + kstep, 0, cvA); PG8_STAGE(PG8_SB(1, 1), cB + hstepB + kstep, voffB);
    PG8_WAIT_V(6); PG8_BAR;
    for (;;) {
        const bool has_next = S.next(ui + 1, nxt);
        const char* nA = has_next ? (const char*)g.A + nxt.aoff : cA; const char* nB = has_next ? (const char*)g.Bt + nxt.boff : cB;
        for (int t = 0; t < nt; t += 2) {
            const bool last = (t == nt - 2);
            const char* a1 = cA + (size_t)(t + 1) * kstep;
            const char* a2 = last ? nA : cA + (size_t)(t + 2) * kstep; const char* b2 = last ? nB : cB + (size_t)(t + 2) * kstep;
            const char* a3 = a2 + kstep; const char* b3 = b2 + kstep;
            if constexpr (GATHER) { if (last && has_next) { PG8_GOFF(nvA, nxt); } }
            PG8_LDB(B0, 0, 0); PG8_SCHED; PG8_LDA(At, 0, 0); PG8_STAGE_A(PG8_SA(1, 1), a1, 1, cvA);
            PG8_WAIT_L(8); PG8_BAR; PG8_WAIT_L(0); PG8_MMA(0, 0, At, B0); PG8_BAR; PG8_SCHED;
            PG8_LDB(B1, 0, 1); PG8_STAGE(PG8_SB(0, 0), b2, voffB);
            PG8_BAR; PG8_WAIT_L(0); PG8_MMA(0, 1, At, B1); PG8_BAR;
            PG8_LDA(At, 0, 1); PG8_STAGE_A(PG8_SA(0, 0), a2, 0, nvA);
            PG8_BAR; PG8_WAIT_L(0); PG8_MMA(1, 0, At, B0); PG8_BAR; PG8_SCHED;
            PG8_STAGE(PG8_SB(0, 1), b2 + hstepB, voffB);
            PG8_WAIT_V(6); PG8_BAR; PG8_MMA(1, 1, At, B1); PG8_BAR;
            PG8_LDB(B0, 1, 0); PG8_SCHED; PG8_LDA(At, 1, 0); PG8_STAGE_A(PG8_SA(0, 1), a2, 1, nvA);
            PG8_WAIT_L(8); PG8_BAR; PG8_WAIT_L(0); PG8_MMA(0, 0, At, B0); PG8_BAR; PG8_SCHED;
            PG8_LDB(B1, 1, 1); PG8_STAGE(PG8_SB(1, 0), b3, voffB);
            PG8_BAR; PG8_WAIT_L(0); PG8_MMA(0, 1, At, B1); PG8_BAR;
            PG8_LDA(At, 1, 1); PG8_STAGE_A(PG8_SA(1, 0), a3, 0, nvA);
            PG8_BAR; PG8_WAIT_L(0); PG8_MMA(1, 0, At, B0); PG8_BAR; PG8_SCHED;
            PG8_STAGE(PG8_SB(1, 1), b3 + hstepB, voffB);
            PG8_WAIT_V(6); PG8_BAR; PG8_MMA(1, 1, At, B1); PG8_BAR;
        }
        if constexpr (FP8) { asm volatile("s_nop 15\n\ts_nop 15" ::: "memory"); }
        E(acc, cur, wr, wc, fr, fq);
        if (!has_next) break;
#pragma unroll
        for (int a = 0; a < 2; ++a)
#pragma unroll
            for (int b = 0; b < 2; ++b)
#pragma unroll
                for (int m = 0; m < 4; ++m)
#pragma unroll
                    for (int n = 0; n < 2; ++n) acc[a][b][m][n] = (f32x4){0.f, 0.f, 0.f, 0.f};
        cur = nxt; cA = nA; cB = nB; ++ui;
        if constexpr (GATHER) {
#pragma unroll
            for (int _h = 0; _h < 2; ++_h)
#pragma unroll
                for (int _i = 0; _i < 2; ++_i) cvA[_h][_i] = nvA[_h][_i];
        }
    }
    PG8_WAIT_V(0);
    if (wr == 0) PG8_BAR;
    PG8_BAR;
#undef PG8_SA
#undef PG8_SB
#undef PG8_STAGE
#undef PG8_STAGE_A
#undef PG8_GOFF
#undef PG8_LDA
#undef PG8_LDB
#undef PG8_MMA
#undef PG8_WAIT_V
#undef PG8_WAIT_L
#undef PG8_BAR
#undef PG8_SCHED
}
}
using pg8::Unit;
using pg8::Gemm;
using pg8::GridSched;
#define EPI_ARGS f32x4 (&acc)[2][2][4][2], const Unit& u, int wr, int wc, int fr, int fq
#define EPI_FOR_ROWS for (int ai = 0; ai < 2; ++ai) for (int m = 0; m < 4; ++m)
#define EPI_FOR_COLS for (int bj = 0; bj < 2; ++bj) for (int n = 0; n < 2; ++n)
__device__ __forceinline__ void st_bf16x4(GAS bf16_t* p, f32x4 v) { u32x2 w; w.x = cvt_pk_bf16(v[0], v[1]); w.y = cvt_pk_bf16(v[2], v[3]); *(GAS u32x2*)p = w; }

struct EpiWin {
    GAS bf16_t* U; GAS float* ssq; const GAS float* rope;
    __device__ __forceinline__ void operator()(EPI_ARGS) const {
        const int row0 = u.pm * 256 + wr * 64 + fr, col0 = u.pn * 256 + wc * 32 + 4 * fq;
        if (u.pn == 21 && wc < 2 && u.pm < ML / 256) {
#pragma unroll
            for (int ai = 0; ai < 2; ++ai)
#pragma unroll
                for (int m = 0; m < 4; ++m) {
                    const int r = row0 + ai * 128 + m * 16, tok = r & (SEQ - 1), pos = wc == 0 ? (tok >> 6) : (tok & 63);
                    const f32x4 cs = *(const GAS f32x4*)(rope + pos * 16 + 4 * fq), sn = *(const GAS f32x4*)(rope + 1024 + pos * 16 + 4 * fq);
                    const f32x4 x1 = acc[ai][0][m][0], x2 = acc[ai][0][m][1];
                    acc[ai][0][m][0] = x1 * cs - x2 * sn; acc[ai][0][m][1] = x1 * sn + x2 * cs;
                }
        }
        if (u.pn >= 18 && u.pn <= 20) {
            const int slot = (u.pn - 18) * 4 + wc;
#pragma unroll
            for (int ai = 0; ai < 2; ++ai)
#pragma unroll
                for (int m = 0; m < 4; ++m) {
                    float s = 0.f;
#pragma unroll
                    for (int bj = 0; bj < 2; ++bj)
#pragma unroll
                        for (int n = 0; n < 2; ++n) { const f32x4 x = acc[ai][bj][m][n]; s += (x[0] * x[0] + x[1] * x[1]) + (x[2] * x[2] + x[3] * x[3]); }
                    s += __shfl_xor(s, 16); s += __shfl_xor(s, 32);
                    if (fq == 0) ssq[(size_t)(row0 + ai * 128 + m * 16) * 12 + slot] = s;
                }
        }
#pragma unroll
        for (int ai = 0; ai < 2; ++ai)
#pragma unroll
            for (int m = 0; m < 4; ++m) { GAS bf16_t* rowp = U + (size_t)(row0 + ai * 128 + m * 16) * NU + col0;
#pragma unroll
                for (int bj = 0; bj < 2; ++bj)
#pragma unroll
                    for (int n = 0; n < 2; ++n) st_bf16x4(rowp + bj * 128 + n * 16, acc[ai][bj][m][n]); }
    }
};
struct EpiMlaQ {
    GAS bf16_t* Q; const GAS float* ssq; const GAS float* rope;
    __device__ __forceinline__ void operator()(EPI_ARGS) const {
        const int row0 = u.pm * 256 + wr * 64 + fr, col0 = u.pn * 256 + wc * 32 + 4 * fq;
        float rstd[8];
        { f32x4 p0[8], p1[8];
#pragma unroll
          for (int i = 0; i < 8; ++i) { const int r = row0 + (i >> 2) * 128 + (i & 3) * 16; p0[i] = *(const GAS f32x4*)(ssq + (size_t)r * 12); p1[i] = *(const GAS f32x4*)(ssq + (size_t)r * 12 + 4); }
#pragma unroll
          for (int i = 0; i < 8; ++i) rstd[i] = rsqrtf(((p0[i][0] + p0[i][1]) + (p0[i][2] + p0[i][3]) + (p1[i][0] + p1[i][1]) + (p1[i][2] + p1[i][3])) * (1.f / 512.f) + EPS); }
        const bool rot = u.pn == 2 && u.pm < ML / 256;
#pragma unroll
        for (int ai = 0; ai < 2; ++ai) {
            f32x4 cs[4], sn[4];
#pragma unroll
            for (int m = 0; m < 4; ++m) { const int r = row0 + ai * 128 + m * 16; const int tok = r & (SEQ - 1), pos = rot ? ((wc & 1) == 0 ? (tok >> 6) : (tok & 63)) : 0;
                cs[m] = *(const GAS f32x4*)(rope + pos * 16 + 4 * fq); sn[m] = *(const GAS f32x4*)(rope + 1024 + pos * 16 + 4 * fq); }
#pragma unroll
            for (int m = 0; m < 4; ++m) {
                const int r = row0 + ai * 128 + m * 16, i = ai * 4 + m;
#pragma unroll
                for (int bj = 0; bj < 2; ++bj) {
                    f32x4 a = acc[ai][bj][m][0] * rstd[i], b = acc[ai][bj][m][1] * rstd[i];
                    if (rot) { const f32x4 x1 = a, x2 = b; a = x1 * cs[m] - x2 * sn[m]; b = x1 * sn[m] + x2 * cs[m]; }
                    GAS bf16_t* rowp = Q + (size_t)r * 768 + col0 + bj * 128;
                    st_bf16x4(rowp, a); st_bf16x4(rowp + 16, b);
                }
            }
        }
    }
};
struct EpiMlaKV {
    GAS bf16_t* KV; const GAS float* ssq;
    __device__ __forceinline__ void operator()(EPI_ARGS) const {
        const int row0 = u.pm * 256 + wr * 64 + fr, col0 = u.pn * 256 + wc * 32 + 4 * fq;
        f32x4 p0[8];
#pragma unroll
        for (int i = 0; i < 8; ++i) { const int r = row0 + (i >> 2) * 128 + (i & 3) * 16; p0[i] = *(const GAS f32x4*)(ssq + (size_t)r * 12 + 8); }
#pragma unroll
        for (int ai = 0; ai < 2; ++ai)
#pragma unroll
            for (int m = 0; m < 4; ++m) {
                const int r = row0 + ai * 128 + m * 16, i = ai * 4 + m;
                const float rstd = rsqrtf(((p0[i][0] + p0[i][1]) + (p0[i][2] + p0[i][3])) * (1.f / 256.f) + EPS);
                GAS bf16_t* rowp = KV + (size_t)r * 1024 + col0;
#pragma unroll
                for (int bj = 0; bj < 2; ++bj)
#pragma unroll
                    for (int n = 0; n < 2; ++n) st_bf16x4(rowp + bj * 128 + n * 16, acc[ai][bj][m][n] * rstd);
            }
    }
};
struct EpiGate {
    GAS unsigned char* G;
    __device__ __forceinline__ void operator()(EPI_ARGS) const {
        const __amdgpu_buffer_rsrc_t rsrc = __builtin_amdgcn_make_buffer_rsrc((void*)G, 0, 0x7fffffff, 0x00020000);
        const int voff = threadIdx.x * 8; const int tbase = (u.pm * 32 + u.pn) * 65536;
#pragma unroll
        for (int ai = 0; ai < 2; ++ai)
#pragma unroll
            for (int bj = 0; bj < 2; ++bj)
#pragma unroll
                for (int m = 0; m < 4; ++m) {
                    u32x2 w;
#pragma unroll
                    for (int n = 0; n < 2; ++n) { const f32x4 v = acc[ai][bj][m][n]; unsigned d = 0;
#pragma unroll
                        for (int j = 0; j < 4; ++j) { const float g = __builtin_amdgcn_rcpf(__builtin_fmaf(__builtin_amdgcn_exp2f(v[j]), 1.f / 255.f, 1.f / 255.f)); d = __builtin_amdgcn_cvt_pk_u8_f32(g, j, d); }
                        if (n == 0) w.x = d; else w.y = d; }
                    __builtin_amdgcn_raw_buffer_store_b64(w, rsrc, voff, tbase + ((ai * 2 + bj) * 4 + m) * 4096, 0);
                }
    }
};
struct EpiMerge {
    const GAS unsigned char* G; GAS unsigned char* ACC; GAS unsigned char* part; const GAS float* rssd;
    __device__ __forceinline__ void operator()(EPI_ARGS) const {
        const int row0 = u.pm * 256 + wr * 64 + fr, col0 = u.pn * 256 + wc * 32 + 4 * fq, k = u.aux;
        const __amdgpu_buffer_rsrc_t rg = __builtin_amdgcn_make_buffer_rsrc((void*)G, 0, 0x7fffffff, 0x00020000);
        const __amdgpu_buffer_rsrc_t rp = __builtin_amdgcn_make_buffer_rsrc((void*)part, 0, 131072, 0x00020000);
        const int vg = threadIdx.x * 8, vp = threadIdx.x * 16; const int tbase = (u.pm * 32 + k * 8 + u.pn) * 65536;
#pragma unroll
        for (int ai = 0; ai < 2; ++ai) {
            u32x2 gw[2][4]; u32x4 pw[2][4]; float rsv[4];
#pragma unroll
            for (int m = 0; m < 4; ++m) { rsv[m] = (k == 3) ? rssd[row0 + ai * 128 + m * 16] : 1.f;
#pragma unroll
                for (int bj = 0; bj < 2; ++bj) { const int idx2 = (ai * 2 + bj) * 4 + m; gw[bj][m] = __builtin_amdgcn_raw_buffer_load_b64(rg, vg, tbase + idx2 * 4096, 0);
                    if (k > 0) pw[bj][m] = __builtin_amdgcn_raw_buffer_load_b128(rp, vp, idx2 * 8192, 16); } }
#pragma unroll
            for (int m = 0; m < 4; ++m) {
                const int r = row0 + ai * 128 + m * 16; const float rs = rsv[m] * (1.f / 255.f);
#pragma unroll
                for (int bj = 0; bj < 2; ++bj) {
                    const int idx2 = (ai * 2 + bj) * 4 + m; const u32x2 g2 = gw[bj][m];
                    f32x4 v0, v1;
                    v0[0] = (float)(g2.x & 0xffu); v0[1] = (float)((g2.x >> 8) & 0xffu); v0[2] = (float)((g2.x >> 16) & 0xffu); v0[3] = (float)(g2.x >> 24);
                    v1[0] = (float)(g2.y & 0xffu); v1[1] = (float)((g2.y >> 8) & 0xffu); v1[2] = (float)((g2.y >> 16) & 0xffu); v1[3] = (float)(g2.y >> 24);
                    v0 = v0 * acc[ai][bj][m][0] * rs; v1 = v1 * acc[ai][bj][m][1] * rs;
                    if (k > 0) { const u32x4 p4 = pw[bj][m];
                        v0 += (f32x4){bflo(p4.x), bfhi(p4.x), bflo(p4.y), bfhi(p4.y)}; v1 += (f32x4){bflo(p4.z), bfhi(p4.z), bflo(p4.w), bfhi(p4.w)}; }
                    if (k < 3) { u32x4 ow; ow.x = cvt_pk_bf16(v0[0], v0[1]); ow.y = cvt_pk_bf16(v0[2], v0[3]); ow.z = cvt_pk_bf16(v1[0], v1[1]); ow.w = cvt_pk_bf16(v1[2], v1[3]);
                        __builtin_amdgcn_raw_buffer_store_b128(ow, rp, vp, idx2 * 8192, 16); }
                    else { GAS unsigned char* op = ACC + (size_t)r * DM + col0 + bj * 128;
#pragma unroll
                        for (int j = 0; j < 4; ++j) { v0[j] = __builtin_amdgcn_fmed3f(v0[j], -448.f, 448.f); v1[j] = __builtin_amdgcn_fmed3f(v1[j], -448.f, 448.f); }
                        unsigned w0 = 0, w1 = 0; w0 = __builtin_amdgcn_cvt_pk_fp8_f32(v0[0], v0[1], w0, false); w0 = __builtin_amdgcn_cvt_pk_fp8_f32(v0[2], v0[3], w0, true);
                        w1 = __builtin_amdgcn_cvt_pk_fp8_f32(v1[0], v1[1], w1, false); w1 = __builtin_amdgcn_cvt_pk_fp8_f32(v1[2], v1[3], w1, true);
                        *(GAS unsigned*)op = w0; *(GAS unsigned*)(op + 16) = w1; }
                }
            }
            asm volatile("" ::: "memory");
        }
    }
};
struct EpiBf16 {
    GAS bf16_t* O; int ld;
    __device__ __forceinline__ void operator()(EPI_ARGS) const {
        const int row0 = u.pm * 256 + wr * 64 + fr, col0 = u.pn * 256 + wc * 32 + 4 * fq;
#pragma unroll
        for (int ai = 0; ai < 2; ++ai)
#pragma unroll
            for (int m = 0; m < 4; ++m) { GAS bf16_t* rowp = O + (size_t)(row0 + ai * 128 + m * 16) * ld + col0;
#pragma unroll
                for (int bj = 0; bj < 2; ++bj)
#pragma unroll
                    for (int n = 0; n < 2; ++n) st_bf16x4(rowp + bj * 128 + n * 16, acc[ai][bj][m][n]); }
    }
};
struct EpiRouter {
    GAS float* LOG;
    __device__ __forceinline__ void operator()(EPI_ARGS) const {
        if (wc >= 2) return;
        const int row0 = u.pm * 256 + wr * 64 + fr, col0 = wc * 32 + 4 * fq;
#pragma unroll
        for (int ai = 0; ai < 2; ++ai)
#pragma unroll
            for (int m = 0; m < 4; ++m) { GAS float* rowp = LOG + ((size_t)u.aux * MT + (row0 + ai * 128 + m * 16)) * 64 + col0;
#pragma unroll
                for (int n = 0; n < 2; ++n) *(GAS f32x4*)(rowp + n * 16) = acc[ai][0][m][n]; }
    }
};
struct RouterSched {
    int nM, G, c;
    __device__ __forceinline__ bool next(int i, Unit& u) const {
        const long L = (long)i * G + c; if (L >= (long)nM * 4) return false;
        u.pm = (int)(L >> 2); u.pn = 0; u.aux = (int)(L & 3); u.aux2 = 0;
        u.aoff = ((size_t)u.pm * 256 * DM + (size_t)u.aux * 512) * 2; u.boff = (size_t)u.aux * 512 * 2; return true;
    }
    __device__ __forceinline__ int arow(const Unit&, int) const { return 0; }
};
struct MoeSched {
    const volatile LAS int* tb; const volatile LAS int* cnt; const GAS int* list; int nN, G, c, mode;
    __device__ __forceinline__ bool next(int i, Unit& u) const {
        const long L = (long)i * G + c; const int NT = tb[32];
        const int ti = (int)(L / nN); if (ti >= NT) return false;
        u.pn = (int)(L % nN); int e = 0;
        while (e < 31 && ti >= tb[e + 1]) ++e;
        u.aux = e; u.aux2 = ti - tb[e]; u.pm = ti;
        if (mode == 1) { u.aoff = 0; u.boff = ((size_t)e * 1024 + (size_t)u.pn * 256) * DM; }
        else { u.aoff = (size_t)ti * 256 * DEXP; u.boff = ((size_t)e * DM + (size_t)u.pn * 256) * DEXP; }
        return true;
    }
    __device__ __forceinline__ int acnt(const Unit& u) const { return cnt[u.aux]; }
    __device__ __forceinline__ int arow(const Unit& u, int r, int n_e) const {
        const int pos = u.aux2 * 256 + r; const int e = u.aux;
        const bool in = pos < n_e; const int v = list[(size_t)e * MT + (in ? pos : 0)] >> 1;
        return in ? v : 0;
    }
};
struct EpiMoe1 {
    GAS unsigned char* H1;
    __device__ __forceinline__ void operator()(EPI_ARGS) const {
        const int row0 = u.pm * 256 + wr * 64 + fr, col0 = u.pn * 128 + wc * 32 + 4 * fq;
#pragma unroll
        for (int ai = 0; ai < 2; ++ai)
#pragma unroll
            for (int m = 0; m < 4; ++m) { GAS unsigned char* rowp = H1 + (size_t)(row0 + ai * 128 + m * 16) * DEXP + col0;
#pragma unroll
                for (int n = 0; n < 2; ++n) { const f32x4 a = acc[ai][0][m][n], b = acc[ai][1][m][n]; f32x4 v;
#pragma unroll
                    for (int j = 0; j < 4; ++j) v[j] = __builtin_amdgcn_fmed3f(a[j] * __builtin_amdgcn_rcpf(1.f + __builtin_amdgcn_exp2f(-1.4426950409f * a[j])) * b[j], -448.f, 448.f);
                    unsigned w = 0; w = __builtin_amdgcn_cvt_pk_fp8_f32(v[0], v[1], w, false); w = __builtin_amdgcn_cvt_pk_fp8_f32(v[2], v[3], w, true);
                    *(GAS unsigned*)(rowp + n * 16) = w; } }
    }
};
struct EpiMoe2 {
    GAS bf16_t* Y2; const GAS int* list; const GAS float* wl; const volatile LAS int* cnt;
    __device__ __forceinline__ void operator()(EPI_ARGS) const {
        const int e = u.aux, n_e = cnt[e], col0 = u.pn * 256 + wc * 32 + 4 * fq;
        int ts[8]; float w[8];
#pragma unroll
        for (int i = 0; i < 8; ++i) { const int pos = u.aux2 * 256 + (i >> 2) * 128 + wr * 64 + (i & 3) * 16 + fr; const bool ok = pos < n_e;
            const int pc = ok ? pos : 0; const int tv = list[(size_t)e * MT + pc]; const float wv = wl[(size_t)e * MT + pc];
            ts[i] = ok ? tv : -1; w[i] = ok ? wv : 0.f; }
#pragma unroll
        for (int ai = 0; ai < 2; ++ai)
#pragma unroll
            for (int m = 0; m < 4; ++m) { const int i = ai * 4 + m;
                if (ts[i] >= 0) {
                    GAS bf16_t* rowp = Y2 + (size_t)ts[i] * DM + col0;
#pragma unroll
                    for (int bj = 0; bj < 2; ++bj)
#pragma unroll
                        for (int n = 0; n < 2; ++n) st_bf16x4(rowp + bj * 128 + n * 16, acc[ai][bj][m][n] * w[i]);
                }
            }
    }
};

struct WinSched {
    GridSched gs; int mode;
    __device__ __forceinline__ bool next(int i, Unit& u) const {
        const long L = (long)i * gs.G + gs.c; if (L >= gs.nwg) return false;
        int j; gs.map((int)L, u.pm, j);
        u.pn = mode == 0 ? (j < 17 ? 4 + j : 5 + j) : (j < 4 ? j : 21);
        u.aux = 0; u.aux2 = 0; u.aoff = gs.a0 + (size_t)u.pm * gs.a_tile; u.boff = gs.b0 + (size_t)u.pn * gs.b_tile; return true;
    }
    __device__ __forceinline__ int arow(const Unit&, int) const { return 0; }
};
struct MergeSched {
    GridSched gs;
    __device__ __forceinline__ bool next(int i, Unit& u) const {
        const long L = (long)(i >> 2) * gs.G + gs.c; if (L >= gs.nwg) return false;
        gs.map((int)L, u.pm, u.pn); const int k = i & 3; u.aux = k; u.aux2 = 0;
        u.aoff = (size_t)u.pm * 256 * DM + (size_t)k * 512; u.boff = ((size_t)k * DM + (size_t)u.pn * 256) * 512; return true;
    }
    __device__ __forceinline__ int arow(const Unit&, int) const { return 0; }
};

__device__ __forceinline__ void tr_block(const GAS float* colp, int ldw, float nscale, const GAS float* kscale, int k0, GAS bf16_t* WT, int K, int n0, LAS float* scr, int lane) {
    float v[32];
#pragma unroll
    for (int i = 0; i < 32; ++i) { const int kk = 2 * i + (lane >> 5); v[i] = colp[(size_t)(k0 + kk) * ldw]; }
    if (kscale) {
#pragma unroll
        for (int i = 0; i < 32; ++i) { const int kk = 2 * i + (lane >> 5); v[i] *= kscale[k0 + kk]; }
    }
#pragma unroll
    for (int i = 0; i < 32; ++i) { const int kk = 2 * i + (lane >> 5); scr[kk * 33 + (lane & 31)] = v[i] * nscale; }
    LDS_WAIT(); asm volatile("" ::: "memory");
    const int c = lane & 7;
#pragma unroll
    for (int j = 0; j < 4; ++j) { const int n = (lane >> 3) + 8 * j; const LAS float* s = scr + (8 * c) * 33 + n;
        u32x4 o; o.x = cvt_pk_bf16(s[0 * 33], s[1 * 33]); o.y = cvt_pk_bf16(s[2 * 33], s[3 * 33]); o.z = cvt_pk_bf16(s[4 * 33], s[5 * 33]); o.w = cvt_pk_bf16(s[6 * 33], s[7 * 33]);
        *(GAS u32x4*)(WT + (size_t)(n0 + n) * K + k0 + 8 * c) = o; }
    LDS_WAIT(); asm volatile("" ::: "memory");
}

__device__ __forceinline__ void tr_block8(const GAS float* colp, int ldw, float nscale, int k0, GAS unsigned char* WT, int K, int n0, LAS float* scr, int lane) {
    float v[32];
#pragma unroll
    for (int i = 0; i < 32; ++i) { const int kk = 2 * i + (lane >> 5); v[i] = colp[(size_t)(k0 + kk) * ldw]; }
#pragma unroll
    for (int i = 0; i < 32; ++i) { const int kk = 2 * i + (lane >> 5); scr[kk * 33 + (lane & 31)] = v[i] * nscale; }
    LDS_WAIT(); asm volatile("" ::: "memory");
    const int c = lane & 7;
#pragma unroll
    for (int j = 0; j < 4; ++j) { const int n = (lane >> 3) + 8 * j; const LAS float* s = scr + (8 * c) * 33 + n;
        u32x2 o; unsigned w = 0; w = __builtin_amdgcn_cvt_pk_fp8_f32(s[0 * 33], s[1 * 33], w, false); w = __builtin_amdgcn_cvt_pk_fp8_f32(s[2 * 33], s[3 * 33], w, true); o.x = w;
        w = 0; w = __builtin_amdgcn_cvt_pk_fp8_f32(s[4 * 33], s[5 * 33], w, false); w = __builtin_amdgcn_cvt_pk_fp8_f32(s[6 * 33], s[7 * 33], w, true); o.y = w;
        *(GAS u32x2*)(WT + (size_t)(n0 + n) * K + k0 + 8 * c) = o; }
    LDS_WAIT(); asm volatile("" ::: "memory");
}

__device__ __forceinline__ void tr_block8k(const GAS float* colp, int ldw, float nscale, const GAS float* kscale, int k0, GAS unsigned char* WT, int K, int n0, LAS float* scr, int lane) {
    float v[32];
#pragma unroll
    for (int i = 0; i < 32; ++i) { const int kk = 2 * i + (lane >> 5); v[i] = colp[(size_t)(k0 + kk) * ldw]; }
    if (kscale) {
#pragma unroll
        for (int i = 0; i < 32; ++i) { const int kk = 2 * i + (lane >> 5); v[i] *= kscale[k0 + kk]; }
    }
#pragma unroll
    for (int i = 0; i < 32; ++i) { const int kk = 2 * i + (lane >> 5); scr[kk * 33 + (lane & 31)] = v[i] * nscale; }
    LDS_WAIT(); asm volatile("" ::: "memory");
    const int c = lane & 7;
#pragma unroll
    for (int j = 0; j < 4; ++j) { const int n = (lane >> 3) + 8 * j; const LAS float* s = scr + (8 * c) * 33 + n;
        u32x2 o; unsigned w = 0; w = __builtin_amdgcn_cvt_pk_fp8_f32(s[0 * 33], s[1 * 33], w, false); w = __builtin_amdgcn_cvt_pk_fp8_f32(s[2 * 33], s[3 * 33], w, true); o.x = w;
        w = 0; w = __builtin_amdgcn_cvt_pk_fp8_f32(s[4 * 33], s[5 * 33], w, false); w = __builtin_amdgcn_cvt_pk_fp8_f32(s[6 * 33], s[7 * 33], w, true); o.y = w;
        *(GAS u32x2*)(WT + (size_t)(n0 + n) * K + k0 + 8 * c) = o; }
    LDS_WAIT(); asm volatile("" ::: "memory");
}
__device__ __forceinline__ int win_src(int n) {
    if (n < 2048) return n;
    if (n < 5440) return n + 16;
    if (n < 5456) return 2048 + (n - 5440);
    if (n < 5472) return 6992 + (n - 5456);
    if (n < 5632) return -1;
    if (n < 6144) return 5456 + (n - 5632);
    return 5968 + (n - 6144);
}
constexpr int IT_WIN = 32 * 224, IT_WUQ = 8 * 24, IT_WUKV = 4 * 32, IT_WG = 32 * 64, IT_WBR = 8 * 64, IT_WOUT = 32 * 64, IT_WR = 32 * 8, IT_W13 = 32 * 32, IT_W2 = 8 * 64;
constexpr int IT_LAYER = IT_WIN + IT_WUQ + IT_WUKV + 4 * IT_WG + 4 * IT_WBR + IT_WOUT + IT_WR;
constexpr int IT_MOE = NEXP * (IT_W13 + IT_W2);
__device__ __forceinline__ void cvt_layer_item(Frame& F, int l, int r, LAS float* scr) {
    const int lane = F.lane, nl = lane & 31;
    if (r < IT_WIN) { const int nb = r % 224, kb = r / 224, n = nb * 32 + nl, sc = win_src(n);
        const int ct = nb >> 3;
        if (ct >= 4 && ct != 21) tr_block8(INP(I_WIN) + (size_t)l * DM * DIN + (sc >= 0 ? sc : 0), DIN, sc >= 0 ? 64.f : 0.f, kb * 64, WSP(unsigned char, WS_WIN8) + (size_t)l * NU * DM, DM, nb * 32, scr, lane);
        else tr_block(INP(I_WIN) + (size_t)l * DM * DIN + (sc >= 0 ? sc : 0), DIN, sc < 0 ? 0.f : (n < 512 ? 0.08838834764831845f : 1.f), nullptr, kb * 64, WSP(bf16_t, WS_WIN) + (size_t)l * NU * DM, DM, nb * 32, scr, lane);
        return; }
    r -= IT_WIN;
    if (r < IT_WUQ) { const int nb = r % 24, kb = r / 24, n = nb * 32 + nl; const int sc = n < 512 ? (n >> 7) * 192 + (n & 127) : ((n - 512) >> 6) * 192 + 128 + ((n - 512) & 63);
        tr_block(INP(I_WUQ) + (size_t)l * 512 * 768 + sc, 768, 0.07216878364870323f * 1.4426950408889634f, INP(I_MLAGQ) + l * 512, kb * 64, WSP(bf16_t, WS_WUQ) + (size_t)l * 768 * 512, 512, nb * 32, scr, lane); return; }
    r -= IT_WUQ;
    if (r < IT_WUKV) { const int nb = r % 32, kb = r / 32, n = nb * 32 + nl; const int sc = n < 512 ? (n >> 7) * 256 + (n & 127) : ((n - 512) >> 7) * 256 + 128 + ((n - 512) & 127);
        tr_block(INP(I_WUKV) + (size_t)l * 256 * 1024 + sc, 1024, 1.f, INP(I_MLAGKV) + l * 256, kb * 64, WSP(bf16_t, WS_WUKV) + (size_t)l * 1024 * 256, 256, nb * 32, scr, lane); return; }
    r -= IT_WUKV;
    if (r < 4 * IT_WG) { const int k = r / IT_WG, q = r % IT_WG, nb = q % 64, kb = q / 64;
        tr_block8(INP(I_WGATE) + (size_t)(l * 4 + k) * DM * DM + nb * 32 + nl, DM, -92.33248261689366f  , kb * 64, WSP(unsigned char, WS_WG) + ((size_t)l * 8192 + (size_t)k * 2048) * DM, DM, nb * 32, scr, lane); return; }
    r -= 4 * IT_WG;
    if (r < 4 * IT_WBR) { const int k = r / IT_WBR, q = r % IT_WBR, nb = q % 64, kb = q / 64;
        const GAS float* ks = k == 1 ? INP(I_HGNG) + l * 512 : (k == 3 ? INP(I_SSDNG) + l * 512 : nullptr);
        tr_block8k(INP(I_WBR) + (size_t)(l * 4 + k) * 512 * DM + nb * 32 + nl, DM, 64.f, ks, kb * 64, WSP(unsigned char, WS_WBR) + (size_t)(l * 4 + k) * DM * 512, 512, nb * 32, scr, lane); return; }
    r -= 4 * IT_WBR;
    if (r < IT_WOUT) { const int nb = r % 64, kb = r / 64;
        tr_block8(INP(I_WOUT) + (size_t)l * DM * DM + nb * 32 + nl, DM, 64.f, kb * 64, WSP(unsigned char, WS_WOUT) + (size_t)l * DM * DM, DM, nb * 32, scr, lane); return; }
    r -= IT_WOUT;
    { const int nb = r % 8, kb = r / 8, n = nb * 32 + nl; const GAS float* cp = INP(I_WGRP) + (size_t)l * DM * 4; int ld = 4;
      if (n < 4) { cp += n; } else if (n < 36) { cp = INP(I_WEXP) + (size_t)l * DM * 32 + (n - 4); ld = 32; }
      tr_block(cp, ld, n < 36 ? 1.f : 0.f, nullptr, kb * 64, WSP(bf16_t, WS_WR) + (size_t)l * 256 * DM, DM, nb * 32, scr, lane); }
}
__device__ __forceinline__ void cvt_moe_item(Frame& F, int l, int r, LAS float* scr) {
    const int lane = F.lane, nl = lane & 31;
    if (r < NEXP * IT_W13) { const int e = r / IT_W13, q = r % IT_W13, nb = q % 32, kb = q / 32, n = nb * 32 + nl;
        const int c = (n >> 8) * 128 + (n & 127); const GAS float* src = ((n >> 7) & 1) ? INP(I_W3) : INP(I_W1);
        tr_block8(src + (size_t)(l * NEXP + e) * DM * DEXP + c, DEXP, 64.f, kb * 64, WSP(unsigned char, WS_W13) + (size_t)e * 1024 * DM, DM, nb * 32, scr, lane); return; }
    r -= NEXP * IT_W13;
    { const int e = r / IT_W2, q = r % IT_W2, nb = q % 64, kb = q / 64;
      tr_block8(INP(I_W2) + (size_t)(l * NEXP + e) * DEXP * DM + nb * 32 + nl, DM, 64.f, kb * 64, WSP(unsigned char, WS_W2) + (size_t)e * DM * DEXP, DEXP, nb * 32, scr, lane); }
}
__device__ __forceinline__ void ada_task(Frame& F, int task, LAS float* scr) {
    const int ks = task & 15, cg = (task >> 4) % 48, l = task / (16 * 48); const int col = cg * 256 + F.lane * 4;
    for (int i = F.lane; i < 9 * 128; i += 64) { const int r = i >> 7, kk = ks * 128 + (i & 127); const float c = r < 8 ? INP(I_C)[r * DM + kk] : INP(I_CCTX)[kk]; scr[i] = siluf_(c); }
    LDS_WAIT(); asm volatile("" ::: "memory");
    f32x4 a[9];
#pragma unroll
    for (int r = 0; r < 9; ++r) a[r] = (f32x4){0.f, 0.f, 0.f, 0.f};
    const GAS float* W = INP(I_WADA) + ((size_t)l * DM + ks * 128) * 12288 + col;
    for (int k = 0; k < 128; k += 8) {
        f32x4 w[8];
#pragma unroll
        for (int q = 0; q < 8; ++q) w[q] = *(const GAS f32x4*)(W + (size_t)(k + q) * 12288);
#pragma unroll
        for (int q = 0; q < 8; ++q) {
#pragma unroll
            for (int r = 0; r < 9; ++r) a[r] += scr[r * 128 + k + q] * w[q];
        }
    }
    GAS float* P = WSP(float, WS_MODP) + ((size_t)(l * 16 + ks) * 9) * 12288 + col;
#pragma unroll
    for (int r = 0; r < 9; ++r) *(GAS f32x4*)(P + (size_t)r * 12288) = a[r];
    LDS_WAIT(); asm volatile("" ::: "memory");
}
__device__ __forceinline__ void tables_task(Frame& F) {
    GAS float* T = WSP(float, WS_TAB); const int lane = F.lane;
    for (int i = 0; i < 16; ++i) { const float inv = expf(-(float)i * (9.210340371976184f / 16.f)); const float ang = (float)lane * inv; T[lane * 16 + i] = cosf(ang); T[1024 + lane * 16 + i] = sinf(ang); }
    for (int j = lane; j < 512; j += 64) { const float a0 = INP(I_HGLB)[j], a1 = INP(I_HGLB)[512 + j], a2 = INP(I_HGLB)[1024 + j];
        const float mx = fmaxf(a0, fmaxf(a1, a2)), e0 = expf(a0 - mx), e1 = expf(a1 - mx), e2 = expf(a2 - mx), s = e0 + e1 + e2;
        T[2048 + j] = e0 / s; T[2048 + 512 + j] = (e0 + e1) / s; }
}
constexpr int N_ADA = 2 * 48 * 16;
__device__ __forceinline__ void phase_prologue(Frame& F) {
    LAS float* scr = (LAS float*)(F.lds + F.wave * 16384);
    const int gw = F.vcu * 8 + F.wave, NGW = F.G * 8;
    constexpr int TOTAL = N_ADA + 1 + IT_LAYER;
    for (int it = gw; it < TOTAL; it += NGW) {
        int r = it;
        if (r < N_ADA) { ada_task(F, r, scr); continue; } r -= N_ADA;
        if (r == 0) { tables_task(F); continue; } r -= 1;
        cvt_layer_item(F, 0, r, scr);
    }
}
__device__ __forceinline__ void phase_modfin(Frame& F) {
    const int gt = F.vcu * 512 + F.tid, NT_ = F.G * 512;
    for (int i = gt; i < 2 * 9 * 12288; i += NT_) { const int l = i / (9 * 12288), rc = i % (9 * 12288), col = rc % 12288;
        float s = INP(I_BADA)[l * 12288 + col];
#pragma unroll
        for (int ks = 0; ks < 16; ++ks) s += WSP(float, WS_MODP)[((size_t)(l * 16 + ks) * 9) * 12288 + rc];
        WSP(float, WS_MOD)[i] = s; }
}

struct Row8 { f32x4 v[8]; };
__device__ __forceinline__ void ld_row_f32(Row8& R, const GAS float* p, int lane) {
#pragma unroll
    for (int j = 0; j < 8; ++j) R.v[j] = ((const GAS f32x4*)p)[64 * j + lane];
}
__device__ __forceinline__ void st_row_f32(const Row8& R, GAS float* p, int lane) {
#pragma unroll
    for (int j = 0; j < 8; ++j) ((GAS f32x4*)p)[64 * j + lane] = R.v[j];
}
__device__ __forceinline__ void ld_row_bf16(Row8& R, const GAS bf16_t* p, int lane) {
#pragma unroll
    for (int j = 0; j < 8; ++j) { const u32x2 w = ((const GAS u32x2*)p)[64 * j + lane]; R.v[j] = (f32x4){bflo(w.x), bfhi(w.x), bflo(w.y), bfhi(w.y)}; }
}
__device__ __forceinline__ void st_row_bf16(const Row8& R, GAS bf16_t* p, int lane) {
#pragma unroll
    for (int j = 0; j < 8; ++j) { u32x2 w; w.x = cvt_pk_bf16(R.v[j][0], R.v[j][1]); w.y = cvt_pk_bf16(R.v[j][2], R.v[j][3]); ((GAS u32x2*)p)[64 * j + lane] = w; }
}
__device__ __forceinline__ float row_rstd(const Row8& R) {
    float s = 0.f;
#pragma unroll
    for (int j = 0; j < 8; ++j) s += (R.v[j][0] * R.v[j][0] + R.v[j][1] * R.v[j][1]) + (R.v[j][2] * R.v[j][2] + R.v[j][3] * R.v[j][3]);
    return rsqrtf(wave_sum(s) * (1.f / DM) + EPS);
}
__device__ __forceinline__ void st_modnorm(const Row8& R, float rstd, const GAS float* g, const GAS float* shift, const GAS float* scale, GAS bf16_t* o, int lane) {
#pragma unroll
    for (int j = 0; j < 8; ++j) { const int c = 64 * j + lane; const f32x4 gg = ((const GAS f32x4*)g)[c], sh = ((const GAS f32x4*)shift)[c], sc = ((const GAS f32x4*)scale)[c];
        const f32x4 h = (R.v[j] * rstd * gg) * (sc + 1.f) + sh; u32x2 w; w.x = cvt_pk_bf16(h[0], h[1]); w.y = cvt_pk_bf16(h[2], h[3]); ((GAS u32x2*)o)[c] = w; }
}
__device__ __forceinline__ void st_modnorm8(const Row8& R, float rstd, const GAS float* g, const GAS float* shift, const GAS float* scale, GAS unsigned char* o, int lane) {
#pragma unroll
    for (int j = 0; j < 8; ++j) { const int c = 64 * j + lane; const f32x4 gg = ((const GAS f32x4*)g)[c], sh = ((const GAS f32x4*)shift)[c], sc = ((const GAS f32x4*)scale)[c];
        f32x4 h = (R.v[j] * rstd * gg) * (sc + 1.f) + sh;
#pragma unroll
        for (int q = 0; q < 4; ++q) h[q] = __builtin_amdgcn_fmed3f(h[q], -448.f, 448.f);
        unsigned w = 0; w = __builtin_amdgcn_cvt_pk_fp8_f32(h[0], h[1], w, false); w = __builtin_amdgcn_cvt_pk_fp8_f32(h[2], h[3], w, true); ((GAS unsigned*)o)[c] = w; }
}
__device__ __forceinline__ void st_modnorm2(const Row8& R, float rstd, const GAS float* g, const GAS float* shift, const GAS float* scale, GAS bf16_t* o16, GAS unsigned char* o8, int lane) {
#pragma unroll
    for (int j = 0; j < 8; ++j) { const int c = 64 * j + lane; const f32x4 gg = ((const GAS f32x4*)g)[c], sh = ((const GAS f32x4*)shift)[c], sc = ((const GAS f32x4*)scale)[c];
        f32x4 h = (R.v[j] * rstd * gg) * (sc + 1.f) + sh; u32x2 w; w.x = cvt_pk_bf16(h[0], h[1]); w.y = cvt_pk_bf16(h[2], h[3]); ((GAS u32x2*)o16)[c] = w;
#pragma unroll
        for (int q = 0; q < 4; ++q) h[q] = __builtin_amdgcn_fmed3f(h[q], -448.f, 448.f);
        unsigned w8 = 0; w8 = __builtin_amdgcn_cvt_pk_fp8_f32(h[0], h[1], w8, false); w8 = __builtin_amdgcn_cvt_pk_fp8_f32(h[2], h[3], w8, true); ((GAS unsigned*)o8)[c] = w8; }
}
__device__ __forceinline__ const GAS float* mod_row(Frame& F, int l, int r) { return WSP(float, WS_MOD) + (size_t)(l * 9 + (r < ML ? (r >> 11) : 8)) * 12288; }
struct RawX { f32x4 f[8]; };
__device__ __forceinline__ void ld_raw_f32(RawX& R, const GAS float* p, int lane) {
#pragma unroll
    for (int j = 0; j < 8; ++j) R.f[j] = ((const GAS f32x4*)p)[64 * j + lane];
}
__device__ __forceinline__ void ld_raw_bf16(RawX& R, const GAS bf16_t* p, int lane) {
#pragma unroll
    for (int j = 0; j < 8; ++j) { const u32x2 w = ((const GAS u32x2*)p)[64 * j + lane]; R.f[j] = (f32x4){__uint_as_float(w.x), __uint_as_float(w.y), 0.f, 0.f}; }
}
__device__ __forceinline__ void raw_to_row(Row8& X, const RawX& R, bool is_bf16) {
#pragma unroll
    for (int j = 0; j < 8; ++j) { if (is_bf16) { const unsigned a = __float_as_uint(R.f[j][0]), b = __float_as_uint(R.f[j][1]); X.v[j] = (f32x4){bflo(a), bfhi(a), bflo(b), bfhi(b)}; } else X.v[j] = R.f[j]; }
}
struct RawB { u32x2 w[8]; };
__device__ __forceinline__ void ld_rawb(RawB& R, const GAS bf16_t* p, int lane) {
#pragma unroll
    for (int j = 0; j < 8; ++j) R.w[j] = ((const GAS u32x2*)p)[64 * j + lane];
}
__device__ __forceinline__ void rawb_to_row(Row8& X, const RawB& R) {
#pragma unroll
    for (int j = 0; j < 8; ++j) X.v[j] = (f32x4){bflo(R.w[j].x), bfhi(R.w[j].x), bflo(R.w[j].y), bfhi(R.w[j].y)};
}
__device__ __forceinline__ int row_grp(int r) { return r < ML ? (r >> 11) : 8; }
__device__ __forceinline__ void stage_vec(Frame& F, LAS float* dst, const GAS float* src) { ((LAS f32x4*)dst)[F.tid] = ((const GAS f32x4*)src)[F.tid]; }
__device__ __forceinline__ void st_modnorm2_l(const Row8& R, float rstd, const LAS float* g, const LAS float* shift, const LAS float* scale, GAS bf16_t* o16, GAS unsigned char* o8, int lane) {
#pragma unroll
    for (int j = 0; j < 8; ++j) { const int c = 64 * j + lane; const f32x4 gg = ((const LAS f32x4*)g)[c], sh = ((const LAS f32x4*)shift)[c], sc = ((const LAS f32x4*)scale)[c];
        f32x4 h = (R.v[j] * rstd * gg) * (sc + 1.f) + sh; u32x2 w; w.x = cvt_pk_bf16(h[0], h[1]); w.y = cvt_pk_bf16(h[2], h[3]); ((GAS u32x2*)o16)[c] = w;
#pragma unroll
        for (int q = 0; q < 4; ++q) h[q] = __builtin_amdgcn_fmed3f(h[q], -448.f, 448.f);
        unsigned w8 = 0; w8 = __builtin_amdgcn_cvt_pk_fp8_f32(h[0], h[1], w8, false); w8 = __builtin_amdgcn_cvt_pk_fp8_f32(h[2], h[3], w8, true); ((GAS unsigned*)o8)[c] = w8; }
}
__device__ __forceinline__ void phase_rwA(Frame& F, int l) {
    const int rpb = (MT + F.G - 1) / F.G, rlo = F.vcu * rpb, rhi = (rlo + rpb < MT ? rlo + rpb : MT) - 1;
    if (rlo > rhi) return;
    LAS float* Lf = (LAS float*)F.lds; const int ga = row_grp(rlo), gb = row_grp(rhi);
    stage_vec(F, Lf, INP(I_NORMG) + (size_t)(l * 4 + 0) * DM);
#pragma unroll
    for (int v = 0; v < 2; ++v) { stage_vec(F, Lf + (1 + v) * 2048, WSP(float, WS_MOD) + (size_t)(l * 9 + ga) * 12288 + v * DM); stage_vec(F, Lf + (3 + v) * 2048, WSP(float, WS_MOD) + (size_t)(l * 9 + gb) * 12288 + v * DM); }
    __syncthreads();
    for (int i0 = F.wave; i0 < rpb; i0 += 16) {
        const int r0 = rlo + i0, r1 = r0 + 8; const bool two = i0 + 8 < rpb && r1 <= rhi;
        if (r0 > rhi) break;
        RawX Ra, Rb; ld_raw_f32(Ra, r0 < ML ? INP(I_X) + (size_t)r0 * DM : INP(I_CTX) + (size_t)(r0 - ML) * DM, F.lane);
        if (two) ld_raw_f32(Rb, r1 < ML ? INP(I_X) + (size_t)r1 * DM : INP(I_CTX) + (size_t)(r1 - ML) * DM, F.lane);
#pragma unroll
        for (int q = 0; q < 2; ++q) { if (q == 1 && !two) break; const int r = q ? r1 : r0;
            Row8 R; raw_to_row(R, q ? Rb : Ra, false);
            const float rstd = row_rstd(R); const LAS float* md = Lf + (row_grp(r) == ga ? 1 : 3) * 2048;
            st_modnorm2_l(R, rstd, Lf, md, md + 2048, WSP(bf16_t, WS_HIN) + (size_t)r * DM, WSP(unsigned char, WS_H8) + (size_t)r * DM, F.lane); }
    }
}
__device__ __forceinline__ void phase_rwB(Frame& F, int l, int mrows) {
    const int rpb = (mrows + F.G - 1) / F.G, rlo = F.vcu * rpb, rhi = (rlo + rpb < mrows ? rlo + rpb : mrows) - 1;
    if (rlo > rhi) return;
    LAS float* Lf = (LAS float*)F.lds; const int ga = row_grp(rlo), gb = row_grp(rhi);
    stage_vec(F, Lf, INP(I_NORMG) + (size_t)(l * 4 + 1) * DM); stage_vec(F, Lf + 2048, INP(I_NORMG) + (size_t)(l * 4 + 2) * DM);
#pragma unroll
    for (int v = 0; v < 3; ++v) { stage_vec(F, Lf + (2 + v) * 2048, WSP(float, WS_MOD) + (size_t)(l * 9 + ga) * 12288 + (2 + v) * DM); stage_vec(F, Lf + (5 + v) * 2048, WSP(float, WS_MOD) + (size_t)(l * 9 + gb) * 12288 + (2 + v) * DM); }
    __syncthreads();
    const LAS float* g1 = Lf; const LAS float* g2 = Lf + 2048;
    for (int i0 = F.wave; i0 < rpb; i0 += 16) {
        const int r0 = rlo + i0, r1 = r0 + 8; const bool two = i0 + 8 < rpb && r1 <= rhi;
        if (r0 > rhi) break;
        RawB Ya, Yb; RawX Xa, Xb;
#define RWB_LOAD(Y_, X_, r_) do { ld_rawb(Y_, WSP(bf16_t, WS_RB + RB_Y) + (size_t)(r_) * DM, F.lane); \
        if ((r_) < ML) { if (l == 0) ld_raw_f32(X_, INP(I_X) + (size_t)(r_) * DM, F.lane); else ld_raw_bf16(X_, (const GAS bf16_t*)(F.out + (size_t)(r_) * DM), F.lane); } \
        else ld_raw_f32(X_, l == 0 ? INP(I_CTX) + (size_t)((r_) - ML) * DM : WSP(float, WS_XC) + (size_t)((r_) - ML) * DM, F.lane); } while (0)
        RWB_LOAD(Ya, Xa, r0); if (two) RWB_LOAD(Yb, Xb, r1);
#undef RWB_LOAD
#pragma unroll
        for (int q = 0; q < 2; ++q) { if (q == 1 && !two) break; const int r = q ? r1 : r0;
            Row8 Y, X; rawb_to_row(Y, q ? Yb : Ya); raw_to_row(X, q ? Xb : Xa, r < ML && l != 0);
            const float ry = row_rstd(Y); const LAS float* md = Lf + (row_grp(r) == ga ? 2 : 5) * 2048;
#pragma unroll
            for (int j = 0; j < 8; ++j) { const int c = 64 * j + F.lane; X.v[j] += ((const LAS f32x4*)md)[c] * (Y.v[j] * ry * ((const LAS f32x4*)g1)[c]); }
            if (r < ML) st_row_bf16(X, (GAS bf16_t*)(F.out + (size_t)r * DM), F.lane); else st_row_f32(X, WSP(float, WS_XC) + (size_t)(r - ML) * DM, F.lane);
            const float rx = row_rstd(X);
            st_modnorm2_l(X, rx, g2, md + 2048, md + 4096, WSP(bf16_t, WS_H) + (size_t)r * DM, WSP(unsigned char, WS_H8) + (size_t)r * DM, F.lane); }
    }
}
__device__ __forceinline__ void phase_rwC(Frame& F, int l, int mrows) {
    const int rpb = (mrows + F.G - 1) / F.G, rlo = F.vcu * rpb, rhi = (rlo + rpb < mrows ? rlo + rpb : mrows) - 1;
    if (rlo > rhi) return;
    LAS float* Lf = (LAS float*)F.lds; const int ga = row_grp(rlo), gb = row_grp(rhi);
    stage_vec(F, Lf, INP(I_NORMG) + (size_t)(l * 4 + 3) * DM);
    stage_vec(F, Lf + 2 * 2048, WSP(float, WS_MOD) + (size_t)(l * 9 + ga) * 12288 + 5 * DM); stage_vec(F, Lf + 5 * 2048, WSP(float, WS_MOD) + (size_t)(l * 9 + gb) * 12288 + 5 * DM);
    if (l + 1 < DEPTH) { stage_vec(F, Lf + 2048, INP(I_NORMG) + (size_t)((l + 1) * 4 + 0) * DM);
#pragma unroll
        for (int v = 0; v < 2; ++v) { stage_vec(F, Lf + (3 + v) * 2048, WSP(float, WS_MOD) + (size_t)((l + 1) * 9 + ga) * 12288 + v * DM); stage_vec(F, Lf + (6 + v) * 2048, WSP(float, WS_MOD) + (size_t)((l + 1) * 9 + gb) * 12288 + v * DM); } }
    __syncthreads();
    const LAS float* g3 = Lf;
    for (int i0 = F.wave; i0 < rpb; i0 += 16) {
        const int r0 = rlo + i0, r1 = r0 + 8; const bool two = i0 + 8 < rpb && r1 <= rhi;
        if (r0 > rhi) break;
        RawB Aa, Ba, Ab, Bb; RawX Xa, Xb;
#define RWC_LOAD(A_, B_, X_, r_) do { ld_rawb(A_, WSP(bf16_t, WS_RB + RB_Y2) + (size_t)(2 * (r_)) * DM, F.lane); ld_rawb(B_, WSP(bf16_t, WS_RB + RB_Y2) + (size_t)(2 * (r_) + 1) * DM, F.lane); \
        if ((r_) < ML) ld_raw_bf16(X_, (const GAS bf16_t*)(F.out + (size_t)(r_) * DM), F.lane); else ld_raw_f32(X_, WSP(float, WS_XC) + (size_t)((r_) - ML) * DM, F.lane); } while (0)
        RWC_LOAD(Aa, Ba, Xa, r0); if (two) RWC_LOAD(Ab, Bb, Xb, r1);
#undef RWC_LOAD
#pragma unroll
        for (int q = 0; q < 2; ++q) { if (q == 1 && !two) break; const int r = q ? r1 : r0;
            Row8 A, B, X; rawb_to_row(A, q ? Ab : Aa); rawb_to_row(B, q ? Bb : Ba); raw_to_row(X, q ? Xb : Xa, r < ML);
#pragma unroll
            for (int j = 0; j < 8; ++j) A.v[j] += B.v[j];
            const float ry = row_rstd(A); const LAS float* md = Lf + (row_grp(r) == ga ? 2 : 5) * 2048;
#pragma unroll
            for (int j = 0; j < 8; ++j) { const int c = 64 * j + F.lane; X.v[j] += ((const LAS f32x4*)md)[c] * (A.v[j] * ry * ((const LAS f32x4*)g3)[c]); }
            if (r >= ML) st_row_f32(X, WSP(float, WS_XC) + (size_t)(r - ML) * DM, F.lane);
            else if (l + 1 < DEPTH) st_row_bf16(X, (GAS bf16_t*)(F.out + (size_t)r * DM), F.lane);
            else st_row_f32(X, F.out + (size_t)r * DM, F.lane);
            if (l + 1 < DEPTH) { const float rx = row_rstd(X);
                st_modnorm2_l(X, rx, Lf + 2048, md + 2048, md + 4096, WSP(bf16_t, WS_HIN) + (size_t)r * DM, WSP(unsigned char, WS_H8) + (size_t)r * DM, F.lane); } }
    }
}
__device__ __forceinline__ void ld8bf(float (&o)[8], const GAS bf16_t* p) { const u32x4 w = *(const GAS u32x4*)p; o[0] = bflo(w.x); o[1] = bfhi(w.x); o[2] = bflo(w.y); o[3] = bfhi(w.y); o[4] = bflo(w.z); o[5] = bfhi(w.z); o[6] = bflo(w.w); o[7] = bfhi(w.w); }
__device__ __forceinline__ void st8bf(GAS bf16_t* p, const float (&v)[8]) { u32x4 w; w.x = cvt_pk_bf16(v[0], v[1]); w.y = cvt_pk_bf16(v[2], v[3]); w.z = cvt_pk_bf16(v[4], v[5]); w.w = cvt_pk_bf16(v[6], v[7]); *(GAS u32x4*)p = w; }
__device__ __forceinline__ void st8fp8(GAS unsigned char* p, const float (&v)[8]) {
    float c[8];
#pragma unroll
    for (int j = 0; j < 8; ++j) c[j] = __builtin_amdgcn_fmed3f(v[j], -448.f, 448.f);
    u32x2 o; unsigned w = 0; w = __builtin_amdgcn_cvt_pk_fp8_f32(c[0], c[1], w, false); w = __builtin_amdgcn_cvt_pk_fp8_f32(c[2], c[3], w, true); o.x = w;
    w = 0; w = __builtin_amdgcn_cvt_pk_fp8_f32(c[4], c[5], w, false); w = __builtin_amdgcn_cvt_pk_fp8_f32(c[6], c[7], w, true); o.y = w; *(GAS u32x2*)p = o;
}
__device__ __forceinline__ void unpk8(float (&o)[8], u32x4 w) { o[0] = bflo(w.x); o[1] = bfhi(w.x); o[2] = bflo(w.y); o[3] = bfhi(w.y); o[4] = bflo(w.z); o[5] = bfhi(w.z); o[6] = bflo(w.w); o[7] = bfhi(w.w); }
__device__ __forceinline__ void phase_finish(Frame& F, int l, int mrows) {
    const int gw = F.vcu * 8 + F.wave, NGW = F.G * 8, c8 = F.lane * 8;
    const GAS bf16_t* Y = WSP(bf16_t, WS_YFB); const GAS bf16_t* U = WSP(bf16_t, WS_RA); GAS unsigned char* BR = WSP(unsigned char, WS_BR); const GAS float* dskip = INP(I_SSDD) + l * 8;
    const float dsk = dskip[F.lane >> 3];
    struct FinRow { u32x4 v[10]; };
#define FIN_LOAD(R_, r_) do { const size_t r__ = (size_t)(r_); \
        R_.v[0] = *(const GAS u32x4*)(Y + ((size_t)0 * MT + r__) * 512 + c8); R_.v[1] = *(const GAS u32x4*)(Y + ((size_t)1 * MT + r__) * 512 + c8); R_.v[2] = *(const GAS u32x4*)(U + r__ * NU + U_MLO + c8); \
        R_.v[3] = *(const GAS u32x4*)(Y + ((size_t)2 * MT + r__) * 512 + c8); R_.v[4] = *(const GAS u32x4*)(Y + ((size_t)3 * MT + r__) * 512 + c8); R_.v[5] = *(const GAS u32x4*)(U + r__ * NU + U_HGG + c8); \
        R_.v[6] = *(const GAS u32x4*)(Y + ((size_t)4 * MT + r__) * 512 + c8); R_.v[7] = *(const GAS u32x4*)(Y + ((size_t)5 * MT + r__) * 512 + c8); R_.v[8] = *(const GAS u32x4*)(U + r__ * NU + U_Z + c8); \
        R_.v[9] = *(const GAS u32x4*)(WSP(bf16_t, WS_XBC) + r__ * 1024 + c8); } while (0)
    for (int r0 = gw; r0 < mrows; r0 += 2 * NGW) {
        const int r1 = r0 + NGW; const bool two = r1 < mrows;
        FinRow Ra, Rb; FIN_LOAD(Ra, r0); if (two) FIN_LOAD(Rb, r1);
#pragma unroll
        for (int q = 0; q < 2; ++q) { if (q == 1 && !two) break; const int r = q ? r1 : r0; const FinRow& R = q ? Rb : Ra;
            float a[8], b[8], g[8], o[8];
            unpk8(a, R.v[0]); unpk8(b, R.v[1]); unpk8(g, R.v[2]);
#pragma unroll
            for (int j = 0; j < 8; ++j) o[j] = (a[j] + b[j]) * sigmoidf_(g[j]);
            st8fp8(BR + (size_t)r * DM + c8, o);
            unpk8(a, R.v[3]); unpk8(b, R.v[4]); unpk8(g, R.v[5]);
            float ss = 0.f;
#pragma unroll
            for (int j = 0; j < 8; ++j) { a[j] += b[j]; ss += a[j] * a[j]; }
            ss += __shfl_xor(ss, 1); ss += __shfl_xor(ss, 2); ss += __shfl_xor(ss, 4); ss += __shfl_xor(ss, 8);
            const float rh = rsqrtf(ss * (1.f / 128.f) + EPS);
#pragma unroll
            for (int j = 0; j < 8; ++j) o[j] = a[j] * rh * sigmoidf_(g[j]);
            st8fp8(BR + (size_t)r * DM + 512 + c8, o);
            unpk8(a, R.v[6]); unpk8(b, R.v[7]); unpk8(g, R.v[8]);
            float s2 = 0.f, xh[8]; unpk8(xh, R.v[9]);
#pragma unroll
            for (int j = 0; j < 8; ++j) { o[j] = (a[j] + b[j] + dsk * xh[j]) * siluf_(g[j]); s2 += o[j] * o[j]; }
            s2 = wave_sum(s2);
            if (F.lane == 0) WSP(float, WS_RSSD)[r] = rsqrtf(s2 * (1.f / 512.f) + EPS);
            st8fp8(BR + (size_t)r * DM + 1536 + c8, o);
        }
    }
#undef FIN_LOAD
}

__device__ __forceinline__ void phase_ssdconv(Frame& F, int l) {
    const int gw = F.vcu * 8 + F.wave, NGW = F.G * 8, c16 = F.lane * 16;
    const GAS bf16_t* U = WSP(bf16_t, WS_RA); GAS bf16_t* X2 = WSP(bf16_t, WS_XBC);
    float w0[16], w1[16], w2[16], cb[16];
    { const GAS float* cw = INP(I_CONVW) + (size_t)l * 3 * 1024 + c16; const GAS float* bb = INP(I_CONVB) + l * 1024 + c16;
#pragma unroll
      for (int j = 0; j < 16; ++j) { w0[j] = cw[j]; w1[j] = cw[1024 + j]; w2[j] = cw[2048 + j]; cb[j] = bb[j]; } }
    for (int r = gw; r < MT; r += NGW) {
        const int t = r < ML ? (r & (SEQ - 1)) : ((r - ML) & (CTXL - 1)), tn = r < ML ? SEQ : CTXL;
        const GAS bf16_t* up = U + (size_t)r * NU + U_XBC + c16;
        float a[16], p_[16], n_[16];
        { const bool hp = t > 0, hn = t + 1 < tn; const GAS bf16_t* pp = hp ? up - NU : up; const GAS bf16_t* np = hn ? up + NU : up; const float pf = hp ? 1.f : 0.f, nf = hn ? 1.f : 0.f;
          const u32x4 ra0 = *(const GAS u32x4*)up, ra1 = *(const GAS u32x4*)(up + 8), rp0 = *(const GAS u32x4*)pp, rp1 = *(const GAS u32x4*)(pp + 8), rn0 = *(const GAS u32x4*)np, rn1 = *(const GAS u32x4*)(np + 8);
          float t8[8];
          unpk8(t8, ra0);
#pragma unroll
          for (int j = 0; j < 8; ++j) a[j] = t8[j]; unpk8(t8, ra1);
#pragma unroll
          for (int j = 0; j < 8; ++j) a[8 + j] = t8[j]; unpk8(t8, rp0);
#pragma unroll
          for (int j = 0; j < 8; ++j) p_[j] = t8[j] * pf; unpk8(t8, rp1);
#pragma unroll
          for (int j = 0; j < 8; ++j) p_[8 + j] = t8[j] * pf; unpk8(t8, rn0);
#pragma unroll
          for (int j = 0; j < 8; ++j) n_[j] = t8[j] * nf; unpk8(t8, rn1);
#pragma unroll
          for (int j = 0; j < 8; ++j) n_[8 + j] = t8[j] * nf; }
        float o[8];
#pragma unroll
        for (int j = 0; j < 8; ++j) o[j] = siluf_(w0[j] * p_[j] + w1[j] * a[j] + w2[j] * n_[j] + cb[j]);
        st8bf(X2 + (size_t)r * 1024 + c16, o);
#pragma unroll
        for (int j = 0; j < 8; ++j) o[j] = siluf_(w0[8 + j] * p_[8 + j] + w1[8 + j] * a[8 + j] + w2[8 + j] * n_[8 + j] + cb[8 + j]);
        st8bf(X2 + (size_t)r * 1024 + c16 + 8, o);
    }
}

__device__ __forceinline__ void phase_scanprep(Frame& F, int l) {
    const int gw = F.vcu * 8 + F.wave, NGW = F.G * 8, lane = F.lane, r32 = lane & 31, hi = lane >> 5;
    const GAS bf16_t* U = WSP(bf16_t, WS_RA);
    constexpr int N_ML = 64 * 72, N_SSD = 64 * 72, N_HG = 64 * 72 * 2, N_MLC = 32 * 72;
    for (int it = gw; it < N_ML + N_SSD + N_HG + N_MLC; it += NGW) {
        if (it >= N_ML + N_SSD + N_HG) {
            const int q = it - (N_ML + N_SSD + N_HG), cg = q % 72, bh = q / 72, b = bh >> 2, h = bh & 3;
            GAS bf16_t* dst = WSP(bf16_t, WS_MLC) + ((size_t)bh * 2304 + 32 * cg) * 384;
#pragma unroll 1
            for (int ib = 0; ib < 3; ++ib) { u32x4 v[8];
#pragma unroll
                for (int i = 0; i < 8; ++i) { const int piece = (ib * 8 + i) * 64 + lane, rr = piece / 48, pc = piece % 48, ci = 32 * cg + rr;
                    const int trow = ci < CTXL ? ML + b * CTXL + ci : b * SEQ + (ci - CTXL);
                    v[i] = *(const GAS u32x4*)(U + (size_t)trow * NU + (pc >> 4) * 512 + h * 128 + (pc & 15) * 8); }
#pragma unroll
                for (int i = 0; i < 8; ++i) { const int piece = (ib * 8 + i) * 64 + lane; *(GAS u32x4*)(dst + (size_t)piece * 8) = v[i]; } }
            continue;
        }
        if (it < N_ML) {
            const int c = it % 72, task = it / 72, b = task >> 3, h = (task >> 1) & 3, dir = task & 1, cg = U_MLG + dir * 8 + h;
            const float fbias = INP(I_MLFB)[l * 8 + dir * 4 + h];
            const GAS bf16_t* gp = U + (size_t)prow(b, dir, 32 * c + r32) * NU + cg; const float gi = bf2f(gp[0]), gf = bf2f(gp[4]);
            const float x_ = gf + fbias, flog = fminf(x_, 0.f) - log1pf(__expf(-fabsf(x_)));
            const float Fl = scn::scan_add32(flog, r32), bl = gi - Fl, Ml = scn::scan_max32(bl, r32);
            if (hi == 0) *(GAS f32x4*)(WSP(float, WS_MLS) + ((size_t)task * 2304 + 32 * c + r32) * 8) = (f32x4){Fl, bl, Ml, 0.f};
        } else if (it < N_ML + N_SSD) {
            const int q = it - N_ML, c = q % 72, t3 = q / 72, b = t3 >> 3, hp = (t3 >> 1) & 3, dir = t3 & 1, hd = 2 * hp + hi;
            const float dtb = INP(I_DTB)[l * 16 + dir * 8 + hd], aneg = -__expf(INP(I_ALOG)[l * 16 + dir * 8 + hd]);
            const float xr_ = bf2f(U[(size_t)prow(b, dir, 32 * c + r32) * NU + U_DT + dir * 8 + hd]) + dtb;
            const float dt_ = fmaxf(xr_, 0.f) + log1pf(__expf(-fabsf(xr_))), at = scn::scan_add32(dt_ * aneg, r32), ae = __shfl(at, 31, 32);
            GAS float* rp = WSP(float, WS_SSDS) + ((size_t)((b * 2 + dir) * 8 + hd) * 2304 + 32 * c + r32) * 8;
            *(GAS f32x4*)rp = (f32x4){dt_, at, __expf(at), __expf(ae - at)}; *(GAS f32x4*)(rp + 4) = (f32x4){__expf(ae), 0.f, 0.f, 0.f};
        } else {
            const int q = it - N_ML - N_SSD, half = q & 1, c = (q >> 1) % 72, task = (q >> 1) / 72, b = task >> 3, h = (task >> 1) & 3, dir = task & 1, r16 = lane >> 2, ch0 = half * 64 + 16 * (lane & 3);
            GAS unsigned char* item = F.ws + WS_HGP + (size_t)(task * 72 + c) * HGP_ITEM;
            const GAS float* lbp = WSP(float, WS_TAB) + 2048 + l * 512 + h * 128 + ch0;
            float lb[16], cc[16], ee[16];
            u32x4 raw[2][4];
#pragma unroll
            for (int rb = 0; rb < 2; ++rb) { const GAS bf16_t* up = U + (size_t)prow(b, dir, 32 * c + rb * 16 + r16) * NU;
                raw[rb][0] = *(const GAS u32x4*)(up + U_HGF + dir * 512 + h * 128 + ch0); raw[rb][1] = *(const GAS u32x4*)(up + U_HGF + dir * 512 + h * 128 + ch0 + 8);
                raw[rb][2] = *(const GAS u32x4*)(up + U_HGQ + h * 128 + ch0); raw[rb][3] = *(const GAS u32x4*)(up + U_HGQ + h * 128 + ch0 + 8); }
#pragma unroll
            for (int j = 0; j < 16; ++j) { lb[j] = lbp[j]; cc[j] = 0.f; ee[j] = 0.f; }
#pragma unroll
            for (int rb = 0; rb < 2; ++rb) {
                const int rloc = rb * 16 + r16;
                float fa[8], fb[8], qa[8], qb[8], q1[16], k1[16];
                unpk8(fa, raw[rb][0]); unpk8(fb, raw[rb][1]); unpk8(qa, raw[rb][2]); unpk8(qb, raw[rb][3]);
#pragma unroll
                for (int j = 0; j < 16; ++j) {
                    const float fr_ = j < 8 ? fa[j & 7] : fb[j & 7], qr_ = j < 8 ? qa[j & 7] : qb[j & 7];
                    const float f_ = lb[j] + (1.f - lb[j]) * __builtin_amdgcn_rcpf(1.f + __expf(-fr_)); float x_ = __logf(f_);
                    { const float o = __shfl_up(x_, 4); if (lane >= 4) x_ += o; } { const float o = __shfl_up(x_, 8); if (lane >= 8) x_ += o; }
                    { const float o = __shfl_up(x_, 16); if (lane >= 16) x_ += o; } { const float o = __shfl_up(x_, 32); if (lane >= 32) x_ += o; }
                    const float tot = __shfl(x_, 60 + (lane & 3));
                    float g_;
                    if (rb == 0) { cc[j] = tot; g_ = x_; } else { g_ = cc[j] + x_; ee[j] = cc[j] + tot; }
                    const float e1 = __expf(g_ - cc[j]);
                    q1[j] = qr_ * __builtin_amdgcn_rcpf(1.f + __expf(-qr_)) * e1; k1[j] = (1.f - f_) * __builtin_amdgcn_rcpf(e1);
                }
                float t8[8];
#pragma unroll
                for (int j = 0; j < 8; ++j) t8[j] = q1[j]; st8bf((GAS bf16_t*)(item + scn::rowl(rloc, ch0 * 2)), t8);
#pragma unroll
                for (int j = 0; j < 8; ++j) t8[j] = q1[8 + j]; st8bf((GAS bf16_t*)(item + scn::rowl(rloc, ch0 * 2 + 16)), t8);
#pragma unroll
                for (int j = 0; j < 8; ++j) t8[j] = k1[j]; st8bf((GAS bf16_t*)(item + 8192 + scn::rowl(rloc, ch0 * 2)), t8);
#pragma unroll
                for (int j = 0; j < 8; ++j) t8[j] = k1[8 + j]; st8bf((GAS bf16_t*)(item + 8192 + scn::rowl(rloc, ch0 * 2 + 16)), t8);
            }
            if (r16 == 0) { GAS float* vv = (GAS float*)(item + 16384) + ch0;
#pragma unroll
                for (int j = 0; j < 16; ++j) { vv[j] = __expf(cc[j]); vv[128 + j] = __expf(ee[j] - cc[j]); } }
        }
    }
}
constexpr size_t CTL_CNTB = 131072;
__device__ __forceinline__ void phase_route(Frame& F, int l, int mrows, const XcdBarrier& bar) {
    unsigned* cnt = F.ctl + CW_CNT + l * 64;
    GAS int* list = WSP(int, WS_LIST); GAS float* wl = WSP(float, WS_WL);
    GAS int* cntb = (GAS int*)(F.ws + WS_CTL + CTL_CNTB) + (size_t)l * 1024 * 32;
    LAS int* ch = (LAS int*)F.lds;
    LAS int* off = ch + 1024;
    LAS int* part = ch + 2048;
    LAS int* base = ch + 2048 + 1024;
    const int t = F.tid, bx = F.vcu, G = F.G;
    const int rpb = (mrows + G - 1) / G, r = bx * rpb + t; const bool act = t < rpb && r < mrows;
    int ea = -1, eb = -1; float wa = 0.f, wb = 0.f;
    if (act) {
        const GAS float* lg0 = WSP(float, WS_LOG) + (size_t)r * 64;
        f32x4 lgv[9];
#pragma unroll
        for (int q = 0; q < 9; ++q) { lgv[q] = *(const GAS f32x4*)(lg0 + 4 * q);
#pragma unroll
            for (int ks = 1; ks < 4; ++ks) lgv[q] += *(const GAS f32x4*)(lg0 + (size_t)ks * MT * 64 + 4 * q); }
        const f32x4 g = lgv[0]; int gi = 0; float gm = g[0];
#pragma unroll
        for (int i = 1; i < 4; ++i) if (g[i] > gm) { gm = g[i]; gi = i; }
        float gs = 0.f;
#pragma unroll
        for (int i = 0; i < 4; ++i) gs += __expf(g[i] - gm);
        const float gp = 1.f / gs;
        f32x4 e0 = lgv[1], e1 = lgv[2];
        if (gi == 1) { e0 = lgv[3]; e1 = lgv[4]; } else if (gi == 2) { e0 = lgv[5]; e1 = lgv[6]; } else if (gi == 3) { e0 = lgv[7]; e1 = lgv[8]; }
        float ev[8] = {e0[0], e0[1], e0[2], e0[3], e1[0], e1[1], e1[2], e1[3]};
        int i1 = 0; float v1 = ev[0];
#pragma unroll
        for (int i = 1; i < 8; ++i) if (ev[i] > v1) { v1 = ev[i]; i1 = i; }
        int i2 = -1; float v2 = -3.4e38f;
#pragma unroll
        for (int i = 0; i < 8; ++i) if (i != i1 && ev[i] > v2) { v2 = ev[i]; i2 = i; }
        const float w1 = 1.f / (1.f + __expf(v2 - v1)), w2 = 1.f - w1;
        ea = gi * 8 + i1; eb = gi * 8 + i2; wa = w1 * gp; wb = w2 * gp;
    }
    ch[2 * t] = ea; ch[2 * t + 1] = eb;
    __syncthreads();
    if (t < 32) {
        int c = 0; const int n2 = 2 * (rpb < 512 ? rpb : 512);
#pragma unroll 8
        for (int i = 0; i < n2; ++i) { if (ch[i] == t) { off[i] = c; ++c; } }
        cntb[bx * 32 + t] = c;
    }
    xcd_barrier(bar);
    { const int e = t & 31, p = t >> 5; int sp = 0, sa = 0;
      for (int b2 = p; b2 < G; b2 += 16) { const int c = cntb[b2 * 32 + e]; sa += c; sp += b2 < bx ? c : 0; }
      part[p * 32 + e] = sp; part[512 + p * 32 + e] = sa; }
    __syncthreads();
    if (t < 32) { int sp = 0, sa = 0;
#pragma unroll
        for (int p = 0; p < 16; ++p) { sp += part[p * 32 + t]; sa += part[512 + p * 32 + t]; }
        base[t] = sp; if (bx == 0) cnt[t] = (unsigned)sa; }
    __syncthreads();
    if (act) { const int pa = base[ea] + off[2 * t], pb = base[eb] + off[2 * t + 1];
        list[(size_t)ea * MT + pa] = r * 2; wl[(size_t)ea * MT + pa] = wa;
        list[(size_t)eb * MT + pb] = r * 2 + 1; wl[(size_t)eb * MT + pb] = wb; }
    __syncthreads();
}
__device__ __forceinline__ void moe_tables(Frame& F, int l) {
    __syncthreads();
    if (F.tid < 32) F.MISC[64 + F.tid] = __hip_atomic_load(F.ctl + CW_CNT + l * 64 + F.tid, __ATOMIC_RELAXED, __HIP_MEMORY_SCOPE_AGENT);
    __syncthreads();
    if (F.tid == 0) { int s = 0; for (int e = 0; e < 32; ++e) { F.MISC[16 + e] = s; s += ((int)F.MISC[64 + e] + 255) >> 8; } F.MISC[48] = s; }
    __syncthreads();
}

constexpr int NSTEP = CTXL + SEQ;
namespace scn {
enum { K_ML = 0, K_HG = 1, K_SSD = 2 };
constexpr int GRP_BYTES = 65536, O_QT = 0, O_KT = 8192, O_QH = 16384, O_KH = 24576, O_VT = 34816, O_VH = 45056, O_SC = 55296, O_N = 59392, O_TOT = 60416;
constexpr int NCH = (CTXL + SEQ) / 32;
__device__ __forceinline__ int crow(int r, int hi) { return (r & 3) + 8 * (r >> 2) + 4 * hi; }
template <int OFF> __device__ __forceinline__ s16x4 trr(int base) { s16x4 r; asm volatile("ds_read_b64_tr_b16 %0, %1 offset:%2" : "=&v"(r) : "v"(base), "i"(OFF) : "memory"); return r; }
#define SCN_PK(L, H) (bf16x8){L[0], L[1], L[2], L[3], H[0], H[1], H[2], H[3]}
template <int S1, int CB> __device__ __forceinline__ bf16x8 trfrag(int base) { const s16x4 lo = trr<S1 * 5120 + CB * 2>(base), hi_ = trr<S1 * 5120 + 2560 + CB * 2>(base); return SCN_PK(lo, hi_); }
__device__ __forceinline__ void unpack8(float (&o)[8], u32x4 w) { o[0] = bflo(w.x); o[1] = bfhi(w.x); o[2] = bflo(w.y); o[3] = bfhi(w.y); o[4] = bflo(w.z); o[5] = bfhi(w.z); o[6] = bflo(w.w); o[7] = bfhi(w.w); }
__device__ __forceinline__ u32x4 pack8(const float (&v)[8]) { u32x4 w; w.x = cvt_pk_bf16(v[0], v[1]); w.y = cvt_pk_bf16(v[2], v[3]); w.z = cvt_pk_bf16(v[4], v[5]); w.w = cvt_pk_bf16(v[6], v[7]); return w; }

template <int KIND>
__device__ __forceinline__ void scan_block(Frame& F, int l, int task) {
    const int tid = F.tid, wave = F.wave, lane = tid & 63, grp = wave >> 2, vb = wave & 3, gt = tid & 255, r32 = lane & 31, hi = lane >> 5;
    LAS char* L = (LAS char*)F.lds + grp * GRP_BYTES;
    const int Lb = (int)(uintptr_t)L;
    const int b = task >> 3, hx = (task >> 1) & 3, dir = task & 1;
    const int srow = gt >> 3, sp = gt & 7;
    const GAS bf16_t* U = WSP(bf16_t, WS_RA); const GAS bf16_t* X2 = WSP(bf16_t, WS_XBC);
    GAS bf16_t* YO = WSP(bf16_t, WS_YFB) + (size_t)(KIND * 2 + dir) * MT * 512;
    LAS float* SC = (LAS float*)(L + O_SC);
    int cq = 0, ck = 0, cv = 0;
    const GAS float* recA = nullptr; const GAS float* recB = nullptr; const GAS unsigned char* hgp = nullptr; const GAS bf16_t* mlc = nullptr;
    if constexpr (KIND == K_ML) { cq = U_MLQ + hx * 128 + 16 * sp; ck = U_MLK + hx * 128 + 16 * sp; cv = U_MLV + hx * 128 + 16 * sp;
        recA = WSP(float, WS_MLS) + (size_t)task * 2304 * 8; recB = recA; mlc = WSP(bf16_t, WS_MLC) + (size_t)(b * 4 + hx) * 2304 * 384; }
    if constexpr (KIND == K_HG) { cv = U_HGI + hx * 128 + 16 * sp; hgp = F.ws + WS_HGP + (size_t)task * 72 * HGP_ITEM; }
    if constexpr (KIND == K_SSD) { const int g = hx >> 1; cq = 768 + g * 128 + 16 * sp; ck = 512 + g * 128 + 16 * sp; cv = hx * 128 + 16 * sp;
        recA = WSP(float, WS_SSDS) + (size_t)((b * 2 + dir) * 8 + 2 * hx + (sp >> 2)) * 2304 * 8;
        recB = WSP(float, WS_SSDS) + (size_t)((b * 2 + dir) * 8 + 2 * hx + hi) * 2304 * 8; }
    f32x16 S[4];
#pragma unroll
    for (int k = 0; k < 4; ++k)
#pragma unroll
        for (int r = 0; r < 16; ++r) S[k][r] = 0.f;
    if (KIND == K_ML) { LAS float* nn = (LAS float*)(L + O_N); nn[gt] = 0.f; }
    float Fs = 0.f, Bp = -INFINITY;
    const int i16 = lane & 15, g4 = lane >> 4;
    const int trb = Lb + (4 * hi + (i16 >> 2)) * 320 + (16 * (g4 & 1) + 4 * (i16 & 3)) * 2;
    struct Pre { u32x4 a0, a1, b0, b1, c0, c1; f32x4 sA, sB; float g1; }; Pre P0;
#define SCN_LOAD(P, c_) do { const int c__ = (c_); const int row_ = prow(b, dir, 32 * c__ + srow); \
        if constexpr (KIND == K_SSD) { const GAS bf16_t* xp = X2 + (size_t)row_ * 1024; P.a0 = *(const GAS u32x4*)(xp + cq); P.a1 = *(const GAS u32x4*)(xp + cq + 8); P.b0 = *(const GAS u32x4*)(xp + ck); P.b1 = *(const GAS u32x4*)(xp + ck + 8); P.c0 = *(const GAS u32x4*)(xp + cv); P.c1 = *(const GAS u32x4*)(xp + cv + 8); \
            P.sA = *(const GAS f32x4*)(recA + (size_t)(32 * c__ + srow) * 8); P.sB = *(const GAS f32x4*)(recB + (size_t)(32 * c__ + r32) * 8); P.g1 = recB[(size_t)(32 * c__ + r32) * 8 + 4]; } \
        else if constexpr (KIND == K_ML) { const int p__ = 32 * c__ + srow; const int ci_ = p__ < CTXL ? (dir ? CTXL - 1 - p__ : p__) : CTXL + (dir ? SEQ - 1 - (p__ - CTXL) : p__ - CTXL); \
            const GAS bf16_t* up = mlc + (size_t)ci_ * 384 + 16 * sp; P.a0 = *(const GAS u32x4*)(up); P.a1 = *(const GAS u32x4*)(up + 8); P.b0 = *(const GAS u32x4*)(up + 128); P.b1 = *(const GAS u32x4*)(up + 136); P.c0 = *(const GAS u32x4*)(up + 256); P.c1 = *(const GAS u32x4*)(up + 264); \
            P.sA = *(const GAS f32x4*)(recA + (size_t)(32 * c__ + srow) * 8); P.sB = *(const GAS f32x4*)(recB + (size_t)(32 * c__ + r32) * 8); } \
        else { const GAS unsigned char* it_ = hgp + (size_t)c__ * HGP_ITEM; const int ra_ = rowl(srow, 32 * sp), rb_ = rowl(srow, 32 * sp + 16); \
            P.a0 = *(const GAS u32x4*)(it_ + ra_); P.a1 = *(const GAS u32x4*)(it_ + rb_); P.b0 = *(const GAS u32x4*)(it_ + 8192 + ra_); P.b1 = *(const GAS u32x4*)(it_ + 8192 + rb_); \
            const GAS bf16_t* up = U + (size_t)row_ * NU; P.c0 = *(const GAS u32x4*)(up + cv); P.c1 = *(const GAS u32x4*)(up + cv + 8); \
            if (gt < 64) P.sA = *(const GAS f32x4*)((const GAS float*)(it_ + 16384) + 4 * gt); } } while (0)
#define SCN_STAGE(P, NPAR) do { \
        const int ra = rowl(srow, 32 * sp), rb = rowl(srow, 32 * sp + 16), ta = srow * 320 + 32 * sp; \
        *(LAS u32x4*)(L + O_QT + ra) = P.a0; *(LAS u32x4*)(L + O_QT + rb) = P.a1; *(LAS u32x4*)(L + O_KT + ra) = P.b0; *(LAS u32x4*)(L + O_KT + rb) = P.b1; \
        if constexpr (KIND == K_ML) { \
            const float Fle = __shfl(P.sB[0], 31, 32), Mle = __shfl(P.sB[2], 31, 32);         \
            const float bt = P.sB[1] - Fs, Bt = fmaxf(Bp, P.sB[2] - Fs), Be = fmaxf(Bp, Mle - Fs); \
            if (vb == 0 && hi == 0) { SC[r32] = bt; SC[32 + r32] = Bt; SC[64 + r32] = __expf(Bp - Bt); SC[96 + r32] = __expf(-(Fs + P.sB[0] + Bt)); if (r32 == 0) SC[128] = __expf(Bp - Be); } \
            const float win = __expf(P.sA[1] - Fs - Be); Fs += Fle; Bp = Be; \
            { LAS const float* nq = (LAS const float*)(L + O_N) + (NPAR) * 128 + 16 * sp;        \
              const f32x4 n0 = *(const LAS f32x4*)(nq), n1 = *(const LAS f32x4*)(nq + 4), n2 = *(const LAS f32x4*)(nq + 8), n3 = *(const LAS f32x4*)(nq + 12); \
              float qa[8], qb[8]; unpack8(qa, P.a0); unpack8(qb, P.a1); \
              float d = ((qa[0] * n0[0] + qa[1] * n0[1]) + (qa[2] * n0[2] + qa[3] * n0[3])) + ((qa[4] * n1[0] + qa[5] * n1[1]) + (qa[6] * n1[2] + qa[7] * n1[3])) \
                      + ((qb[0] * n2[0] + qb[1] * n2[1]) + (qb[2] * n2[2] + qb[3] * n2[3])) + ((qb[4] * n3[0] + qb[5] * n3[1]) + (qb[6] * n3[2] + qb[7] * n3[3])); \
              d += __shfl_xor(d, 1); d += __shfl_xor(d, 2); d += __shfl_xor(d, 4); \
              if (sp == 0) SC[160 + srow] = d; } \
            float ka[8], kb_[8]; unpack8(ka, P.b0); unpack8(kb_, P.b1); \
            _Pragma("unroll") for (int j = 0; j < 8; ++j) { ka[j] *= win; kb_[j] *= win; } \
            *(LAS u32x4*)(L + O_KH + ta) = pack8(ka); *(LAS u32x4*)(L + O_KH + ta + 16) = pack8(kb_); *(LAS u32x4*)(L + O_VT + ta) = P.c0; *(LAS u32x4*)(L + O_VT + ta + 16) = P.c1; \
        } else if constexpr (KIND == K_SSD) { \
            if (vb == 0) { SC[hi * 32 + r32] = P.sB[1]; SC[64 + hi * 32 + r32] = P.sB[2]; if (r32 == 0) SC[128 + hi] = P.g1; } \
            const float dts = P.sA[0], vsc = P.sA[3]; float va[8], vb_[8]; unpack8(va, P.c0); unpack8(vb_, P.c1); \
            *(LAS u32x4*)(L + O_KH + ta) = P.b0; *(LAS u32x4*)(L + O_KH + ta + 16) = P.b1; \
            _Pragma("unroll") for (int j = 0; j < 8; ++j) { va[j] *= dts; vb_[j] *= dts; } \
            *(LAS u32x4*)(L + O_VT + ta) = pack8(va); *(LAS u32x4*)(L + O_VT + ta + 16) = pack8(vb_); \
            _Pragma("unroll") for (int j = 0; j < 8; ++j) { va[j] *= vsc; vb_[j] *= vsc; } \
            *(LAS u32x4*)(L + O_VH + ta) = pack8(va); *(LAS u32x4*)(L + O_VH + ta + 16) = pack8(vb_); \
        } else { \
            *(LAS u32x4*)(L + O_KH + ta) = P.b0; *(LAS u32x4*)(L + O_KH + ta + 16) = P.b1; *(LAS u32x4*)(L + O_VT + ta) = P.c0; *(LAS u32x4*)(L + O_VT + ta + 16) = P.c1; \
            if (gt < 64) *(LAS f32x4*)(SC + 4 * gt) = P.sA; \
        } } while (0)
    constexpr int OQH = O_QT, OVH = (KIND == K_SSD) ? O_VH : O_VT;
    auto compute = [&](const int c) __attribute__((always_inline)) {
        const int hh = vb >> 1;
        if constexpr (KIND == K_HG) {
#pragma unroll
            for (int kb = 0; kb < 4; ++kb)
#pragma unroll
                for (int r = 0; r < 16; ++r) S[kb][r] *= SC[32 * kb + crow(r, hi)];
        }
        f32x16 acc;
#pragma unroll
        for (int r = 0; r < 16; ++r) acc[r] = 0.f;
        if (c > 0) {
#pragma unroll
            for (int kb = 0; kb < 4; ++kb)
#pragma unroll
                for (int s1 = 0; s1 < 2; ++s1) {
                    u32x4 aw; aw.x = cvt_pk_bf16(S[kb][8 * s1 + 0], S[kb][8 * s1 + 1]); aw.y = cvt_pk_bf16(S[kb][8 * s1 + 2], S[kb][8 * s1 + 3]); aw.z = cvt_pk_bf16(S[kb][8 * s1 + 4], S[kb][8 * s1 + 5]); aw.w = cvt_pk_bf16(S[kb][8 * s1 + 6], S[kb][8 * s1 + 7]);
                    const int cb0 = (32 * kb + 16 * s1 + 4 * hi) * 2;
                    const u32x2 lo = *(const LAS u32x2*)(L + OQH + rowl(r32, cb0)), hi2 = *(const LAS u32x2*)(L + OQH + rowl(r32, cb0 + 16));
                    const u32x4 bw = {lo.x, lo.y, hi2.x, hi2.y};
                    acc = __builtin_amdgcn_mfma_f32_32x32x16_bf16(__builtin_bit_cast(bf16x8, aw), __builtin_bit_cast(bf16x8, bw), acc, 0, 0, 0);
                }
            if constexpr (KIND == K_ML) { const float w = SC[64 + r32];
#pragma unroll
                for (int r = 0; r < 16; ++r) acc[r] *= w; }
            if constexpr (KIND == K_SSD) { const float w = SC[64 + hh * 32 + r32];
#pragma unroll
                for (int r = 0; r < 16; ++r) acc[r] *= w; }
        }
        f32x16 p;
#pragma unroll
        for (int r = 0; r < 16; ++r) p[r] = 0.f;
#pragma unroll
        for (int kk = 0; kk < 8; ++kk) { const int cb0 = (16 * kk + 8 * hi) * 2;
            const bf16x8 a = *(const LAS bf16x8*)(L + O_KT + rowl(r32, cb0)), bq = *(const LAS bf16x8*)(L + O_QT + rowl(r32, cb0));
            p = __builtin_amdgcn_mfma_f32_32x32x16_bf16(a, bq, p, 0, 0, 0); }
        float den = 0.f;
        if constexpr (KIND == K_ML) { const float Bt = SC[32 + r32];
            f32x4 bs4[4];
#pragma unroll
            for (int q = 0; q < 4; ++q) bs4[q] = *(const LAS f32x4*)(SC + 8 * q + 4 * hi);
#pragma unroll
            for (int r = 0; r < 16; ++r) { const int s_ = crow(r, hi); float w = __expf(fminf(bs4[r >> 2][r & 3] - Bt, 0.f)); w = s_ <= r32 ? w : 0.f; p[r] *= w; den += p[r]; }
            { auto rr = __builtin_amdgcn_permlane32_swap(__float_as_uint(den), __float_as_uint(den), false, false); den = __uint_as_float(rr[0]) + __uint_as_float(rr[1]); }
        } else if constexpr (KIND == K_SSD) { const float at = SC[hh * 32 + r32];
            f32x4 as_[4];
#pragma unroll
            for (int q = 0; q < 4; ++q) as_[q] = *(const LAS f32x4*)(SC + hh * 32 + 8 * q + 4 * hi);
#pragma unroll
            for (int r = 0; r < 16; ++r) { const int s_ = crow(r, hi); float w = __expf(fminf(at - as_[r >> 2][r & 3], 0.f)); p[r] *= s_ <= r32 ? w : 0.f; }
        } else {
#pragma unroll
            for (int r = 0; r < 16; ++r) { if (crow(r, hi) > r32) p[r] = 0.f; }
        }
        {
            u32x4 w0, w1; w0.x = cvt_pk_bf16(p[0], p[1]); w0.y = cvt_pk_bf16(p[2], p[3]); w0.z = cvt_pk_bf16(p[4], p[5]); w0.w = cvt_pk_bf16(p[6], p[7]);
            w1.x = cvt_pk_bf16(p[8], p[9]); w1.y = cvt_pk_bf16(p[10], p[11]); w1.z = cvt_pk_bf16(p[12], p[13]); w1.w = cvt_pk_bf16(p[14], p[15]);
            const int vbase = trb + O_VT + vb * 64;
            const bf16x8 v0 = trfrag<0, 0>(vbase), v1 = trfrag<1, 0>(vbase);
            asm volatile("s_waitcnt lgkmcnt(0)" ::: "memory"); __builtin_amdgcn_sched_barrier(0);
            acc = __builtin_amdgcn_mfma_f32_32x32x16_bf16(v0, __builtin_bit_cast(bf16x8, w0), acc, 0, 0, 0);
            acc = __builtin_amdgcn_mfma_f32_32x32x16_bf16(v1, __builtin_bit_cast(bf16x8, w1), acc, 0, 0, 0);
        }
        float oscale = 1.f;
        if constexpr (KIND == K_ML) {
            LAS const float* nn = (LAS const float*)(L + O_N) + (c & 1) * 128;
            const float ds = SC[160 + r32] * SC[64 + r32];
            oscale = __builtin_amdgcn_rcpf(fmaxf(fabsf(den + ds), SC[96 + r32]));
            { const int k = 32 * vb + r32; float sm = 0.f;
#pragma unroll
              for (int s_ = 0; s_ < 16; ++s_) sm += bf2f(*(const LAS bf16_t*)(L + O_KH + (16 * hi + s_) * 320 + k * 2));
              { auto rr = __builtin_amdgcn_permlane32_swap(__float_as_uint(sm), __float_as_uint(sm), false, false); sm = __uint_as_float(rr[0]) + __uint_as_float(rr[1]); }
              LAS float* n2 = (LAS float*)(L + O_N) + ((c + 1) & 1) * 128;
              if (hi == 0) n2[k] = SC[128] * nn[k] + sm; }
        }
        { const int orow = prow(b, dir, 32 * c + r32); GAS bf16_t* yp = YO + (size_t)orow * 512 + hx * 128 + 32 * vb + 4 * hi;
#pragma unroll
          for (int q = 0; q < 4; ++q) { u32x2 w; w.x = cvt_pk_bf16(acc[4 * q] * oscale, acc[4 * q + 1] * oscale); w.y = cvt_pk_bf16(acc[4 * q + 2] * oscale, acc[4 * q + 3] * oscale); *(GAS u32x2*)(yp + 8 * q) = w; } }
        {
            const int kbase = trb + O_KH, vbase = trb + OVH + vb * 64;
            const bf16x8 vh0 = trfrag<0, 0>(vbase), vh1 = trfrag<1, 0>(vbase);
            const bf16x8 k00 = trfrag<0, 0>(kbase), k01 = trfrag<1, 0>(kbase), k10 = trfrag<0, 32>(kbase), k11 = trfrag<1, 32>(kbase);
            const bf16x8 k20 = trfrag<0, 64>(kbase), k21 = trfrag<1, 64>(kbase), k30 = trfrag<0, 96>(kbase), k31 = trfrag<1, 96>(kbase);
            if constexpr (KIND != K_HG) { const float rd = KIND == K_ML ? SC[128] : SC[128 + hh];
#pragma unroll
                for (int kb = 0; kb < 4; ++kb)
#pragma unroll
                    for (int r = 0; r < 16; ++r) S[kb][r] *= rd; }
            asm volatile("s_waitcnt lgkmcnt(0)" ::: "memory"); __builtin_amdgcn_sched_barrier(0);
            S[0] = __builtin_amdgcn_mfma_f32_32x32x16_bf16(k00, vh0, S[0], 0, 0, 0); S[0] = __builtin_amdgcn_mfma_f32_32x32x16_bf16(k01, vh1, S[0], 0, 0, 0);
            S[1] = __builtin_amdgcn_mfma_f32_32x32x16_bf16(k10, vh0, S[1], 0, 0, 0); S[1] = __builtin_amdgcn_mfma_f32_32x32x16_bf16(k11, vh1, S[1], 0, 0, 0);
            S[2] = __builtin_amdgcn_mfma_f32_32x32x16_bf16(k20, vh0, S[2], 0, 0, 0); S[2] = __builtin_amdgcn_mfma_f32_32x32x16_bf16(k21, vh1, S[2], 0, 0, 0);
            S[3] = __builtin_amdgcn_mfma_f32_32x32x16_bf16(k30, vh0, S[3], 0, 0, 0); S[3] = __builtin_amdgcn_mfma_f32_32x32x16_bf16(k31, vh1, S[3], 0, 0, 0);
            if constexpr (KIND == K_HG) {
#pragma unroll
                for (int kb = 0; kb < 4; ++kb)
#pragma unroll
                    for (int r = 0; r < 16; ++r) S[kb][r] *= SC[128 + 32 * kb + crow(r, hi)];
            }
        }
    };
    {
        SCN_LOAD(P0, 0);
        __syncthreads();
        SCN_STAGE(P0, 0);
        __syncthreads();
        for (int c = 0; c < NCH; ++c) {
            if (c + 1 < NCH) SCN_LOAD(P0, c + 1);
            compute(c);
            __syncthreads();
            if (c + 1 < NCH) { SCN_STAGE(P0, (c + 1) & 1); }
            __syncthreads();
        }
    }
#undef SCN_LOAD
#undef SCN_STAGE
}
}

namespace att {
constexpr int KVBLK = 64, SHM_V = 64 * 128 * 2, SHM_K = 64 * 192 * 2;
constexpr float THRL = 11.5f;
#define AKSWZ(row, colB) ((row) * 384 + ((colB) ^ (((row) & 7) << 4)))
#define ASBAR() __builtin_amdgcn_sched_barrier(0)
__device__ __forceinline__ int crow(int r, int hi) { return (r & 3) + 8 * (r >> 2) + 4 * hi; }
__device__ __forceinline__ void partialSM(f32x16& p0, f32x16& p1, float& m_reg, float& mn, float& alpha) {
    float pmax = p0[0];
#pragma unroll
    for (int r = 1; r < 16; ++r) pmax = fmaxf(pmax, p0[r]);
#pragma unroll
    for (int r = 0; r < 16; ++r) pmax = fmaxf(pmax, p1[r]);
    { auto rr = __builtin_amdgcn_permlane32_swap(__float_as_uint(pmax), __float_as_uint(pmax), false, false); pmax = fmaxf(__uint_as_float(rr[0]), __uint_as_float(rr[1])); }
    if (__builtin_expect(__all(pmax - m_reg <= THRL), 1)) { mn = m_reg; alpha = 1.f; }
    else { mn = fmaxf(m_reg, pmax); alpha = __builtin_amdgcn_exp2f(m_reg - mn); m_reg = mn; }
#pragma unroll
    for (int r = 0; r < 16; ++r) p0[r] = __builtin_amdgcn_exp2f(p0[r] - mn);
#pragma unroll
    for (int r = 0; r < 16; ++r) p1[r] = p1[r] - mn;
}
__device__ __forceinline__ void finishSM(f32x16& p0, f32x16& p1, float alpha, float& l_reg, bf16x8& pa0, bf16x8& pa1, bf16x8& pa2, bf16x8& pa3) {
#pragma unroll
    for (int r = 0; r < 16; ++r) p1[r] = __builtin_amdgcn_exp2f(p1[r]);
    float ps = 0;
#pragma unroll
    for (int r = 0; r < 16; ++r) ps += p0[r];
#pragma unroll
    for (int r = 0; r < 16; ++r) ps += p1[r];
    { auto rr = __builtin_amdgcn_permlane32_swap(__float_as_uint(ps), __float_as_uint(ps), false, false); ps = __uint_as_float(rr[0]) + __uint_as_float(rr[1]); }
    l_reg = l_reg * alpha + ps;
#define APK4(P, BASE, OUT) do { unsigned a0 = cvt_pk_bf16(P[BASE + 0], P[BASE + 1]), a1 = cvt_pk_bf16(P[BASE + 2], P[BASE + 3]);   \
    unsigned b0 = cvt_pk_bf16(P[BASE + 4], P[BASE + 5]), b1 = cvt_pk_bf16(P[BASE + 6], P[BASE + 7]);                              \
    auto r0 = __builtin_amdgcn_permlane32_swap(a0, b0, false, false); auto r1 = __builtin_amdgcn_permlane32_swap(a1, b1, false, false); \
    u32x4 w = {r0[0], r1[0], r0[1], r1[1]}; OUT = __builtin_bit_cast(bf16x8, w); } while (0)
    APK4(p0, 0, pa0); APK4(p0, 8, pa1); APK4(p1, 0, pa2); APK4(p1, 8, pa3);
#undef APK4
}
__device__ __forceinline__ void qkt(f32x16& p0, f32x16& p1, const LAS char* Ks, const bf16x8* qr, int r32, int hi) {
    p0 = f32x16{}; p1 = f32x16{};
#pragma unroll
    for (int d0 = 0; d0 < 12; ++d0) { const int cb = (d0 * 16 + hi * 8) * 2;
        const bf16x8 b0 = *(const LAS bf16x8*)(Ks + AKSWZ(r32, cb));
        const bf16x8 b1 = *(const LAS bf16x8*)(Ks + AKSWZ(32 + r32, cb));
        p0 = __builtin_amdgcn_mfma_f32_32x32x16_bf16(b0, qr[d0], p0, 0, 0, 0);
        p1 = __builtin_amdgcn_mfma_f32_32x32x16_bf16(b1, qr[d0], p1, 0, 0, 0); }
}
__device__ __forceinline__ int v_st(int k, int c) { const int kk = (k & ~0xC) | ((k & 4) << 1) | ((k & 8) >> 1); return ((kk >> 3) * 4 + (c >> 5)) * 512 + ((kk & 7) * 32 + (c & 31)) * 2; }
__device__ __forceinline__ int v_rd_base(int lane) { return ((lane & 3) << 3) | (((lane >> 2) & 3) << 6) | (((lane >> 4) & 1) << 5) | (((lane >> 5) & 1) << 8); }
constexpr int v_rd_off(int d0, int ks, int half) { return d0 * 512 + ks * 4096 + half * 2048; }
template <int OFF> __device__ __forceinline__ s16x4 tr_read(int vb) { s16x4 r; asm volatile("ds_read_b64_tr_b16 %0, %1 offset:%2" : "=&v"(r) : "v"(vb), "i"(OFF) : "memory"); return r; }
template <int D0> __device__ __forceinline__ void pv_one(f32x16& od, int vb, bf16x8 pa0, bf16x8 pa1, bf16x8 pa2, bf16x8 pa3) {
    const s16x4 l0 = tr_read<v_rd_off(D0, 0, 0)>(vb), h0 = tr_read<v_rd_off(D0, 0, 1)>(vb), l1 = tr_read<v_rd_off(D0, 1, 0)>(vb), h1 = tr_read<v_rd_off(D0, 1, 1)>(vb);
    const s16x4 l2 = tr_read<v_rd_off(D0, 2, 0)>(vb), h2 = tr_read<v_rd_off(D0, 2, 1)>(vb), l3 = tr_read<v_rd_off(D0, 3, 0)>(vb), h3 = tr_read<v_rd_off(D0, 3, 1)>(vb);
    asm volatile("s_waitcnt lgkmcnt(0)" ::: "memory"); ASBAR();
#define APK(L, H) (bf16x8){L[0], L[1], L[2], L[3], H[0], H[1], H[2], H[3]}
    od = __builtin_amdgcn_mfma_f32_32x32x16_bf16(pa0, APK(l0, h0), od, 0, 0, 0);
    od = __builtin_amdgcn_mfma_f32_32x32x16_bf16(pa1, APK(l1, h1), od, 0, 0, 0);
    od = __builtin_amdgcn_mfma_f32_32x32x16_bf16(pa2, APK(l2, h2), od, 0, 0, 0);
    od = __builtin_amdgcn_mfma_f32_32x32x16_bf16(pa3, APK(l3, h3), od, 0, 0, 0);
#undef APK
}
__device__ __forceinline__ void pv_d0(f32x16* o, int vb, bf16x8 pa0, bf16x8 pa1, bf16x8 pa2, bf16x8 pa3) {
    pv_one<0>(o[0], vb, pa0, pa1, pa2, pa3); pv_one<1>(o[1], vb, pa0, pa1, pa2, pa3); pv_one<2>(o[2], vb, pa0, pa1, pa2, pa3); pv_one<3>(o[3], vb, pa0, pa1, pa2, pa3);
}
__device__ __forceinline__ void attn_unit(const GAS bf16_t* __restrict__ QB, const GAS bf16_t* __restrict__ KVB, const GAS bf16_t* __restrict__ U, GAS unsigned char* __restrict__ BR,
                                          int qrow0, int h, int kctx0, int klat0, int nct, int NT, LAS char* lds) {
    const int tid = opaque_tid(), wid = tid >> 6, lane = tid & 63, r32 = lane & 31, hi = lane >> 5;
    LAS char* V_lds = lds; LAS char* K_lds = lds + 2 * SHM_V;
    LAS float* ws = (LAS float*)(lds + 2 * SHM_V + 2 * SHM_K) + wid * 64; LAS float* li_l = ws; LAS float* al_l = ws + 32;
    float m_reg = -1e30f, l_reg = 0; f32x16 o[4] = {}; bf16x8 qr[12];
    const GAS bf16_t* Qw = QB + (size_t)(qrow0 + wid * 32 + r32) * 768;
#pragma unroll
    for (int d0 = 0; d0 < 8; ++d0) qr[d0] = *(const GAS bf16x8*)(Qw + h * 128 + d0 * 16 + hi * 8);
#pragma unroll
    for (int d0 = 8; d0 < 12; ++d0) qr[d0] = *(const GAS bf16x8*)(Qw + 512 + h * 64 + (d0 - 8) * 16 + hi * 8);
    const int sr = tid >> 4, sc = (tid & 15) * 8, vst0 = v_st(sr, sc), vst1 = v_st(32 + sr, sc), rr_ = tid >> 3, rc_ = (tid & 7) * 8;
    const int vb0 = (int)(uintptr_t)V_lds + v_rd_base(lane);
    struct { bf16x8 vs0, vs1, ks0, ks1, kr; } sr_[1];
#define ASLOAD(i, j_) do { const int j__ = (j_); const int k0 = j__ < nct ? kctx0 + 64 * j__ : klat0 + 64 * (j__ - nct); \
    sr_[i].vs0 = *(const GAS bf16x8*)(KVB + (size_t)(k0 + sr) * 1024 + 512 + h * 128 + sc); sr_[i].vs1 = *(const GAS bf16x8*)(KVB + (size_t)(k0 + 32 + sr) * 1024 + 512 + h * 128 + sc); \
    sr_[i].ks0 = *(const GAS bf16x8*)(KVB + (size_t)(k0 + sr) * 1024 + h * 128 + sc); sr_[i].ks1 = *(const GAS bf16x8*)(KVB + (size_t)(k0 + 32 + sr) * 1024 + h * 128 + sc); \
    sr_[i].kr = *(const GAS bf16x8*)(U + (size_t)(k0 + rr_) * NU + U_KR + rc_); } while (0)
#define ASWRITE(b, i) do { *(LAS bf16x8*)(V_lds + (b) * SHM_V + vst0) = sr_[i].vs0; *(LAS bf16x8*)(V_lds + (b) * SHM_V + vst1) = sr_[i].vs1; \
    *(LAS bf16x8*)(K_lds + (b) * SHM_K + AKSWZ(sr, sc * 2)) = sr_[i].ks0; *(LAS bf16x8*)(K_lds + (b) * SHM_K + AKSWZ(32 + sr, sc * 2)) = sr_[i].ks1; \
    *(LAS bf16x8*)(K_lds + (b) * SHM_K + AKSWZ(rr_, 256 + rc_ * 2)) = sr_[i].kr; } while (0)
#define ASWAIT() asm volatile("s_waitcnt vmcnt(0)" ::: "memory")
#define ARESC(a) do { if (__any((a) < 1.f)) { if (hi == 0) al_l[r32] = (a); asm volatile("s_waitcnt lgkmcnt(0)" ::: "memory"); \
    _Pragma("unroll") for (int d = 0; d < 4; ++d) _Pragma("unroll") for (int r = 0; r < 16; ++r) o[d][r] *= al_l[crow(r, hi)]; } } while (0)
    f32x16 pA0, pA1; float mnA, alA; bf16x8 pa0, pa1, pa2, pa3;
    ASLOAD(0, 0); asm volatile("s_waitcnt vmcnt(0)" ::: "memory"); ASWRITE(0, 0); __syncthreads();
    for (int j = 0; j < NT; ++j) {
        const int bsel = j & 1;
        if (j + 1 < NT) ASLOAD(0, j + 1);
        ASBAR(); qkt(pA0, pA1, K_lds + bsel * SHM_K, qr, r32, hi);
        partialSM(pA0, pA1, m_reg, mnA, alA);
        ARESC(alA);
        finishSM(pA0, pA1, alA, l_reg, pa0, pa1, pa2, pa3); ASBAR();
        pv_d0(o, vb0 + bsel * SHM_V, pa0, pa1, pa2, pa3);
        if (j + 1 < NT) { ASWAIT(); ASWRITE(bsel ^ 1, 0); }
        __syncthreads();
    }
    if (hi == 0) li_l[r32] = l_reg; asm volatile("s_waitcnt lgkmcnt(0)" ::: "memory");
    GAS unsigned char* Ow = BR + (size_t)(qrow0 + wid * 32) * DM + 1024 + h * 128;
#pragma unroll
    for (int r = 0; r < 16; ++r) { const int orow = crow(r, hi); const float rl = __builtin_amdgcn_rcpf(li_l[orow]);
#pragma unroll
        for (int d0 = 0; d0 < 4; ++d0) { const float v = __builtin_amdgcn_fmed3f(o[d0][r] * rl, -448.f, 448.f); Ow[(size_t)orow * DM + d0 * 32 + r32] = (unsigned char)(__builtin_amdgcn_cvt_pk_fp8_f32(v, 0.f, 0u, false) & 0xffu); } }
    __syncthreads();
#undef ASLOAD
#undef ASWRITE
#undef ASWAIT
#undef ARESC
}
}

constexpr int PH_PER_LAYER = 13, NPHASE = 2 + DEPTH * PH_PER_LAYER;
struct Args { const float* in[N_IN]; float* out; unsigned char* ws; int ph_lo, ph_hi; };
static_assert(sizeof(Args) == N_IN * 8 + 8 + 8 + 8, "Args has no padding");

#ifndef REP_G1
#define REP_G1 1
#endif
#ifndef REP_G2
#define REP_G2 1
#endif
#ifndef REP_G5
#define REP_G5 1
#endif
#ifndef REP_G6
#define REP_G6 1
#endif
#ifndef REP_G8
#define REP_G8 1
#endif
#ifndef REP_G10
#define REP_G10 1
#endif
#ifndef REP_G11
#define REP_G11 1
#endif
#ifndef REP_R4
#define REP_R4 1
#endif
#ifndef PH_MASK
#define PH_MASK 0xffffffffu
#endif
#define IN(k) (lo <= (k) && (k) < hi)
#define EN(j) ((PH_MASK >> (j)) & 1u)
#ifndef SUBMASK
#define SUBMASK 7
#endif
#define REFRESH() do { F.tid = opaque_tid(); F.lane = F.tid & 63; F.wave = __builtin_amdgcn_readfirstlane(F.tid >> 6); \
    F.ws = (GAS unsigned char*)opaque_ptr(args.ws); F.ctl = (unsigned*)opaque_ptr(args.ws + WS_CTL); F.out = (GAS float*)opaque_ptr(args.out); } while (0)
#ifdef PROBE_MASK
#define STAMP(k) do { if (blockIdx.x == 0 && threadIdx.x == 0) ((volatile unsigned long long*)(args.ws + WS_CTL + 65536))[16 + (k)] = __builtin_amdgcn_s_memrealtime(); } while (0)
#else
#define STAMP(k) do { } while (0)
#endif
#define SEAM(k) do { if (IN(k) && IN((k) + 1)) xcd_barrier(bar); STAMP((k) + 1); } while (0)
template <int l> __device__ __forceinline__ void layer_phases(Frame& F, const Args& args, const XcdBarrier& bar, const int lo, const int hi, char* ldsg) {
        const int pb = 2 + l * PH_PER_LAYER;
        const int mrows = (l + 1 < DEPTH) ? MT : ML;
        GAS bf16_t* const Hb = WSP(bf16_t, WS_H); GAS bf16_t* const Ub = WSP(bf16_t, WS_RA);
        if (IN(pb + 0) && EN(0) && l == 0) { REFRESH(); phase_rwA(F, l); }
        if (l == 0) SEAM(pb + 0);
        if (IN(pb + 1) && EN(1)) for (int rp_ = 0; rp_ < REP_G1; ++rp_) { REFRESH();
            EpiWin E{Ub, WSP(float, WS_SSQ), WSP(float, WS_TAB)};
            { Gemm g{WSP(bf16_t, WS_HIN), WSP(bf16_t, WS_WIN) + (size_t)l * NU * DM, DM, DM, DM};
              WinSched S; S.gs.init(MT / 256, 5, F.G, (int)blockIdx.x, (size_t)256 * DM * 2, (size_t)256 * DM * 2, 0, 0); S.mode = 1;
              pg8::gemm_phase<EpiWin, WinSched, false>(F.lds, g, S, E); }
            { Gemm g{(const GAS bf16_t*)WSP(unsigned char, WS_H8), (const GAS bf16_t*)(WSP(unsigned char, WS_WIN8) + (size_t)l * NU * DM), DM / 2, DM / 2, DM / 2};
              WinSched S; S.gs.init(MT / 256, 23, F.G, (int)((blockIdx.x + 152) & 255), (size_t)256 * DM, (size_t)256 * DM, 0, 0); S.mode = 0;
              pg8::gemm_phase<EpiWin, WinSched, false, true>(F.lds, g, S, E); }
        }
        SEAM(pb + 1);
        if (IN(pb + 2) && EN(2)) for (int rp_ = 0; rp_ < REP_G2; ++rp_) { REFRESH();
            if (SUBMASK & 1) { Gemm g{Ub, WSP(bf16_t, WS_WUQ) + (size_t)l * 768 * 512, NU, 512, 512};
              GridSched S; S.init(MT / 256, 3, F.G, (int)blockIdx.x, (size_t)256 * NU * 2, (size_t)256 * 512 * 2, (size_t)U_CQ * 2, 0);
              EpiMlaQ E{WSP(bf16_t, WS_QB), WSP(float, WS_SSQ), WSP(float, WS_TAB)};
              pg8::gemm_phase<EpiMlaQ, GridSched, false>(F.lds, g, S, E); }
            if (SUBMASK & 2) { Gemm g{Ub, WSP(bf16_t, WS_WUKV) + (size_t)l * 1024 * 256, NU, 256, 256};
              GridSched S; S.init(MT / 256, 4, F.G, (int)blockIdx.x, (size_t)256 * NU * 2, (size_t)256 * 256 * 2, (size_t)U_CKV * 2, 0);
              EpiMlaKV E{WSP(bf16_t, WS_KVB), WSP(float, WS_SSQ)};
              pg8::gemm_phase<EpiMlaKV, GridSched, false>(F.lds, g, S, E); }
            if (SUBMASK & 4) { Gemm g{(const GAS bf16_t*)WSP(unsigned char, WS_H8), (const GAS bf16_t*)(WSP(unsigned char, WS_WG) + (size_t)l * 8192 * DM), DM / 2, DM / 2, DM / 2};
              GridSched S; S.init(mrows / 256, 32, F.G, (int)blockIdx.x, (size_t)256 * DM, (size_t)256 * DM, 0, 0);
              EpiGate E{WSP(unsigned char, WS_RB)};
              pg8::gemm_phase<EpiGate, GridSched, false, true>(F.lds, g, S, E); }
            phase_ssdconv(F, l);
            phase_scanprep(F, l);
        }
        SEAM(pb + 2);
#ifndef REP_MIX
#define REP_MIX 1
#endif
        if (IN(pb + 3) && EN(3)) for (int rep_ = 0; rep_ < REP_MIX; ++rep_) { REFRESH();
            const int bx = blockIdx.x;
#ifndef REPMASK
#define REPMASK 15
#endif
#ifdef ONLYK
            const int SCANMASK = ONLYK;
#else
            const int SCANMASK = rep_ == 0 ? 15 : REPMASK;
#endif
            if (bx < 64) {
                if (__builtin_amdgcn_readfirstlane(F.wave) < 4) scn::scan_block<scn::K_ML>(F, l, bx); else scn::scan_block<scn::K_HG>(F, l, bx); }
            else if (bx < 96) { scn::scan_block<scn::K_SSD>(F, l, (bx - 64) * 2 + (F.wave >> 2)); }
            else if (SCANMASK & 8) {
                const int natt = 256 + (l + 1 < DEPTH ? 32 : 0), nab = F.G - 96;
                for (int ua = bx - 96; ua < natt; ua += nab) {
                    if (ua < 256) { const int b = ua >> 5, h = (ua >> 3) & 3, qb = ua & 7;
                        att::attn_unit(WSP(bf16_t, WS_QB), WSP(bf16_t, WS_KVB), Ub, WSP(unsigned char, WS_BR), b * SEQ + qb * 256, h, ML + b * CTXL, b * SEQ, 4, 36, (LAS char*)F.lds); }
                    else { const int uc = ua - 256, b = uc >> 2, h = uc & 3;
                        att::attn_unit(WSP(bf16_t, WS_QB), WSP(bf16_t, WS_KVB), Ub, WSP(unsigned char, WS_BR), ML + b * CTXL, h, ML + b * CTXL, 0, 4, 4, (LAS char*)F.lds); }
                }
                if (rep_ == 0) {
                    LAS float* scr = (LAS float*)(F.lds + F.wave * 16384);
                    if (l + 1 == DEPTH) { for (int it = (bx - 96) * 8 + F.wave; it < IT_MOE; it += (F.G - 96) * 8) cvt_moe_item(F, l, it, scr); }
                    else { for (int it = (bx - 96) * 8 + F.wave; it < IT_LAYER + IT_MOE / 2; it += (F.G - 96) * 8) { if (it < IT_LAYER) cvt_layer_item(F, l + 1, it, scr); else cvt_moe_item(F, l, it - IT_LAYER, scr); } }
                }
            }
        }
        SEAM(pb + 3);
        if (IN(pb + 4) && EN(4)) for (int rp_ = 0; rp_ < REP_R4; ++rp_) { REFRESH(); phase_finish(F, l, mrows); }
        SEAM(pb + 4);
        if (IN(pb + 5) && EN(5)) for (int rp_ = 0; rp_ < REP_G5; ++rp_) { REFRESH();
            Gemm g{(const GAS bf16_t*)WSP(unsigned char, WS_BR), (const GAS bf16_t*)(WSP(unsigned char, WS_WBR) + (size_t)l * 4 * DM * 512), DM / 2, 256, 256};
            MergeSched S; S.gs.init(mrows / 256, 8, F.G, (int)blockIdx.x, 0, 0, 0, 0);
            EpiMerge E{WSP(unsigned char, WS_RB), WSP(unsigned char, WS_RA + RA_ACC), F.ws + WS_RA + RA_PART + (size_t)blockIdx.x * 131072, WSP(float, WS_RSSD)};
            pg8::gemm_phase<EpiMerge, MergeSched, false, true>(F.lds, g, S, E);
            if (l == 0 && blockIdx.x >= 64) {
                LAS float* scr = (LAS float*)(F.lds + F.wave * 16384);
                for (int it = IT_MOE / 2 + ((int)blockIdx.x - 64) * 8 + F.wave; it < IT_MOE; it += 192 * 8) cvt_moe_item(F, 0, it, scr);
            }
        }
        SEAM(pb + 5);
        if (IN(pb + 6) && EN(6)) for (int rp_ = 0; rp_ < REP_G6; ++rp_) { REFRESH();
            Gemm g{(const GAS bf16_t*)WSP(unsigned char, WS_RA + RA_ACC), (const GAS bf16_t*)(WSP(unsigned char, WS_WOUT) + (size_t)l * DM * DM), DM / 2, DM / 2, DM / 2};
            GridSched S; S.init(mrows / 256, 8, F.G, (int)blockIdx.x, (size_t)256 * DM, (size_t)256 * DM, 0, 0);
            EpiBf16 E{WSP(bf16_t, WS_RB + RB_Y), DM};
            pg8::gemm_phase<EpiBf16, GridSched, false, true>(F.lds, g, S, E);
        }
        SEAM(pb + 6);
        if (IN(pb + 7) && EN(7)) { REFRESH(); phase_rwB(F, l, mrows); }
        SEAM(pb + 7);
        if (IN(pb + 8) && EN(8)) for (int rp_ = 0; rp_ < REP_G8; ++rp_) { REFRESH();
            Gemm g{Hb, WSP(bf16_t, WS_WR) + (size_t)l * 256 * DM, DM, DM, 512};
            RouterSched S{mrows / 256, F.G, (int)blockIdx.x};
            EpiRouter E{WSP(float, WS_LOG)};
            pg8::gemm_phase<EpiRouter, RouterSched, false>(F.lds, g, S, E);
        }
        SEAM(pb + 8);
        if (IN(pb + 9) && EN(9)) { REFRESH(); phase_route(F, l, mrows, bar); }
        SEAM(pb + 9);
        if (IN(pb + 10) && EN(10)) for (int rp_ = 0; rp_ < REP_G10; ++rp_) { REFRESH();
            moe_tables(F, l);
            Gemm g{(const GAS bf16_t*)WSP(unsigned char, WS_H8), (const GAS bf16_t*)WSP(unsigned char, WS_W13), DM / 2, DM / 2, DM / 2};
            MoeSched S{(const volatile LAS int*)(F.MISC + 16), (const volatile LAS int*)(F.MISC + 64), WSP(int, WS_LIST), 4, F.G, (int)blockIdx.x, 1};
            EpiMoe1 E{WSP(unsigned char, WS_RA + RA_H1)};
            pg8::gemm_phase<EpiMoe1, MoeSched, true, true>(F.lds, g, S, E);
        }
        SEAM(pb + 10);
        if (IN(pb + 11) && EN(11)) for (int rp_ = 0; rp_ < REP_G11; ++rp_) { REFRESH();
            moe_tables(F, l);
            Gemm g{(const GAS bf16_t*)WSP(unsigned char, WS_RA + RA_H1), (const GAS bf16_t*)WSP(unsigned char, WS_W2), DEXP / 2, DEXP / 2, DEXP / 2};
            MoeSched S{(const volatile LAS int*)(F.MISC + 16), (const volatile LAS int*)(F.MISC + 64), WSP(int, WS_LIST), 8, F.G, (int)blockIdx.x, 2};
            EpiMoe2 E{WSP(bf16_t, WS_RB + RB_Y2), WSP(int, WS_LIST), WSP(float, WS_WL), (const volatile LAS int*)(F.MISC + 64)};
            pg8::gemm_phase<EpiMoe2, MoeSched, false, true>(F.lds, g, S, E);
        }
        SEAM(pb + 11);
        if (IN(pb + 12) && EN(12)) { REFRESH(); phase_rwC(F, l, mrows); }
        SEAM(pb + 12);
    }

__global__ void __launch_bounds__(512, 2) fwd_kernel(Args args) {
    extern __shared__ __attribute__((aligned(16))) unsigned char lds_raw[];
    Frame F;
    F.lds = (LAS unsigned char*)lds_raw;
    F.MISC = (volatile LAS unsigned*)(F.lds + MISC_OFF);
    F.tid = threadIdx.x; F.lane = F.tid & 63; F.wave = __builtin_amdgcn_readfirstlane(F.tid >> 6);
    F.G = gridDim.x; { const int bx = blockIdx.x; F.vcu = (F.G % 8 == 0) ? (bx % 8) * (F.G / 8) + bx / 8 : bx; }
    F.ws = (GAS unsigned char*)args.ws; F.ctl = (unsigned*)(args.ws + WS_CTL); F.out = (GAS float*)args.out;
    F.inp = args.in;
    for (int u = F.tid; u < (LDS_BYTES - MISC_OFF) / 4; u += 512) F.MISC[u] = 0u;
    __syncthreads();
    const int lo = args.ph_lo, hi = args.ph_hi;
    XcdBarrier bar; bar.bar = F.ctl + CW_BAR; bar.x = 0; bar.st = nullptr;
    if (hi - lo > 1) bar = xcd_barrier_post(F.ctl + CW_BAR, F.MISC + 8);
    char* ldsg = (char*)lds_raw;

#ifndef REP_PRO
#define REP_PRO 1
#endif
    STAMP(0);
    if (IN(0) && EN(13)) for (int rep_ = 0; rep_ < REP_PRO; ++rep_) { phase_prologue(F); } SEAM(0);
    if (IN(1) && EN(14)) { phase_modfin(F); } SEAM(1);

    layer_phases<0>(F, args, bar, lo, hi, ldsg);
    layer_phases<1>(F, args, bar, lo, hi, ldsg);
#ifdef PROBE_MASK
    __syncthreads();
    if (blockIdx.x == 0 && threadIdx.x == 0) {
        STAMP(NPHASE);
        volatile unsigned long long* T = (volatile unsigned long long*)(args.ws + WS_CTL + 65536) + 16; unsigned long long acc_ = 0;
        for (int k = 0; k < NPHASE; ++k) if ((PROBE_MASK >> k) & 1ull) { const unsigned long long a_ = T[k], b_ = T[k + 1]; if (a_ && b_ > a_) acc_ += b_ - a_; }
        args.out[0] = 3.0f + (float)acc_ * 0.001f;
    }
#endif
#undef IN
#undef SEAM
}


#ifdef DUMP_OFF
__global__ void dump_kernel(GAS float* out, const unsigned char* ws) {
    const size_t OUTN = (size_t)ML * DM; const size_t i0 = (size_t)blockIdx.x * blockDim.x + threadIdx.x, st = (size_t)gridDim.x * blockDim.x;
    for (size_t i = i0; i < OUTN; i += st) { float a = 0.f;
#if DUMP_F32
        const GAS float* src = (const GAS float*)(ws + (size_t)DUMP_OFF); for (size_t j = i; j < (size_t)DUMP_ELEMS; j += OUTN) a += src[j];
#else
        const GAS bf16_t* src = (const GAS bf16_t*)(ws + (size_t)DUMP_OFF); for (size_t j = i; j < (size_t)DUMP_ELEMS; j += OUTN) a += bf2f(src[j]);
#endif
        out[i] = a; }
}
#endif
extern "C" void kernel_launch(void* const* d_in, const int* in_sizes, int n_in, void* d_out, int out_size, void* d_ws, size_t ws_size, hipStream_t stream) {
    static int grid = 0;
    if (grid == 0) {
        if (n_in != N_IN || out_size != ML * DM || ws_size < WS_END) { fprintf(stderr, "kernel_launch: unexpected shapes: n_in %d out %d ws %zu (need %zu)\n", n_in, out_size, ws_size, (size_t)WS_END); grid = -1; return; }
        int dev = 0, cus = 0, per_cu = 0;
        if (hipGetDevice(&dev) != hipSuccess || hipDeviceGetAttribute(&cus, hipDeviceAttributeMultiprocessorCount, dev) != hipSuccess) { grid = -1; return; }
        if (hipFuncSetAttribute((const void*)fwd_kernel, hipFuncAttributeMaxDynamicSharedMemorySize, LDS_BYTES) != hipSuccess) { fprintf(stderr, "kernel_launch: hipFuncSetAttribute failed\n"); grid = -1; return; }
        if (hipOccupancyMaxActiveBlocksPerMultiprocessor(&per_cu, (const void*)fwd_kernel, 512, LDS_BYTES) != hipSuccess || per_cu < 1) { fprintf(stderr, "kernel_launch: occupancy query says %d\n", per_cu); }
        (void)hipGetLastError();
        grid = cus;
    }
    if (grid < 0) return;
    if (hipMemsetAsync((char*)d_ws + WS_CTL, 0, CTL_BYTES, stream) != hipSuccess) return;
    Args a{};
    for (int i = 0; i < N_IN; ++i) a.in[i] = (const float*)d_in[i];
    a.out = (float*)d_out; a.ws = (unsigned char*)d_ws;
#if MK_SINGLE
    a.ph_lo = 0; a.ph_hi = NPHASE;
    hipLaunchKernelGGL(fwd_kernel, dim3(grid), dim3(512), LDS_BYTES, stream, a);
#else
#ifndef MK_STOP
#define MK_STOP NPHASE
#endif
    for (int ph = 0; ph < MK_STOP; ++ph) {
        if (ph == 2 + PH_PER_LAYER) continue;
        a.ph_lo = ph; a.ph_hi = ph + 1;
        hipLaunchKernelGGL(fwd_kernel, dim3(grid), dim3(512), LDS_BYTES, stream, a);
    }
#endif
#ifdef DUMP_OFF
    hipLaunchKernelGGL(dump_kernel, dim3(2048), dim3(256), 0, stream, (float*)d_out, (const unsigned char*)d_ws);
#endif
    const hipError_t le = hipPeekAtLastError();
    if (le != hipSuccess) fprintf(stderr, "kernel_launch: launch failed: %s\n", hipGetErrorName(le));
}
```

```cpp
#include <hip/hip_runtime.h>
#include <cstdio>
#include <cstdint>

#ifndef MK_SINGLE
#define MK_SINGLE 1
#endif

constexpr int DM = 2048, NBATCH = 8, SEQ = 2048, CTXL = 256, DEPTH = 2;
constexpr int ML = NBATCH * SEQ;
constexpr int MC = NBATCH * CTXL;
constexpr int MT = ML + MC;
constexpr int DIN = 7008, NU = 7168;
constexpr int U_MLQ = 0, U_MLK = 512, U_MLV = 1024, U_MLO = 1536, U_HGQ = 2048, U_HGI = 2560, U_HGG = 3072, U_HGF = 3584,
              U_CQ = 4608, U_CKV = 5120, U_KR = 5376, U_MLG = 5440, U_DT = 5456, U_Z = 5632, U_XBC = 6144;
constexpr float EPS = 1e-6f;
constexpr int NEXP = 32, DEXP = 512;
constexpr int MOE_ROWS = 2 * MT + NEXP * 256;

enum { I_X = 0, I_C, I_CTX, I_CCTX, I_WADA, I_BADA, I_NORMG, I_WIN, I_MLFB, I_HGLB, I_HGNG, I_MLAGQ, I_MLAGKV, I_WUQ, I_WUKV,
       I_CONVW, I_CONVB, I_ALOG, I_DTB, I_SSDD, I_SSDNG, I_WGATE, I_WBR, I_WOUT, I_WGRP, I_WEXP, I_W1, I_W3, I_W2, N_IN };

constexpr size_t al256(size_t x) { return (x + 255) / 256 * 256; }
constexpr size_t WS_CTL = 0, CTL_BYTES = 1u << 20;
constexpr size_t WS_WIN = WS_CTL + CTL_BYTES;
constexpr size_t WS_WUQ = WS_WIN + (size_t)2 * NU * DM * 2;
constexpr size_t WS_WUKV = WS_WUQ + (size_t)2 * 768 * 512 * 2;
constexpr size_t WS_WG = WS_WUKV + (size_t)2 * 1024 * 256 * 2;
constexpr size_t WS_WBR = WS_WG + (size_t)2 * 8192 * DM;
constexpr size_t WS_WOUT = WS_WBR + (size_t)2 * 4 * DM * 512 * 2;
constexpr size_t WS_WR = WS_WOUT + (size_t)2 * DM * DM;
constexpr size_t WS_WIN8 = WS_WR + (size_t)2 * 256 * DM * 2;
constexpr size_t WS_W13 = WS_WIN8 + (size_t)2 * NU * DM;
constexpr size_t WS_W2 = WS_W13 + (size_t)NEXP * 1024 * DM * 2;
constexpr size_t WS_MODP = WS_W2 + (size_t)NEXP * DM * 512 * 2;
constexpr size_t WS_MOD = WS_MODP + (size_t)2 * 16 * 9 * 12288 * 4;
constexpr size_t WS_TAB = WS_MOD + (size_t)2 * 9 * 12288 * 4;
constexpr size_t WS_XC = WS_TAB + 16384;
constexpr size_t WS_H8 = WS_XC + (size_t)MC * DM * 4;
constexpr size_t WS_H = WS_H8 + (size_t)MT * DM;
constexpr size_t WS_HIN = WS_H;
constexpr size_t WS_QB = WS_H + (size_t)MT * DM * 2;
constexpr size_t WS_KVB = WS_QB + (size_t)MT * 768 * 2;
constexpr size_t WS_SSQ = WS_KVB + (size_t)MT * 1024 * 2;
constexpr size_t WS_BR = WS_SSQ + (size_t)MT * 12 * 4;
constexpr size_t WS_YFB = WS_BR + (size_t)MT * DM * 2;
constexpr size_t WS_RSSD = WS_YFB + (size_t)6 * MT * 512 * 2;
constexpr size_t WS_LOG = WS_RSSD + al256((size_t)MT * 4);
constexpr size_t WS_LIST = WS_LOG + (size_t)4 * MT * 64 * 4;
constexpr size_t WS_WL = WS_LIST + (size_t)NEXP * MT * 4;
constexpr size_t WS_XBC = WS_WL + (size_t)NEXP * MT * 4;
constexpr size_t HGP_ITEM = 8192 + 8192 + 1024;
constexpr size_t WS_HGP = WS_XBC + (size_t)MT * 1024 * 2;
constexpr size_t WS_MLS = WS_HGP + (size_t)64 * 72 * HGP_ITEM;
constexpr size_t WS_SSDS = WS_MLS + (size_t)64 * 2304 * 32;
constexpr size_t WS_MLC = WS_SSDS + (size_t)128 * 2304 * 32;
constexpr size_t WS_RA = WS_MLC + (size_t)32 * 2304 * 384 * 2;
constexpr size_t RA_BYTES = (size_t)MT * NU * 2;
constexpr size_t WS_RB = WS_RA + RA_BYTES;
constexpr size_t RB_BYTES = ((size_t)80 << 20) + (size_t)2 * MT * DM * 2;
constexpr size_t WS_END = WS_RB + RB_BYTES;
constexpr size_t RA_ACC = 0, RA_PART = (size_t)80 << 20, RA_H1 = (size_t)150 << 20;
constexpr size_t RB_Y = 0, RB_Y2 = (size_t)80 << 20;
static_assert(RA_PART >= (size_t)MT * DM * 2 && RA_H1 >= RA_PART + (size_t)256 * 65536 * 4 && RA_H1 + (size_t)MOE_ROWS * 512 * 2 <= RA_BYTES, "region A");
static_assert(RB_Y2 >= (size_t)MT * DM * 2 && RB_Y2 + (size_t)2 * MT * DM * 2 <= RB_BYTES && (size_t)MT * 8192 <= RB_BYTES, "region B");
constexpr int CW_CNT = 64;
constexpr int CW_BAR = 4096;

constexpr int RING_BYTES = 131072, MISC_OFF = RING_BYTES, LDS_BYTES = 147456;

#define GAS __attribute__((address_space(1)))
#define LAS __attribute__((address_space(3)))
typedef unsigned short bf16_t;
typedef short bf16x8 __attribute__((ext_vector_type(8)));
typedef short s16x4 __attribute__((ext_vector_type(4)));
typedef float f32x4 __attribute__((ext_vector_type(4)));
typedef float f32x2 __attribute__((ext_vector_type(2)));
typedef float f32x16 __attribute__((ext_vector_type(16)));
typedef unsigned u32x4 __attribute__((ext_vector_type(4)));
typedef unsigned u32x2 __attribute__((ext_vector_type(2)));
#define LDS_WAIT() asm volatile("s_waitcnt lgkmcnt(0)" ::: "memory")
#define VM_WAIT() asm volatile("s_waitcnt vmcnt(0)" ::: "memory")
typedef __bf16 bf16x2_t __attribute__((ext_vector_type(2)));
__device__ __forceinline__ unsigned cvt_pk_bf16(float lo, float hi) { const f32x2 v = {lo, hi}; return __builtin_bit_cast(unsigned, __builtin_convertvector(v, bf16x2_t)); }
__device__ __forceinline__ bf16_t f2bf(float f) { return (bf16_t)(cvt_pk_bf16(f, 0.f) & 0xffffu); }
__device__ __forceinline__ float bf2f(bf16_t b) { return __uint_as_float(((unsigned)b) << 16); }
__device__ __forceinline__ float bflo(unsigned w) { return __uint_as_float(w << 16); }
__device__ __forceinline__ float bfhi(unsigned w) { return __uint_as_float(w & 0xffff0000u); }
__device__ __forceinline__ float sigmoidf_(float x) { return 1.f / (1.f + __expf(-x)); }
__device__ __forceinline__ float siluf_(float x) { return x / (1.f + __expf(-x)); }
__device__ __forceinline__ int opaque_tid() { int t = threadIdx.x; asm volatile("" : "+v"(t)); return t; }
__device__ __forceinline__ const void* opaque_ptr(const void* p) {
    unsigned lo = (unsigned)(uintptr_t)p, hi = (unsigned)((uintptr_t)p >> 32); asm volatile("" : "+v"(lo), "+v"(hi));
    lo = __builtin_amdgcn_readfirstlane(lo); hi = __builtin_amdgcn_readfirstlane(hi); return (const void*)(((uintptr_t)hi << 32) | lo); }
__device__ __forceinline__ float wave_sum(float v) {
#pragma unroll
    for (int o = 1; o < 64; o <<= 1) v += __shfl_xor(v, o);
    return v;
}

__device__ __forceinline__ int prow(int b, int dir, int p) { if (p < CTXL) return ML + b * CTXL + (dir ? CTXL - 1 - p : p); const int q = p - CTXL; return b * SEQ + (dir ? SEQ - 1 - q : q); }
namespace scn {
__device__ __forceinline__ int rowl(int row, int colB) { return row * 256 + (colB ^ ((row & 7) << 4)); }
__device__ __forceinline__ float scan_add32(float v, int r32) {
#pragma unroll
    for (int d = 1; d < 32; d <<= 1) { const float o = __shfl_up(v, d, 32); if (r32 >= d) v += o; }
    return v;
}
__device__ __forceinline__ float scan_max32(float v, int r32) {
#pragma unroll
    for (int d = 1; d < 32; d <<= 1) { const float o = __shfl_up(v, d, 32); if (r32 >= d) v = fmaxf(v, o); }
    return v;
}
}

#define XB_TMO      128
#define XB_XCNT(j)  (256  + 64 * (j))
#define XB_XSUB(j)  (1280 + 64 * (j))
#define XB_XGEN(j)  (2304 + 64 * (j))
#define XB_TOP      3328
#define XB_TOPGEN   3392
#define XCD_BAR_WORDS 3456
#define XB_SPIN_CAP (1u << 18)
__device__ __forceinline__ unsigned xb_ld(unsigned* p)              { return __hip_atomic_load(p, __ATOMIC_RELAXED, __HIP_MEMORY_SCOPE_AGENT); }
__device__ __forceinline__ unsigned xb_add(unsigned* p, unsigned v) { return __hip_atomic_fetch_add(p, v, __ATOMIC_RELAXED, __HIP_MEMORY_SCOPE_AGENT); }
__device__ __forceinline__ unsigned xb_xcc_id() { return (unsigned)__builtin_amdgcn_s_getreg((3 << 11) | 20) & 0xFu; }
#define XB_SPIN(cond, bar) do { unsigned _sp = 0; while (cond) { __builtin_amdgcn_s_sleep(1); \
    if ((++_sp & 255u) == 0u) { if (xb_ld(&(bar)[XB_TMO])) break; if (_sp > XB_SPIN_CAP) { atomicAdd(&(bar)[XB_TMO], 1u); break; } } } } while (0)
struct XcdBarrier { unsigned* bar; unsigned x; volatile LAS unsigned* st; };
__device__ __forceinline__ XcdBarrier xcd_barrier_post(unsigned* bar, volatile LAS unsigned* st) {
    XcdBarrier b; b.bar = bar; b.x = xb_xcc_id(); b.st = st;
    if (threadIdx.x == 0) (void)xb_add(&bar[XB_XCNT(b.x)], 1u);
    return b;
}
__device__ __forceinline__ void xcd_barrier_complete(unsigned* bar, unsigned x, unsigned& nloc, unsigned& nx) {
    const unsigned G = gridDim.x * gridDim.y * gridDim.z;
    unsigned sum, cnt, mine, sp = 0u;
    for (;;) {
        sum = 0u; cnt = 0u; mine = 0u;
#pragma unroll
        for (unsigned j = 0; j < 16; ++j) { const unsigned c = xb_ld(&bar[XB_XCNT(j)]); sum += c; cnt += (c > 0u) ? 1u : 0u; mine = (j == x) ? c : mine; }
        if (sum == G) break;
        __builtin_amdgcn_s_sleep(1);
        if ((++sp & 255u) == 0u) { if (xb_ld(&bar[XB_TMO])) break; if (sp > XB_SPIN_CAP) { atomicAdd(&bar[XB_TMO], 1u); break; } }
    }
    nloc = mine > 0u ? mine : 1u; nx = cnt > 0u ? cnt : 1u;
}
__device__ __forceinline__ void xcd_barrier(const XcdBarrier& b) {
    asm volatile("s_waitcnt vmcnt(0)" ::: "memory");
    __syncthreads();
    if (threadIdx.x == 0) {
        unsigned* bar = b.bar;
        __builtin_amdgcn_s_waitcnt(0);
        unsigned nloc = b.st[0], nx = b.st[1];
        if (nloc == 0u) { xcd_barrier_complete(bar, b.x, nloc, nx); b.st[0] = nloc; b.st[1] = nx; }
        const unsigned old = xb_add(&bar[XB_XSUB(b.x)], 1u);
        const unsigned gen = old / nloc;
        if (old + 1u == (gen + 1u) * nloc) {
            __builtin_amdgcn_fence(__ATOMIC_RELEASE, "agent");
            asm volatile("s_waitcnt vmcnt(0)" ::: "memory");
            const unsigned og = xb_add(&bar[XB_TOP], 1u);
            const unsigned tg = og / nx;
            if (og + 1u == (tg + 1u) * nx) xb_add(&bar[XB_TOPGEN], 1u);
            else XB_SPIN(xb_ld(&bar[XB_TOPGEN]) == tg, bar);
            __builtin_amdgcn_fence(__ATOMIC_ACQUIRE, "agent");
            xb_add(&bar[XB_XGEN(b.x)], 1u);
            asm volatile("s_waitcnt vmcnt(0)" ::: "memory");
        } else {
            XB_SPIN(xb_ld(&bar[XB_XGEN(b.x)]) == gen, bar);
            __builtin_amdgcn_fence(__ATOMIC_ACQUIRE, "agent");
            asm volatile("s_waitcnt vmcnt(0)" ::: "memory");
        }
    }
    __syncthreads();
}

struct Frame {
    LAS unsigned char* lds;
    volatile LAS unsigned* MISC;
    unsigned* ctl;
    int tid, lane, wave, vcu, G;
    const float* const* inp;
    GAS float* out;
    GAS unsigned char* ws;
};
#define WSP(T, off) ((GAS T*)(F.ws + (off)))
#define INP(i) ((const GAS float*)F.inp[i])

namespace pg8 {
constexpr int BM = 256, BK = 64, HALF = 128, HTB = HALF * BK * 2, STAGE_BYTES = 8 * HTB, NXCD = 8, WGM = 8;
__host__ __device__ __forceinline__ int lds_byte(int r, int c) { const int st = (r >> 4) * 2 + (c >> 5), rr = r & 15, cc = c & 31, ob = rr * 64 + cc * 2; return st * 1024 + (ob ^ (((ob >> 9) & 1) << 5)); }
__host__ __device__ __forceinline__ void stage_rc(int b, int& R, int& C) { const int st = b / 1024, sb = b % 1024, swz = sb ^ (((sb >> 9) & 1) << 5); R = (st >> 1) * 16 + swz / 64; C = (st & 1) * 32 + (swz % 64) / 2; }

struct Unit { int pm, pn, aux, aux2; size_t aoff, boff; };
struct Gemm { const GAS bf16_t* A; const GAS bf16_t* Bt; int lda, ldb, K; };

struct GridSched {
    int nM, nN, nwg, G, c; size_t a_tile, b_tile, a0, b0;
    __device__ __forceinline__ void init(int nM_, int nN_, int G_, int c_, size_t a_tile_, size_t b_tile_, size_t a0_, size_t b0_) { nM = nM_; nN = nN_; nwg = nM * nN; G = G_; c = c_; a_tile = a_tile_; b_tile = b_tile_; a0 = a0_; b0 = b0_; }
    __device__ __forceinline__ void map(int L, int& pm, int& pn) const {
        int wgid = L; { const int q = nwg / NXCD, r = nwg % NXCD, xcd = wgid % NXCD, off = wgid / NXCD; wgid = (xcd < r ? xcd * (q + 1) : r * (q + 1) + (xcd - r) * q) + off; }
        const int nig = WGM * nN, gid = wgid / nig, fm = gid * WGM, gsz = (nM - fm) < WGM ? (nM - fm) : WGM;
        pm = fm + ((wgid % nig) % gsz); pn = (wgid % nig) / gsz;
    }
    __device__ __forceinline__ bool next(int i, Unit& u) const {
        const long L = (long)i * G + c; if (L >= nwg) return false;
        map((int)L, u.pm, u.pn); u.aux = 0; u.aux2 = 0; u.aoff = a0 + (size_t)u.pm * a_tile; u.boff = b0 + (size_t)u.pn * b_tile; return true;
    }
    __device__ __forceinline__ int arow(const Unit&, int) const { return 0; }
};

template <class Epi, class Sched, bool GATHER, bool FP8 = false>
__device__ __forceinline__ void gemm_phase(LAS unsigned char* lds, const Gemm g, const Sched& S, const Epi& E) {
    const int tid = opaque_tid(), wid = __builtin_amdgcn_readfirstlane(tid >> 6), lane = tid & 63, wr = wid >> 2, wc = wid & 3, fr = lane & 15, fq = lane >> 4;
    int nt = g.K / BK; asm volatile("" : "+s"(nt));
    unsigned voffA[2], voffB[2];
#pragma unroll
    for (int i = 0; i < 2; ++i) { int R, C; stage_rc(tid * 16 + i * 8192, R, C);
        voffA[i] = (unsigned)(R * g.lda + C) * 2u; voffB[i] = (unsigned)(R * g.ldb + C) * 2u; }
    const size_t kstep = (size_t)(BK * 2);
    const size_t hstepA = (size_t)HALF * g.lda * 2, hstepB = (size_t)HALF * g.ldb * 2;
    const unsigned ldsw = (unsigned)wid * 1024u;
    const int aoff = lds_byte(wr * 64 + fr, fq * 8), boff = lds_byte(wc * 32 + fr, fq * 8);
#define PG8_SA(b, h) (((b) * 2 + (h)) * HTB)
#define PG8_SB(b, h) ((4 + (b) * 2 + (h)) * HTB)
#define PG8_STAGE(bufoff, gbase, voff) do { _Pragma("unroll") for (int _i = 0; _i < 2; ++_i) \
        __builtin_amdgcn_global_load_lds((const unsigned*)((const char*)(gbase) + (voff)[_i]), (LAS unsigned*)(lds + (bufoff) + ldsw + _i * 8192), 16, 0, 0); } while (0)
#define PG8_LDA(dst, b, h) do { _Pragma("unroll") for (int m = 0; m < 4; ++m) { dst[m].lo = *(const LAS v4i_t*)(lds + PG8_SA(b, h) + aoff + m * 2048); dst[m].hi = *(const LAS v4i_t*)(lds + PG8_SA(b, h) + aoff + m * 2048 + 1024); } } while (0)
#define PG8_LDB(dst, b, h) do { _Pragma("unroll") for (int n = 0; n < 2; ++n) { dst[n].lo = *(const LAS v4i_t*)(lds + PG8_SB(b, h) + boff + n * 2048); dst[n].hi = *(const LAS v4i_t*)(lds + PG8_SB(b, h) + boff + n * 2048 + 1024); } } while (0)
typedef int v8i_t __attribute__((ext_vector_type(8))); typedef int v4i_t __attribute__((ext_vector_type(4)));
#define PG8_MMA(ai, bj, At, Bt) do { __builtin_amdgcn_s_setprio(1); _Pragma("unroll") for (int m = 0; m < 4; ++m) _Pragma("unroll") for (int n = 0; n < 2; ++n) { \
        if constexpr (FP8) { asm volatile("v_mfma_scale_f32_16x16x128_f8f6f4 %0, %1, %2, %0, %3, %4 op_sel_hi:[0,0,0]" : "+v"(acc[ai][bj][m][n]) : "v"(Bt[n]), "v"(At[m]), "v"(scW), "v"(scA)); } \
        else { acc[ai][bj][m][n] = __builtin_amdgcn_mfma_f32_16x16x32_bf16(__builtin_bit_cast(bf16x8, (v4i_t)Bt[n].lo), __builtin_bit_cast(bf16x8, (v4i_t)At[m].lo), acc[ai][bj][m][n], 0, 0, 0); \
               acc[ai][bj][m][n] = __builtin_amdgcn_mfma_f32_16x16x32_bf16(__builtin_bit_cast(bf16x8, (v4i_t)Bt[n].hi), __builtin_bit_cast(bf16x8, (v4i_t)At[m].hi), acc[ai][bj][m][n], 0, 0, 0); } } \
        __builtin_amdgcn_s_setprio(0); } while (0)
#if GEMM_SAFE
#define PG8_WAIT_V(n) asm volatile("s_waitcnt vmcnt(0)" ::: "memory")
#else
#define PG8_WAIT_V(n) asm volatile("s_waitcnt vmcnt(" #n ")" ::: "memory")
#endif
#define PG8_WAIT_L(n) asm volatile("s_waitcnt lgkmcnt(" #n ")" ::: "memory")
#define PG8_BAR __builtin_amdgcn_s_barrier()
#define PG8_SCHED __builtin_amdgcn_sched_barrier(0)
    unsigned cvA[2][2], nvA[2][2];
#define PG8_GOFF(dst, u) do { if constexpr (GATHER) { const int ne_ = S.acnt(u); int gr_[2][2], gc_[2];        \
        _Pragma("unroll") for (int _i = 0; _i < 2; ++_i) { int R_; stage_rc(tid * 16 + _i * 8192, R_, gc_[_i]); _Pragma("unroll") for (int _h = 0; _h < 2; ++_h) gr_[_h][_i] = S.arow(u, _h * HALF + R_, ne_); } \
        _Pragma("unroll") for (int _i = 0; _i < 2; ++_i) _Pragma("unroll") for (int _h = 0; _h < 2; ++_h) dst[_h][_i] = (unsigned)(((size_t)gr_[_h][_i] * (size_t)g.lda + (size_t)gc_[_i]) * 2u); } } while (0)
#define PG8_STAGE_A(bufoff, base, half, vh) do { if constexpr (GATHER) { PG8_STAGE(bufoff, base, (vh)[half]); } else { PG8_STAGE(bufoff, (base) + (half) * hstepA, voffA); } } while (0)
    Unit cur, nxt; int ui = 0;
    if (!S.next(0, cur)) return;
    f32x4 acc[2][2][4][2];
#pragma unroll
    for (int a = 0; a < 2; ++a)
#pragma unroll
        for (int b = 0; b < 2; ++b)
#pragma unroll
            for (int m = 0; m < 4; ++m)
#pragma unroll
                for (int n = 0; n < 2; ++n) acc[a][b][m][n] = (f32x4){0.f, 0.f, 0.f, 0.f};
    int scW = 0x79797979, scA = 0x7f7f7f7f; asm volatile("" : "+v"(scW), "+v"(scA));
    v8i_t At[4], B0[2], B1[2];
    const char* cA = (const char*)g.A + cur.aoff; const char* cB = (const char*)g.Bt + cur.boff;
    PG8_GOFF(cvA, cur);
#pragma unroll
    for (int _h = 0; _h < 2; ++_h)
#pragma unroll
        for (int _i = 0; _i < 2; ++_i) nvA[_h][_i] = cvA[_h][_i];
    PG8_STAGE(PG8_SB(0, 0), cB, voffB); PG8_STAGE_A(PG8_SA(0, 0), cA, 0, cvA); PG8_STAGE(PG8_SB(0, 1), cB + hstepB, voffB); PG8_STAGE_A(PG8_SA(0, 1), cA, 1, cvA);
    if (wr == 1) PG8_BAR;
    PG8_WAIT_V(4); PG8_BAR;
    PG8_STAGE(PG8_SB(1, 0), cB + kstep, voffB); PG8_STAGE_A(PG8_SA(1, 0), cA + kstep, 0, cvA); PG8_STAGE(PG8_SB(1, 1), cB + hstepB + kstep, voffB);
    PG8_WAIT_V(6); PG8_BAR;
    for (;;) {
        const bool has_next = S.next(ui + 1, nxt);
        const char* nA = has_next ? (const char*)g.A + nxt.aoff : cA; const char* nB = has_next ? (const char*)g.Bt + nxt.boff : cB;
        for (int t = 0; t < nt; t += 2) {
            const bool last = (t == nt - 2);
            const char* a1 = cA + (size_t)(t + 1) * kstep;
            const char* a2 = last ? nA : cA + (size_t)(t + 2) * kstep; const char* b2 = last ? nB : cB + (size_t)(t + 2) * kstep;
            const char* a3 = a2 + kstep; const char* b3 = b2 + kstep;
            if constexpr (GATHER) { if (last && has_next) { PG8_GOFF(nvA, nxt); } }
            PG8_LDB(B0, 0, 0); PG8_SCHED; PG8_LDA(At, 0, 0); PG8_STAGE_A(PG8_SA(1, 1), a1, 1, cvA);
            PG8_WAIT_L(8); PG8_BAR; PG8_WAIT_L(0); PG8_MMA(0, 0, At, B0); PG8_BAR; PG8_SCHED;
            PG8_LDB(B1, 0, 1); PG8_STAGE(PG8_SB(0, 0), b2, voffB);
            PG8_BAR; PG8_WAIT_L(0); PG8_MMA(0, 1, At, B1); PG8_BAR;
            PG8_LDA(At, 0, 1); PG8_STAGE_A(PG8_SA(0, 0), a2, 0, nvA);
            PG8_BAR; PG8_WAIT_L(0); PG8_MMA(1, 0, At, B0); PG8_BAR; PG8_SCHED;
            PG8_STAGE(PG8_SB(0, 1), b2 + hstepB, voffB);
            PG8_WAIT_V(6); PG8_BAR; PG8_MMA(1, 1, At, B1); PG8_BAR;
            PG8_LDB(B0, 1, 0); PG8_SCHED; PG8_LDA(At, 1, 0); PG8_STAGE_A(PG8_SA(0, 1), a2, 1, nvA);
            PG8_WAIT_L(8); PG8_BAR; PG8_WAIT_L(0); PG8_MMA(0, 0, At, B0); PG8_BAR; PG8_SCHED;
            PG8_LDB(B1, 1, 1); PG8_STAGE(PG8_SB(1, 0), b3, voffB);
            PG8_BAR; PG8_WAIT_L(0); PG8_MMA(0, 1, At, B1); PG8_BAR;
            PG8_LDA(At, 1, 1); PG8_STAGE_A(PG8_SA(1, 0), a3, 0, nvA);
            PG8_BAR; PG8_WAIT_L(0); PG8_MMA(1, 0, At, B0); PG8_BAR; PG8_SCHED;
            PG8_STAGE(PG8_SB(1, 1), b3 + hstepB, voffB);
            PG8_WAIT_V(6); PG8_BAR; PG8_MMA(1, 1, At, B1); PG8_BAR;
        }
        if constexpr (FP8) { asm volatile("s_nop 15\n\ts_nop 15" ::: "memory"); }
        E(acc, cur, wr, wc, fr, fq);
        if (!has_next) break;
#pragma unroll
        for (int a = 0; a < 2; ++a)
#pragma unroll
            for (int b = 0; b < 2; ++b)
#pragma unroll
                for (int m = 0; m < 4; ++m)
#pragma unroll
                    for (int n = 0; n < 2; ++n) acc[a][b][m][n] = (f32x4){0.f, 0.f, 0.f, 0.f};
        cur = nxt; cA = nA; cB = nB; ++ui;
        if constexpr (GATHER) {
#pragma unroll
            for (int _h = 0; _h < 2; ++_h)
#pragma unroll
                for (int _i = 0; _i < 2; ++_i) cvA[_h][_i] = nvA[_h][_i];
        }
    }
    PG8_WAIT_V(0);
    if (wr == 0) PG8_BAR;
    PG8_BAR;
#undef PG8_SA
#undef PG8_SB
#undef PG8_STAGE
#undef PG8_STAGE_A
#undef PG8_GOFF
#undef PG8_LDA
#undef PG8_LDB
#undef PG8_MMA
#undef PG8_WAIT_V
#undef PG8_WAIT_L
#undef PG8_BAR
#undef PG8_SCHED
}
}
using pg8::Unit;
using pg8::Gemm;
using pg8::GridSched;
#define EPI_ARGS f32x4 (&acc)[2][2][4][2], const Unit& u, int wr, int wc, int fr, int fq
#define EPI_FOR_ROWS for (int ai = 0; ai < 2; ++ai) for (int m = 0; m < 4; ++m)
#define EPI_FOR_COLS for (int bj = 0; bj < 2; ++bj) for (int n = 0; n < 2; ++n)
__device__ __forceinline__ void st_bf16x4(GAS bf16_t* p, f32x4 v) { u32x2 w; w.x = cvt_pk_bf16(v[0], v[1]); w.y = cvt_pk_bf16(v[2], v[3]); *(GAS u32x2*)p = w; }

struct EpiWin {
    GAS bf16_t* U; GAS float* ssq; const GAS float* rope;
    __device__ __forceinline__ void operator()(EPI_ARGS) const {
        const int row0 = u.pm * 256 + wr * 64 + fr, col0 = u.pn * 256 + wc * 32 + 4 * fq;
        if (u.pn == 21 && wc < 2 && u.pm < ML / 256) {
#pragma unroll
            for (int ai = 0; ai < 2; ++ai)
#pragma unroll
                for (int m = 0; m < 4; ++m) {
                    const int r = row0 + ai * 128 + m * 16, tok = r & (SEQ - 1), pos = wc == 0 ? (tok >> 6) : (tok & 63);
                    const f32x4 cs = *(const GAS f32x4*)(rope + pos * 16 + 4 * fq), sn = *(const GAS f32x4*)(rope + 1024 + pos * 16 + 4 * fq);
                    const f32x4 x1 = acc[ai][0][m][0], x2 = acc[ai][0][m][1];
                    acc[ai][0][m][0] = x1 * cs - x2 * sn; acc[ai][0][m][1] = x1 * sn + x2 * cs;
                }
        }
        if (u.pn >= 18 && u.pn <= 20) {
            const int slot = (u.pn - 18) * 4 + wc;
#pragma unroll
            for (int ai = 0; ai < 2; ++ai)
#pragma unroll
                for (int m = 0; m < 4; ++m) {
                    float s = 0.f;
#pragma unroll
                    for (int bj = 0; bj < 2; ++bj)
#pragma unroll
                        for (int n = 0; n < 2; ++n) { const f32x4 x = acc[ai][bj][m][n]; s += (x[0] * x[0] + x[1] * x[1]) + (x[2] * x[2] + x[3] * x[3]); }
                    s += __shfl_xor(s, 16); s += __shfl_xor(s, 32);
                    if (fq == 0) ssq[(size_t)(row0 + ai * 128 + m * 16) * 12 + slot] = s;
                }
        }
#pragma unroll
        for (int ai = 0; ai < 2; ++ai)
#pragma unroll
            for (int m = 0; m < 4; ++m) { GAS bf16_t* rowp = U + (size_t)(row0 + ai * 128 + m * 16) * NU + col0;
#pragma unroll
                for (int bj = 0; bj < 2; ++bj)
#pragma unroll
                    for (int n = 0; n < 2; ++n) st_bf16x4(rowp + bj * 128 + n * 16, acc[ai][bj][m][n]); }
    }
};
struct EpiMlaQ {
    GAS bf16_t* Q; const GAS float* ssq; const GAS float* rope;
    __device__ __forceinline__ void operator()(EPI_ARGS) const {
        const int row0 = u.pm * 256 + wr * 64 + fr, col0 = u.pn * 256 + wc * 32 + 4 * fq;
        float rstd[8];
        { f32x4 p0[8], p1[8];
#pragma unroll
          for (int i = 0; i < 8; ++i) { const int r = row0 + (i >> 2) * 128 + (i & 3) * 16; p0[i] = *(const GAS f32x4*)(ssq + (size_t)r * 12); p1[i] = *(const GAS f32x4*)(ssq + (size_t)r * 12 + 4); }
#pragma unroll
          for (int i = 0; i < 8; ++i) rstd[i] = rsqrtf(((p0[i][0] + p0[i][1]) + (p0[i][2] + p0[i][3]) + (p1[i][0] + p1[i][1]) + (p1[i][2] + p1[i][3])) * (1.f / 512.f) + EPS); }
        const bool rot = u.pn == 2 && u.pm < ML / 256;
#pragma unroll
        for (int ai = 0; ai < 2; ++ai) {
            f32x4 cs[4], sn[4];
#pragma unroll
            for (int m = 0; m < 4; ++m) { const int r = row0 + ai * 128 + m * 16; const int tok = r & (SEQ - 1), pos = rot ? ((wc & 1) == 0 ? (tok >> 6) : (tok & 63)) : 0;
                cs[m] = *(const GAS f32x4*)(rope + pos * 16 + 4 * fq); sn[m] = *(const GAS f32x4*)(rope + 1024 + pos * 16 + 4 * fq); }
#pragma unroll
            for (int m = 0; m < 4; ++m) {
                const int r = row0 + ai * 128 + m * 16, i = ai * 4 + m;
#pragma unroll
                for (int bj = 0; bj < 2; ++bj) {
                    f32x4 a = acc[ai][bj][m][0] * rstd[i], b = acc[ai][bj][m][1] * rstd[i];
                    if (rot) { const f32x4 x1 = a, x2 = b; a = x1 * cs[m] - x2 * sn[m]; b = x1 * sn[m] + x2 * cs[m]; }
                    GAS bf16_t* rowp = Q + (size_t)r * 768 + col0 + bj * 128;
                    st_bf16x4(rowp, a); st_bf16x4(rowp + 16, b);
                }
            }
        }
    }
};
struct EpiMlaKV {
    GAS bf16_t* KV; const GAS float* ssq;
    __device__ __forceinline__ void operator()(EPI_ARGS) const {
        const int row0 = u.pm * 256 + wr * 64 + fr, col0 = u.pn * 256 + wc * 32 + 4 * fq;
        f32x4 p0[8];
#pragma unroll
        for (int i = 0; i < 8; ++i) { const int r = row0 + (i >> 2) * 128 + (i & 3) * 16; p0[i] = *(const GAS f32x4*)(ssq + (size_t)r * 12 + 8); }
#pragma unroll
        for (int ai = 0; ai < 2; ++ai)
#pragma unroll
            for (int m = 0; m < 4; ++m) {
                const int r = row0 + ai * 128 + m * 16, i = ai * 4 + m;
                const float rstd = rsqrtf(((p0[i][0] + p0[i][1]) + (p0[i][2] + p0[i][3])) * (1.f / 256.f) + EPS);
                GAS bf16_t* rowp = KV + (size_t)r * 1024 + col0;
#pragma unroll
                for (int bj = 0; bj < 2; ++bj)
#pragma unroll
                    for (int n = 0; n < 2; ++n) st_bf16x4(rowp + bj * 128 + n * 16, acc[ai][bj][m][n] * rstd);
            }
    }
};
struct EpiGate {
    GAS unsigned char* G;
    __device__ __forceinline__ void operator()(EPI_ARGS) const {
        const __amdgpu_buffer_rsrc_t rsrc = __builtin_amdgcn_make_buffer_rsrc((void*)G, 0, 0x7fffffff, 0x00020000);
        const int voff = threadIdx.x * 8; const int tbase = (u.pm * 32 + u.pn) * 65536;
#pragma unroll
        for (int ai = 0; ai < 2; ++ai)
#pragma unroll
            for (int bj = 0; bj < 2; ++bj)
#pragma unroll
                for (int m = 0; m < 4; ++m) {
                    u32x2 w;
#pragma unroll
                    for (int n = 0; n < 2; ++n) { const f32x4 v = acc[ai][bj][m][n]; unsigned d = 0;
#pragma unroll
                        for (int j = 0; j < 4; ++j) { const float g = __builtin_amdgcn_rcpf(__builtin_fmaf(__builtin_amdgcn_exp2f(v[j]), 1.f / 255.f, 1.f / 255.f)); d = __builtin_amdgcn_cvt_pk_u8_f32(g, j, d); }
                        if (n == 0) w.x = d; else w.y = d; }
                    __builtin_amdgcn_raw_buffer_store_b64(w, rsrc, voff, tbase + ((ai * 2 + bj) * 4 + m) * 4096, 0);
                }
    }
};
struct EpiMerge {
    const GAS unsigned char* G; GAS unsigned char* ACC; GAS unsigned char* part; const GAS float* rssd;
    __device__ __forceinline__ void operator()(EPI_ARGS) const {
        const int row0 = u.pm * 256 + wr * 64 + fr, col0 = u.pn * 256 + wc * 32 + 4 * fq, k = u.aux;
        const __amdgpu_buffer_rsrc_t rg = __builtin_amdgcn_make_buffer_rsrc((void*)G, 0, 0x7fffffff, 0x00020000);
        const __amdgpu_buffer_rsrc_t rp = __builtin_amdgcn_make_buffer_rsrc((void*)part, 0, 131072, 0x00020000);
        const int vg = threadIdx.x * 8, vp = threadIdx.x * 16; const int tbase = (u.pm * 32 + k * 8 + u.pn) * 65536;
#pragma unroll
        for (int ai = 0; ai < 2; ++ai) {
            u32x2 gw[2][4]; u32x4 pw[2][4]; float rsv[4];
#pragma unroll
            for (int m = 0; m < 4; ++m) { rsv[m] = (k == 3) ? rssd[row0 + ai * 128 + m * 16] : 1.f;
#pragma unroll
                for (int bj = 0; bj < 2; ++bj) { const int idx2 = (ai * 2 + bj) * 4 + m; gw[bj][m] = __builtin_amdgcn_raw_buffer_load_b64(rg, vg, tbase + idx2 * 4096, 0);
                    if (k > 0) pw[bj][m] = __builtin_amdgcn_raw_buffer_load_b128(rp, vp, idx2 * 8192, 16); } }
#pragma unroll
            for (int m = 0; m < 4; ++m) {
                const int r = row0 + ai * 128 + m * 16; const float rs = rsv[m] * (1.f / 255.f);
#pragma unroll
                for (int bj = 0; bj < 2; ++bj) {
                    const int idx2 = (ai * 2 + bj) * 4 + m; const u32x2 g2 = gw[bj][m];
                    f32x4 v0, v1;
                    v0[0] = (float)(g2.x & 0xffu); v0[1] = (float)((g2.x >> 8) & 0xffu); v0[2] = (float)((g2.x >> 16) & 0xffu); v0[3] = (float)(g2.x >> 24);
                    v1[0] = (float)(g2.y & 0xffu); v1[1] = (float)((g2.y >> 8) & 0xffu); v1[2] = (float)((g2.y >> 16) & 0xffu); v1[3] = (float)(g2.y >> 24);
                    v0 = v0 * acc[ai][bj][m][0] * rs; v1 = v1 * acc[ai][bj][m][1] * rs;
                    if (k > 0) { const u32x4 p4 = pw[bj][m];
                        v0 += (f32x4){bflo(p4.x), bfhi(p4.x), bflo(p4.y), bfhi(p4.y)}; v1 += (f32x4){bflo(p4.z), bfhi(p4.z), bflo(p4.w), bfhi(p4.w)}; }
                    if (k < 3) { u32x4 ow; ow.x = cvt_pk_bf16(v0[0], v0[1]); ow.y = cvt_pk_bf16(v0[2], v0[3]); ow.z = cvt_pk_bf16(v1[0], v1[1]); ow.w = cvt_pk_bf16(v1[2], v1[3]);
                        __builtin_amdgcn_raw_buffer_store_b128(ow, rp, vp, idx2 * 8192, 16); }
                    else { GAS unsigned char* op = ACC + (size_t)r * DM + col0 + bj * 128;
#pragma unroll
                        for (int j = 0; j < 4; ++j) { v0[j] = __builtin_amdgcn_fmed3f(v0[j], -448.f, 448.f); v1[j] = __builtin_amdgcn_fmed3f(v1[j], -448.f, 448.f); }
                        unsigned w0 = 0, w1 = 0; w0 = __builtin_amdgcn_cvt_pk_fp8_f32(v0[0], v0[1], w0, false); w0 = __builtin_amdgcn_cvt_pk_fp8_f32(v0[2], v0[3], w0, true);
                        w1 = __builtin_amdgcn_cvt_pk_fp8_f32(v1[0], v1[1], w1, false); w1 = __builtin_amdgcn_cvt_pk_fp8_f32(v1[2], v1[3], w1, true);
                        *(GAS unsigned*)op = w0; *(GAS unsigned*)(op + 16) = w1; }
                }
            }
            asm volatile("" ::: "memory");
        }
    }
};
struct EpiBf16 {
    GAS bf16_t* O; int ld;
    __device__ __forceinline__ void operator()(EPI_ARGS) const {
        const int row0 = u.pm * 256 + wr * 64 + fr, col0 = u.pn * 256 + wc * 32 + 4 * fq;
#pragma unroll
        for (int ai = 0; ai < 2; ++ai)
#pragma unroll
            for (int m = 0; m < 4; ++m) { GAS bf16_t* rowp = O + (size_t)(row0 + ai * 128 + m * 16) * ld + col0;
#pragma unroll
                for (int bj = 0; bj < 2; ++bj)
#pragma unroll
                    for (int n = 0; n < 2; ++n) st_bf16x4(rowp + bj * 128 + n * 16, acc[ai][bj][m][n]); }
    }
};
struct EpiRouter {
    GAS float* LOG;
    __device__ __forceinline__ void operator()(EPI_ARGS) const {
        if (wc >= 2) return;
        const int row0 = u.pm * 256 + wr * 64 + fr, col0 = wc * 32 + 4 * fq;
#pragma unroll
        for (int ai = 0; ai < 2; ++ai)
#pragma unroll
            for (int m = 0; m < 4; ++m) { GAS float* rowp = LOG + ((size_t)u.aux * MT + (row0 + ai * 128 + m * 16)) * 64 + col0;
#pragma unroll
                for (int n = 0; n < 2; ++n) *(GAS f32x4*)(rowp + n * 16) = acc[ai][0][m][n]; }
    }
};
struct RouterSched {
    int nM, G, c;
    __device__ __forceinline__ bool next(int i, Unit& u) const {
        const long L = (long)i * G + c; if (L >= (long)nM * 4) return false;
        u.pm = (int)(L >> 2); u.pn = 0; u.aux = (int)(L & 3); u.aux2 = 0;
        u.aoff = ((size_t)u.pm * 256 * DM + (size_t)u.aux * 512) * 2; u.boff = (size_t)u.aux * 512 * 2; return true;
    }
    __device__ __forceinline__ int arow(const Unit&, int) const { return 0; }
};
struct MoeSched {
    const volatile LAS int* tb; const volatile LAS int* cnt; const GAS int* list; int nN, G, c, mode;
    __device__ __forceinline__ bool next(int i, Unit& u) const {
        const long L = (long)i * G + c; const int NT = tb[32];
        const int ti = (int)(L / nN); if (ti >= NT) return false;
        u.pn = (int)(L % nN); int e = 0;
        while (e < 31 && ti >= tb[e + 1]) ++e;
        u.aux = e; u.aux2 = ti - tb[e]; u.pm = ti;
        if (mode == 1) { u.aoff = 0; u.boff = ((size_t)e * 1024 + (size_t)u.pn * 256) * DM; }
        else { u.aoff = (size_t)ti * 256 * DEXP; u.boff = ((size_t)e * DM + (size_t)u.pn * 256) * DEXP; }
        return true;
    }
    __device__ __forceinline__ int acnt(const Unit& u) const { return cnt[u.aux]; }
    __device__ __forceinline__ int arow(const Unit& u, int r, int n_e) const {
        const int pos = u.aux2 * 256 + r; const int e = u.aux;
        const bool in = pos < n_e; const int v = list[(size_t)e * MT + (in ? pos : 0)] >> 1;
        return in ? v : 0;
    }
};
struct EpiMoe1 {
    GAS unsigned char* H1;
    __device__ __forceinline__ void operator()(EPI_ARGS) const {
        const int row0 = u.pm * 256 + wr * 64 + fr, col0 = u.pn * 128 + wc * 32 + 4 * fq;
#pragma unroll
        for (int ai = 0; ai < 2; ++ai)
#pragma unroll
            for (int m = 0; m < 4; ++m) { GAS unsigned char* rowp = H1 + (size_t)(row0 + ai * 128 + m * 16) * DEXP + col0;
#pragma unroll
                for (int n = 0; n < 2; ++n) { const f32x4 a = acc[ai][0][m][n], b = acc[ai][1][m][n]; f32x4 v;
#pragma unroll
                    for (int j = 0; j < 4; ++j) v[j] = __builtin_amdgcn_fmed3f(a[j] * __builtin_amdgcn_rcpf(1.f + __builtin_amdgcn_exp2f(-1.4426950409f * a[j])) * b[j], -448.f, 448.f);
                    unsigned w = 0; w = __builtin_amdgcn_cvt_pk_fp8_f32(v[0], v[1], w, false); w = __builtin_amdgcn_cvt_pk_fp8_f32(v[2], v[3], w, true);
                    *(GAS unsigned*)(rowp + n * 16) = w; } }
    }
};
struct EpiMoe2 {
    GAS bf16_t* Y2; const GAS int* list; const GAS float* wl; const volatile LAS int* cnt;
    __device__ __forceinline__ void operator()(EPI_ARGS) const {
        const int e = u.aux, n_e = cnt[e], col0 = u.pn * 256 + wc * 32 + 4 * fq;
        int ts[8]; float w[8];
#pragma unroll
        for (int i = 0; i < 8; ++i) { const int pos = u.aux2 * 256 + (i >> 2) * 128 + wr * 64 + (i & 3) * 16 + fr; const bool ok = pos < n_e;
            const int pc = ok ? pos : 0; const int tv = list[(size_t)e * MT + pc]; const float wv = wl[(size_t)e * MT + pc];
            ts[i] = ok ? tv : -1; w[i] = ok ? wv : 0.f; }
#pragma unroll
        for (int ai = 0; ai < 2; ++ai)
#pragma unroll
            for (int m = 0; m < 4; ++m) { const int i = ai * 4 + m;
                if (ts[i] >= 0) {
                    GAS bf16_t* rowp = Y2 + (size_t)ts[i] * DM + col0;
#pragma unroll
                    for (int bj = 0; bj < 2; ++bj)
#pragma unroll
                        for (int n = 0; n < 2; ++n) st_bf16x4(rowp + bj * 128 + n * 16, acc[ai][bj][m][n] * w[i]);
                }
            }
    }
};

struct WinSched {
    GridSched gs; int mode;
    __device__ __forceinline__ bool next(int i, Unit& u) const {
        const long L = (long)i * gs.G + gs.c; if (L >= gs.nwg) return false;
        int j; gs.map((int)L, u.pm, j);
        u.pn = mode == 0 ? (j < 17 ? 4 + j : 5 + j) : (j < 4 ? j : 21);
        u.aux = 0; u.aux2 = 0; u.aoff = gs.a0 + (size_t)u.pm * gs.a_tile; u.boff = gs.b0 + (size_t)u.pn * gs.b_tile; return true;
    }
    __device__ __forceinline__ int arow(const Unit&, int) const { return 0; }
};
struct MergeSched {
    GridSched gs;
    __device__ __forceinline__ bool next(int i, Unit& u) const {
        const long L = (long)(i >> 2) * gs.G + gs.c; if (L >= gs.nwg) return false;
        gs.map((int)L, u.pm, u.pn); const int k = i & 3; u.aux = k; u.aux2 = 0;
        u.aoff = (size_t)u.pm * 256 * DM + (size_t)k * 512; u.boff = ((size_t)k * DM + (size_t)u.pn * 256) * 512; return true;
    }
    __device__ __forceinline__ int arow(const Unit&, int) const { return 0; }
};

__device__ __forceinline__ void tr_block(const GAS float* colp, int ldw, float nscale, const GAS float* kscale, int k0, GAS bf16_t* WT, int K, int n0, LAS float* scr, int lane) {
    float v[32];
#pragma unroll
    for (int i = 0; i < 32; ++i) { const int kk = 2 * i + (lane >> 5); v[i] = colp[(size_t)(k0 + kk) * ldw]; }
    if (kscale) {
#pragma unroll
        for (int i = 0; i < 32; ++i) { const int kk = 2 * i + (lane >> 5); v[i] *= kscale[k0 + kk]; }
    }
#pragma unroll
    for (int i = 0; i < 32; ++i) { const int kk = 2 * i + (lane >> 5); scr[kk * 33 + (lane & 31)] = v[i] * nscale; }
    LDS_WAIT(); asm volatile("" ::: "memory");
    const int c = lane & 7;
#pragma unroll
    for (int j = 0; j < 4; ++j) { const int n = (lane >> 3) + 8 * j; const LAS float* s = scr + (8 * c) * 33 + n;
        u32x4 o; o.x = cvt_pk_bf16(s[0 * 33], s[1 * 33]); o.y = cvt_pk_bf16(s[2 * 33], s[3 * 33]); o.z = cvt_pk_bf16(s[4 * 33], s[5 * 33]); o.w = cvt_pk_bf16(s[6 * 33], s[7 * 33]);
        *(GAS u32x4*)(WT + (size_t)(n0 + n) * K + k0 + 8 * c) = o; }
    LDS_WAIT(); asm volatile("" ::: "memory");
}

__device__ __forceinline__ void tr_block8(const GAS float* colp, int ldw, float nscale, int k0, GAS unsigned char* WT, int K, int n0, LAS float* scr, int lane) {
    float v[32];
#pragma unroll
    for (int i = 0; i < 32; ++i) { const int kk = 2 * i + (lane >> 5); v[i] = colp[(size_t)(k0 + kk) * ldw]; }
#pragma unroll
    for (int i = 0; i < 32; ++i) { const int kk = 2 * i + (lane >> 5); scr[kk * 33 + (lane & 31)] = v[i] * nscale; }
    LDS_WAIT(); asm volatile("" ::: "memory");
    const int c = lane & 7;
#pragma unroll
    for (int j = 0; j < 4; ++j) { const int n = (lane >> 3) + 8 * j; const LAS float* s = scr + (8 * c) * 33 + n;
        u32x2 o; unsigned w = 0; w = __builtin_amdgcn_cvt_pk_fp8_f32(s[0 * 33], s[1 * 33], w, false); w = __builtin_amdgcn_cvt_pk_fp8_f32(s[2 * 33], s[3 * 33], w, true); o.x = w;
        w = 0; w = __builtin_amdgcn_cvt_pk_fp8_f32(s[4 * 33], s[5 * 33], w, false); w = __builtin_amdgcn_cvt_pk_fp8_f32(s[6 * 33], s[7 * 33], w, true); o.y = w;
        *(GAS u32x2*)(WT + (size_t)(n0 + n) * K + k0 + 8 * c) = o; }
    LDS_WAIT(); asm volatile("" ::: "memory");
}

__device__ __forceinline__ void tr_block8k(const GAS float* colp, int ldw, float nscale, const GAS float* kscale, int k0, GAS unsigned char* WT, int K, int n0, LAS float* scr, int lane) {
    float v[32];
#pragma unroll
    for (int i = 0; i < 32; ++i) { const int kk = 2 * i + (lane >> 5); v[i] = colp[(size_t)(k0 + kk) * ldw]; }
    if (kscale) {
#pragma unroll
        for (int i = 0; i < 32; ++i) { const int kk = 2 * i + (lane >> 5); v[i] *= kscale[k0 + kk]; }
    }
#pragma unroll
    for (int i = 0; i < 32; ++i) { const int kk = 2 * i + (lane >> 5); scr[kk * 33 + (lane & 31)] = v[i] * nscale; }
    LDS_WAIT(); asm volatile("" ::: "memory");
    const int c = lane & 7;
#pragma unroll
    for (int j = 0; j < 4; ++j) { const int n = (lane >> 3) + 8 * j; const LAS float* s = scr + (8 * c) * 33 + n;
        u32x2 o; unsigned w = 0; w = __builtin_amdgcn_cvt_pk_fp8_f32(s[0 * 33], s[1 * 33], w, false); w = __builtin_amdgcn_cvt_pk_fp8_f32(s[2 * 33], s[3 * 33], w, true); o.x = w;
        w = 0; w = __builtin_amdgcn_cvt_pk_fp8_f32(s[4 * 33], s[5 * 33], w, false); w = __builtin_amdgcn_cvt_pk_fp8_f32(s[6 * 33], s[7 * 33], w, true); o.y = w;
        *(GAS u32x2*)(WT + (size_t)(n0 + n) * K + k0 + 8 * c) = o; }
    LDS_WAIT(); asm volatile("" ::: "memory");
}
__device__ __forceinline__ int win_src(int n) {
    if (n < 2048) return n;
    if (n < 5440) return n + 16;
    if (n < 5456) return 2048 + (n - 5440);
    if (n < 5472) return 6992 + (n - 5456);
    if (n < 5632) return -1;
    if (n < 6144) return 5456 + (n - 5632);
    return 5968 + (n - 6144);
}
constexpr int IT_WIN = 32 * 224, IT_WUQ = 8 * 24, IT_WUKV = 4 * 32, IT_WG = 32 * 64, IT_WBR = 8 * 64, IT_WOUT = 32 * 64, IT_WR = 32 * 8, IT_W13 = 32 * 32, IT_W2 = 8 * 64;
constexpr int IT_LAYER = IT_WIN + IT_WUQ + IT_WUKV + 4 * IT_WG + 4 * IT_WBR + IT_WOUT + IT_WR;
constexpr int IT_MOE = NEXP * (IT_W13 + IT_W2);
__device__ __forceinline__ void cvt_layer_item(Frame& F, int l, int r, LAS float* scr) {
    const int lane = F.lane, nl = lane & 31;
    if (r < IT_WIN) { const int nb = r % 224, kb = r / 224, n = nb * 32 + nl, sc = win_src(n);
        const int ct = nb >> 3;
        if (ct >= 4 && ct != 21) tr_block8(INP(I_WIN) + (size_t)l * DM * DIN + (sc >= 0 ? sc : 0), DIN, sc >= 0 ? 64.f : 0.f, kb * 64, WSP(unsigned char, WS_WIN8) + (size_t)l * NU * DM, DM, nb * 32, scr, lane);
        else tr_block(INP(I_WIN) + (size_t)l * DM * DIN + (sc >= 0 ? sc : 0), DIN, sc < 0 ? 0.f : (n < 512 ? 0.08838834764831845f : 1.f), nullptr, kb * 64, WSP(bf16_t, WS_WIN) + (size_t)l * NU * DM, DM, nb * 32, scr, lane);
        return; }
    r -= IT_WIN;
    if (r < IT_WUQ) { const int nb = r % 24, kb = r / 24, n = nb * 32 + nl; const int sc = n < 512 ? (n >> 7) * 192 + (n & 127) : ((n - 512) >> 6) * 192 + 128 + ((n - 512) & 63);
        tr_block(INP(I_WUQ) + (size_t)l * 512 * 768 + sc, 768, 0.07216878364870323f * 1.4426950408889634f, INP(I_MLAGQ) + l * 512, kb * 64, WSP(bf16_t, WS_WUQ) + (size_t)l * 768 * 512, 512, nb * 32, scr, lane); return; }
    r -= IT_WUQ;
    if (r < IT_WUKV) { const int nb = r % 32, kb = r / 32, n = nb * 32 + nl; const int sc = n < 512 ? (n >> 7) * 256 + (n & 127) : ((n - 512) >> 7) * 256 + 128 + ((n - 512) & 127);
        tr_block(INP(I_WUKV) + (size_t)l * 256 * 1024 + sc, 1024, 1.f, INP(I_MLAGKV) + l * 256, kb * 64, WSP(bf16_t, WS_WUKV) + (size_t)l * 1024 * 256, 256, nb * 32, scr, lane); return; }
    r -= IT_WUKV;
    if (r < 4 * IT_WG) { const int k = r / IT_WG, q = r % IT_WG, nb = q % 64, kb = q / 64;
        tr_block8(INP(I_WGATE) + (size_t)(l * 4 + k) * DM * DM + nb * 32 + nl, DM, -92.33248261689366f  , kb * 64, WSP(unsigned char, WS_WG) + ((size_t)l * 8192 + (size_t)k * 2048) * DM, DM, nb * 32, scr, lane); return; }
    r -= 4 * IT_WG;
    if (r < 4 * IT_WBR) { const int k = r / IT_WBR, q = r % IT_WBR, nb = q % 64, kb = q / 64;
        const GAS float* ks = k == 1 ? INP(I_HGNG) + l * 512 : (k == 3 ? INP(I_SSDNG) + l * 512 : nullptr);
        tr_block8k(INP(I_WBR) + (size_t)(l * 4 + k) * 512 * DM + nb * 32 + nl, DM, 64.f, ks, kb * 64, WSP(unsigned char, WS_WBR) + (size_t)(l * 4 + k) * DM * 512, 512, nb * 32, scr, lane); return; }
    r -= 4 * IT_WBR;
    if (r < IT_WOUT) { const int nb = r % 64, kb = r / 64;
        tr_block8(INP(I_WOUT) + (size_t)l * DM * DM + nb * 32 + nl, DM, 64.f, kb * 64, WSP(unsigned char, WS_WOUT) + (size_t)l * DM * DM, DM, nb * 32, scr, lane); return; }
    r -= IT_WOUT;
    { const int nb = r % 8, kb = r / 8, n = nb * 32 + nl; const GAS float* cp = INP(I_WGRP) + (size_t)l * DM * 4; int ld = 4;
      if (n < 4) { cp += n; } else if (n < 36) { cp = INP(I_WEXP) + (size_t)l * DM * 32 + (n - 4); ld = 32; }
      tr_block(cp, ld, n < 36 ? 1.f : 0.f, nullptr, kb * 64, WSP(bf16_t, WS_WR) + (size_t)l * 256 * DM, DM, nb * 32, scr, lane); }
}
__device__ __forceinline__ void cvt_moe_item(Frame& F, int l, int r, LAS float* scr) {
    const int lane = F.lane, nl = lane & 31;
    if (r < NEXP * IT_W13) { const int e = r / IT_W13, q = r % IT_W13, nb = q % 32, kb = q / 32, n = nb * 32 + nl;
        const int c = (n >> 8) * 128 + (n & 127); const GAS float* src = ((n >> 7) & 1) ? INP(I_W3) : INP(I_W1);
        tr_block8(src + (size_t)(l * NEXP + e) * DM * DEXP + c, DEXP, 64.f, kb * 64, WSP(unsigned char, WS_W13) + (size_t)e * 1024 * DM, DM, nb * 32, scr, lane); return; }
    r -= NEXP * IT_W13;
    { const int e = r / IT_W2, q = r % IT_W2, nb = q % 64, kb = q / 64;
      tr_block8(INP(I_W2) + (size_t)(l * NEXP + e) * DEXP * DM + nb * 32 + nl, DM, 64.f, kb * 64, WSP(unsigned char, WS_W2) + (size_t)e * DM * DEXP, DEXP, nb * 32, scr, lane); }
}
__device__ __forceinline__ void ada_task(Frame& F, int task, LAS float* scr) {
    const int ks = task & 15, cg = (task >> 4) % 48, l = task / (16 * 48); const int col = cg * 256 + F.lane * 4;
    for (int i = F.lane; i < 9 * 128; i += 64) { const int r = i >> 7, kk = ks * 128 + (i & 127); const float c = r < 8 ? INP(I_C)[r * DM + kk] : INP(I_CCTX)[kk]; scr[i] = siluf_(c); }
    LDS_WAIT(); asm volatile("" ::: "memory");
    f32x4 a[9];
#pragma unroll
    for (int r = 0; r < 9; ++r) a[r] = (f32x4){0.f, 0.f, 0.f, 0.f};
    const GAS float* W = INP(I_WADA) + ((size_t)l * DM + ks * 128) * 12288 + col;
    for (int k = 0; k < 128; k += 8) {
        f32x4 w[8];
#pragma unroll
        for (int q = 0; q < 8; ++q) w[q] = *(const GAS f32x4*)(W + (size_t)(k + q) * 12288);
#pragma unroll
        for (int q = 0; q < 8; ++q) {
#pragma unroll
            for (int r = 0; r < 9; ++r) a[r] += scr[r * 128 + k + q] * w[q];
        }
    }
    GAS float* P = WSP(float, WS_MODP) + ((size_t)(l * 16 + ks) * 9) * 12288 + col;
#pragma unroll
    for (int r = 0; r < 9; ++r) *(GAS f32x4*)(P + (size_t)r * 12288) = a[r];
    LDS_WAIT(); asm volatile("" ::: "memory");
}
__device__ __forceinline__ void tables_task(Frame& F) {
    GAS float* T = WSP(float, WS_TAB); const int lane = F.lane;
    for (int i = 0; i < 16; ++i) { const float inv = expf(-(float)i * (9.210340371976184f / 16.f)); const float ang = (float)lane * inv; T[lane * 16 + i] = cosf(ang); T[1024 + lane * 16 + i] = sinf(ang); }
    for (int j = lane; j < 512; j += 64) { const float a0 = INP(I_HGLB)[j], a1 = INP(I_HGLB)[512 + j], a2 = INP(I_HGLB)[1024 + j];
        const float mx = fmaxf(a0, fmaxf(a1, a2)), e0 = expf(a0 - mx), e1 = expf(a1 - mx), e2 = expf(a2 - mx), s = e0 + e1 + e2;
        T[2048 + j] = e0 / s; T[2048 + 512 + j] = (e0 + e1) / s; }
}
constexpr int N_ADA = 2 * 48 * 16;
__device__ __forceinline__ void phase_prologue(Frame& F) {
    LAS float* scr = (LAS float*)(F.lds + F.wave * 16384);
    const int gw = F.vcu * 8 + F.wave, NGW = F.G * 8;
    constexpr int TOTAL = N_ADA + 1 + IT_LAYER;
    for (int it = gw; it < TOTAL; it += NGW) {
        int r = it;
        if (r < N_ADA) { ada_task(F, r, scr); continue; } r -= N_ADA;
        if (r == 0) { tables_task(F); continue; } r -= 1;
        cvt_layer_item(F, 0, r, scr);
    }
}
__device__ __forceinline__ void phase_modfin(Frame& F) {
    const int gt = F.vcu * 512 + F.tid, NT_ = F.G * 512;
    for (int i = gt; i < 2 * 9 * 12288; i += NT_) { const int l = i / (9 * 12288), rc = i % (9 * 12288), col = rc % 12288;
        float s = INP(I_BADA)[l * 12288 + col];
#pragma unroll
        for (int ks = 0; ks < 16; ++ks) s += WSP(float, WS_MODP)[((size_t)(l * 16 + ks) * 9) * 12288 + rc];
        WSP(float, WS_MOD)[i] = s; }
}

struct Row8 { f32x4 v[8]; };
__device__ __forceinline__ void ld_row_f32(Row8& R, const GAS float* p, int lane) {
#pragma unroll
    for (int j = 0; j < 8; ++j) R.v[j] = ((const GAS f32x4*)p)[64 * j + lane];
}
__device__ __forceinline__ void st_row_f32(const Row8& R, GAS float* p, int lane) {
#pragma unroll
    for (int j = 0; j < 8; ++j) ((GAS f32x4*)p)[64 * j + lane] = R.v[j];
}
__device__ __forceinline__ void ld_row_bf16(Row8& R, const GAS bf16_t* p, int lane) {
#pragma unroll
    for (int j = 0; j < 8; ++j) { const u32x2 w = ((const GAS u32x2*)p)[64 * j + lane]; R.v[j] = (f32x4){bflo(w.x), bfhi(w.x), bflo(w.y), bfhi(w.y)}; }
}
__device__ __forceinline__ void st_row_bf16(const Row8& R, GAS bf16_t* p, int lane) {
#pragma unroll
    for (int j = 0; j < 8; ++j) { u32x2 w; w.x = cvt_pk_bf16(R.v[j][0], R.v[j][1]); w.y = cvt_pk_bf16(R.v[j][2], R.v[j][3]); ((GAS u32x2*)p)[64 * j + lane] = w; }
}
__device__ __forceinline__ float row_rstd(const Row8& R) {
    float s = 0.f;
#pragma unroll
    for (int j = 0; j < 8; ++j) s += (R.v[j][0] * R.v[j][0] + R.v[j][1] * R.v[j][1]) + (R.v[j][2] * R.v[j][2] + R.v[j][3] * R.v[j][3]);
    return rsqrtf(wave_sum(s) * (1.f / DM) + EPS);
}
__device__ __forceinline__ void st_modnorm(const Row8& R, float rstd, const GAS float* g, const GAS float* shift, const GAS float* scale, GAS bf16_t* o, int lane) {
#pragma unroll
    for (int j = 0; j < 8; ++j) { const int c = 64 * j + lane; const f32x4 gg = ((const GAS f32x4*)g)[c], sh = ((const GAS f32x4*)shift)[c], sc = ((const GAS f32x4*)scale)[c];
        const f32x4 h = (R.v[j] * rstd * gg) * (sc + 1.f) + sh; u32x2 w; w.x = cvt_pk_bf16(h[0], h[1]); w.y = cvt_pk_bf16(h[2], h[3]); ((GAS u32x2*)o)[c] = w; }
}
__device__ __forceinline__ void st_modnorm8(const Row8& R, float rstd, const GAS float* g, const GAS float* shift, const GAS float* scale, GAS unsigned char* o, int lane) {
#pragma unroll
    for (int j = 0; j < 8; ++j) { const int c = 64 * j + lane; const f32x4 gg = ((const GAS f32x4*)g)[c], sh = ((const GAS f32x4*)shift)[c], sc = ((const GAS f32x4*)scale)[c];
        f32x4 h = (R.v[j] * rstd * gg) * (sc + 1.f) + sh;
#pragma unroll
        for (int q = 0; q < 4; ++q) h[q] = __builtin_amdgcn_fmed3f(h[q], -448.f, 448.f);
        unsigned w = 0; w = __builtin_amdgcn_cvt_pk_fp8_f32(h[0], h[1], w, false); w = __builtin_amdgcn_cvt_pk_fp8_f32(h[2], h[3], w, true); ((GAS unsigned*)o)[c] = w; }
}
__device__ __forceinline__ void st_modnorm2(const Row8& R, float rstd, const GAS float* g, const GAS float* shift, const GAS float* scale, GAS bf16_t* o16, GAS unsigned char* o8, int lane) {
#pragma unroll
    for (int j = 0; j < 8; ++j) { const int c = 64 * j + lane; const f32x4 gg = ((const GAS f32x4*)g)[c], sh = ((const GAS f32x4*)shift)[c], sc = ((const GAS f32x4*)scale)[c];
        f32x4 h = (R.v[j] * rstd * gg) * (sc + 1.f) + sh; u32x2 w; w.x = cvt_pk_bf16(h[0], h[1]); w.y = cvt_pk_bf16(h[2], h[3]); ((GAS u32x2*)o16)[c] = w;
#pragma unroll
        for (int q = 0; q < 4; ++q) h[q] = __builtin_amdgcn_fmed3f(h[q], -448.f, 448.f);
        unsigned w8 = 0; w8 = __builtin_amdgcn_cvt_pk_fp8_f32(h[0], h[1], w8, false); w8 = __builtin_amdgcn_cvt_pk_fp8_f32(h[2], h[3], w8, true); ((GAS unsigned*)o8)[c] = w8; }
}
__device__ __forceinline__ const GAS float* mod_row(Frame& F, int l, int r) { return WSP(float, WS_MOD) + (size_t)(l * 9 + (r < ML ? (r >> 11) : 8)) * 12288; }
struct RawX { f32x4 f[8]; };
__device__ __forceinline__ void ld_raw_f32(RawX& R, const GAS float* p, int lane) {
#pragma unroll
    for (int j = 0; j < 8; ++j) R.f[j] = ((const GAS f32x4*)p)[64 * j + lane];
}
__device__ __forceinline__ void ld_raw_bf16(RawX& R, const GAS bf16_t* p, int lane) {
#pragma unroll
    for (int j = 0; j < 8; ++j) { const u32x2 w = ((const GAS u32x2*)p)[64 * j + lane]; R.f[j] = (f32x4){__uint_as_float(w.x), __uint_as_float(w.y), 0.f, 0.f}; }
}
__device__ __forceinline__ void raw_to_row(Row8& X, const RawX& R, bool is_bf16) {
#pragma unroll
    for (int j = 0; j < 8; ++j) { if (is_bf16) { const unsigned a = __float_as_uint(R.f[j][0]), b = __float_as_uint(R.f[j][1]); X.v[j] = (f32x4){bflo(a), bfhi(a), bflo(b), bfhi(b)}; } else X.v[j] = R.f[j]; }
}
struct RawB { u32x2 w[8]; };
__device__ __forceinline__ void ld_rawb(RawB& R, const GAS bf16_t* p, int lane) {
#pragma unroll
    for (int j = 0; j < 8; ++j) R.w[j] = ((const GAS u32x2*)p)[64 * j + lane];
}
__device__ __forceinline__ void rawb_to_row(Row8& X, const RawB& R) {
#pragma unroll
    for (int j = 0; j < 8; ++j) X.v[j] = (f32x4){bflo(R.w[j].x), bfhi(R.w[j].x), bflo(R.w[j].y), bfhi(R.w[j].y)};
}
__device__ __forceinline__ int row_grp(int r) { return r < ML ? (r >> 11) : 8; }
__device__ __forceinline__ void stage_vec(Frame& F, LAS float* dst, const GAS float* src) { ((LAS f32x4*)dst)[F.tid] = ((const GAS f32x4*)src)[F.tid]; }
__device__ __forceinline__ void st_modnorm2_l(const Row8& R, float rstd, const LAS float* g, const LAS float* shift, const LAS float* scale, GAS bf16_t* o16, GAS unsigned char* o8, int lane) {
#pragma unroll
    for (int j = 0; j < 8; ++j) { const int c = 64 * j + lane; const f32x4 gg = ((const LAS f32x4*)g)[c], sh = ((const LAS f32x4*)shift)[c], sc = ((const LAS f32x4*)scale)[c];
        f32x4 h = (R.v[j] * rstd * gg) * (sc + 1.f) + sh; u32x2 w; w.x = cvt_pk_bf16(h[0], h[1]); w.y = cvt_pk_bf16(h[2], h[3]); ((GAS u32x2*)o16)[c] = w;
#pragma unroll
        for (int q = 0; q < 4; ++q) h[q] = __builtin_amdgcn_fmed3f(h[q], -448.f, 448.f);
        unsigned w8 = 0; w8 = __builtin_amdgcn_cvt_pk_fp8_f32(h[0], h[1], w8, false); w8 = __builtin_amdgcn_cvt_pk_fp8_f32(h[2], h[3], w8, true); ((GAS unsigned*)o8)[c] = w8; }
}
__device__ __forceinline__ void phase_rwA(Frame& F, int l) {
    const int rpb = (MT + F.G - 1) / F.G, rlo = F.vcu * rpb, rhi = (rlo + rpb < MT ? rlo + rpb : MT) - 1;
    if (rlo > rhi) return;
    LAS float* Lf = (LAS float*)F.lds; const int ga = row_grp(rlo), gb = row_grp(rhi);
    stage_vec(F, Lf, INP(I_NORMG) + (size_t)(l * 4 + 0) * DM);
#pragma unroll
    for (int v = 0; v < 2; ++v) { stage_vec(F, Lf + (1 + v) * 2048, WSP(float, WS_MOD) + (size_t)(l * 9 + ga) * 12288 + v * DM); stage_vec(F, Lf + (3 + v) * 2048, WSP(float, WS_MOD) + (size_t)(l * 9 + gb) * 12288 + v * DM); }
    __syncthreads();
    for (int i0 = F.wave; i0 < rpb; i0 += 16) {
        const int r0 = rlo + i0, r1 = r0 + 8; const bool two = i0 + 8 < rpb && r1 <= rhi;
        if (r0 > rhi) break;
        RawX Ra, Rb; ld_raw_f32(Ra, r0 < ML ? INP(I_X) + (size_t)r0 * DM : INP(I_CTX) + (size_t)(r0 - ML) * DM, F.lane);
        if (two) ld_raw_f32(Rb, r1 < ML ? INP(I_X) + (size_t)r1 * DM : INP(I_CTX) + (size_t)(r1 - ML) * DM, F.lane);
#pragma unroll
        for (int q = 0; q < 2; ++q) { if (q == 1 && !two) break; const int r = q ? r1 : r0;
            Row8 R; raw_to_row(R, q ? Rb : Ra, false);
            const float rstd = row_rstd(R); const LAS float* md = Lf + (row_grp(r) == ga ? 1 : 3) * 2048;
            st_modnorm2_l(R, rstd, Lf, md, md + 2048, WSP(bf16_t, WS_HIN) + (size_t)r * DM, WSP(unsigned char, WS_H8) + (size_t)r * DM, F.lane); }
    }
}
__device__ __forceinline__ void phase_rwB(Frame& F, int l, int mrows) {
    const int rpb = (mrows + F.G - 1) / F.G, rlo = F.vcu * rpb, rhi = (rlo + rpb < mrows ? rlo + rpb : mrows) - 1;
    if (rlo > rhi) return;
    LAS float* Lf = (LAS float*)F.lds; const int ga = row_grp(rlo), gb = row_grp(rhi);
    stage_vec(F, Lf, INP(I_NORMG) + (size_t)(l * 4 + 1) * DM); stage_vec(F, Lf + 2048, INP(I_NORMG) + (size_t)(l * 4 + 2) * DM);
#pragma unroll
    for (int v = 0; v < 3; ++v) { stage_vec(F, Lf + (2 + v) * 2048, WSP(float, WS_MOD) + (size_t)(l * 9 + ga) * 12288 + (2 + v) * DM); stage_vec(F, Lf + (5 + v) * 2048, WSP(float, WS_MOD) + (size_t)(l * 9 + gb) * 12288 + (2 + v) * DM); }
    __syncthreads();
    const LAS float* g1 = Lf; const LAS float* g2 = Lf + 2048;
    for (int i0 = F.wave; i0 < rpb; i0 += 16) {
        const int r0 = rlo + i0, r1 = r0 + 8; const bool two = i0 + 8 < rpb && r1 <= rhi;
        if (r0 > rhi) break;
        RawB Ya, Yb; RawX Xa, Xb;
#define RWB_LOAD(Y_, X_, r_) do { ld_rawb(Y_, WSP(bf16_t, WS_RB + RB_Y) + (size_t)(r_) * DM, F.lane); \
        if ((r_) < ML) { if (l == 0) ld_raw_f32(X_, INP(I_X) + (size_t)(r_) * DM, F.lane); else ld_raw_bf16(X_, (const GAS bf16_t*)(F.out + (size_t)(r_) * DM), F.lane); } \
        else ld_raw_f32(X_, l == 0 ? INP(I_CTX) + (size_t)((r_) - ML) * DM : WSP(float, WS_XC) + (size_t)((r_) - ML) * DM, F.lane); } while (0)
        RWB_LOAD(Ya, Xa, r0); if (two) RWB_LOAD(Yb, Xb, r1);
#undef RWB_LOAD
#pragma unroll
        for (int q = 0; q < 2; ++q) { if (q == 1 && !two) break; const int r = q ? r1 : r0;
            Row8 Y, X; rawb_to_row(Y, q ? Yb : Ya); raw_to_row(X, q ? Xb : Xa, r < ML && l != 0);
            const float ry = row_rstd(Y); const LAS float* md = Lf + (row_grp(r) == ga ? 2 : 5) * 2048;
#pragma unroll
            for (int j = 0; j < 8; ++j) { const int c = 64 * j + F.lane; X.v[j] += ((const LAS f32x4*)md)[c] * (Y.v[j] * ry * ((const LAS f32x4*)g1)[c]); }
            if (r < ML) st_row_bf16(X, (GAS bf16_t*)(F.out + (size_t)r * DM), F.lane); else st_row_f32(X, WSP(float, WS_XC) + (size_t)(r - ML) * DM, F.lane);
            const float rx = row_rstd(X);
            st_modnorm2_l(X, rx, g2, md + 2048, md + 4096, WSP(bf16_t, WS_H) + (size_t)r * DM, WSP(unsigned char, WS_H8) + (size_t)r * DM, F.lane); }
    }
}
__device__ __forceinline__ void phase_rwC(Frame& F, int l, int mrows) {
    const int rpb = (mrows + F.G - 1) / F.G, rlo = F.vcu * rpb, rhi = (rlo + rpb < mrows ? rlo + rpb : mrows) - 1;
    if (rlo > rhi) return;
    LAS float* Lf = (LAS float*)F.lds; const int ga = row_grp(rlo), gb = row_grp(rhi);
    stage_vec(F, Lf, INP(I_NORMG) + (size_t)(l * 4 + 3) * DM);
    stage_vec(F, Lf + 2 * 2048, WSP(float, WS_MOD) + (size_t)(l * 9 + ga) * 12288 + 5 * DM); stage_vec(F, Lf + 5 * 2048, WSP(float, WS_MOD) + (size_t)(l * 9 + gb) * 12288 + 5 * DM);
    if (l + 1 < DEPTH) { stage_vec(F, Lf + 2048, INP(I_NORMG) + (size_t)((l + 1) * 4 + 0) * DM);
#pragma unroll
        for (int v = 0; v < 2; ++v) { stage_vec(F, Lf + (3 + v) * 2048, WSP(float, WS_MOD) + (size_t)((l + 1) * 9 + ga) * 12288 + v * DM); stage_vec(F, Lf + (6 + v) * 2048, WSP(float, WS_MOD) + (size_t)((l + 1) * 9 + gb) * 12288 + v * DM); } }
    __syncthreads();
    const LAS float* g3 = Lf;
    for (int i0 = F.wave; i0 < rpb; i0 += 16) {
        const int r0 = rlo + i0, r1 = r0 + 8; const bool two = i0 + 8 < rpb && r1 <= rhi;
        if (r0 > rhi) break;
        RawB Aa, Ba, Ab, Bb; RawX Xa, Xb;
#define RWC_LOAD(A_, B_, X_, r_) do { ld_rawb(A_, WSP(bf16_t, WS_RB + RB_Y2) + (size_t)(2 * (r_)) * DM, F.lane); ld_rawb(B_, WSP(bf16_t, WS_RB + RB_Y2) + (size_t)(2 * (r_) + 1) * DM, F.lane); \
        if ((r_) < ML) ld_raw_bf16(X_, (const GAS bf16_t*)(F.out + (size_t)(r_) * DM), F.lane); else ld_raw_f32(X_, WSP(float, WS_XC) + (size_t)((r_) - ML) * DM, F.lane); } while (0)
        RWC_LOAD(Aa, Ba, Xa, r0); if (two) RWC_LOAD(Ab, Bb, Xb, r1);
#undef RWC_LOAD
#pragma unroll
        for (int q = 0; q < 2; ++q) { if (q == 1 && !two) break; const int r = q ? r1 : r0;
            Row8 A, B, X; rawb_to_row(A, q ? Ab : Aa); rawb_to_row(B, q ? Bb : Ba); raw_to_row(X, q ? Xb : Xa, r < ML);
#pragma unroll
            for (int j = 0; j < 8; ++j) A.v[j] += B.v[j];
            const float ry = row_rstd(A); const LAS float* md = Lf + (row_grp(r) == ga ? 2 : 5) * 2048;
#pragma unroll
            for (int j = 0; j < 8; ++j) { const int c = 64 * j + F.lane; X.v[j] += ((const LAS f32x4*)md)[c] * (A.v[j] * ry * ((const LAS f32x4*)g3)[c]); }
            if (r >= ML) st_row_f32(X, WSP(float, WS_XC) + (size_t)(r - ML) * DM, F.lane);
            else if (l + 1 < DEPTH) st_row_bf16(X, (GAS bf16_t*)(F.out + (size_t)r * DM), F.lane);
            else st_row_f32(X, F.out + (size_t)r * DM, F.lane);
            if (l + 1 < DEPTH) { const float rx = row_rstd(X);
                st_modnorm2_l(X, rx, Lf + 2048, md + 2048, md + 4096, WSP(bf16_t, WS_HIN) + (size_t)r * DM, WSP(unsigned char, WS_H8) + (size_t)r * DM, F.lane); } }
    }
}
__device__ __forceinline__ void ld8bf(float (&o)[8], const GAS bf16_t* p) { const u32x4 w = *(const GAS u32x4*)p; o[0] = bflo(w.x); o[1] = bfhi(w.x); o[2] = bflo(w.y); o[3] = bfhi(w.y); o[4] = bflo(w.z); o[5] = bfhi(w.z); o[6] = bflo(w.w); o[7] = bfhi(w.w); }
__device__ __forceinline__ void st8bf(GAS bf16_t* p, const float (&v)[8]) { u32x4 w; w.x = cvt_pk_bf16(v[0], v[1]); w.y = cvt_pk_bf16(v[2], v[3]); w.z = cvt_pk_bf16(v[4], v[5]); w.w = cvt_pk_bf16(v[6], v[7]); *(GAS u32x4*)p = w; }
__device__ __forceinline__ void st8fp8(GAS unsigned char* p, const float (&v)[8]) {
    float c[8];
#pragma unroll
    for (int j = 0; j < 8; ++j) c[j] = __builtin_amdgcn_fmed3f(v[j], -448.f, 448.f);
    u32x2 o; unsigned w = 0; w = __builtin_amdgcn_cvt_pk_fp8_f32(c[0], c[1], w, false); w = __builtin_amdgcn_cvt_pk_fp8_f32(c[2], c[3], w, true); o.x = w;
    w = 0; w = __builtin_amdgcn_cvt_pk_fp8_f32(c[4], c[5], w, false); w = __builtin_amdgcn_cvt_pk_fp8_f32(c[6], c[7], w, true); o.y = w; *(GAS u32x2*)p = o;
}
__device__ __forceinline__ void unpk8(float (&o)[8], u32x4 w) { o[0] = bflo(w.x); o[1] = bfhi(w.x); o[2] = bflo(w.y); o[3] = bfhi(w.y); o[4] = bflo(w.z); o[5] = bfhi(w.z); o[6] = bflo(w.w); o[7] = bfhi(w.w); }
__device__ __forceinline__ void phase_finish(Frame& F, int l, int mrows) {
    const int gw = F.vcu * 8 + F.wave, NGW = F.G * 8, c8 = F.lane * 8;
    const GAS bf16_t* Y = WSP(bf16_t, WS_YFB); const GAS bf16_t* U = WSP(bf16_t, WS_RA); GAS unsigned char* BR = WSP(unsigned char, WS_BR); const GAS float* dskip = INP(I_SSDD) + l * 8;
    const float dsk = dskip[F.lane >> 3];
    struct FinRow { u32x4 v[10]; };
#define FIN_LOAD(R_, r_) do { const size_t r__ = (size_t)(r_); \
        R_.v[0] = *(const GAS u32x4*)(Y + ((size_t)0 * MT + r__) * 512 + c8); R_.v[1] = *(const GAS u32x4*)(Y + ((size_t)1 * MT + r__) * 512 + c8); R_.v[2] = *(const GAS u32x4*)(U + r__ * NU + U_MLO + c8); \
        R_.v[3] = *(const GAS u32x4*)(Y + ((size_t)2 * MT + r__) * 512 + c8); R_.v[4] = *(const GAS u32x4*)(Y + ((size_t)3 * MT + r__) * 512 + c8); R_.v[5] = *(const GAS u32x4*)(U + r__ * NU + U_HGG + c8); \
        R_.v[6] = *(const GAS u32x4*)(Y + ((size_t)4 * MT + r__) * 512 + c8); R_.v[7] = *(const GAS u32x4*)(Y + ((size_t)5 * MT + r__) * 512 + c8); R_.v[8] = *(const GAS u32x4*)(U + r__ * NU + U_Z + c8); \
        R_.v[9] = *(const GAS u32x4*)(WSP(bf16_t, WS_XBC) + r__ * 1024 + c8); } while (0)
    for (int r0 = gw; r0 < mrows; r0 += 2 * NGW) {
        const int r1 = r0 + NGW; const bool two = r1 < mrows;
        FinRow Ra, Rb; FIN_LOAD(Ra, r0); if (two) FIN_LOAD(Rb, r1);
#pragma unroll
        for (int q = 0; q < 2; ++q) { if (q == 1 && !two) break; const int r = q ? r1 : r0; const FinRow& R = q ? Rb : Ra;
            float a[8], b[8], g[8], o[8];
            unpk8(a, R.v[0]); unpk8(b, R.v[1]); unpk8(g, R.v[2]);
#pragma unroll
            for (int j = 0; j < 8; ++j) o[j] = (a[j] + b[j]) * sigmoidf_(g[j]);
            st8fp8(BR + (size_t)r * DM + c8, o);
            unpk8(a, R.v[3]); unpk8(b, R.v[4]); unpk8(g, R.v[5]);
            float ss = 0.f;
#pragma unroll
            for (int j = 0; j < 8; ++j) { a[j] += b[j]; ss += a[j] * a[j]; }
            ss += __shfl_xor(ss, 1); ss += __shfl_xor(ss, 2); ss += __shfl_xor(ss, 4); ss += __shfl_xor(ss, 8);
            const float rh = rsqrtf(ss * (1.f / 128.f) + EPS);
#pragma unroll
            for (int j = 0; j < 8; ++j) o[j] = a[j] * rh * sigmoidf_(g[j]);
            st8fp8(BR + (size_t)r * DM + 512 + c8, o);
            unpk8(a, R.v[6]); unpk8(b, R.v[7]); unpk8(g, R.v[8]);
            float s2 = 0.f, xh[8]; unpk8(xh, R.v[9]);
#pragma unroll
            for (int j = 0; j < 8; ++j) { o[j] = (a[j] + b[j] + dsk * xh[j]) * siluf_(g[j]); s2 += o[j] * o[j]; }
            s2 = wave_sum(s2);
            if (F.lane == 0) WSP(float, WS_RSSD)[r] = rsqrtf(s2 * (1.f / 512.f) + EPS);
            st8fp8(BR + (size_t)r * DM + 1536 + c8, o);
        }
    }
#undef FIN_LOAD
}

__device__ __forceinline__ void phase_ssdconv(Frame& F, int l) {
    const int gw = F.vcu * 8 + F.wave, NGW = F.G * 8, c16 = F.lane * 16;
    const GAS bf16_t* U = WSP(bf16_t, WS_RA); GAS bf16_t* X2 = WSP(bf16_t, WS_XBC);
    float w0[16], w1[16], w2[16], cb[16];
    { const GAS float* cw = INP(I_CONVW) + (size_t)l * 3 * 1024 + c16; const GAS float* bb = INP(I_CONVB) + l * 1024 + c16;
#pragma unroll
      for (int j = 0; j < 16; ++j) { w0[j] = cw[j]; w1[j] = cw[1024 + j]; w2[j] = cw[2048 + j]; cb[j] = bb[j]; } }
    for (int r = gw; r < MT; r += NGW) {
        const int t = r < ML ? (r & (SEQ - 1)) : ((r - ML) & (CTXL - 1)), tn = r < ML ? SEQ : CTXL;
        const GAS bf16_t* up = U + (size_t)r * NU + U_XBC + c16;
        float a[16], p_[16], n_[16];
        { const bool hp = t > 0, hn = t + 1 < tn; const GAS bf16_t* pp = hp ? up - NU : up; const GAS bf16_t* np = hn ? up + NU : up; const float pf = hp ? 1.f : 0.f, nf = hn ? 1.f : 0.f;
          const u32x4 ra0 = *(const GAS u32x4*)up, ra1 = *(const GAS u32x4*)(up + 8), rp0 = *(const GAS u32x4*)pp, rp1 = *(const GAS u32x4*)(pp + 8), rn0 = *(const GAS u32x4*)np, rn1 = *(const GAS u32x4*)(np + 8);
          float t8[8];
          unpk8(t8, ra0);
#pragma unroll
          for (int j = 0; j < 8; ++j) a[j] = t8[j]; unpk8(t8, ra1);
#pragma unroll
          for (int j = 0; j < 8; ++j) a[8 + j] = t8[j]; unpk8(t8, rp0);
#pragma unroll
          for (int j = 0; j < 8; ++j) p_[j] = t8[j] * pf; unpk8(t8, rp1);
#pragma unroll
          for (int j = 0; j < 8; ++j) p_[8 + j] = t8[j] * pf; unpk8(t8, rn0);
#pragma unroll
          for (int j = 0; j < 8; ++j) n_[j] = t8[j] * nf; unpk8(t8, rn1);
#pragma unroll
          for (int j = 0; j < 8; ++j) n_[8 + j] = t8[j] * nf; }
        float o[8];
#pragma unroll
        for (int j = 0; j < 8; ++j) o[j] = siluf_(w0[j] * p_[j] + w1[j] * a[j] + w2[j] * n_[j] + cb[j]);
        st8bf(X2 + (size_t)r * 1024 + c16, o);
#pragma unroll
        for (int j = 0; j < 8; ++j) o[j] = siluf_(w0[8 + j] * p_[8 + j] + w1[8 + j] * a[8 + j] + w2[8 + j] * n_[8 + j] + cb[8 + j]);
        st8bf(X2 + (size_t)r * 1024 + c16 + 8, o);
    }
}

__device__ __forceinline__ void phase_scanprep(Frame& F, int l) {
    const int gw = F.vcu * 8 + F.wave, NGW = F.G * 8, lane = F.lane, r32 = lane & 31, hi = lane >> 5;
    const GAS bf16_t* U = WSP(bf16_t, WS_RA);
    constexpr int N_ML = 64 * 72, N_SSD = 64 * 72, N_HG = 64 * 72 * 2, N_MLC = 32 * 72;
    for (int it = gw; it < N_ML + N_SSD + N_HG + N_MLC; it += NGW) {
        if (it >= N_ML + N_SSD + N_HG) {
            const int q = it - (N_ML + N_SSD + N_HG), cg = q % 72, bh = q / 72, b = bh >> 2, h = bh & 3;
            GAS bf16_t* dst = WSP(bf16_t, WS_MLC) + ((size_t)bh * 2304 + 32 * cg) * 384;
#pragma unroll 1
            for (int ib = 0; ib < 3; ++ib) { u32x4 v[8];
#pragma unroll
                for (int i = 0; i < 8; ++i) { const int piece = (ib * 8 + i) * 64 + lane, rr = piece / 48, pc = piece % 48, ci = 32 * cg + rr;
                    const int trow = ci < CTXL ? ML + b * CTXL + ci : b * SEQ + (ci - CTXL);
                    v[i] = *(const GAS u32x4*)(U + (size_t)trow * NU + (pc >> 4) * 512 + h * 128 + (pc & 15) * 8); }
#pragma unroll
                for (int i = 0; i < 8; ++i) { const int piece = (ib * 8 + i) * 64 + lane; *(GAS u32x4*)(dst + (size_t)piece * 8) = v[i]; } }
            continue;
        }
        if (it < N_ML) {
            const int c = it % 72, task = it / 72, b = task >> 3, h = (task >> 1) & 3, dir = task & 1, cg = U_MLG + dir * 8 + h;
            const float fbias = INP(I_MLFB)[l * 8 + dir * 4 + h];
            const GAS bf16_t* gp = U + (size_t)prow(b, dir, 32 * c + r32) * NU + cg; const float gi = bf2f(gp[0]), gf = bf2f(gp[4]);
            const float x_ = gf + fbias, flog = fminf(x_, 0.f) - log1pf(__expf(-fabsf(x_)));
            const float Fl = scn::scan_add32(flog, r32), bl = gi - Fl, Ml = scn::scan_max32(bl, r32);
            if (hi == 0) *(GAS f32x4*)(WSP(float, WS_MLS) + ((size_t)task * 2304 + 32 * c + r32) * 8) = (f32x4){Fl, bl, Ml, 0.f};
        } else if (it < N_ML + N_SSD) {
            const int q = it - N_ML, c = q % 72, t3 = q / 72, b = t3 >> 3, hp = (t3 >> 1) & 3, dir = t3 & 1, hd = 2 * hp + hi;
            const float dtb = INP(I_DTB)[l * 16 + dir * 8 + hd], aneg = -__expf(INP(I_ALOG)[l * 16 + dir * 8 + hd]);
            const float xr_ = bf2f(U[(size_t)prow(b, dir, 32 * c + r32) * NU + U_DT + dir * 8 + hd]) + dtb;
            const float dt_ = fmaxf(xr_, 0.f) + log1pf(__expf(-fabsf(xr_))), at = scn::scan_add32(dt_ * aneg, r32), ae = __shfl(at, 31, 32);
            GAS float* rp = WSP(float, WS_SSDS) + ((size_t)((b * 2 + dir) * 8 + hd) * 2304 + 32 * c + r32) * 8;
            *(GAS f32x4*)rp = (f32x4){dt_, at, __expf(at), __expf(ae - at)}; *(GAS f32x4*)(rp + 4) = (f32x4){__expf(ae), 0.f, 0.f, 0.f};
        } else {
            const int q = it - N_ML - N_SSD, half = q & 1, c = (q >> 1) % 72, task = (q >> 1) / 72, b = task >> 3, h = (task >> 1) & 3, dir = task & 1, r16 = lane >> 2, ch0 = half * 64 + 16 * (lane & 3);
            GAS unsigned char* item = F.ws + WS_HGP + (size_t)(task * 72 + c) * HGP_ITEM;
            const GAS float* lbp = WSP(float, WS_TAB) + 2048 + l * 512 + h * 128 + ch0;
            float lb[16], cc[16], ee[16];
            u32x4 raw[2][4];
#pragma unroll
            for (int rb = 0; rb < 2; ++rb) { const GAS bf16_t* up = U + (size_t)prow(b, dir, 32 * c + rb * 16 + r16) * NU;
                raw[rb][0] = *(const GAS u32x4*)(up + U_HGF + dir * 512 + h * 128 + ch0); raw[rb][1] = *(const GAS u32x4*)(up + U_HGF + dir * 512 + h * 128 + ch0 + 8);
                raw[rb][2] = *(const GAS u32x4*)(up + U_HGQ + h * 128 + ch0); raw[rb][3] = *(const GAS u32x4*)(up + U_HGQ + h * 128 + ch0 + 8); }
#pragma unroll
            for (int j = 0; j < 16; ++j) { lb[j] = lbp[j]; cc[j] = 0.f; ee[j] = 0.f; }
#pragma unroll
            for (int rb = 0; rb < 2; ++rb) {
                const int rloc = rb * 16 + r16;
                float fa[8], fb[8], qa[8], qb[8], q1[16], k1[16];
                unpk8(fa, raw[rb][0]); unpk8(fb, raw[rb][1]); unpk8(qa, raw[rb][2]); unpk8(qb, raw[rb][3]);
#pragma unroll
                for (int j = 0; j < 16; ++j) {
                    const float fr_ = j < 8 ? fa[j & 7] : fb[j & 7], qr_ = j < 8 ? qa[j & 7] : qb[j & 7];
                    const float f_ = lb[j] + (1.f - lb[j]) * __builtin_amdgcn_rcpf(1.f + __expf(-fr_)); float x_ = __logf(f_);
                    { const float o = __shfl_up(x_, 4); if (lane >= 4) x_ += o; } { const float o = __shfl_up(x_, 8); if (lane >= 8) x_ += o; }
                    { const float o = __shfl_up(x_, 16); if (lane >= 16) x_ += o; } { const float o = __shfl_up(x_, 32); if (lane >= 32) x_ += o; }
                    const float tot = __shfl(x_, 60 + (lane & 3));
                    float g_;
                    if (rb == 0) { cc[j] = tot; g_ = x_; } else { g_ = cc[j] + x_; ee[j] = cc[j] + tot; }
                    const float e1 = __expf(g_ - cc[j]);
                    q1[j] = qr_ * __builtin_amdgcn_rcpf(1.f + __expf(-qr_)) * e1; k1[j] = (1.f - f_) * __builtin_amdgcn_rcpf(e1);
                }
                float t8[8];
#pragma unroll
                for (int j = 0; j < 8; ++j) t8[j] = q1[j]; st8bf((GAS bf16_t*)(item + scn::rowl(rloc, ch0 * 2)), t8);
#pragma unroll
                for (int j = 0; j < 8; ++j) t8[j] = q1[8 + j]; st8bf((GAS bf16_t*)(item + scn::rowl(rloc, ch0 * 2 + 16)), t8);
#pragma unroll
                for (int j = 0; j < 8; ++j) t8[j] = k1[j]; st8bf((GAS bf16_t*)(item + 8192 + scn::rowl(rloc, ch0 * 2)), t8);
#pragma unroll
                for (int j = 0; j < 8; ++j) t8[j] = k1[8 + j]; st8bf((GAS bf16_t*)(item + 8192 + scn::rowl(rloc, ch0 * 2 + 16)), t8);
            }
            if (r16 == 0) { GAS float* vv = (GAS float*)(item + 16384) + ch0;
#pragma unroll
                for (int j = 0; j < 16; ++j) { vv[j] = __expf(cc[j]); vv[128 + j] = __expf(ee[j] - cc[j]); } }
        }
    }
}
constexpr size_t CTL_CNTB = 131072;
__device__ __forceinline__ void phase_route(Frame& F, int l, int mrows, const XcdBarrier& bar) {
    unsigned* cnt = F.ctl + CW_CNT + l * 64;
    GAS int* list = WSP(int, WS_LIST); GAS float* wl = WSP(float, WS_WL);
    GAS int* cntb = (GAS int*)(F.ws + WS_CTL + CTL_CNTB) + (size_t)l * 1024 * 32;
    LAS int* ch = (LAS int*)F.lds;
    LAS int* off = ch + 1024;
    LAS int* part = ch + 2048;
    LAS int* base = ch + 2048 + 1024;
    const int t = F.tid, bx = F.vcu, G = F.G;
    const int rpb = (mrows + G - 1) / G, r = bx * rpb + t; const bool act = t < rpb && r < mrows;
    int ea = -1, eb = -1; float wa = 0.f, wb = 0.f;
    if (act) {
        const GAS float* lg0 = WSP(float, WS_LOG) + (size_t)r * 64;
        f32x4 lgv[9];
#pragma unroll
        for (int q = 0; q < 9; ++q) { lgv[q] = *(const GAS f32x4*)(lg0 + 4 * q);
#pragma unroll
            for (int ks = 1; ks < 4; ++ks) lgv[q] += *(const GAS f32x4*)(lg0 + (size_t)ks * MT * 64 + 4 * q); }
        const f32x4 g = lgv[0]; int gi = 0; float gm = g[0];
#pragma unroll
        for (int i = 1; i < 4; ++i) if (g[i] > gm) { gm = g[i]; gi = i; }
        float gs = 0.f;
#pragma unroll
        for (int i = 0; i < 4; ++i) gs += __expf(g[i] - gm);
        const float gp = 1.f / gs;
        f32x4 e0 = lgv[1], e1 = lgv[2];
        if (gi == 1) { e0 = lgv[3]; e1 = lgv[4]; } else if (gi == 2) { e0 = lgv[5]; e1 = lgv[6]; } else if (gi == 3) { e0 = lgv[7]; e1 = lgv[8]; }
        float ev[8] = {e0[0], e0[1], e0[2], e0[3], e1[0], e1[1], e1[2], e1[3]};
        int i1 = 0; float v1 = ev[0];
#pragma unroll
        for (int i = 1; i < 8; ++i) if (ev[i] > v1) { v1 = ev[i]; i1 = i; }
        int i2 = -1; float v2 = -3.4e38f;
#pragma unroll
        for (int i = 0; i < 8; ++i) if (i != i1 && ev[i] > v2) { v2 = ev[i]; i2 = i; }
        const float w1 = 1.f / (1.f + __expf(v2 - v1)), w2 = 1.f - w1;
        ea = gi * 8 + i1; eb = gi * 8 + i2; wa = w1 * gp; wb = w2 * gp;
    }
    ch[2 * t] = ea; ch[2 * t + 1] = eb;
    __syncthreads();
    if (t < 32) {
        int c = 0; const int n2 = 2 * (rpb < 512 ? rpb : 512);
#pragma unroll 8
        for (int i = 0; i < n2; ++i) { if (ch[i] == t) { off[i] = c; ++c; } }
        cntb[bx * 32 + t] = c;
    }
    xcd_barrier(bar);
    { const int e = t & 31, p = t >> 5; int sp = 0, sa = 0;
      for (int b2 = p; b2 < G; b2 += 16) { const int c = cntb[b2 * 32 + e]; sa += c; sp += b2 < bx ? c : 0; }
      part[p * 32 + e] = sp; part[512 + p * 32 + e] = sa; }
    __syncthreads();
    if (t < 32) { int sp = 0, sa = 0;
#pragma unroll
        for (int p = 0; p < 16; ++p) { sp += part[p * 32 + t]; sa += part[512 + p * 32 + t]; }
        base[t] = sp; if (bx == 0) cnt[t] = (unsigned)sa; }
    __syncthreads();
    if (act) { const int pa = base[ea] + off[2 * t], pb = base[eb] + off[2 * t + 1];
        list[(size_t)ea * MT + pa] = r * 2; wl[(size_t)ea * MT + pa] = wa;
        list[(size_t)eb * MT + pb] = r * 2 + 1; wl[(size_t)eb * MT + pb] = wb; }
    __syncthreads();
}
__device__ __forceinline__ void moe_tables(Frame& F, int l) {
    __syncthreads();
    if (F.tid < 32) F.MISC[64 + F.tid] = __hip_atomic_load(F.ctl + CW_CNT + l * 64 + F.tid, __ATOMIC_RELAXED, __HIP_MEMORY_SCOPE_AGENT);
    __syncthreads();
    if (F.tid == 0) { int s = 0; for (int e = 0; e < 32; ++e) { F.MISC[16 + e] = s; s += ((int)F.MISC[64 + e] + 255) >> 8; } F.MISC[48] = s; }
    __syncthreads();
}

constexpr int NSTEP = CTXL + SEQ;
namespace scn {
enum { K_ML = 0, K_HG = 1, K_SSD = 2 };
constexpr int GRP_BYTES = 65536, O_QT = 0, O_KT = 8192, O_QH = 16384, O_KH = 24576, O_VT = 34816, O_VH = 45056, O_SC = 55296, O_N = 59392, O_TOT = 60416;
constexpr int NCH = (CTXL + SEQ) / 32;
__device__ __forceinline__ int crow(int r, int hi) { return (r & 3) + 8 * (r >> 2) + 4 * hi; }
template <int OFF> __device__ __forceinline__ s16x4 trr(int base) { s16x4 r; asm volatile("ds_read_b64_tr_b16 %0, %1 offset:%2" : "=&v"(r) : "v"(base), "i"(OFF) : "memory"); return r; }
#define SCN_PK(L, H) (bf16x8){L[0], L[1], L[2], L[3], H[0], H[1], H[2], H[3]}
template <int S1, int CB> __device__ __forceinline__ bf16x8 trfrag(int base) { const s16x4 lo = trr<S1 * 5120 + CB * 2>(base), hi_ = trr<S1 * 5120 + 2560 + CB * 2>(base); return SCN_PK(lo, hi_); }
__device__ __forceinline__ void unpack8(float (&o)[8], u32x4 w) { o[0] = bflo(w.x); o[1] = bfhi(w.x); o[2] = bflo(w.y); o[3] = bfhi(w.y); o[4] = bflo(w.z); o[5] = bfhi(w.z); o[6] = bflo(w.w); o[7] = bfhi(w.w); }
__device__ __forceinline__ u32x4 pack8(const float (&v)[8]) { u32x4 w; w.x = cvt_pk_bf16(v[0], v[1]); w.y = cvt_pk_bf16(v[2], v[3]); w.z = cvt_pk_bf16(v[4], v[5]); w.w = cvt_pk_bf16(v[6], v[7]); return w; }

template <int KIND>
__device__ __forceinline__ void scan_block(Frame& F, int l, int task) {
    const int tid = F.tid, wave = F.wave, lane = tid & 63, grp = wave >> 2, vb = wave & 3, gt = tid & 255, r32 = lane & 31, hi = lane >> 5;
    LAS char* L = (LAS char*)F.lds + grp * GRP_BYTES;
    const int Lb = (int)(uintptr_t)L;
    const int b = task >> 3, hx = (task >> 1) & 3, dir = task & 1;
    const int srow = gt >> 3, sp = gt & 7;
    const GAS bf16_t* U = WSP(bf16_t, WS_RA); const GAS bf16_t* X2 = WSP(bf16_t, WS_XBC);
    GAS bf16_t* YO = WSP(bf16_t, WS_YFB) + (size_t)(KIND * 2 + dir) * MT * 512;
    LAS float* SC = (LAS float*)(L + O_SC);
    int cq = 0, ck = 0, cv = 0;
    const GAS float* recA = nullptr; const GAS float* recB = nullptr; const GAS unsigned char* hgp = nullptr; const GAS bf16_t* mlc = nullptr;
    if constexpr (KIND == K_ML) { cq = U_MLQ + hx * 128 + 16 * sp; ck = U_MLK + hx * 128 + 16 * sp; cv = U_MLV + hx * 128 + 16 * sp;
        recA = WSP(float, WS_MLS) + (size_t)task * 2304 * 8; recB = recA; mlc = WSP(bf16_t, WS_MLC) + (size_t)(b * 4 + hx) * 2304 * 384; }
    if constexpr (KIND == K_HG) { cv = U_HGI + hx * 128 + 16 * sp; hgp = F.ws + WS_HGP + (size_t)task * 72 * HGP_ITEM; }
    if constexpr (KIND == K_SSD) { const int g = hx >> 1; cq = 768 + g * 128 + 16 * sp; ck = 512 + g * 128 + 16 * sp; cv = hx * 128 + 16 * sp;
        recA = WSP(float, WS_SSDS) + (size_t)((b * 2 + dir) * 8 + 2 * hx + (sp >> 2)) * 2304 * 8;
        recB = WSP(float, WS_SSDS) + (size_t)((b * 2 + dir) * 8 + 2 * hx + hi) * 2304 * 8; }
    f32x16 S[4];
#pragma unroll
    for (int k = 0; k < 4; ++k)
#pragma unroll
        for (int r = 0; r < 16; ++r) S[k][r] = 0.f;
    if (KIND == K_ML) { LAS float* nn = (LAS float*)(L + O_N); nn[gt] = 0.f; }
    float Fs = 0.f, Bp = -INFINITY;
    const int i16 = lane & 15, g4 = lane >> 4;
    const int trb = Lb + (4 * hi + (i16 >> 2)) * 320 + (16 * (g4 & 1) + 4 * (i16 & 3)) * 2;
    struct Pre { u32x4 a0, a1, b0, b1, c0, c1; f32x4 sA, sB; float g1; }; Pre P0;
#define SCN_LOAD(P, c_) do { const int c__ = (c_); const int row_ = prow(b, dir, 32 * c__ + srow); \
        if constexpr (KIND == K_SSD) { const GAS bf16_t* xp = X2 + (size_t)row_ * 1024; P.a0 = *(const GAS u32x4*)(xp + cq); P.a1 = *(const GAS u32x4*)(xp + cq + 8); P.b0 = *(const GAS u32x4*)(xp + ck); P.b1 = *(const GAS u32x4*)(xp + ck + 8); P.c0 = *(const GAS u32x4*)(xp + cv); P.c1 = *(const GAS u32x4*)(xp + cv + 8); \
            P.sA = *(const GAS f32x4*)(recA + (size_t)(32 * c__ + srow) * 8); P.sB = *(const GAS f32x4*)(recB + (size_t)(32 * c__ + r32) * 8); P.g1 = recB[(size_t)(32 * c__ + r32) * 8 + 4]; } \
        else if constexpr (KIND == K_ML) { const int p__ = 32 * c__ + srow; const int ci_ = p__ < CTXL ? (dir ? CTXL - 1 - p__ : p__) : CTXL + (dir ? SEQ - 1 - (p__ - CTXL) : p__ - CTXL); \
            const GAS bf16_t* up = mlc + (size_t)ci_ * 384 + 16 * sp; P.a0 = *(const GAS u32x4*)(up); P.a1 = *(const GAS u32x4*)(up + 8); P.b0 = *(const GAS u32x4*)(up + 128); P.b1 = *(const GAS u32x4*)(up + 136); P.c0 = *(const GAS u32x4*)(up + 256); P.c1 = *(const GAS u32x4*)(up + 264); \
            P.sA = *(const GAS f32x4*)(recA + (size_t)(32 * c__ + srow) * 8); P.sB = *(const GAS f32x4*)(recB + (size_t)(32 * c__ + r32) * 8); } \
        else { const GAS unsigned char* it_ = hgp + (size_t)c__ * HGP_ITEM; const int ra_ = rowl(srow, 32 * sp), rb_ = rowl(srow, 32 * sp + 16); \
            P.a0 = *(const GAS u32x4*)(it_ + ra_); P.a1 = *(const GAS u32x4*)(it_ + rb_); P.b0 = *(const GAS u32x4*)(it_ + 8192 + ra_); P.b1 = *(const GAS u32x4*)(it_ + 8192 + rb_); \
            const GAS bf16_t* up = U + (size_t)row_ * NU; P.c0 = *(const GAS u32x4*)(up + cv); P.c1 = *(const GAS u32x4*)(up + cv + 8); \
            if (gt < 64) P.sA = *(const GAS f32x4*)((const GAS float*)(it_ + 16384) + 4 * gt); } } while (0)
#define SCN_STAGE(P, NPAR) do { \
        const int ra = rowl(srow, 32 * sp), rb = rowl(srow, 32 * sp + 16), ta = srow * 320 + 32 * sp; \
        *(LAS u32x4*)(L + O_QT + ra) = P.a0; *(LAS u32x4*)(L + O_QT + rb) = P.a1; *(LAS u32x4*)(L + O_KT + ra) = P.b0; *(LAS u32x4*)(L + O_KT + rb) = P.b1; \
        if constexpr (KIND == K_ML) { \
            const float Fle = __shfl(P.sB[0], 31, 32), Mle = __shfl(P.sB[2], 31, 32);         \
            const float bt = P.sB[1] - Fs, Bt = fmaxf(Bp, P.sB[2] - Fs), Be = fmaxf(Bp, Mle - Fs); \
            if (vb == 0 && hi == 0) { SC[r32] = bt; SC[32 + r32] = Bt; SC[64 + r32] = __expf(Bp - Bt); SC[96 + r32] = __expf(-(Fs + P.sB[0] + Bt)); if (r32 == 0) SC[128] = __expf(Bp - Be); } \
            const float win = __expf(P.sA[1] - Fs - Be); Fs += Fle; Bp = Be; \
            { LAS const float* nq = (LAS const float*)(L + O_N) + (NPAR) * 128 + 16 * sp;        \
              const f32x4 n0 = *(const LAS f32x4*)(nq), n1 = *(const LAS f32x4*)(nq + 4), n2 = *(const LAS f32x4*)(nq + 8), n3 = *(const LAS f32x4*)(nq + 12); \
              float qa[8], qb[8]; unpack8(qa, P.a0); unpack8(qb, P.a1); \
              float d = ((qa[0] * n0[0] + qa[1] * n0[1]) + (qa[2] * n0[2] + qa[3] * n0[3])) + ((qa[4] * n1[0] + qa[5] * n1[1]) + (qa[6] * n1[2] + qa[7] * n1[3])) \
                      + ((qb[0] * n2[0] + qb[1] * n2[1]) + (qb[2] * n2[2] + qb[3] * n2[3])) + ((qb[4] * n3[0] + qb[5] * n3[1]) + (qb[6] * n3[2] + qb[7] * n3[3])); \
              d += __shfl_xor(d, 1); d += __shfl_xor(d, 2); d += __shfl_xor(d, 4); \
              if (sp == 0) SC[160 + srow] = d; } \
            float ka[8], kb_[8]; unpack8(ka, P.b0); unpack8(kb_, P.b1); \
            _Pragma("unroll") for (int j = 0; j < 8; ++j) { ka[j] *= win; kb_[j] *= win; } \
            *(LAS u32x4*)(L + O_KH + ta) = pack8(ka); *(LAS u32x4*)(L + O_KH + ta + 16) = pack8(kb_); *(LAS u32x4*)(L + O_VT + ta) = P.c0; *(LAS u32x4*)(L + O_VT + ta + 16) = P.c1; \
        } else if constexpr (KIND == K_SSD) { \
            if (vb == 0) { SC[hi * 32 + r32] = P.sB[1]; SC[64 + hi * 32 + r32] = P.sB[2]; if (r32 == 0) SC[128 + hi] = P.g1; } \
            const float dts = P.sA[0], vsc = P.sA[3]; float va[8], vb_[8]; unpack8(va, P.c0); unpack8(vb_, P.c1); \
            *(LAS u32x4*)(L + O_KH + ta) = P.b0; *(LAS u32x4*)(L + O_KH + ta + 16) = P.b1; \
            _Pragma("unroll") for (int j = 0; j < 8; ++j) { va[j] *= dts; vb_[j] *= dts; } \
            *(LAS u32x4*)(L + O_VT + ta) = pack8(va); *(LAS u32x4*)(L + O_VT + ta + 16) = pack8(vb_); \
            _Pragma("unroll") for (int j = 0; j < 8; ++j) { va[j] *= vsc; vb_[j] *= vsc; } \
            *(LAS u32x4*)(L + O_VH + ta) = pack8(va); *(LAS u32x4*)(L + O_VH + ta + 16) = pack8(vb_); \
        } else { \
            *(LAS u32x4*)(L + O_KH + ta) = P.b0; *(LAS u32x4*)(L + O_KH + ta + 16) = P.b1; *(LAS u32x4*)(L + O_VT + ta) = P.c0; *(LAS u32x4*)(L + O_VT + ta + 16) = P.c1; \
            if (gt < 64) *(LAS f32x4*)(SC + 4 * gt) = P.sA; \
        } } while (0)
    constexpr int OQH = O_QT, OVH = (KIND == K_SSD) ? O_VH : O_VT;
    auto compute = [&](const int c) __attribute__((always_inline)) {
        const int hh = vb >> 1;
        if constexpr (KIND == K_HG) {
#pragma unroll
            for (int kb = 0; kb < 4; ++kb)
#pragma unroll
                for (int r = 0; r < 16; ++r) S[kb][r] *= SC[32 * kb + crow(r, hi)];
        }
        f32x16 acc;
#pragma unroll
        for (int r = 0; r < 16; ++r) acc[r] = 0.f;
        if (c > 0) {
#pragma unroll
            for (int kb = 0; kb < 4; ++kb)
#pragma unroll
                for (int s1 = 0; s1 < 2; ++s1) {
                    u32x4 aw; aw.x = cvt_pk_bf16(S[kb][8 * s1 + 0], S[kb][8 * s1 + 1]); aw.y = cvt_pk_bf16(S[kb][8 * s1 + 2], S[kb][8 * s1 + 3]); aw.z = cvt_pk_bf16(S[kb][8 * s1 + 4], S[kb][8 * s1 + 5]); aw.w = cvt_pk_bf16(S[kb][8 * s1 + 6], S[kb][8 * s1 + 7]);
                    const int cb0 = (32 * kb + 16 * s1 + 4 * hi) * 2;
                    const u32x2 lo = *(const LAS u32x2*)(L + OQH + rowl(r32, cb0)), hi2 = *(const LAS u32x2*)(L + OQH + rowl(r32, cb0 + 16));
                    const u32x4 bw = {lo.x, lo.y, hi2.x, hi2.y};
                    acc = __builtin_amdgcn_mfma_f32_32x32x16_bf16(__builtin_bit_cast(bf16x8, aw), __builtin_bit_cast(bf16x8, bw), acc, 0, 0, 0);
                }
            if constexpr (KIND == K_ML) { const float w = SC[64 + r32];
#pragma unroll
                for (int r = 0; r < 16; ++r) acc[r] *= w; }
            if constexpr (KIND == K_SSD) { const float w = SC[64 + hh * 32 + r32];
#pragma unroll
                for (int r = 0; r < 16; ++r) acc[r] *= w; }
        }
        f32x16 p;
#pragma unroll
        for (int r = 0; r < 16; ++r) p[r] = 0.f;
#pragma unroll
        for (int kk = 0; kk < 8; ++kk) { const int cb0 = (16 * kk + 8 * hi) * 2;
            const bf16x8 a = *(const LAS bf16x8*)(L + O_KT + rowl(r32, cb0)), bq = *(const LAS bf16x8*)(L + O_QT + rowl(r32, cb0));
            p = __builtin_amdgcn_mfma_f32_32x32x16_bf16(a, bq, p, 0, 0, 0); }
        float den = 0.f;
        if constexpr (KIND == K_ML) { const float Bt = SC[32 + r32];
            f32x4 bs4[4];
#pragma unroll
            for (int q = 0; q < 4; ++q) bs4[q] = *(const LAS f32x4*)(SC + 8 * q + 4 * hi);
#pragma unroll
            for (int r = 0; r < 16; ++r) { const int s_ = crow(r, hi); float w = __expf(fminf(bs4[r >> 2][r & 3] - Bt, 0.f)); w = s_ <= r32 ? w : 0.f; p[r] *= w; den += p[r]; }
            { auto rr = __builtin_amdgcn_permlane32_swap(__float_as_uint(den), __float_as_uint(den), false, false); den = __uint_as_float(rr[0]) + __uint_as_float(rr[1]); }
        } else if constexpr (KIND == K_SSD) { const float at = SC[hh * 32 + r32];
            f32x4 as_[4];
#pragma unroll
            for (int q = 0; q < 4; ++q) as_[q] = *(const LAS f32x4*)(SC + hh * 32 + 8 * q + 4 * hi);
#pragma unroll
            for (int r = 0; r < 16; ++r) { const int s_ = crow(r, hi); float w = __expf(fminf(at - as_[r >> 2][r & 3], 0.f)); p[r] *= s_ <= r32 ? w : 0.f; }
        } else {
#pragma unroll
            for (int r = 0; r < 16; ++r) { if (crow(r, hi) > r32) p[r] = 0.f; }
        }
        {
            u32x4 w0, w1; w0.x = cvt_pk_bf16(p[0], p[1]); w0.y = cvt_pk_bf16(p[2], p[3]); w0.z = cvt_pk_bf16(p[4], p[5]); w0.w = cvt_pk_bf16(p[6], p[7]);
            w1.x = cvt_pk_bf16(p[8], p[9]); w1.y = cvt_pk_bf16(p[10], p[11]); w1.z = cvt_pk_bf16(p[12], p[13]); w1.w = cvt_pk_bf16(p[14], p[15]);
            const int vbase = trb + O_VT + vb * 64;
            const bf16x8 v0 = trfrag<0, 0>(vbase), v1 = trfrag<1, 0>(vbase);
            asm volatile("s_waitcnt lgkmcnt(0)" ::: "memory"); __builtin_amdgcn_sched_barrier(0);
            acc = __builtin_amdgcn_mfma_f32_32x32x16_bf16(v0, __builtin_bit_cast(bf16x8, w0), acc, 0, 0, 0);
            acc = __builtin_amdgcn_mfma_f32_32x32x16_bf16(v1, __builtin_bit_cast(bf16x8, w1), acc, 0, 0, 0);
        }
        float oscale = 1.f;
        if constexpr (KIND == K_ML) {
            LAS const float* nn = (LAS const float*)(L + O_N) + (c & 1) * 128;
            const float ds = SC[160 + r32] * SC[64 + r32];
            oscale = __builtin_amdgcn_rcpf(fmaxf(fabsf(den + ds), SC[96 + r32]));
            { const int k = 32 * vb + r32; float sm = 0.f;
#pragma unroll
              for (int s_ = 0; s_ < 16; ++s_) sm += bf2f(*(const LAS bf16_t*)(L + O_KH + (16 * hi + s_) * 320 + k * 2));
              { auto rr = __builtin_amdgcn_permlane32_swap(__float_as_uint(sm), __float_as_uint(sm), false, false); sm = __uint_as_float(rr[0]) + __uint_as_float(rr[1]); }
              LAS float* n2 = (LAS float*)(L + O_N) + ((c + 1) & 1) * 128;
              if (hi == 0) n2[k] = SC[128] * nn[k] + sm; }
        }
        { const int orow = prow(b, dir, 32 * c + r32); GAS bf16_t* yp = YO + (size_t)orow * 512 + hx * 128 + 32 * vb + 4 * hi;
#pragma unroll
          for (int q = 0; q < 4; ++q) { u32x2 w; w.x = cvt_pk_bf16(acc[4 * q] * oscale, acc[4 * q + 1] * oscale); w.y = cvt_pk_bf16(acc[4 * q + 2] * oscale, acc[4 * q + 3] * oscale); *(GAS u32x2*)(yp + 8 * q) = w; } }
        {
            const int kbase = trb + O_KH, vbase = trb + OVH + vb * 64;
            const bf16x8 vh0 = trfrag<0, 0>(vbase), vh1 = trfrag<1, 0>(vbase);
            const bf16x8 k00 = trfrag<0, 0>(kbase), k01 = trfrag<1, 0>(kbase), k10 = trfrag<0, 32>(kbase), k11 = trfrag<1, 32>(kbase);
            const bf16x8 k20 = trfrag<0, 64>(kbase), k21 = trfrag<1, 64>(kbase), k30 = trfrag<0, 96>(kbase), k31 = trfrag<1, 96>(kbase);
            if constexpr (KIND != K_HG) { const float rd = KIND == K_ML ? SC[128] : SC[128 + hh];
#pragma unroll
                for (int kb = 0; kb < 4; ++kb)
#pragma unroll
                    for (int r = 0; r < 16; ++r) S[kb][r] *= rd; }
            asm volatile("s_waitcnt lgkmcnt(0)" ::: "memory"); __builtin_amdgcn_sched_barrier(0);
            S[0] = __builtin_amdgcn_mfma_f32_32x32x16_bf16(k00, vh0, S[0], 0, 0, 0); S[0] = __builtin_amdgcn_mfma_f32_32x32x16_bf16(k01, vh1, S[0], 0, 0, 0);
            S[1] = __builtin_amdgcn_mfma_f32_32x32x16_bf16(k10, vh0, S[1], 0, 0, 0); S[1] = __builtin_amdgcn_mfma_f32_32x32x16_bf16(k11, vh1, S[1], 0, 0, 0);
            S[2] = __builtin_amdgcn_mfma_f32_32x32x16_bf16(k20, vh0, S[2], 0, 0, 0); S[2] = __builtin_amdgcn_mfma_f32_32x32x16_bf16(k21, vh1, S[2], 0, 0, 0);
            S[3] = __builtin_amdgcn_mfma_f32_32x32x16_bf16(k30, vh0, S[3], 0, 0, 0); S[3] = __builtin_amdgcn_mfma_f32_32x32x16_bf16(k31, vh1, S[3], 0, 0, 0);
            if constexpr (KIND == K_HG) {
#pragma unroll
                for (int kb = 0; kb < 4; ++kb)
#pragma unroll
                    for (int r = 0; r < 16; ++r) S[kb][r] *= SC[128 + 32 * kb + crow(r, hi)];
            }
        }
    };
    {
        SCN_LOAD(P0, 0);
        __syncthreads();
        SCN_STAGE(P0, 0);
        __syncthreads();
        for (int c = 0; c < NCH; ++c) {
            if (c + 1 < NCH) SCN_LOAD(P0, c + 1);
            compute(c);
            __syncthreads();
            if (c + 1 < NCH) { SCN_STAGE(P0, (c + 1) & 1); }
            __syncthreads();
        }
    }
#undef SCN_LOAD
#undef SCN_STAGE
}
}

namespace att {
constexpr int KVBLK = 64, SHM_V = 64 * 128 * 2, SHM_K = 64 * 192 * 2;
constexpr float THRL = 11.5f;
#define AKSWZ(row, colB) ((row) * 384 + ((colB) ^ (((row) & 7) << 4)))
#define ASBAR() __builtin_amdgcn_sched_barrier(0)
__device__ __forceinline__ int crow(int r, int hi) { return (r & 3) + 8 * (r >> 2) + 4 * hi; }
__device__ __forceinline__ void partialSM(f32x16& p0, f32x16& p1, float& m_reg, float& mn, float& alpha) {
    float pmax = p0[0];
#pragma unroll
    for (int r = 1; r < 16; ++r) pmax = fmaxf(pmax, p0[r]);
#pragma unroll
    for (int r = 0; r < 16; ++r) pmax = fmaxf(pmax, p1[r]);
    { auto rr = __builtin_amdgcn_permlane32_swap(__float_as_uint(pmax), __float_as_uint(pmax), false, false); pmax = fmaxf(__uint_as_float(rr[0]), __uint_as_float(rr[1])); }
    if (__builtin_expect(__all(pmax - m_reg <= THRL), 1)) { mn = m_reg; alpha = 1.f; }
    else { mn = fmaxf(m_reg, pmax); alpha = __builtin_amdgcn_exp2f(m_reg - mn); m_reg = mn; }
#pragma unroll
    for (int r = 0; r < 16; ++r) p0[r] = __builtin_amdgcn_exp2f(p0[r] - mn);
#pragma unroll
    for (int r = 0; r < 16; ++r) p1[r] = p1[r] - mn;
}
__device__ __forceinline__ void finishSM(f32x16& p0, f32x16& p1, float alpha, float& l_reg, bf16x8& pa0, bf16x8& pa1, bf16x8& pa2, bf16x8& pa3) {
#pragma unroll
    for (int r = 0; r < 16; ++r) p1[r] = __builtin_amdgcn_exp2f(p1[r]);
    float ps = 0;
#pragma unroll
    for (int r = 0; r < 16; ++r) ps += p0[r];
#pragma unroll
    for (int r = 0; r < 16; ++r) ps += p1[r];
    { auto rr = __builtin_amdgcn_permlane32_swap(__float_as_uint(ps), __float_as_uint(ps), false, false); ps = __uint_as_float(rr[0]) + __uint_as_float(rr[1]); }
    l_reg = l_reg * alpha + ps;
#define APK4(P, BASE, OUT) do { unsigned a0 = cvt_pk_bf16(P[BASE + 0], P[BASE + 1]), a1 = cvt_pk_bf16(P[BASE + 2], P[BASE + 3]);   \
    unsigned b0 = cvt_pk_bf16(P[BASE + 4], P[BASE + 5]), b1 = cvt_pk_bf16(P[BASE + 6], P[BASE + 7]);                              \
    auto r0 = __builtin_amdgcn_permlane32_swap(a0, b0, false, false); auto r1 = __builtin_amdgcn_permlane32_swap(a1, b1, false, false); \
    u32x4 w = {r0[0], r1[0], r0[1], r1[1]}; OUT = __builtin_bit_cast(bf16x8, w); } while (0)
    APK4(p0, 0, pa0); APK4(p0, 8, pa1); APK4(p1, 0, pa2); APK4(p1, 8, pa3);
#undef APK4
}
__device__ __forceinline__ void qkt(f32x16& p0, f32x16& p1, const LAS char* Ks, const bf16x8* qr, int r32, int hi) {
    p0 = f32x16{}; p1 = f32x16{};
#pragma unroll
    for (int d0 = 0; d0 < 12; ++d0) { const int cb = (d0 * 16 + hi * 8) * 2;
        const bf16x8 b0 = *(const LAS bf16x8*)(Ks + AKSWZ(r32, cb));
        const bf16x8 b1 = *(const LAS bf16x8*)(Ks + AKSWZ(32 + r32, cb));
        p0 = __builtin_amdgcn_mfma_f32_32x32x16_bf16(b0, qr[d0], p0, 0, 0, 0);
        p1 = __builtin_amdgcn_mfma_f32_32x32x16_bf16(b1, qr[d0], p1, 0, 0, 0); }
}
__device__ __forceinline__ int v_st(int k, int c) { const int kk = (k & ~0xC) | ((k & 4) << 1) | ((k & 8) >> 1); return ((kk >> 3) * 4 + (c >> 5)) * 512 + ((kk & 7) * 32 + (c & 31)) * 2; }
__device__ __forceinline__ int v_rd_base(int lane) { return ((lane & 3) << 3) | (((lane >> 2) & 3) << 6) | (((lane >> 4) & 1) << 5) | (((lane >> 5) & 1) << 8); }
constexpr int v_rd_off(int d0, int ks, int half) { return d0 * 512 + ks * 4096 + half * 2048; }
template <int OFF> __device__ __forceinline__ s16x4 tr_read(int vb) { s16x4 r; asm volatile("ds_read_b64_tr_b16 %0, %1 offset:%2" : "=&v"(r) : "v"(vb), "i"(OFF) : "memory"); return r; }
template <int D0> __device__ __forceinline__ void pv_one(f32x16& od, int vb, bf16x8 pa0, bf16x8 pa1, bf16x8 pa2, bf16x8 pa3) {
    const s16x4 l0 = tr_read<v_rd_off(D0, 0, 0)>(vb), h0 = tr_read<v_rd_off(D0, 0, 1)>(vb), l1 = tr_read<v_rd_off(D0, 1, 0)>(vb), h1 = tr_read<v_rd_off(D0, 1, 1)>(vb);
    const s16x4 l2 = tr_read<v_rd_off(D0, 2, 0)>(vb), h2 = tr_read<v_rd_off(D0, 2, 1)>(vb), l3 = tr_read<v_rd_off(D0, 3, 0)>(vb), h3 = tr_read<v_rd_off(D0, 3, 1)>(vb);
    asm volatile("s_waitcnt lgkmcnt(0)" ::: "memory"); ASBAR();
#define APK(L, H) (bf16x8){L[0], L[1], L[2], L[3], H[0], H[1], H[2], H[3]}
    od = __builtin_amdgcn_mfma_f32_32x32x16_bf16(pa0, APK(l0, h0), od, 0, 0, 0);
    od = __builtin_amdgcn_mfma_f32_32x32x16_bf16(pa1, APK(l1, h1), od, 0, 0, 0);
    od = __builtin_amdgcn_mfma_f32_32x32x16_bf16(pa2, APK(l2, h2), od, 0, 0, 0);
    od = __builtin_amdgcn_mfma_f32_32x32x16_bf16(pa3, APK(l3, h3), od, 0, 0, 0);
#undef APK
}
__device__ __forceinline__ void pv_d0(f32x16* o, int vb, bf16x8 pa0, bf16x8 pa1, bf16x8 pa2, bf16x8 pa3) {
    pv_one<0>(o[0], vb, pa0, pa1, pa2, pa3); pv_one<1>(o[1], vb, pa0, pa1, pa2, pa3); pv_one<2>(o[2], vb, pa0, pa1, pa2, pa3); pv_one<3>(o[3], vb, pa0, pa1, pa2, pa3);
}
__device__ __forceinline__ void attn_unit(const GAS bf16_t* __restrict__ QB, const GAS bf16_t* __restrict__ KVB, const GAS bf16_t* __restrict__ U, GAS unsigned char* __restrict__ BR,
                                          int qrow0, int h, int kctx0, int klat0, int nct, int NT, LAS char* lds) {
    const int tid = opaque_tid(), wid = tid >> 6, lane = tid & 63, r32 = lane & 31, hi = lane >> 5;
    LAS char* V_lds = lds; LAS char* K_lds = lds + 2 * SHM_V;
    LAS float* ws = (LAS float*)(lds + 2 * SHM_V + 2 * SHM_K) + wid * 64; LAS float* li_l = ws; LAS float* al_l = ws + 32;
    float m_reg = -1e30f, l_reg = 0; f32x16 o[4] = {}; bf16x8 qr[12];
    const GAS bf16_t* Qw = QB + (size_t)(qrow0 + wid * 32 + r32) * 768;
#pragma unroll
    for (int d0 = 0; d0 < 8; ++d0) qr[d0] = *(const GAS bf16x8*)(Qw + h * 128 + d0 * 16 + hi * 8);
#pragma unroll
    for (int d0 = 8; d0 < 12; ++d0) qr[d0] = *(const GAS bf16x8*)(Qw + 512 + h * 64 + (d0 - 8) * 16 + hi * 8);
    const int sr = tid >> 4, sc = (tid & 15) * 8, vst0 = v_st(sr, sc), vst1 = v_st(32 + sr, sc), rr_ = tid >> 3, rc_ = (tid & 7) * 8;
    const int vb0 = (int)(uintptr_t)V_lds + v_rd_base(lane);
    struct { bf16x8 vs0, vs1, ks0, ks1, kr; } sr_[1];
#define ASLOAD(i, j_) do { const int j__ = (j_); const int k0 = j__ < nct ? kctx0 + 64 * j__ : klat0 + 64 * (j__ - nct); \
    sr_[i].vs0 = *(const GAS bf16x8*)(KVB + (size_t)(k0 + sr) * 1024 + 512 + h * 128 + sc); sr_[i].vs1 = *(const GAS bf16x8*)(KVB + (size_t)(k0 + 32 + sr) * 1024 + 512 + h * 128 + sc); \
    sr_[i].ks0 = *(const GAS bf16x8*)(KVB + (size_t)(k0 + sr) * 1024 + h * 128 + sc); sr_[i].ks1 = *(const GAS bf16x8*)(KVB + (size_t)(k0 + 32 + sr) * 1024 + h * 128 + sc); \
    sr_[i].kr = *(const GAS bf16x8*)(U + (size_t)(k0 + rr_) * NU + U_KR + rc_); } while (0)
#define ASWRITE(b, i) do { *(LAS bf16x8*)(V_lds + (b) * SHM_V + vst0) = sr_[i].vs0; *(LAS bf16x8*)(V_lds + (b) * SHM_V + vst1) = sr_[i].vs1; \
    *(LAS bf16x8*)(K_lds + (b) * SHM_K + AKSWZ(sr, sc * 2)) = sr_[i].ks0; *(LAS bf16x8*)(K_lds + (b) * SHM_K + AKSWZ(32 + sr, sc * 2)) = sr_[i].ks1; \
    *(LAS bf16x8*)(K_lds + (b) * SHM_K + AKSWZ(rr_, 256 + rc_ * 2)) = sr_[i].kr; } while (0)
#define ASWAIT() asm volatile("s_waitcnt vmcnt(0)" ::: "memory")
#define ARESC(a) do { if (__any((a) < 1.f)) { if (hi == 0) al_l[r32] = (a); asm volatile("s_waitcnt lgkmcnt(0)" ::: "memory"); \
    _Pragma("unroll") for (int d = 0; d < 4; ++d) _Pragma("unroll") for (int r = 0; r < 16; ++r) o[d][r] *= al_l[crow(r, hi)]; } } while (0)
    f32x16 pA0, pA1; float mnA, alA; bf16x8 pa0, pa1, pa2, pa3;
    ASLOAD(0, 0); asm volatile("s_waitcnt vmcnt(0)" ::: "memory"); ASWRITE(0, 0); __syncthreads();
    for (int j = 0; j < NT; ++j) {
        const int bsel = j & 1;
        if (j + 1 < NT) ASLOAD(0, j + 1);
        ASBAR(); qkt(pA0, pA1, K_lds + bsel * SHM_K, qr, r32, hi);
        partialSM(pA0, pA1, m_reg, mnA, alA);
        ARESC(alA);
        finishSM(pA0, pA1, alA, l_reg, pa0, pa1, pa2, pa3); ASBAR();
        pv_d0(o, vb0 + bsel * SHM_V, pa0, pa1, pa2, pa3);
        if (j + 1 < NT) { ASWAIT(); ASWRITE(bsel ^ 1, 0); }
        __syncthreads();
    }
    if (hi == 0) li_l[r32] = l_reg; asm volatile("s_waitcnt lgkmcnt(0)" ::: "memory");
    GAS unsigned char* Ow = BR + (size_t)(qrow0 + wid * 32) * DM + 1024 + h * 128;
#pragma unroll
    for (int r = 0; r < 16; ++r) { const int orow = crow(r, hi); const float rl = __builtin_amdgcn_rcpf(li_l[orow]);
#pragma unroll
        for (int d0 = 0; d0 < 4; ++d0) { const float v = __builtin_amdgcn_fmed3f(o[d0][r] * rl, -448.f, 448.f); Ow[(size_t)orow * DM + d0 * 32 + r32] = (unsigned char)(__builtin_amdgcn_cvt_pk_fp8_f32(v, 0.f, 0u, false) & 0xffu); } }
    __syncthreads();
#undef ASLOAD
#undef ASWRITE
#undef ASWAIT
#undef ARESC
}
}

constexpr int PH_PER_LAYER = 13, NPHASE = 2 + DEPTH * PH_PER_LAYER;
struct Args { const float* in[N_IN]; float* out; unsigned char* ws; int ph_lo, ph_hi; };
static_assert(sizeof(Args) == N_IN * 8 + 8 + 8 + 8, "Args has no padding");

#ifndef REP_G1
#define REP_G1 1
#endif
#ifndef REP_G2
#define REP_G2 1
#endif
#ifndef REP_G5
#define REP_G5 1
#endif
#ifndef REP_G6
#define REP_G6 1
#endif
#ifndef REP_G8
#define REP_G8 1
#endif
#ifndef REP_G10
#define REP_G10 1
#endif
#ifndef REP_G11
#define REP_G11 1
#endif
#ifndef REP_R4
#define REP_R4 1
#endif
#ifndef PH_MASK
#define PH_MASK 0xffffffffu
#endif
#define IN(k) (lo <= (k) && (k) < hi)
#define EN(j) ((PH_MASK >> (j)) & 1u)
#ifndef SUBMASK
#define SUBMASK 7
#endif
#define REFRESH() do { F.tid = opaque_tid(); F.lane = F.tid & 63; F.wave = __builtin_amdgcn_readfirstlane(F.tid >> 6); \
    F.ws = (GAS unsigned char*)opaque_ptr(args.ws); F.ctl = (unsigned*)opaque_ptr(args.ws + WS_CTL); F.out = (GAS float*)opaque_ptr(args.out); } while (0)
#ifdef PROBE_MASK
#define STAMP(k) do { if (blockIdx.x == 0 && threadIdx.x == 0) ((volatile unsigned long long*)(args.ws + WS_CTL + 65536))[16 + (k)] = __builtin_amdgcn_s_memrealtime(); } while (0)
#else
#define STAMP(k) do { } while (0)
#endif
#define SEAM(k) do { if (IN(k) && IN((k) + 1)) xcd_barrier(bar); STAMP((k) + 1); } while (0)
template <int l> __device__ __forceinline__ void layer_phases(Frame& F, const Args& args, const XcdBarrier& bar, const int lo, const int hi, char* ldsg) {
        const int pb = 2 + l * PH_PER_LAYER;
        const int mrows = (l + 1 < DEPTH) ? MT : ML;
        GAS bf16_t* const Hb = WSP(bf16_t, WS_H); GAS bf16_t* const Ub = WSP(bf16_t, WS_RA);
        if (IN(pb + 0) && EN(0) && l == 0) { REFRESH(); phase_rwA(F, l); }
        if (l == 0) SEAM(pb + 0);
        if (IN(pb + 1) && EN(1)) for (int rp_ = 0; rp_ < REP_G1; ++rp_) { REFRESH();
            EpiWin E{Ub, WSP(float, WS_SSQ), WSP(float, WS_TAB)};
            { Gemm g{WSP(bf16_t, WS_HIN), WSP(bf16_t, WS_WIN) + (size_t)l * NU * DM, DM, DM, DM};
              WinSched S; S.gs.init(MT / 256, 5, F.G, (int)blockIdx.x, (size_t)256 * DM * 2, (size_t)256 * DM * 2, 0, 0); S.mode = 1;
              pg8::gemm_phase<EpiWin, WinSched, false>(F.lds, g, S, E); }
            { Gemm g{(const GAS bf16_t*)WSP(unsigned char, WS_H8), (const GAS bf16_t*)(WSP(unsigned char, WS_WIN8) + (size_t)l * NU * DM), DM / 2, DM / 2, DM / 2};
              WinSched S; S.gs.init(MT / 256, 23, F.G, (int)((blockIdx.x + 152) & 255), (size_t)256 * DM, (size_t)256 * DM, 0, 0); S.mode = 0;
              pg8::gemm_phase<EpiWin, WinSched, false, true>(F.lds, g, S, E); }
        }
        SEAM(pb + 1);
        if (IN(pb + 2) && EN(2)) for (int rp_ = 0; rp_ < REP_G2; ++rp_) { REFRESH();
            if (SUBMASK & 1) { Gemm g{Ub, WSP(bf16_t, WS_WUQ) + (size_t)l * 768 * 512, NU, 512, 512};
              GridSched S; S.init(MT / 256, 3, F.G, (int)blockIdx.x, (size_t)256 * NU * 2, (size_t)256 * 512 * 2, (size_t)U_CQ * 2, 0);
              EpiMlaQ E{WSP(bf16_t, WS_QB), WSP(float, WS_SSQ), WSP(float, WS_TAB)};
              pg8::gemm_phase<EpiMlaQ, GridSched, false>(F.lds, g, S, E); }
            if (SUBMASK & 2) { Gemm g{Ub, WSP(bf16_t, WS_WUKV) + (size_t)l * 1024 * 256, NU, 256, 256};
              GridSched S; S.init(MT / 256, 4, F.G, (int)((blockIdx.x + 40u) % (unsigned)F.G), (size_t)256 * NU * 2, (size_t)256 * 256 * 2, (size_t)U_CKV * 2, 0);
              EpiMlaKV E{WSP(bf16_t, WS_KVB), WSP(float, WS_SSQ)};
              pg8::gemm_phase<EpiMlaKV, GridSched, false>(F.lds, g, S, E); }
            if (SUBMASK & 4) { Gemm g{(const GAS bf16_t*)WSP(unsigned char, WS_H8), (const GAS bf16_t*)(WSP(unsigned char, WS_WG) + (size_t)l * 8192 * DM), DM / 2, DM / 2, DM / 2};
              GridSched S; S.init(mrows / 256, 32, F.G, (int)blockIdx.x, (size_t)256 * DM, (size_t)256 * DM, 0, 0);
              EpiGate E{WSP(unsigned char, WS_RB)};
              pg8::gemm_phase<EpiGate, GridSched, false, true>(F.lds, g, S, E); }
            phase_ssdconv(F, l);
            phase_scanprep(F, l);
        }
        SEAM(pb + 2);
#ifndef REP_MIX
#define REP_MIX 1
#endif
        if (IN(pb + 3) && EN(3)) for (int rep_ = 0; rep_ < REP_MIX; ++rep_) { REFRESH();
            const int bx = blockIdx.x;
#ifndef REPMASK
#define REPMASK 15
#endif
#ifdef ONLYK
            const int SCANMASK = ONLYK;
#else
            const int SCANMASK = rep_ == 0 ? 15 : REPMASK;
#endif
            if (bx < 64) {
                if (__builtin_amdgcn_readfirstlane(F.wave) < 4) scn::scan_block<scn::K_ML>(F, l, bx); else scn::scan_block<scn::K_HG>(F, l, bx); }
            else if (bx < 96) { scn::scan_block<scn::K_SSD>(F, l, (bx - 64) * 2 + (F.wave >> 2)); }
            else if (SCANMASK & 8) {
                const int natt = 256 + (l + 1 < DEPTH ? 32 : 0), nab = F.G - 96;
                for (int ua = bx - 96; ua < natt; ua += nab) {
                    if (ua < 256) { const int b = ua >> 5, h = (ua >> 3) & 3, qb = ua & 7;
                        att::attn_unit(WSP(bf16_t, WS_QB), WSP(bf16_t, WS_KVB), Ub, WSP(unsigned char, WS_BR), b * SEQ + qb * 256, h, ML + b * CTXL, b * SEQ, 4, 36, (LAS char*)F.lds); }
                    else { const int uc = ua - 256, b = uc >> 2, h = uc & 3;
                        att::attn_unit(WSP(bf16_t, WS_QB), WSP(bf16_t, WS_KVB), Ub, WSP(unsigned char, WS_BR), ML + b * CTXL, h, ML + b * CTXL, 0, 4, 4, (LAS char*)F.lds); }
                }
                if (rep_ == 0) {
                    LAS float* scr = (LAS float*)(F.lds + F.wave * 16384);
                    if (l + 1 == DEPTH) { for (int it = (bx - 96) * 8 + F.wave; it < IT_MOE; it += (F.G - 96) * 8) cvt_moe_item(F, l, it, scr); }
                    else { for (int it = (bx - 96) * 8 + F.wave; it < IT_LAYER + IT_MOE / 2; it += (F.G - 96) * 8) { if (it < IT_LAYER) cvt_layer_item(F, l + 1, it, scr); else cvt_moe_item(F, l, it - IT_LAYER, scr); } }
                }
            }
        }
        SEAM(pb + 3);
        if (IN(pb + 4) && EN(4)) for (int rp_ = 0; rp_ < REP_R4; ++rp_) { REFRESH(); phase_finish(F, l, mrows); }
        SEAM(pb + 4);
        if (IN(pb + 5) && EN(5)) for (int rp_ = 0; rp_ < REP_G5; ++rp_) { REFRESH();
            Gemm g{(const GAS bf16_t*)WSP(unsigned char, WS_BR), (const GAS bf16_t*)(WSP(unsigned char, WS_WBR) + (size_t)l * 4 * DM * 512), DM / 2, 256, 256};
            MergeSched S; S.gs.init(mrows / 256, 8, F.G, (int)blockIdx.x, 0, 0, 0, 0);
            EpiMerge E{WSP(unsigned char, WS_RB), WSP(unsigned char, WS_RA + RA_ACC), F.ws + WS_RA + RA_PART + (size_t)blockIdx.x * 131072, WSP(float, WS_RSSD)};
            pg8::gemm_phase<EpiMerge, MergeSched, false, true>(F.lds, g, S, E);
            if (l == 0 && blockIdx.x >= 64) {
                LAS float* scr = (LAS float*)(F.lds + F.wave * 16384);
                for (int it = IT_MOE / 2 + ((int)blockIdx.x - 64) * 8 + F.wave; it < IT_MOE; it += 192 * 8) cvt_moe_item(F, 0, it, scr);
            }
        }
        SEAM(pb + 5);
        if (IN(pb + 6) && EN(6)) for (int rp_ = 0; rp_ < REP_G6; ++rp_) { REFRESH();
            Gemm g{(const GAS bf16_t*)WSP(unsigned char, WS_RA + RA_ACC), (const GAS bf16_t*)(WSP(unsigned char, WS_WOUT) + (size_t)l * DM * DM), DM / 2, DM / 2, DM / 2};
            GridSched S; S.init(mrows / 256, 8, F.G, (int)blockIdx.x, (size_t)256 * DM, (size_t)256 * DM, 0, 0);
            EpiBf16 E{WSP(bf16_t, WS_RB + RB_Y), DM};
            pg8::gemm_phase<EpiBf16, GridSched, false, true>(F.lds, g, S, E);
        }
        SEAM(pb + 6);
        if (IN(pb + 7) && EN(7)) { REFRESH(); phase_rwB(F, l, mrows); }
        SEAM(pb + 7);
        if (IN(pb + 8) && EN(8)) for (int rp_ = 0; rp_ < REP_G8; ++rp_) { REFRESH();
            Gemm g{Hb, WSP(bf16_t, WS_WR) + (size_t)l * 256 * DM, DM, DM, 512};
            RouterSched S{mrows / 256, F.G, (int)blockIdx.x};
            EpiRouter E{WSP(float, WS_LOG)};
            pg8::gemm_phase<EpiRouter, RouterSched, false>(F.lds, g, S, E);
        }
        SEAM(pb + 8);
        if (IN(pb + 9) && EN(9)) { REFRESH(); phase_route(F, l, mrows, bar); }
        SEAM(pb + 9);
        if (IN(pb + 10) && EN(10)) for (int rp_ = 0; rp_ < REP_G10; ++rp_) { REFRESH();
            moe_tables(F, l);
            Gemm g{(const GAS bf16_t*)WSP(unsigned char, WS_H8), (const GAS bf16_t*)WSP(unsigned char, WS_W13), DM / 2, DM / 2, DM / 2};
            MoeSched S{(const volatile LAS int*)(F.MISC + 16), (const volatile LAS int*)(F.MISC + 64), WSP(int, WS_LIST), 4, F.G, (int)blockIdx.x, 1};
            EpiMoe1 E{WSP(unsigned char, WS_RA + RA_H1)};
            pg8::gemm_phase<EpiMoe1, MoeSched, true, true>(F.lds, g, S, E);
        }
        SEAM(pb + 10);
        if (IN(pb + 11) && EN(11)) for (int rp_ = 0; rp_ < REP_G11; ++rp_) { REFRESH();
            moe_tables(F, l);
            Gemm g{(const GAS bf16_t*)WSP(unsigned char, WS_RA + RA_H1), (const GAS bf16_t*)WSP(unsigned char, WS_W2), DEXP / 2, DEXP / 2, DEXP / 2};
            MoeSched S{(const volatile LAS int*)(F.MISC + 16), (const volatile LAS int*)(F.MISC + 64), WSP(int, WS_LIST), 8, F.G, (int)blockIdx.x, 2};
            EpiMoe2 E{WSP(bf16_t, WS_RB + RB_Y2), WSP(int, WS_LIST), WSP(float, WS_WL), (const volatile LAS int*)(F.MISC + 64)};
            pg8::gemm_phase<EpiMoe2, MoeSched, false, true>(F.lds, g, S, E);
        }
        SEAM(pb + 11);
        if (IN(pb + 12) && EN(12)) { REFRESH(); phase_rwC(F, l, mrows); }
        SEAM(pb + 12);
    }

__global__ void __launch_bounds__(512, 2) fwd_kernel(Args args) {
    extern __shared__ __attribute__((aligned(16))) unsigned char lds_raw[];
    Frame F;
    F.lds = (LAS unsigned char*)lds_raw;
    F.MISC = (volatile LAS unsigned*)(F.lds + MISC_OFF);
    F.tid = threadIdx.x; F.lane = F.tid & 63; F.wave = __builtin_amdgcn_readfirstlane(F.tid >> 6);
    F.G = gridDim.x; { const int bx = blockIdx.x; F.vcu = (F.G % 8 == 0) ? (bx % 8) * (F.G / 8) + bx / 8 : bx; }
    F.ws = (GAS unsigned char*)args.ws; F.ctl = (unsigned*)(args.ws + WS_CTL); F.out = (GAS float*)args.out;
    F.inp = args.in;
    for (int u = F.tid; u < (LDS_BYTES - MISC_OFF) / 4; u += 512) F.MISC[u] = 0u;
    __syncthreads();
    const int lo = args.ph_lo, hi = args.ph_hi;
    XcdBarrier bar; bar.bar = F.ctl + CW_BAR; bar.x = 0; bar.st = nullptr;
    if (hi - lo > 1) bar = xcd_barrier_post(F.ctl + CW_BAR, F.MISC + 8);
    char* ldsg = (char*)lds_raw;

#ifndef REP_PRO
#define REP_PRO 1
#endif
    STAMP(0);
    if (IN(0) && EN(13)) for (int rep_ = 0; rep_ < REP_PRO; ++rep_) { phase_prologue(F); } SEAM(0);
    if (IN(1) && EN(14)) { phase_modfin(F); } SEAM(1);

    layer_phases<0>(F, args, bar, lo, hi, ldsg);
    layer_phases<1>(F, args, bar, lo, hi, ldsg);
#ifdef PROBE_MASK
    __syncthreads();
    if (blockIdx.x == 0 && threadIdx.x == 0) {
        STAMP(NPHASE);
        volatile unsigned long long* T = (volatile unsigned long long*)(args.ws + WS_CTL + 65536) + 16; unsigned long long acc_ = 0;
        for (int k = 0; k < NPHASE; ++k) if ((PROBE_MASK >> k) & 1ull) { const unsigned long long a_ = T[k], b_ = T[k + 1]; if (a_ && b_ > a_) acc_ += b_ - a_; }
        args.out[0] = 3.0f + (float)acc_ * 0.001f;
    }
#endif
#undef IN
#undef SEAM
}


#ifdef DUMP_OFF
__global__ void dump_kernel(GAS float* out, const unsigned char* ws) {
    const size_t OUTN = (size_t)ML * DM; const size_t i0 = (size_t)blockIdx.x * blockDim.x + threadIdx.x, st = (size_t)gridDim.x * blockDim.x;
    for (size_t i = i0; i < OUTN; i += st) { float a = 0.f;
#if DUMP_F32
        const GAS float* src = (const GAS float*)(ws + (size_t)DUMP_OFF); for (size_t j = i; j < (size_t)DUMP_ELEMS; j += OUTN) a += src[j];
#else
        const GAS bf16_t* src = (const GAS bf16_t*)(ws + (size_t)DUMP_OFF); for (size_t j = i; j < (size_t)DUMP_ELEMS; j += OUTN) a += bf2f(src[j]);
#endif
        out[i] = a; }
}
#endif
extern "C" void kernel_launch(void* const* d_in, const int* in_sizes, int n_in, void* d_out, int out_size, void* d_ws, size_t ws_size, hipStream_t stream) {
    static int grid = 0;
    if (grid == 0) {
        if (n_in != N_IN || out_size != ML * DM || ws_size < WS_END) { fprintf(stderr, "kernel_launch: unexpected shapes: n_in %d out %d ws %zu (need %zu)\n", n_in, out_size, ws_size, (size_t)WS_END); grid = -1; return; }
        int dev = 0, cus = 0, per_cu = 0;
        if (hipGetDevice(&dev) != hipSuccess || hipDeviceGetAttribute(&cus, hipDeviceAttributeMultiprocessorCount, dev) != hipSuccess) { grid = -1; return; }
        if (hipFuncSetAttribute((const void*)fwd_kernel, hipFuncAttributeMaxDynamicSharedMemorySize, LDS_BYTES) != hipSuccess) { fprintf(stderr, "kernel_launch: hipFuncSetAttribute failed\n"); grid = -1; return; }
        if (hipOccupancyMaxActiveBlocksPerMultiprocessor(&per_cu, (const void*)fwd_kernel, 512, LDS_BYTES) != hipSuccess || per_cu < 1) { fprintf(stderr, "kernel_launch: occupancy query says %d\n", per_cu); }
        (void)hipGetLastError();
        grid = cus;
    }
    if (grid < 0) return;
    if (hipMemsetAsync((char*)d_ws + WS_CTL, 0, CTL_BYTES, stream) != hipSuccess) return;
    Args a{};
    for (int i = 0; i < N_IN; ++i) a.in[i] = (const float*)d_in[i];
    a.out = (float*)d_out; a.ws = (unsigned char*)d_ws;
#if MK_SINGLE
    a.ph_lo = 0; a.ph_hi = NPHASE;
    hipLaunchKernelGGL(fwd_kernel, dim3(grid), dim3(512), LDS_BYTES, stream, a);
#else
#ifndef MK_STOP
#define MK_STOP NPHASE
#endif
    for (int ph = 0; ph < MK_STOP; ++ph) {
        if (ph == 2 + PH_PER_LAYER) continue;
        a.ph_lo = ph; a.ph_hi = ph + 1;
        hipLaunchKernelGGL(fwd_kernel, dim3(grid), dim3(512), LDS_BYTES, stream, a);
    }
#endif
#ifdef DUMP_OFF
    hipLaunchKernelGGL(dump_kernel, dim3(2048), dim3(256), 0, stream, (float*)d_out, (const unsigned char*)d_ws);
#endif
    const hipError_t le = hipPeekAtLastError();
    if (le != hipSuccess) fprintf(stderr, "kernel_launch: launch failed: %s\n", hipGetErrorName(le));
}
```

```cpp
#include <hip/hip_runtime.h>
#include <cstdio>
#include <cstdint>

#ifndef MK_SINGLE
#define MK_SINGLE 1
#endif

constexpr int DM = 2048, NBATCH = 8, SEQ = 2048, CTXL = 256, DEPTH = 2;
constexpr int ML = NBATCH * SEQ;
constexpr int MC = NBATCH * CTXL;
constexpr int MT = ML + MC;
constexpr int DIN = 7008, NU = 7168;
constexpr int U_MLQ = 0, U_MLK = 512, U_MLV = 1024, U_MLO = 1536, U_HGQ = 2048, U_HGI = 2560, U_HGG = 3072, U_HGF = 3584,
              U_CQ = 4608, U_CKV = 5120, U_KR = 5376, U_MLG = 5440, U_DT = 5456, U_Z = 5632, U_XBC = 6144;
constexpr float EPS = 1e-6f;
constexpr int NEXP = 32, DEXP = 512;
constexpr int MOE_ROWS = 2 * MT + NEXP * 256;

enum { I_X = 0, I_C, I_CTX, I_CCTX, I_WADA, I_BADA, I_NORMG, I_WIN, I_MLFB, I_HGLB, I_HGNG, I_MLAGQ, I_MLAGKV, I_WUQ, I_WUKV,
       I_CONVW, I_CONVB, I_ALOG, I_DTB, I_SSDD, I_SSDNG, I_WGATE, I_WBR, I_WOUT, I_WGRP, I_WEXP, I_W1, I_W3, I_W2, N_IN };

constexpr size_t al256(size_t x) { return (x + 255) / 256 * 256; }
constexpr size_t WS_CTL = 0, CTL_BYTES = 1u << 20;
constexpr size_t WS_WIN = WS_CTL + CTL_BYTES;
constexpr size_t WS_WUQ = WS_WIN + (size_t)2 * NU * DM * 2;
constexpr size_t WS_WUKV = WS_WUQ + (size_t)2 * 768 * 512 * 2;
constexpr size_t WS_WG = WS_WUKV + (size_t)2 * 1024 * 256 * 2;
constexpr size_t WS_WBR = WS_WG + (size_t)2 * 8192 * DM;
constexpr size_t WS_WOUT = WS_WBR + (size_t)2 * 4 * DM * 512 * 2;
constexpr size_t WS_WR = WS_WOUT + (size_t)2 * DM * DM;
constexpr size_t WS_WIN8 = WS_WR + (size_t)2 * 256 * DM * 2;
constexpr size_t WS_W13 = WS_WIN8 + (size_t)2 * NU * DM;
constexpr size_t WS_W2 = WS_W13 + (size_t)NEXP * 1024 * DM * 2;
constexpr size_t WS_MODP = WS_W2 + (size_t)NEXP * DM * 512 * 2;
constexpr size_t WS_MOD = WS_MODP + (size_t)2 * 16 * 9 * 12288 * 4;
constexpr size_t WS_TAB = WS_MOD + (size_t)2 * 9 * 12288 * 4;
constexpr size_t WS_XC = WS_TAB + 16384;
constexpr size_t WS_H8 = WS_XC + (size_t)MC * DM * 4;
constexpr size_t WS_H = WS_H8 + (size_t)MT * DM;
constexpr size_t WS_HIN = WS_H;
constexpr size_t WS_QB = WS_H + (size_t)MT * DM * 2;
constexpr size_t WS_KVB = WS_QB + (size_t)MT * 768 * 2;
constexpr size_t WS_SSQ = WS_KVB + (size_t)MT * 1024 * 2;
constexpr size_t WS_BR = WS_SSQ + (size_t)MT * 12 * 4;
constexpr size_t WS_YFB = WS_BR + (size_t)MT * DM * 2;
constexpr size_t WS_RSSD = WS_YFB + (size_t)6 * MT * 512 * 2;
constexpr size_t WS_LOG = WS_RSSD + al256((size_t)MT * 4);
constexpr size_t WS_LIST = WS_LOG + (size_t)4 * MT * 64 * 4;
constexpr size_t WS_WL = WS_LIST + (size_t)NEXP * MT * 4;
constexpr size_t WS_XBC = WS_WL + (size_t)NEXP * MT * 4;
constexpr size_t HGP_ITEM = 8192 + 8192 + 1024;
constexpr size_t WS_HGP = WS_XBC + (size_t)MT * 1024 * 2;
constexpr size_t WS_MLS = WS_HGP + (size_t)64 * 72 * HGP_ITEM;
constexpr size_t WS_SSDS = WS_MLS + (size_t)64 * 2304 * 32;
constexpr size_t WS_MLC = WS_SSDS + (size_t)128 * 2304 * 32;
constexpr size_t WS_RA = WS_MLC + (size_t)32 * 2304 * 384 * 2;
constexpr size_t RA_BYTES = (size_t)MT * NU * 2;
constexpr size_t WS_RB = WS_RA + RA_BYTES;
constexpr size_t RB_BYTES = ((size_t)80 << 20) + (size_t)2 * MT * DM * 2;
constexpr size_t WS_END = WS_RB + RB_BYTES;
constexpr size_t RA_ACC = 0, RA_PART = (size_t)80 << 20, RA_H1 = (size_t)150 << 20;
constexpr size_t RB_Y = 0, RB_Y2 = (size_t)80 << 20;
static_assert(RA_PART >= (size_t)MT * DM * 2 && RA_H1 >= RA_PART + (size_t)256 * 65536 * 4 && RA_H1 + (size_t)MOE_ROWS * 512 * 2 <= RA_BYTES, "region A");
static_assert(RB_Y2 >= (size_t)MT * DM * 2 && RB_Y2 + (size_t)2 * MT * DM * 2 <= RB_BYTES && (size_t)MT * 8192 <= RB_BYTES, "region B");
constexpr int CW_CNT = 64;
constexpr int CW_BAR = 4096;

constexpr int RING_BYTES = 131072, MISC_OFF = RING_BYTES, LDS_BYTES = 147456;

#define GAS __attribute__((address_space(1)))
#define LAS __attribute__((address_space(3)))
typedef unsigned short bf16_t;
typedef short bf16x8 __attribute__((ext_vector_type(8)));
typedef short s16x4 __attribute__((ext_vector_type(4)));
typedef float f32x4 __attribute__((ext_vector_type(4)));
typedef float f32x2 __attribute__((ext_vector_type(2)));
typedef float f32x16 __attribute__((ext_vector_type(16)));
typedef unsigned u32x4 __attribute__((ext_vector_type(4)));
typedef unsigned u32x2 __attribute__((ext_vector_type(2)));
#define LDS_WAIT() asm volatile("s_waitcnt lgkmcnt(0)" ::: "memory")
#define VM_WAIT() asm volatile("s_waitcnt vmcnt(0)" ::: "memory")
typedef __bf16 bf16x2_t __attribute__((ext_vector_type(2)));
__device__ __forceinline__ unsigned cvt_pk_bf16(float lo, float hi) { const f32x2 v = {lo, hi}; return __builtin_bit_cast(unsigned, __builtin_convertvector(v, bf16x2_t)); }
__device__ __forceinline__ bf16_t f2bf(float f) { return (bf16_t)(cvt_pk_bf16(f, 0.f) & 0xffffu); }
__device__ __forceinline__ float bf2f(bf16_t b) { return __uint_as_float(((unsigned)b) << 16); }
__device__ __forceinline__ float bflo(unsigned w) { return __uint_as_float(w << 16); }
__device__ __forceinline__ float bfhi(unsigned w) { return __uint_as_float(w & 0xffff0000u); }
__device__ __forceinline__ float sigmoidf_(float x) { return 1.f / (1.f + __expf(-x)); }
__device__ __forceinline__ float siluf_(float x) { return x / (1.f + __expf(-x)); }
__device__ __forceinline__ int opaque_tid() { int t = threadIdx.x; asm volatile("" : "+v"(t)); return t; }
__device__ __forceinline__ const void* opaque_ptr(const void* p) {
    unsigned lo = (unsigned)(uintptr_t)p, hi = (unsigned)((uintptr_t)p >> 32); asm volatile("" : "+v"(lo), "+v"(hi));
    lo = __builtin_amdgcn_readfirstlane(lo); hi = __builtin_amdgcn_readfirstlane(hi); return (const void*)(((uintptr_t)hi << 32) | lo); }
__device__ __forceinline__ float wave_sum(float v) {
#pragma unroll
    for (int o = 1; o < 64; o <<= 1) v += __shfl_xor(v, o);
    return v;
}

__device__ __forceinline__ int prow(int b, int dir, int p) { if (p < CTXL) return ML + b * CTXL + (dir ? CTXL - 1 - p : p); const int q = p - CTXL; return b * SEQ + (dir ? SEQ - 1 - q : q); }
namespace scn {
__device__ __forceinline__ int rowl(int row, int colB) { return row * 256 + (colB ^ ((row & 7) << 4)); }
__device__ __forceinline__ float scan_add32(float v, int r32) {
#pragma unroll
    for (int d = 1; d < 32; d <<= 1) { const float o = __shfl_up(v, d, 32); if (r32 >= d) v += o; }
    return v;
}
__device__ __forceinline__ float scan_max32(float v, int r32) {
#pragma unroll
    for (int d = 1; d < 32; d <<= 1) { const float o = __shfl_up(v, d, 32); if (r32 >= d) v = fmaxf(v, o); }
    return v;
}
}

#define XB_TMO      128
#define XB_XCNT(j)  (256  + 64 * (j))
#define XB_XSUB(j)  (1280 + 64 * (j))
#define XB_XGEN(j)  (2304 + 64 * (j))
#define XB_TOP      3328
#define XB_TOPGEN   3392
#define XCD_BAR_WORDS 3456
#define XB_SPIN_CAP (1u << 18)
__device__ __forceinline__ unsigned xb_ld(unsigned* p)              { return __hip_atomic_load(p, __ATOMIC_RELAXED, __HIP_MEMORY_SCOPE_AGENT); }
__device__ __forceinline__ unsigned xb_add(unsigned* p, unsigned v) { return __hip_atomic_fetch_add(p, v, __ATOMIC_RELAXED, __HIP_MEMORY_SCOPE_AGENT); }
__device__ __forceinline__ unsigned xb_xcc_id() { return (unsigned)__builtin_amdgcn_s_getreg((3 << 11) | 20) & 0xFu; }
#define XB_SPIN(cond, bar) do { unsigned _sp = 0; while (cond) { __builtin_amdgcn_s_sleep(1); \
    if ((++_sp & 255u) == 0u) { if (xb_ld(&(bar)[XB_TMO])) break; if (_sp > XB_SPIN_CAP) { atomicAdd(&(bar)[XB_TMO], 1u); break; } } } } while (0)
struct XcdBarrier { unsigned* bar; unsigned x; volatile LAS unsigned* st; };
__device__ __forceinline__ XcdBarrier xcd_barrier_post(unsigned* bar, volatile LAS unsigned* st) {
    XcdBarrier b; b.bar = bar; b.x = xb_xcc_id(); b.st = st;
    if (threadIdx.x == 0) (void)xb_add(&bar[XB_XCNT(b.x)], 1u);
    return b;
}
__device__ __forceinline__ void xcd_barrier_complete(unsigned* bar, unsigned x, unsigned& nloc, unsigned& nx) {
    const unsigned G = gridDim.x * gridDim.y * gridDim.z;
    unsigned sum, cnt, mine, sp = 0u;
    for (;;) {
        sum = 0u; cnt = 0u; mine = 0u;
#pragma unroll
        for (unsigned j = 0; j < 16; ++j) { const unsigned c = xb_ld(&bar[XB_XCNT(j)]); sum += c; cnt += (c > 0u) ? 1u : 0u; mine = (j == x) ? c : mine; }
        if (sum == G) break;
        __builtin_amdgcn_s_sleep(1);
        if ((++sp & 255u) == 0u) { if (xb_ld(&bar[XB_TMO])) break; if (sp > XB_SPIN_CAP) { atomicAdd(&bar[XB_TMO], 1u); break; } }
    }
    nloc = mine > 0u ? mine : 1u; nx = cnt > 0u ? cnt : 1u;
}
__device__ __forceinline__ void xcd_barrier(const XcdBarrier& b) {
    asm volatile("s_waitcnt vmcnt(0)" ::: "memory");
    __syncthreads();
    if (threadIdx.x == 0) {
        unsigned* bar = b.bar;
        __builtin_amdgcn_s_waitcnt(0);
        unsigned nloc = b.st[0], nx = b.st[1];
        if (nloc == 0u) { xcd_barrier_complete(bar, b.x, nloc, nx); b.st[0] = nloc; b.st[1] = nx; }
        const unsigned old = xb_add(&bar[XB_XSUB(b.x)], 1u);
        const unsigned gen = old / nloc;
        if (old + 1u == (gen + 1u) * nloc) {
            __builtin_amdgcn_fence(__ATOMIC_RELEASE, "agent");
            asm volatile("s_waitcnt vmcnt(0)" ::: "memory");
            const unsigned og = xb_add(&bar[XB_TOP], 1u);
            const unsigned tg = og / nx;
            if (og + 1u == (tg + 1u) * nx) xb_add(&bar[XB_TOPGEN], 1u);
            else XB_SPIN(xb_ld(&bar[XB_TOPGEN]) == tg, bar);
            __builtin_amdgcn_fence(__ATOMIC_ACQUIRE, "agent");
            xb_add(&bar[XB_XGEN(b.x)], 1u);
            asm volatile("s_waitcnt vmcnt(0)" ::: "memory");
        } else {
            XB_SPIN(xb_ld(&bar[XB_XGEN(b.x)]) == gen, bar);
            __builtin_amdgcn_fence(__ATOMIC_ACQUIRE, "agent");
            asm volatile("s_waitcnt vmcnt(0)" ::: "memory");
        }
    }
    __syncthreads();
}

struct Frame {
    LAS unsigned char* lds;
    volatile LAS unsigned* MISC;
    unsigned* ctl;
    int tid, lane, wave, vcu, G;
    const float* const* inp;
    GAS float* out;
    GAS unsigned char* ws;
};
#define WSP(T, off) ((GAS T*)(F.ws + (off)))
#define INP(i) ((const GAS float*)F.inp[i])

namespace pg8 {
constexpr int BM = 256, BK = 64, HALF = 128, HTB = HALF * BK * 2, STAGE_BYTES = 8 * HTB, NXCD = 8, WGM = 8;
__host__ __device__ __forceinline__ int lds_byte(int r, int c) { const int st = (r >> 4) * 2 + (c >> 5), rr = r & 15, cc = c & 31, ob = rr * 64 + cc * 2; return st * 1024 + (ob ^ (((ob >> 9) & 1) << 5)); }
__host__ __device__ __forceinline__ void stage_rc(int b, int& R, int& C) { const int st = b / 1024, sb = b % 1024, swz = sb ^ (((sb >> 9) & 1) << 5); R = (st >> 1) * 16 + swz / 64; C = (st & 1) * 32 + (swz % 64) / 2; }

struct Unit { int pm, pn, aux, aux2; size_t aoff, boff; };
struct Gemm { const GAS bf16_t* A; const GAS bf16_t* Bt; int lda, ldb, K; };

struct GridSched {
    int nM, nN, nwg, G, c; size_t a_tile, b_tile, a0, b0;
    __device__ __forceinline__ void init(int nM_, int nN_, int G_, int c_, size_t a_tile_, size_t b_tile_, size_t a0_, size_t b0_) { nM = nM_; nN = nN_; nwg = nM * nN; G = G_; c = c_; a_tile = a_tile_; b_tile = b_tile_; a0 = a0_; b0 = b0_; }
    __device__ __forceinline__ void map(int L, int& pm, int& pn) const {
        int wgid = L; { const int q = nwg / NXCD, r = nwg % NXCD, xcd = wgid % NXCD, off = wgid / NXCD; wgid = (xcd < r ? xcd * (q + 1) : r * (q + 1) + (xcd - r) * q) + off; }
        const int nig = WGM * nN, gid = wgid / nig, fm = gid * WGM, gsz = (nM - fm) < WGM ? (nM - fm) : WGM;
        pm = fm + ((wgid % nig) % gsz); pn = (wgid % nig) / gsz;
    }
    __device__ __forceinline__ bool next(int i, Unit& u) const {
        const long L = (long)i * G + c; if (L >= nwg) return false;
        map((int)L, u.pm, u.pn); u.aux = 0; u.aux2 = 0; u.aoff = a0 + (size_t)u.pm * a_tile; u.boff = b0 + (size_t)u.pn * b_tile; return true;
    }
    __device__ __forceinline__ int arow(const Unit&, int) const { return 0; }
};

template <class Epi, class Sched, bool GATHER, bool FP8 = false, bool HM = false>
__device__ __forceinline__ void gemm_phase(LAS unsigned char* lds, const Gemm g, const Sched& S, const Epi& E) {
    const int tid = opaque_tid(), wid = __builtin_amdgcn_readfirstlane(tid >> 6), lane = tid & 63, wr = wid >> 2, wc = wid & 3, fr = lane & 15, fq = lane >> 4;
    int nt = g.K / BK; asm volatile("" : "+s"(nt));
    unsigned voffA[2], voffB[2];
#pragma unroll
    for (int i = 0; i < 2; ++i) { int R, C; stage_rc(tid * 16 + i * 8192, R, C);
        voffA[i] = (unsigned)(R * g.lda + C) * 2u; voffB[i] = (unsigned)(R * g.ldb + C) * 2u; }
    const size_t kstep = (size_t)(BK * 2);
    const size_t hstepA = (size_t)HALF * g.lda * 2, hstepB = (size_t)HALF * g.ldb * 2;
    const unsigned ldsw = (unsigned)wid * 1024u;
    const int aoff = lds_byte(wr * 64 + fr, fq * 8), boff = lds_byte(wc * 32 + fr, fq * 8);
#define PG8_SA(b, h) (((b) * 2 + (h)) * HTB)
#define PG8_SB(b, h) ((4 + (b) * 2 + (h)) * HTB)
#define PG8_STAGE(bufoff, gbase, voff) do { _Pragma("unroll") for (int _i = 0; _i < 2; ++_i) \
        __builtin_amdgcn_global_load_lds((const unsigned*)((const char*)(gbase) + (voff)[_i]), (LAS unsigned*)(lds + (bufoff) + ldsw + _i * 8192), 16, 0, 0); } while (0)
#define PG8_LDA(dst, b, h) do { _Pragma("unroll") for (int m = 0; m < 4; ++m) { dst[m].lo = *(const LAS v4i_t*)(lds + PG8_SA(b, h) + aoff + m * 2048); dst[m].hi = *(const LAS v4i_t*)(lds + PG8_SA(b, h) + aoff + m * 2048 + 1024); } } while (0)
#define PG8_LDB(dst, b, h) do { _Pragma("unroll") for (int n = 0; n < 2; ++n) { dst[n].lo = *(const LAS v4i_t*)(lds + PG8_SB(b, h) + boff + n * 2048); dst[n].hi = *(const LAS v4i_t*)(lds + PG8_SB(b, h) + boff + n * 2048 + 1024); } } while (0)
typedef int v8i_t __attribute__((ext_vector_type(8))); typedef int v4i_t __attribute__((ext_vector_type(4)));
#define PG8_MMA(ai, bj, At, Bt) do { __builtin_amdgcn_s_setprio(1); _Pragma("unroll") for (int m = 0; m < 4; ++m) _Pragma("unroll") for (int n = 0; n < 2; ++n) { \
        if constexpr (FP8) { asm volatile("v_mfma_scale_f32_16x16x128_f8f6f4 %0, %1, %2, %0, %3, %4 op_sel_hi:[0,0,0]" : "+v"(acc[ai][bj][m][n]) : "v"(Bt[n]), "v"(At[m]), "v"(scW), "v"(scA)); } \
        else { acc[ai][bj][m][n] = __builtin_amdgcn_mfma_f32_16x16x32_bf16(__builtin_bit_cast(bf16x8, (v4i_t)Bt[n].lo), __builtin_bit_cast(bf16x8, (v4i_t)At[m].lo), acc[ai][bj][m][n], 0, 0, 0); \
               acc[ai][bj][m][n] = __builtin_amdgcn_mfma_f32_16x16x32_bf16(__builtin_bit_cast(bf16x8, (v4i_t)Bt[n].hi), __builtin_bit_cast(bf16x8, (v4i_t)At[m].hi), acc[ai][bj][m][n], 0, 0, 0); } } \
        __builtin_amdgcn_s_setprio(0); } while (0)
#if GEMM_SAFE
#define PG8_WAIT_V(n) asm volatile("s_waitcnt vmcnt(0)" ::: "memory")
#else
#define PG8_WAIT_V(n) asm volatile("s_waitcnt vmcnt(" #n ")" ::: "memory")
#endif
#define PG8_WAIT_L(n) asm volatile("s_waitcnt lgkmcnt(" #n ")" ::: "memory")
#define PG8_BAR __builtin_amdgcn_s_barrier()
#define PG8_SCHED __builtin_amdgcn_sched_barrier(0)
    unsigned cvA[2][2], nvA[2][2];
#define PG8_GOFF(dst, u) do { if constexpr (GATHER) { const int ne_ = S.acnt(u); int gr_[2][2], gc_[2];        \
        _Pragma("unroll") for (int _i = 0; _i < 2; ++_i) { int R_; stage_rc(tid * 16 + _i * 8192, R_, gc_[_i]); _Pragma("unroll") for (int _h = 0; _h < 2; ++_h) gr_[_h][_i] = S.arow(u, _h * HALF + R_, ne_); } \
        _Pragma("unroll") for (int _i = 0; _i < 2; ++_i) _Pragma("unroll") for (int _h = 0; _h < 2; ++_h) dst[_h][_i] = (unsigned)(((size_t)gr_[_h][_i] * (size_t)g.lda + (size_t)gc_[_i]) * 2u); } } while (0)
#define PG8_STAGE_A(bufoff, base, half, vh) do { if constexpr (GATHER) { PG8_STAGE(bufoff, base, (vh)[half]); } else { PG8_STAGE(bufoff, (base) + (half) * hstepA, voffA); } } while (0)
    Unit cur, nxt; int ui = 0;
    if (!S.next(0, cur)) return;
    f32x4 acc[2][2][4][2];
#pragma unroll
    for (int a = 0; a < 2; ++a)
#pragma unroll
        for (int b = 0; b < 2; ++b)
#pragma unroll
            for (int m = 0; m < 4; ++m)
#pragma unroll
                for (int n = 0; n < 2; ++n) acc[a][b][m][n] = (f32x4){0.f, 0.f, 0.f, 0.f};
    int scW = 0x79797979, scA = 0x7f7f7f7f; asm volatile("" : "+v"(scW), "+v"(scA));
    v8i_t At[4], B0[2], B1[2];
    const char* cA = (const char*)g.A + cur.aoff; const char* cB = (const char*)g.Bt + cur.boff;
    PG8_GOFF(cvA, cur);
#pragma unroll
    for (int _h = 0; _h < 2; ++_h)
#pragma unroll
        for (int _i = 0; _i < 2; ++_i) nvA[_h][_i] = cvA[_h][_i];
    PG8_STAGE(PG8_SB(0, 0), cB, voffB); PG8_STAGE_A(PG8_SA(0, 0), cA, 0, cvA); PG8_STAGE(PG8_SB(0, 1), cB + hstepB, voffB); PG8_STAGE_A(PG8_SA(0, 1), cA, 1, cvA);
    if (wr == 1) PG8_BAR;
    PG8_WAIT_V(4); PG8_BAR;
    PG8_STAGE(PG8_SB(1, 0), cB + kstep, voffB); PG8_STAGE_A(PG8_SA(1, 0), cA + kstep, 0, cvA); PG8_STAGE(PG8_SB(1, 1), cB + hstepB + kstep, voffB);
    PG8_WAIT_V(6); PG8_BAR;
    for (;;) {
        const bool has_next = S.next(ui + 1, nxt);
        const char* nA = has_next ? (const char*)g.A + nxt.aoff : cA; const char* nB = has_next ? (const char*)g.Bt + nxt.boff : cB;
        for (int t = 0; t < nt; t += 2) {
            const bool last = (t == nt - 2);
            const char* a1 = cA + (size_t)(t + 1) * kstep;
            const char* a2 = last ? nA : cA + (size_t)(t + 2) * kstep; const char* b2 = last ? nB : cB + (size_t)(t + 2) * kstep;
            const char* a3 = a2 + kstep; const char* b3 = b2 + kstep;
            if constexpr (GATHER) { if (last && has_next) { PG8_GOFF(nvA, nxt); } }
            PG8_LDB(B0, 0, 0); PG8_SCHED; PG8_LDA(At, 0, 0); PG8_STAGE_A(PG8_SA(1, 1), a1, 1, cvA);
            PG8_WAIT_L(8); PG8_BAR; PG8_WAIT_L(0); PG8_MMA(0, 0, At, B0); PG8_BAR; PG8_SCHED;
            PG8_LDB(B1, 0, 1); PG8_STAGE(PG8_SB(0, 0), b2, voffB);
            PG8_BAR; PG8_WAIT_L(0); PG8_MMA(0, 1, At, B1); PG8_BAR;
            if constexpr (!HM) { PG8_LDA(At, 0, 1); } PG8_STAGE_A(PG8_SA(0, 0), a2, 0, nvA);
            PG8_BAR; PG8_WAIT_L(0); if constexpr (!HM) { PG8_MMA(1, 0, At, B0); } PG8_BAR; PG8_SCHED;
            PG8_STAGE(PG8_SB(0, 1), b2 + hstepB, voffB);
            PG8_WAIT_V(6); PG8_BAR; if constexpr (!HM) { PG8_MMA(1, 1, At, B1); } PG8_BAR;
            PG8_LDB(B0, 1, 0); PG8_SCHED; PG8_LDA(At, 1, 0); PG8_STAGE_A(PG8_SA(0, 1), a2, 1, nvA);
            PG8_WAIT_L(8); PG8_BAR; PG8_WAIT_L(0); PG8_MMA(0, 0, At, B0); PG8_BAR; PG8_SCHED;
            PG8_LDB(B1, 1, 1); PG8_STAGE(PG8_SB(1, 0), b3, voffB);
            PG8_BAR; PG8_WAIT_L(0); PG8_MMA(0, 1, At, B1); PG8_BAR;
            if constexpr (!HM) { PG8_LDA(At, 1, 1); } PG8_STAGE_A(PG8_SA(1, 0), a3, 0, nvA);
            PG8_BAR; PG8_WAIT_L(0); if constexpr (!HM) { PG8_MMA(1, 0, At, B0); } PG8_BAR; PG8_SCHED;
            PG8_STAGE(PG8_SB(1, 1), b3 + hstepB, voffB);
            PG8_WAIT_V(6); PG8_BAR; if constexpr (!HM) { PG8_MMA(1, 1, At, B1); } PG8_BAR;
        }
        if constexpr (FP8) { asm volatile("s_nop 15\n\ts_nop 15" ::: "memory"); }
        E(acc, cur, wr, wc, fr, fq);
        if (!has_next) break;
#pragma unroll
        for (int a = 0; a < (HM ? 1 : 2); ++a)
#pragma unroll
            for (int b = 0; b < 2; ++b)
#pragma unroll
                for (int m = 0; m < 4; ++m)
#pragma unroll
                    for (int n = 0; n < 2; ++n) acc[a][b][m][n] = (f32x4){0.f, 0.f, 0.f, 0.f};
        cur = nxt; cA = nA; cB = nB; ++ui;
        if constexpr (GATHER) {
#pragma unroll
            for (int _h = 0; _h < 2; ++_h)
#pragma unroll
                for (int _i = 0; _i < 2; ++_i) cvA[_h][_i] = nvA[_h][_i];
        }
    }
    PG8_WAIT_V(0);
    if (wr == 0) PG8_BAR;
    PG8_BAR;
#undef PG8_SA
#undef PG8_SB
#undef PG8_STAGE
#undef PG8_STAGE_A
#undef PG8_GOFF
#undef PG8_LDA
#undef PG8_LDB
#undef PG8_MMA
#undef PG8_WAIT_V
#undef PG8_WAIT_L
#undef PG8_BAR
#undef PG8_SCHED
}
}
using pg8::Unit;
using pg8::Gemm;
using pg8::GridSched;
#define EPI_ARGS f32x4 (&acc)[2][2][4][2], const Unit& u, int wr, int wc, int fr, int fq
#define EPI_FOR_ROWS for (int ai = 0; ai < 2; ++ai) for (int m = 0; m < 4; ++m)
#define EPI_FOR_COLS for (int bj = 0; bj < 2; ++bj) for (int n = 0; n < 2; ++n)
__device__ __forceinline__ void st_bf16x4(GAS bf16_t* p, f32x4 v) { u32x2 w; w.x = cvt_pk_bf16(v[0], v[1]); w.y = cvt_pk_bf16(v[2], v[3]); *(GAS u32x2*)p = w; }

struct EpiWin {
    GAS bf16_t* U; GAS float* ssq; const GAS float* rope;
    __device__ __forceinline__ void operator()(EPI_ARGS) const {
        const int row0 = u.pm * 256 + wr * 64 + fr, col0 = u.pn * 256 + wc * 32 + 4 * fq;
        if (u.pn == 21 && wc < 2 && u.pm < ML / 256) {
#pragma unroll
            for (int ai = 0; ai < 2; ++ai)
#pragma unroll
                for (int m = 0; m < 4; ++m) {
                    const int r = row0 + ai * 128 + m * 16, tok = r & (SEQ - 1), pos = wc == 0 ? (tok >> 6) : (tok & 63);
                    const f32x4 cs = *(const GAS f32x4*)(rope + pos * 16 + 4 * fq), sn = *(const GAS f32x4*)(rope + 1024 + pos * 16 + 4 * fq);
                    const f32x4 x1 = acc[ai][0][m][0], x2 = acc[ai][0][m][1];
                    acc[ai][0][m][0] = x1 * cs - x2 * sn; acc[ai][0][m][1] = x1 * sn + x2 * cs;
                }
        }
        if (u.pn >= 18 && u.pn <= 20) {
            const int slot = (u.pn - 18) * 4 + wc;
#pragma unroll
            for (int ai = 0; ai < 2; ++ai)
#pragma unroll
                for (int m = 0; m < 4; ++m) {
                    float s = 0.f;
#pragma unroll
                    for (int bj = 0; bj < 2; ++bj)
#pragma unroll
                        for (int n = 0; n < 2; ++n) { const f32x4 x = acc[ai][bj][m][n]; s += (x[0] * x[0] + x[1] * x[1]) + (x[2] * x[2] + x[3] * x[3]); }
                    s += __shfl_xor(s, 16); s += __shfl_xor(s, 32);
                    if (fq == 0) ssq[(size_t)(row0 + ai * 128 + m * 16) * 12 + slot] = s;
                }
        }
#pragma unroll
        for (int ai = 0; ai < 2; ++ai)
#pragma unroll
            for (int m = 0; m < 4; ++m) { GAS bf16_t* rowp = U + (size_t)(row0 + ai * 128 + m * 16) * NU + col0;
#pragma unroll
                for (int bj = 0; bj < 2; ++bj)
#pragma unroll
                    for (int n = 0; n < 2; ++n) st_bf16x4(rowp + bj * 128 + n * 16, acc[ai][bj][m][n]); }
    }
};
struct EpiMlaQ {
    GAS bf16_t* Q; const GAS float* ssq; const GAS float* rope;
    __device__ __forceinline__ void operator()(EPI_ARGS) const {
        const int row0 = u.pm * 256 + wr * 64 + fr, col0 = u.pn * 256 + wc * 32 + 4 * fq;
        float rstd[8];
        { f32x4 p0[8], p1[8];
#pragma unroll
          for (int i = 0; i < 8; ++i) { const int r = row0 + (i >> 2) * 128 + (i & 3) * 16; p0[i] = *(const GAS f32x4*)(ssq + (size_t)r * 12); p1[i] = *(const GAS f32x4*)(ssq + (size_t)r * 12 + 4); }
#pragma unroll
          for (int i = 0; i < 8; ++i) rstd[i] = rsqrtf(((p0[i][0] + p0[i][1]) + (p0[i][2] + p0[i][3]) + (p1[i][0] + p1[i][1]) + (p1[i][2] + p1[i][3])) * (1.f / 512.f) + EPS); }
        const bool rot = u.pn == 2 && u.pm < ML / 256;
#pragma unroll
        for (int ai = 0; ai < 2; ++ai) {
            f32x4 cs[4], sn[4];
#pragma unroll
            for (int m = 0; m < 4; ++m) { const int r = row0 + ai * 128 + m * 16; const int tok = r & (SEQ - 1), pos = rot ? ((wc & 1) == 0 ? (tok >> 6) : (tok & 63)) : 0;
                cs[m] = *(const GAS f32x4*)(rope + pos * 16 + 4 * fq); sn[m] = *(const GAS f32x4*)(rope + 1024 + pos * 16 + 4 * fq); }
#pragma unroll
            for (int m = 0; m < 4; ++m) {
                const int r = row0 + ai * 128 + m * 16, i = ai * 4 + m;
#pragma unroll
                for (int bj = 0; bj < 2; ++bj) {
                    f32x4 a = acc[ai][bj][m][0] * rstd[i], b = acc[ai][bj][m][1] * rstd[i];
                    if (rot) { const f32x4 x1 = a, x2 = b; a = x1 * cs[m] - x2 * sn[m]; b = x1 * sn[m] + x2 * cs[m]; }
                    GAS bf16_t* rowp = Q + (size_t)r * 768 + col0 + bj * 128;
                    st_bf16x4(rowp, a); st_bf16x4(rowp + 16, b);
                }
            }
        }
    }
};
struct EpiMlaKV {
    GAS bf16_t* KV; const GAS float* ssq;
    __device__ __forceinline__ void operator()(EPI_ARGS) const {
        const int row0 = u.pm * 256 + wr * 64 + fr, col0 = u.pn * 256 + wc * 32 + 4 * fq;
        f32x4 p0[8];
#pragma unroll
        for (int i = 0; i < 8; ++i) { const int r = row0 + (i >> 2) * 128 + (i & 3) * 16; p0[i] = *(const GAS f32x4*)(ssq + (size_t)r * 12 + 8); }
#pragma unroll
        for (int ai = 0; ai < 2; ++ai)
#pragma unroll
            for (int m = 0; m < 4; ++m) {
                const int r = row0 + ai * 128 + m * 16, i = ai * 4 + m;
                const float rstd = rsqrtf(((p0[i][0] + p0[i][1]) + (p0[i][2] + p0[i][3])) * (1.f / 256.f) + EPS);
                GAS bf16_t* rowp = KV + (size_t)r * 1024 + col0;
#pragma unroll
                for (int bj = 0; bj < 2; ++bj)
#pragma unroll
                    for (int n = 0; n < 2; ++n) st_bf16x4(rowp + bj * 128 + n * 16, acc[ai][bj][m][n] * rstd);
            }
    }
};
struct EpiGate {
    GAS unsigned char* G;
    __device__ __forceinline__ void operator()(EPI_ARGS) const {
        const __amdgpu_buffer_rsrc_t rsrc = __builtin_amdgcn_make_buffer_rsrc((void*)G, 0, 0x7fffffff, 0x00020000);
        const int voff = threadIdx.x * 8; const int tbase = (u.pm * 32 + u.pn) * 65536;
#pragma unroll
        for (int ai = 0; ai < 2; ++ai)
#pragma unroll
            for (int bj = 0; bj < 2; ++bj)
#pragma unroll
                for (int m = 0; m < 4; ++m) {
                    u32x2 w;
#pragma unroll
                    for (int n = 0; n < 2; ++n) { const f32x4 v = acc[ai][bj][m][n]; unsigned d = 0;
#pragma unroll
                        for (int j = 0; j < 4; ++j) { const float g = __builtin_amdgcn_rcpf(__builtin_fmaf(__builtin_amdgcn_exp2f(v[j]), 1.f / 255.f, 1.f / 255.f)); d = __builtin_amdgcn_cvt_pk_u8_f32(g, j, d); }
                        if (n == 0) w.x = d; else w.y = d; }
                    __builtin_amdgcn_raw_buffer_store_b64(w, rsrc, voff, tbase + ((ai * 2 + bj) * 4 + m) * 4096, 0);
                }
    }
};
struct EpiMerge {
    const GAS unsigned char* G; GAS unsigned char* ACC; const GAS float* rssd;
    __device__ __forceinline__ void operator()(EPI_ARGS) const {
        const int k = u.aux, hf = u.aux2;
        const int row0 = u.pm * 256 + hf * 128 + wr * 64 + fr, col0 = u.pn * 256 + wc * 32 + 4 * fq;
        const __amdgpu_buffer_rsrc_t rg = __builtin_amdgcn_make_buffer_rsrc((void*)G, 0, 0x7fffffff, 0x00020000);
        const int vg = threadIdx.x * 8; const int tbase = (u.pm * 32 + k * 8 + u.pn) * 65536 + hf * 32768;
        u32x2 gw[2][4]; float rsv[4];
#pragma unroll
        for (int m = 0; m < 4; ++m) { rsv[m] = (k == 3) ? rssd[row0 + m * 16] : 1.f;
#pragma unroll
            for (int bj = 0; bj < 2; ++bj) gw[bj][m] = __builtin_amdgcn_raw_buffer_load_b64(rg, vg, tbase + (bj * 4 + m) * 4096, 0); }
#pragma unroll
        for (int m = 0; m < 4; ++m) {
            const int r = row0 + m * 16; const float rs = rsv[m] * (1.f / 255.f);
#pragma unroll
            for (int bj = 0; bj < 2; ++bj) {
                const u32x2 g2 = gw[bj][m];
                f32x4 v0, v1;
                v0[0] = (float)(g2.x & 0xffu); v0[1] = (float)((g2.x >> 8) & 0xffu); v0[2] = (float)((g2.x >> 16) & 0xffu); v0[3] = (float)(g2.x >> 24);
                v1[0] = (float)(g2.y & 0xffu); v1[1] = (float)((g2.y >> 8) & 0xffu); v1[2] = (float)((g2.y >> 16) & 0xffu); v1[3] = (float)(g2.y >> 24);
                v0 = v0 * acc[0][bj][m][0] * rs; v1 = v1 * acc[0][bj][m][1] * rs;
                if (k > 0) { v0 += acc[1][bj][m][0]; v1 += acc[1][bj][m][1]; }
                if (k < 3) { acc[1][bj][m][0] = v0; acc[1][bj][m][1] = v1; }
                else { GAS unsigned char* op = ACC + (size_t)r * DM + col0 + bj * 128;
#pragma unroll
                    for (int j = 0; j < 4; ++j) { v0[j] = __builtin_amdgcn_fmed3f(v0[j], -448.f, 448.f); v1[j] = __builtin_amdgcn_fmed3f(v1[j], -448.f, 448.f); }
                    unsigned w0 = 0, w1 = 0; w0 = __builtin_amdgcn_cvt_pk_fp8_f32(v0[0], v0[1], w0, false); w0 = __builtin_amdgcn_cvt_pk_fp8_f32(v0[2], v0[3], w0, true);
                    w1 = __builtin_amdgcn_cvt_pk_fp8_f32(v1[0], v1[1], w1, false); w1 = __builtin_amdgcn_cvt_pk_fp8_f32(v1[2], v1[3], w1, true);
                    *(GAS unsigned*)op = w0; *(GAS unsigned*)(op + 16) = w1; }
            }
        }
    }
};
struct EpiBf16 {
    GAS bf16_t* O; int ld;
    __device__ __forceinline__ void operator()(EPI_ARGS) const {
        const int row0 = u.pm * 256 + wr * 64 + fr, col0 = u.pn * 256 + wc * 32 + 4 * fq;
#pragma unroll
        for (int ai = 0; ai < 2; ++ai)
#pragma unroll
            for (int m = 0; m < 4; ++m) { GAS bf16_t* rowp = O + (size_t)(row0 + ai * 128 + m * 16) * ld + col0;
#pragma unroll
                for (int bj = 0; bj < 2; ++bj)
#pragma unroll
                    for (int n = 0; n < 2; ++n) st_bf16x4(rowp + bj * 128 + n * 16, acc[ai][bj][m][n]); }
    }
};
struct EpiRouter {
    GAS float* LOG;
    __device__ __forceinline__ void operator()(EPI_ARGS) const {
        if (wc >= 2) return;
        const int row0 = u.pm * 256 + wr * 64 + fr, col0 = wc * 32 + 4 * fq;
#pragma unroll
        for (int ai = 0; ai < 2; ++ai)
#pragma unroll
            for (int m = 0; m < 4; ++m) { GAS float* rowp = LOG + ((size_t)u.aux * MT + (row0 + ai * 128 + m * 16)) * 64 + col0;
#pragma unroll
                for (int n = 0; n < 2; ++n) *(GAS f32x4*)(rowp + n * 16) = acc[ai][0][m][n]; }
    }
};
struct RouterSched {
    int nM, G, c;
    __device__ __forceinline__ bool next(int i, Unit& u) const {
        const long L = (long)i * G + c; if (L >= (long)nM * 4) return false;
        u.pm = (int)(L >> 2); u.pn = 0; u.aux = (int)(L & 3); u.aux2 = 0;
        u.aoff = ((size_t)u.pm * 256 * DM + (size_t)u.aux * 512) * 2; u.boff = (size_t)u.aux * 512 * 2; return true;
    }
    __device__ __forceinline__ int arow(const Unit&, int) const { return 0; }
};
struct MoeSched {
    const volatile LAS int* tb; const volatile LAS int* cnt; const GAS int* list; int nN, G, c, mode;
    __device__ __forceinline__ bool next(int i, Unit& u) const {
        const long L = (long)i * G + c; const int NT = tb[32];
        const int ti = (int)(L / nN); if (ti >= NT) return false;
        u.pn = (int)(L % nN); int e = 0;
        while (e < 31 && ti >= tb[e + 1]) ++e;
        u.aux = e; u.aux2 = ti - tb[e]; u.pm = ti;
        if (mode == 1) { u.aoff = 0; u.boff = ((size_t)e * 1024 + (size_t)u.pn * 256) * DM; }
        else { u.aoff = (size_t)ti * 256 * DEXP; u.boff = ((size_t)e * DM + (size_t)u.pn * 256) * DEXP; }
        return true;
    }
    __device__ __forceinline__ int acnt(const Unit& u) const { return cnt[u.aux]; }
    __device__ __forceinline__ int arow(const Unit& u, int r, int n_e) const {
        const int pos = u.aux2 * 256 + r; const int e = u.aux;
        const bool in = pos < n_e; const int v = list[(size_t)e * MT + (in ? pos : 0)] >> 1;
        return in ? v : 0;
    }
};
struct EpiMoe1 {
    GAS unsigned char* H1;
    __device__ __forceinline__ void operator()(EPI_ARGS) const {
        const int row0 = u.pm * 256 + wr * 64 + fr, col0 = u.pn * 128 + wc * 32 + 4 * fq;
#pragma unroll
        for (int ai = 0; ai < 2; ++ai)
#pragma unroll
            for (int m = 0; m < 4; ++m) { GAS unsigned char* rowp = H1 + (size_t)(row0 + ai * 128 + m * 16) * DEXP + col0;
#pragma unroll
                for (int n = 0; n < 2; ++n) { const f32x4 a = acc[ai][0][m][n], b = acc[ai][1][m][n]; f32x4 v;
#pragma unroll
                    for (int j = 0; j < 4; ++j) v[j] = __builtin_amdgcn_fmed3f(a[j] * __builtin_amdgcn_rcpf(1.f + __builtin_amdgcn_exp2f(-1.4426950409f * a[j])) * b[j], -448.f, 448.f);
                    unsigned w = 0; w = __builtin_amdgcn_cvt_pk_fp8_f32(v[0], v[1], w, false); w = __builtin_amdgcn_cvt_pk_fp8_f32(v[2], v[3], w, true);
                    *(GAS unsigned*)(rowp + n * 16) = w; } }
    }
};
struct EpiMoe2 {
    GAS bf16_t* Y2; const GAS int* list; const GAS float* wl; const volatile LAS int* cnt;
    __device__ __forceinline__ void operator()(EPI_ARGS) const {
        const int e = u.aux, n_e = cnt[e], col0 = u.pn * 256 + wc * 32 + 4 * fq;
        int ts[8]; float w[8];
#pragma unroll
        for (int i = 0; i < 8; ++i) { const int pos = u.aux2 * 256 + (i >> 2) * 128 + wr * 64 + (i & 3) * 16 + fr; const bool ok = pos < n_e;
            const int pc = ok ? pos : 0; const int tv = list[(size_t)e * MT + pc]; const float wv = wl[(size_t)e * MT + pc];
            ts[i] = ok ? tv : -1; w[i] = ok ? wv : 0.f; }
#pragma unroll
        for (int ai = 0; ai < 2; ++ai)
#pragma unroll
            for (int m = 0; m < 4; ++m) { const int i = ai * 4 + m;
                if (ts[i] >= 0) {
                    GAS bf16_t* rowp = Y2 + (size_t)ts[i] * DM + col0;
#pragma unroll
                    for (int bj = 0; bj < 2; ++bj)
#pragma unroll
                        for (int n = 0; n < 2; ++n) st_bf16x4(rowp + bj * 128 + n * 16, acc[ai][bj][m][n] * w[i]);
                }
            }
    }
};

struct WinSched {
    GridSched gs; int mode;
    __device__ __forceinline__ bool next(int i, Unit& u) const {
        const long L = (long)i * gs.G + gs.c; if (L >= gs.nwg) return false;
        int j; gs.map((int)L, u.pm, j);
        u.pn = mode == 0 ? (j < 17 ? 4 + j : 5 + j) : (j < 4 ? j : 21);
        u.aux = 0; u.aux2 = 0; u.aoff = gs.a0 + (size_t)u.pm * gs.a_tile; u.boff = gs.b0 + (size_t)u.pn * gs.b_tile; return true;
    }
    __device__ __forceinline__ int arow(const Unit&, int) const { return 0; }
};
struct MergeSched {
    GridSched gs;
    __device__ __forceinline__ bool next(int i, Unit& u) const {
        const long H = (long)(i >> 2) * gs.G + gs.c; if (H >= 2 * (long)gs.nwg) return false;
        const int hf = H >= gs.nwg ? 1 : 0; gs.map((int)(H - (long)hf * gs.nwg), u.pm, u.pn); const int k = i & 3; u.aux = k; u.aux2 = hf;
        u.aoff = ((size_t)u.pm * 256 + (size_t)hf * 128) * DM + (size_t)k * 512; u.boff = ((size_t)k * DM + (size_t)u.pn * 256) * 512; return true;
    }
    __device__ __forceinline__ int arow(const Unit&, int) const { return 0; }
};

__device__ __forceinline__ void tr_block(const GAS float* colp, int ldw, float nscale, const GAS float* kscale, int k0, GAS bf16_t* WT, int K, int n0, LAS float* scr, int lane) {
    float v[32];
#pragma unroll
    for (int i = 0; i < 32; ++i) { const int kk = 2 * i + (lane >> 5); v[i] = colp[(size_t)(k0 + kk) * ldw]; }
    if (kscale) {
#pragma unroll
        for (int i = 0; i < 32; ++i) { const int kk = 2 * i + (lane >> 5); v[i] *= kscale[k0 + kk]; }
    }
#pragma unroll
    for (int i = 0; i < 32; ++i) { const int kk = 2 * i + (lane >> 5); scr[kk * 33 + (lane & 31)] = v[i] * nscale; }
    LDS_WAIT(); asm volatile("" ::: "memory");
    const int c = lane & 7;
#pragma unroll
    for (int j = 0; j < 4; ++j) { const int n = (lane >> 3) + 8 * j; const LAS float* s = scr + (8 * c) * 33 + n;
        u32x4 o; o.x = cvt_pk_bf16(s[0 * 33], s[1 * 33]); o.y = cvt_pk_bf16(s[2 * 33], s[3 * 33]); o.z = cvt_pk_bf16(s[4 * 33], s[5 * 33]); o.w = cvt_pk_bf16(s[6 * 33], s[7 * 33]);
        *(GAS u32x4*)(WT + (size_t)(n0 + n) * K + k0 + 8 * c) = o; }
    LDS_WAIT(); asm volatile("" ::: "memory");
}

__device__ __forceinline__ void tr_block8(const GAS float* colp, int ldw, float nscale, int k0, GAS unsigned char* WT, int K, int n0, LAS float* scr, int lane) {
    float v[32];
#pragma unroll
    for (int i = 0; i < 32; ++i) { const int kk = 2 * i + (lane >> 5); v[i] = colp[(size_t)(k0 + kk) * ldw]; }
#pragma unroll
    for (int i = 0; i < 32; ++i) { const int kk = 2 * i + (lane >> 5); scr[kk * 33 + (lane & 31)] = v[i] * nscale; }
    LDS_WAIT(); asm volatile("" ::: "memory");
    const int c = lane & 7;
#pragma unroll
    for (int j = 0; j < 4; ++j) { const int n = (lane >> 3) + 8 * j; const LAS float* s = scr + (8 * c) * 33 + n;
        u32x2 o; unsigned w = 0; w = __builtin_amdgcn_cvt_pk_fp8_f32(s[0 * 33], s[1 * 33], w, false); w = __builtin_amdgcn_cvt_pk_fp8_f32(s[2 * 33], s[3 * 33], w, true); o.x = w;
        w = 0; w = __builtin_amdgcn_cvt_pk_fp8_f32(s[4 * 33], s[5 * 33], w, false); w = __builtin_amdgcn_cvt_pk_fp8_f32(s[6 * 33], s[7 * 33], w, true); o.y = w;
        *(GAS u32x2*)(WT + (size_t)(n0 + n) * K + k0 + 8 * c) = o; }
    LDS_WAIT(); asm volatile("" ::: "memory");
}

__device__ __forceinline__ void tr_block8k(const GAS float* colp, int ldw, float nscale, const GAS float* kscale, int k0, GAS unsigned char* WT, int K, int n0, LAS float* scr, int lane) {
    float v[32];
#pragma unroll
    for (int i = 0; i < 32; ++i) { const int kk = 2 * i + (lane >> 5); v[i] = colp[(size_t)(k0 + kk) * ldw]; }
    if (kscale) {
#pragma unroll
        for (int i = 0; i < 32; ++i) { const int kk = 2 * i + (lane >> 5); v[i] *= kscale[k0 + kk]; }
    }
#pragma unroll
    for (int i = 0; i < 32; ++i) { const int kk = 2 * i + (lane >> 5); scr[kk * 33 + (lane & 31)] = v[i] * nscale; }
    LDS_WAIT(); asm volatile("" ::: "memory");
    const int c = lane & 7;
#pragma unroll
    for (int j = 0; j < 4; ++j) { const int n = (lane >> 3) + 8 * j; const LAS float* s = scr + (8 * c) * 33 + n;
        u32x2 o; unsigned w = 0; w = __builtin_amdgcn_cvt_pk_fp8_f32(s[0 * 33], s[1 * 33], w, false); w = __builtin_amdgcn_cvt_pk_fp8_f32(s[2 * 33], s[3 * 33], w, true); o.x = w;
        w = 0; w = __builtin_amdgcn_cvt_pk_fp8_f32(s[4 * 33], s[5 * 33], w, false); w = __builtin_amdgcn_cvt_pk_fp8_f32(s[6 * 33], s[7 * 33], w, true); o.y = w;
        *(GAS u32x2*)(WT + (size_t)(n0 + n) * K + k0 + 8 * c) = o; }
    LDS_WAIT(); asm volatile("" ::: "memory");
}
__device__ __forceinline__ int win_src(int n) {
    if (n < 2048) return n;
    if (n < 5440) return n + 16;
    if (n < 5456) return 2048 + (n - 5440);
    if (n < 5472) return 6992 + (n - 5456);
    if (n < 5632) return -1;
    if (n < 6144) return 5456 + (n - 5632);
    return 5968 + (n - 6144);
}
constexpr int IT_WIN = 32 * 224, IT_WUQ = 8 * 24, IT_WUKV = 4 * 32, IT_WG = 32 * 64, IT_WBR = 8 * 64, IT_WOUT = 32 * 64, IT_WR = 32 * 8, IT_W13 = 32 * 32, IT_W2 = 8 * 64;
constexpr int IT_LAYER = IT_WIN + IT_WUQ + IT_WUKV + 4 * IT_WG + 4 * IT_WBR + IT_WOUT + IT_WR;
constexpr int IT_MOE = NEXP * (IT_W13 + IT_W2);
__device__ __forceinline__ void cvt_layer_item(Frame& F, int l, int r, LAS float* scr) {
    const int lane = F.lane, nl = lane & 31;
    if (r < IT_WIN) { const int nb = r % 224, kb = r / 224, n = nb * 32 + nl, sc = win_src(n);
        const int ct = nb >> 3;
        if (ct >= 4 && ct != 21) tr_block8(INP(I_WIN) + (size_t)l * DM * DIN + (sc >= 0 ? sc : 0), DIN, sc >= 0 ? 64.f : 0.f, kb * 64, WSP(unsigned char, WS_WIN8) + (size_t)l * NU * DM, DM, nb * 32, scr, lane);
        else tr_block(INP(I_WIN) + (size_t)l * DM * DIN + (sc >= 0 ? sc : 0), DIN, sc < 0 ? 0.f : (n < 512 ? 0.08838834764831845f : 1.f), nullptr, kb * 64, WSP(bf16_t, WS_WIN) + (size_t)l * NU * DM, DM, nb * 32, scr, lane);
        return; }
    r -= IT_WIN;
    if (r < IT_WUQ) { const int nb = r % 24, kb = r / 24, n = nb * 32 + nl; const int sc = n < 512 ? (n >> 7) * 192 + (n & 127) : ((n - 512) >> 6) * 192 + 128 + ((n - 512) & 63);
        tr_block(INP(I_WUQ) + (size_t)l * 512 * 768 + sc, 768, 0.07216878364870323f * 1.4426950408889634f, INP(I_MLAGQ) + l * 512, kb * 64, WSP(bf16_t, WS_WUQ) + (size_t)l * 768 * 512, 512, nb * 32, scr, lane); return; }
    r -= IT_WUQ;
    if (r < IT_WUKV) { const int nb = r % 32, kb = r / 32, n = nb * 32 + nl; const int sc = n < 512 ? (n >> 7) * 256 + (n & 127) : ((n - 512) >> 7) * 256 + 128 + ((n - 512) & 127);
        tr_block(INP(I_WUKV) + (size_t)l * 256 * 1024 + sc, 1024, 1.f, INP(I_MLAGKV) + l * 256, kb * 64, WSP(bf16_t, WS_WUKV) + (size_t)l * 1024 * 256, 256, nb * 32, scr, lane); return; }
    r -= IT_WUKV;
    if (r < 4 * IT_WG) { const int k = r / IT_WG, q = r % IT_WG, nb = q % 64, kb = q / 64;
        tr_block8(INP(I_WGATE) + (size_t)(l * 4 + k) * DM * DM + nb * 32 + nl, DM, -92.33248261689366f  , kb * 64, WSP(unsigned char, WS_WG) + ((size_t)l * 8192 + (size_t)k * 2048) * DM, DM, nb * 32, scr, lane); return; }
    r -= 4 * IT_WG;
    if (r < 4 * IT_WBR) { const int k = r / IT_WBR, q = r % IT_WBR, nb = q % 64, kb = q / 64;
        const GAS float* ks = k == 1 ? INP(I_HGNG) + l * 512 : (k == 3 ? INP(I_SSDNG) + l * 512 : nullptr);
        tr_block8k(INP(I_WBR) + (size_t)(l * 4 + k) * 512 * DM + nb * 32 + nl, DM, 64.f, ks, kb * 64, WSP(unsigned char, WS_WBR) + (size_t)(l * 4 + k) * DM * 512, 512, nb * 32, scr, lane); return; }
    r -= 4 * IT_WBR;
    if (r < IT_WOUT) { const int nb = r % 64, kb = r / 64;
        tr_block8(INP(I_WOUT) + (size_t)l * DM * DM + nb * 32 + nl, DM, 64.f, kb * 64, WSP(unsigned char, WS_WOUT) + (size_t)l * DM * DM, DM, nb * 32, scr, lane); return; }
    r -= IT_WOUT;
    { const int nb = r % 8, kb = r / 8, n = nb * 32 + nl; const GAS float* cp = INP(I_WGRP) + (size_t)l * DM * 4; int ld = 4;
      if (n < 4) { cp += n; } else if (n < 36) { cp = INP(I_WEXP) + (size_t)l * DM * 32 + (n - 4); ld = 32; }
      tr_block(cp, ld, n < 36 ? 1.f : 0.f, nullptr, kb * 64, WSP(bf16_t, WS_WR) + (size_t)l * 256 * DM, DM, nb * 32, scr, lane); }
}
__device__ __forceinline__ void cvt_moe_item(Frame& F, int l, int r, LAS float* scr) {
    const int lane = F.lane, nl = lane & 31;
    if (r < NEXP * IT_W13) { const int e = r / IT_W13, q = r % IT_W13, nb = q % 32, kb = q / 32, n = nb * 32 + nl;
        const int c = (n >> 8) * 128 + (n & 127); const GAS float* src = ((n >> 7) & 1) ? INP(I_W3) : INP(I_W1);
        tr_block8(src + (size_t)(l * NEXP + e) * DM * DEXP + c, DEXP, 64.f, kb * 64, WSP(unsigned char, WS_W13) + (size_t)e * 1024 * DM, DM, nb * 32, scr, lane); return; }
    r -= NEXP * IT_W13;
    { const int e = r / IT_W2, q = r % IT_W2, nb = q % 64, kb = q / 64;
      tr_block8(INP(I_W2) + (size_t)(l * NEXP + e) * DEXP * DM + nb * 32 + nl, DM, 64.f, kb * 64, WSP(unsigned char, WS_W2) + (size_t)e * DM * DEXP, DEXP, nb * 32, scr, lane); }
}
__device__ __forceinline__ void ada_task(Frame& F, int task, LAS float* scr) {
    const int ks = task & 15, cg = (task >> 4) % 48, l = task / (16 * 48); const int col = cg * 256 + F.lane * 4;
    for (int i = F.lane; i < 9 * 128; i += 64) { const int r = i >> 7, kk = ks * 128 + (i & 127); const float c = r < 8 ? INP(I_C)[r * DM + kk] : INP(I_CCTX)[kk]; scr[i] = siluf_(c); }
    LDS_WAIT(); asm volatile("" ::: "memory");
    f32x4 a[9];
#pragma unroll
    for (int r = 0; r < 9; ++r) a[r] = (f32x4){0.f, 0.f, 0.f, 0.f};
    const GAS float* W = INP(I_WADA) + ((size_t)l * DM + ks * 128) * 12288 + col;
    for (int k = 0; k < 128; k += 8) {
        f32x4 w[8];
#pragma unroll
        for (int q = 0; q < 8; ++q) w[q] = *(const GAS f32x4*)(W + (size_t)(k + q) * 12288);
#pragma unroll
        for (int q = 0; q < 8; ++q) {
#pragma unroll
            for (int r = 0; r < 9; ++r) a[r] += scr[r * 128 + k + q] * w[q];
        }
    }
    GAS float* P = WSP(float, WS_MODP) + ((size_t)(l * 16 + ks) * 9) * 12288 + col;
#pragma unroll
    for (int r = 0; r < 9; ++r) *(GAS f32x4*)(P + (size_t)r * 12288) = a[r];
    LDS_WAIT(); asm volatile("" ::: "memory");
}
__device__ __forceinline__ void tables_task(Frame& F) {
    GAS float* T = WSP(float, WS_TAB); const int lane = F.lane;
    for (int i = 0; i < 16; ++i) { const float inv = expf(-(float)i * (9.210340371976184f / 16.f)); const float ang = (float)lane * inv; T[lane * 16 + i] = cosf(ang); T[1024 + lane * 16 + i] = sinf(ang); }
    for (int j = lane; j < 512; j += 64) { const float a0 = INP(I_HGLB)[j], a1 = INP(I_HGLB)[512 + j], a2 = INP(I_HGLB)[1024 + j];
        const float mx = fmaxf(a0, fmaxf(a1, a2)), e0 = expf(a0 - mx), e1 = expf(a1 - mx), e2 = expf(a2 - mx), s = e0 + e1 + e2;
        T[2048 + j] = e0 / s; T[2048 + 512 + j] = (e0 + e1) / s; }
}
constexpr int N_ADA = 2 * 48 * 16;
__device__ __forceinline__ void phase_prologue(Frame& F) {
    LAS float* scr = (LAS float*)(F.lds + F.wave * 16384);
    const int gw = F.vcu * 8 + F.wave, NGW = F.G * 8;
    constexpr int TOTAL = N_ADA + 1 + IT_LAYER;
    for (int it = gw; it < TOTAL; it += NGW) {
        int r = it;
        if (r < N_ADA) { ada_task(F, r, scr); continue; } r -= N_ADA;
        if (r == 0) { tables_task(F); continue; } r -= 1;
        cvt_layer_item(F, 0, r, scr);
    }
}
__device__ __forceinline__ void phase_modfin(Frame& F) {
    const int gt = F.vcu * 512 + F.tid, NT_ = F.G * 512;
    for (int i = gt; i < 2 * 9 * 12288; i += NT_) { const int l = i / (9 * 12288), rc = i % (9 * 12288), col = rc % 12288;
        float s = INP(I_BADA)[l * 12288 + col];
#pragma unroll
        for (int ks = 0; ks < 16; ++ks) s += WSP(float, WS_MODP)[((size_t)(l * 16 + ks) * 9) * 12288 + rc];
        WSP(float, WS_MOD)[i] = s; }
}

struct Row8 { f32x4 v[8]; };
__device__ __forceinline__ void ld_row_f32(Row8& R, const GAS float* p, int lane) {
#pragma unroll
    for (int j = 0; j < 8; ++j) R.v[j] = ((const GAS f32x4*)p)[64 * j + lane];
}
__device__ __forceinline__ void st_row_f32(const Row8& R, GAS float* p, int lane) {
#pragma unroll
    for (int j = 0; j < 8; ++j) ((GAS f32x4*)p)[64 * j + lane] = R.v[j];
}
__device__ __forceinline__ void ld_row_bf16(Row8& R, const GAS bf16_t* p, int lane) {
#pragma unroll
    for (int j = 0; j < 8; ++j) { const u32x2 w = ((const GAS u32x2*)p)[64 * j + lane]; R.v[j] = (f32x4){bflo(w.x), bfhi(w.x), bflo(w.y), bfhi(w.y)}; }
}
__device__ __forceinline__ void st_row_bf16(const Row8& R, GAS bf16_t* p, int lane) {
#pragma unroll
    for (int j = 0; j < 8; ++j) { u32x2 w; w.x = cvt_pk_bf16(R.v[j][0], R.v[j][1]); w.y = cvt_pk_bf16(R.v[j][2], R.v[j][3]); ((GAS u32x2*)p)[64 * j + lane] = w; }
}
__device__ __forceinline__ float row_rstd(const Row8& R) {
    float s = 0.f;
#pragma unroll
    for (int j = 0; j < 8; ++j) s += (R.v[j][0] * R.v[j][0] + R.v[j][1] * R.v[j][1]) + (R.v[j][2] * R.v[j][2] + R.v[j][3] * R.v[j][3]);
    return rsqrtf(wave_sum(s) * (1.f / DM) + EPS);
}
__device__ __forceinline__ void st_modnorm(const Row8& R, float rstd, const GAS float* g, const GAS float* shift, const GAS float* scale, GAS bf16_t* o, int lane) {
#pragma unroll
    for (int j = 0; j < 8; ++j) { const int c = 64 * j + lane; const f32x4 gg = ((const GAS f32x4*)g)[c], sh = ((const GAS f32x4*)shift)[c], sc = ((const GAS f32x4*)scale)[c];
        const f32x4 h = (R.v[j] * rstd * gg) * (sc + 1.f) + sh; u32x2 w; w.x = cvt_pk_bf16(h[0], h[1]); w.y = cvt_pk_bf16(h[2], h[3]); ((GAS u32x2*)o)[c] = w; }
}
__device__ __forceinline__ void st_modnorm8(const Row8& R, float rstd, const GAS float* g, const GAS float* shift, const GAS float* scale, GAS unsigned char* o, int lane) {
#pragma unroll
    for (int j = 0; j < 8; ++j) { const int c = 64 * j + lane; const f32x4 gg = ((const GAS f32x4*)g)[c], sh = ((const GAS f32x4*)shift)[c], sc = ((const GAS f32x4*)scale)[c];
        f32x4 h = (R.v[j] * rstd * gg) * (sc + 1.f) + sh;
#pragma unroll
        for (int q = 0; q < 4; ++q) h[q] = __builtin_amdgcn_fmed3f(h[q], -448.f, 448.f);
        unsigned w = 0; w = __builtin_amdgcn_cvt_pk_fp8_f32(h[0], h[1], w, false); w = __builtin_amdgcn_cvt_pk_fp8_f32(h[2], h[3], w, true); ((GAS unsigned*)o)[c] = w; }
}
__device__ __forceinline__ void st_modnorm2(const Row8& R, float rstd, const GAS float* g, const GAS float* shift, const GAS float* scale, GAS bf16_t* o16, GAS unsigned char* o8, int lane) {
#pragma unroll
    for (int j = 0; j < 8; ++j) { const int c = 64 * j + lane; const f32x4 gg = ((const GAS f32x4*)g)[c], sh = ((const GAS f32x4*)shift)[c], sc = ((const GAS f32x4*)scale)[c];
        f32x4 h = (R.v[j] * rstd * gg) * (sc + 1.f) + sh; u32x2 w; w.x = cvt_pk_bf16(h[0], h[1]); w.y = cvt_pk_bf16(h[2], h[3]); ((GAS u32x2*)o16)[c] = w;
#pragma unroll
        for (int q = 0; q < 4; ++q) h[q] = __builtin_amdgcn_fmed3f(h[q], -448.f, 448.f);
        unsigned w8 = 0; w8 = __builtin_amdgcn_cvt_pk_fp8_f32(h[0], h[1], w8, false); w8 = __builtin_amdgcn_cvt_pk_fp8_f32(h[2], h[3], w8, true); ((GAS unsigned*)o8)[c] = w8; }
}
__device__ __forceinline__ const GAS float* mod_row(Frame& F, int l, int r) { return WSP(float, WS_MOD) + (size_t)(l * 9 + (r < ML ? (r >> 11) : 8)) * 12288; }
struct RawX { f32x4 f[8]; };
__device__ __forceinline__ void ld_raw_f32(RawX& R, const GAS float* p, int lane) {
#pragma unroll
    for (int j = 0; j < 8; ++j) R.f[j] = ((const GAS f32x4*)p)[64 * j + lane];
}
__device__ __forceinline__ void ld_raw_bf16(RawX& R, const GAS bf16_t* p, int lane) {
#pragma unroll
    for (int j = 0; j < 8; ++j) { const u32x2 w = ((const GAS u32x2*)p)[64 * j + lane]; R.f[j] = (f32x4){__uint_as_float(w.x), __uint_as_float(w.y), 0.f, 0.f}; }
}
__device__ __forceinline__ void raw_to_row(Row8& X, const RawX& R, bool is_bf16) {
#pragma unroll
    for (int j = 0; j < 8; ++j) { if (is_bf16) { const unsigned a = __float_as_uint(R.f[j][0]), b = __float_as_uint(R.f[j][1]); X.v[j] = (f32x4){bflo(a), bfhi(a), bflo(b), bfhi(b)}; } else X.v[j] = R.f[j]; }
}
struct RawB { u32x2 w[8]; };
__device__ __forceinline__ void ld_rawb(RawB& R, const GAS bf16_t* p, int lane) {
#pragma unroll
    for (int j = 0; j < 8; ++j) R.w[j] = ((const GAS u32x2*)p)[64 * j + lane];
}
__device__ __forceinline__ void rawb_to_row(Row8& X, const RawB& R) {
#pragma unroll
    for (int j = 0; j < 8; ++j) X.v[j] = (f32x4){bflo(R.w[j].x), bfhi(R.w[j].x), bflo(R.w[j].y), bfhi(R.w[j].y)};
}
__device__ __forceinline__ int row_grp(int r) { return r < ML ? (r >> 11) : 8; }
__device__ __forceinline__ void stage_vec(Frame& F, LAS float* dst, const GAS float* src) { ((LAS f32x4*)dst)[F.tid] = ((const GAS f32x4*)src)[F.tid]; }
__device__ __forceinline__ void st_modnorm2_l(const Row8& R, float rstd, const LAS float* g, const LAS float* shift, const LAS float* scale, GAS bf16_t* o16, GAS unsigned char* o8, int lane) {
#pragma unroll
    for (int j = 0; j < 8; ++j) { const int c = 64 * j + lane; const f32x4 gg = ((const LAS f32x4*)g)[c], sh = ((const LAS f32x4*)shift)[c], sc = ((const LAS f32x4*)scale)[c];
        f32x4 h = (R.v[j] * rstd * gg) * (sc + 1.f) + sh; u32x2 w; w.x = cvt_pk_bf16(h[0], h[1]); w.y = cvt_pk_bf16(h[2], h[3]); ((GAS u32x2*)o16)[c] = w;
#pragma unroll
        for (int q = 0; q < 4; ++q) h[q] = __builtin_amdgcn_fmed3f(h[q], -448.f, 448.f);
        unsigned w8 = 0; w8 = __builtin_amdgcn_cvt_pk_fp8_f32(h[0], h[1], w8, false); w8 = __builtin_amdgcn_cvt_pk_fp8_f32(h[2], h[3], w8, true); ((GAS unsigned*)o8)[c] = w8; }
}
__device__ __forceinline__ void phase_rwA(Frame& F, int l) {
    const int rpb = (MT + F.G - 1) / F.G, rlo = F.vcu * rpb, rhi = (rlo + rpb < MT ? rlo + rpb : MT) - 1;
    if (rlo > rhi) return;
    LAS float* Lf = (LAS float*)F.lds; const int ga = row_grp(rlo), gb = row_grp(rhi);
    stage_vec(F, Lf, INP(I_NORMG) + (size_t)(l * 4 + 0) * DM);
#pragma unroll
    for (int v = 0; v < 2; ++v) { stage_vec(F, Lf + (1 + v) * 2048, WSP(float, WS_MOD) + (size_t)(l * 9 + ga) * 12288 + v * DM); stage_vec(F, Lf + (3 + v) * 2048, WSP(float, WS_MOD) + (size_t)(l * 9 + gb) * 12288 + v * DM); }
    __syncthreads();
    for (int i0 = F.wave; i0 < rpb; i0 += 16) {
        const int r0 = rlo + i0, r1 = r0 + 8; const bool two = i0 + 8 < rpb && r1 <= rhi;
        if (r0 > rhi) break;
        RawX Ra, Rb; ld_raw_f32(Ra, r0 < ML ? INP(I_X) + (size_t)r0 * DM : INP(I_CTX) + (size_t)(r0 - ML) * DM, F.lane);
        if (two) ld_raw_f32(Rb, r1 < ML ? INP(I_X) + (size_t)r1 * DM : INP(I_CTX) + (size_t)(r1 - ML) * DM, F.lane);
#pragma unroll
        for (int q = 0; q < 2; ++q) { if (q == 1 && !two) break; const int r = q ? r1 : r0;
            Row8 R; raw_to_row(R, q ? Rb : Ra, false);
            const float rstd = row_rstd(R); const LAS float* md = Lf + (row_grp(r) == ga ? 1 : 3) * 2048;
            st_modnorm2_l(R, rstd, Lf, md, md + 2048, WSP(bf16_t, WS_HIN) + (size_t)r * DM, WSP(unsigned char, WS_H8) + (size_t)r * DM, F.lane); }
    }
}
__device__ __forceinline__ void phase_rwB(Frame& F, int l, int mrows) {
    const int rpb = (mrows + F.G - 1) / F.G, rlo = F.vcu * rpb, rhi = (rlo + rpb < mrows ? rlo + rpb : mrows) - 1;
    if (rlo > rhi) return;
    LAS float* Lf = (LAS float*)F.lds; const int ga = row_grp(rlo), gb = row_grp(rhi);
    stage_vec(F, Lf, INP(I_NORMG) + (size_t)(l * 4 + 1) * DM); stage_vec(F, Lf + 2048, INP(I_NORMG) + (size_t)(l * 4 + 2) * DM);
#pragma unroll
    for (int v = 0; v < 3; ++v) { stage_vec(F, Lf + (2 + v) * 2048, WSP(float, WS_MOD) + (size_t)(l * 9 + ga) * 12288 + (2 + v) * DM); stage_vec(F, Lf + (5 + v) * 2048, WSP(float, WS_MOD) + (size_t)(l * 9 + gb) * 12288 + (2 + v) * DM); }
    __syncthreads();
    const LAS float* g1 = Lf; const LAS float* g2 = Lf + 2048;
    for (int i0 = F.wave; i0 < rpb; i0 += 16) {
        const int r0 = rlo + i0, r1 = r0 + 8; const bool two = i0 + 8 < rpb && r1 <= rhi;
        if (r0 > rhi) break;
        RawB Ya, Yb; RawX Xa, Xb;
#define RWB_LOAD(Y_, X_, r_) do { ld_rawb(Y_, WSP(bf16_t, WS_RB + RB_Y) + (size_t)(r_) * DM, F.lane); \
        if ((r_) < ML) { if (l == 0) ld_raw_f32(X_, INP(I_X) + (size_t)(r_) * DM, F.lane); else ld_raw_bf16(X_, (const GAS bf16_t*)(F.out + (size_t)(r_) * DM), F.lane); } \
        else ld_raw_f32(X_, l == 0 ? INP(I_CTX) + (size_t)((r_) - ML) * DM : WSP(float, WS_XC) + (size_t)((r_) - ML) * DM, F.lane); } while (0)
        RWB_LOAD(Ya, Xa, r0); if (two) RWB_LOAD(Yb, Xb, r1);
#undef RWB_LOAD
#pragma unroll
        for (int q = 0; q < 2; ++q) { if (q == 1 && !two) break; const int r = q ? r1 : r0;
            Row8 Y, X; rawb_to_row(Y, q ? Yb : Ya); raw_to_row(X, q ? Xb : Xa, r < ML && l != 0);
            const float ry = row_rstd(Y); const LAS float* md = Lf + (row_grp(r) == ga ? 2 : 5) * 2048;
#pragma unroll
            for (int j = 0; j < 8; ++j) { const int c = 64 * j + F.lane; X.v[j] += ((const LAS f32x4*)md)[c] * (Y.v[j] * ry * ((const LAS f32x4*)g1)[c]); }
            if (r < ML) st_row_bf16(X, (GAS bf16_t*)(F.out + (size_t)r * DM), F.lane); else st_row_f32(X, WSP(float, WS_XC) + (size_t)(r - ML) * DM, F.lane);
            const float rx = row_rstd(X);
            st_modnorm2_l(X, rx, g2, md + 2048, md + 4096, WSP(bf16_t, WS_H) + (size_t)r * DM, WSP(unsigned char, WS_H8) + (size_t)r * DM, F.lane); }
    }
}
__device__ __forceinline__ void phase_rwC(Frame& F, int l, int mrows) {
    const int rpb = (mrows + F.G - 1) / F.G, rlo = F.vcu * rpb, rhi = (rlo + rpb < mrows ? rlo + rpb : mrows) - 1;
    if (rlo > rhi) return;
    LAS float* Lf = (LAS float*)F.lds; const int ga = row_grp(rlo), gb = row_grp(rhi);
    stage_vec(F, Lf, INP(I_NORMG) + (size_t)(l * 4 + 3) * DM);
    stage_vec(F, Lf + 2 * 2048, WSP(float, WS_MOD) + (size_t)(l * 9 + ga) * 12288 + 5 * DM); stage_vec(F, Lf + 5 * 2048, WSP(float, WS_MOD) + (size_t)(l * 9 + gb) * 12288 + 5 * DM);
    if (l + 1 < DEPTH) { stage_vec(F, Lf + 2048, INP(I_NORMG) + (size_t)((l + 1) * 4 + 0) * DM);
#pragma unroll
        for (int v = 0; v < 2; ++v) { stage_vec(F, Lf + (3 + v) * 2048, WSP(float, WS_MOD) + (size_t)((l + 1) * 9 + ga) * 12288 + v * DM); stage_vec(F, Lf + (6 + v) * 2048, WSP(float, WS_MOD) + (size_t)((l + 1) * 9 + gb) * 12288 + v * DM); } }
    __syncthreads();
    const LAS float* g3 = Lf;
    for (int i0 = F.wave; i0 < rpb; i0 += 16) {
        const int r0 = rlo + i0, r1 = r0 + 8; const bool two = i0 + 8 < rpb && r1 <= rhi;
        if (r0 > rhi) break;
        RawB Aa, Ba, Ab, Bb; RawX Xa, Xb;
#define RWC_LOAD(A_, B_, X_, r_) do { ld_rawb(A_, WSP(bf16_t, WS_RB + RB_Y2) + (size_t)(2 * (r_)) * DM, F.lane); ld_rawb(B_, WSP(bf16_t, WS_RB + RB_Y2) + (size_t)(2 * (r_) + 1) * DM, F.lane); \
        if ((r_) < ML) ld_raw_bf16(X_, (const GAS bf16_t*)(F.out + (size_t)(r_) * DM), F.lane); else ld_raw_f32(X_, WSP(float, WS_XC) + (size_t)((r_) - ML) * DM, F.lane); } while (0)
        RWC_LOAD(Aa, Ba, Xa, r0); if (two) RWC_LOAD(Ab, Bb, Xb, r1);
#undef RWC_LOAD
#pragma unroll
        for (int q = 0; q < 2; ++q) { if (q == 1 && !two) break; const int r = q ? r1 : r0;
            Row8 A, B, X; rawb_to_row(A, q ? Ab : Aa); rawb_to_row(B, q ? Bb : Ba); raw_to_row(X, q ? Xb : Xa, r < ML);
#pragma unroll
            for (int j = 0; j < 8; ++j) A.v[j] += B.v[j];
            const float ry = row_rstd(A); const LAS float* md = Lf + (row_grp(r) == ga ? 2 : 5) * 2048;
#pragma unroll
            for (int j = 0; j < 8; ++j) { const int c = 64 * j + F.lane; X.v[j] += ((const LAS f32x4*)md)[c] * (A.v[j] * ry * ((const LAS f32x4*)g3)[c]); }
            if (r >= ML) st_row_f32(X, WSP(float, WS_XC) + (size_t)(r - ML) * DM, F.lane);
            else if (l + 1 < DEPTH) st_row_bf16(X, (GAS bf16_t*)(F.out + (size_t)r * DM), F.lane);
            else st_row_f32(X, F.out + (size_t)r * DM, F.lane);
            if (l + 1 < DEPTH) { const float rx = row_rstd(X);
                st_modnorm2_l(X, rx, Lf + 2048, md + 2048, md + 4096, WSP(bf16_t, WS_HIN) + (size_t)r * DM, WSP(unsigned char, WS_H8) + (size_t)r * DM, F.lane); } }
    }
}
__device__ __forceinline__ void ld8bf(float (&o)[8], const GAS bf16_t* p) { const u32x4 w = *(const GAS u32x4*)p; o[0] = bflo(w.x); o[1] = bfhi(w.x); o[2] = bflo(w.y); o[3] = bfhi(w.y); o[4] = bflo(w.z); o[5] = bfhi(w.z); o[6] = bflo(w.w); o[7] = bfhi(w.w); }
__device__ __forceinline__ void st8bf(GAS bf16_t* p, const float (&v)[8]) { u32x4 w; w.x = cvt_pk_bf16(v[0], v[1]); w.y = cvt_pk_bf16(v[2], v[3]); w.z = cvt_pk_bf16(v[4], v[5]); w.w = cvt_pk_bf16(v[6], v[7]); *(GAS u32x4*)p = w; }
__device__ __forceinline__ void st8fp8(GAS unsigned char* p, const float (&v)[8]) {
    float c[8];
#pragma unroll
    for (int j = 0; j < 8; ++j) c[j] = __builtin_amdgcn_fmed3f(v[j], -448.f, 448.f);
    u32x2 o; unsigned w = 0; w = __builtin_amdgcn_cvt_pk_fp8_f32(c[0], c[1], w, false); w = __builtin_amdgcn_cvt_pk_fp8_f32(c[2], c[3], w, true); o.x = w;
    w = 0; w = __builtin_amdgcn_cvt_pk_fp8_f32(c[4], c[5], w, false); w = __builtin_amdgcn_cvt_pk_fp8_f32(c[6], c[7], w, true); o.y = w; *(GAS u32x2*)p = o;
}
__device__ __forceinline__ void unpk8(float (&o)[8], u32x4 w) { o[0] = bflo(w.x); o[1] = bfhi(w.x); o[2] = bflo(w.y); o[3] = bfhi(w.y); o[4] = bflo(w.z); o[5] = bfhi(w.z); o[6] = bflo(w.w); o[7] = bfhi(w.w); }
__device__ __forceinline__ void phase_finish(Frame& F, int l, int mrows) {
    const int gw = F.vcu * 8 + F.wave, NGW = F.G * 8, c8 = F.lane * 8;
    const GAS bf16_t* Y = WSP(bf16_t, WS_YFB); const GAS bf16_t* U = WSP(bf16_t, WS_RA); GAS unsigned char* BR = WSP(unsigned char, WS_BR); const GAS float* dskip = INP(I_SSDD) + l * 8;
    const float dsk = dskip[F.lane >> 3];
    struct FinRow { u32x4 v[10]; };
#define FIN_LOAD(R_, r_) do { const size_t r__ = (size_t)(r_); \
        R_.v[0] = *(const GAS u32x4*)(Y + ((size_t)0 * MT + r__) * 512 + c8); R_.v[1] = *(const GAS u32x4*)(Y + ((size_t)1 * MT + r__) * 512 + c8); R_.v[2] = *(const GAS u32x4*)(U + r__ * NU + U_MLO + c8); \
        R_.v[3] = *(const GAS u32x4*)(Y + ((size_t)2 * MT + r__) * 512 + c8); R_.v[4] = *(const GAS u32x4*)(Y + ((size_t)3 * MT + r__) * 512 + c8); R_.v[5] = *(const GAS u32x4*)(U + r__ * NU + U_HGG + c8); \
        R_.v[6] = *(const GAS u32x4*)(Y + ((size_t)4 * MT + r__) * 512 + c8); R_.v[7] = *(const GAS u32x4*)(Y + ((size_t)5 * MT + r__) * 512 + c8); R_.v[8] = *(const GAS u32x4*)(U + r__ * NU + U_Z + c8); \
        R_.v[9] = *(const GAS u32x4*)(WSP(bf16_t, WS_XBC) + r__ * 1024 + c8); } while (0)
    for (int r0 = gw; r0 < mrows; r0 += 2 * NGW) {
        const int r1 = r0 + NGW; const bool two = r1 < mrows;
        FinRow Ra, Rb; FIN_LOAD(Ra, r0); if (two) FIN_LOAD(Rb, r1);
#pragma unroll
        for (int q = 0; q < 2; ++q) { if (q == 1 && !two) break; const int r = q ? r1 : r0; const FinRow& R = q ? Rb : Ra;
            float a[8], b[8], g[8], o[8];
            unpk8(a, R.v[0]); unpk8(b, R.v[1]); unpk8(g, R.v[2]);
#pragma unroll
            for (int j = 0; j < 8; ++j) o[j] = (a[j] + b[j]) * sigmoidf_(g[j]);
            st8fp8(BR + (size_t)r * DM + c8, o);
            unpk8(a, R.v[3]); unpk8(b, R.v[4]); unpk8(g, R.v[5]);
            float ss = 0.f;
#pragma unroll
            for (int j = 0; j < 8; ++j) { a[j] += b[j]; ss += a[j] * a[j]; }
            ss += __shfl_xor(ss, 1); ss += __shfl_xor(ss, 2); ss += __shfl_xor(ss, 4); ss += __shfl_xor(ss, 8);
            const float rh = rsqrtf(ss * (1.f / 128.f) + EPS);
#pragma unroll
            for (int j = 0; j < 8; ++j) o[j] = a[j] * rh * sigmoidf_(g[j]);
            st8fp8(BR + (size_t)r * DM + 512 + c8, o);
            unpk8(a, R.v[6]); unpk8(b, R.v[7]); unpk8(g, R.v[8]);
            float s2 = 0.f, xh[8]; unpk8(xh, R.v[9]);
#pragma unroll
            for (int j = 0; j < 8; ++j) { o[j] = (a[j] + b[j] + dsk * xh[j]) * siluf_(g[j]); s2 += o[j] * o[j]; }
            s2 = wave_sum(s2);
            if (F.lane == 0) WSP(float, WS_RSSD)[r] = rsqrtf(s2 * (1.f / 512.f) + EPS);
            st8fp8(BR + (size_t)r * DM + 1536 + c8, o);
        }
    }
#undef FIN_LOAD
}

__device__ __forceinline__ void phase_ssdconv(Frame& F, int l) {
    const int gw = F.vcu * 8 + F.wave, NGW = F.G * 8, c16 = F.lane * 16;
    const GAS bf16_t* U = WSP(bf16_t, WS_RA); GAS bf16_t* X2 = WSP(bf16_t, WS_XBC);
    float w0[16], w1[16], w2[16], cb[16];
    { const GAS float* cw = INP(I_CONVW) + (size_t)l * 3 * 1024 + c16; const GAS float* bb = INP(I_CONVB) + l * 1024 + c16;
#pragma unroll
      for (int j = 0; j < 16; ++j) { w0[j] = cw[j]; w1[j] = cw[1024 + j]; w2[j] = cw[2048 + j]; cb[j] = bb[j]; } }
    for (int r = gw; r < MT; r += NGW) {
        const int t = r < ML ? (r & (SEQ - 1)) : ((r - ML) & (CTXL - 1)), tn = r < ML ? SEQ : CTXL;
        const GAS bf16_t* up = U + (size_t)r * NU + U_XBC + c16;
        float a[16], p_[16], n_[16];
        { const bool hp = t > 0, hn = t + 1 < tn; const GAS bf16_t* pp = hp ? up - NU : up; const GAS bf16_t* np = hn ? up + NU : up; const float pf = hp ? 1.f : 0.f, nf = hn ? 1.f : 0.f;
          const u32x4 ra0 = *(const GAS u32x4*)up, ra1 = *(const GAS u32x4*)(up + 8), rp0 = *(const GAS u32x4*)pp, rp1 = *(const GAS u32x4*)(pp + 8), rn0 = *(const GAS u32x4*)np, rn1 = *(const GAS u32x4*)(np + 8);
          float t8[8];
          unpk8(t8, ra0);
#pragma unroll
          for (int j = 0; j < 8; ++j) a[j] = t8[j]; unpk8(t8, ra1);
#pragma unroll
          for (int j = 0; j < 8; ++j) a[8 + j] = t8[j]; unpk8(t8, rp0);
#pragma unroll
          for (int j = 0; j < 8; ++j) p_[j] = t8[j] * pf; unpk8(t8, rp1);
#pragma unroll
          for (int j = 0; j < 8; ++j) p_[8 + j] = t8[j] * pf; unpk8(t8, rn0);
#pragma unroll
          for (int j = 0; j < 8; ++j) n_[j] = t8[j] * nf; unpk8(t8, rn1);
#pragma unroll
          for (int j = 0; j < 8; ++j) n_[8 + j] = t8[j] * nf; }
        float o[8];
#pragma unroll
        for (int j = 0; j < 8; ++j) o[j] = siluf_(w0[j] * p_[j] + w1[j] * a[j] + w2[j] * n_[j] + cb[j]);
        st8bf(X2 + (size_t)r * 1024 + c16, o);
#pragma unroll
        for (int j = 0; j < 8; ++j) o[j] = siluf_(w0[8 + j] * p_[8 + j] + w1[8 + j] * a[8 + j] + w2[8 + j] * n_[8 + j] + cb[8 + j]);
        st8bf(X2 + (size_t)r * 1024 + c16 + 8, o);
    }
}

__device__ __forceinline__ void phase_scanprep(Frame& F, int l) {
    const int gw = F.vcu * 8 + F.wave, NGW = F.G * 8, lane = F.lane, r32 = lane & 31, hi = lane >> 5;
    const GAS bf16_t* U = WSP(bf16_t, WS_RA);
    constexpr int N_ML = 64 * 72, N_SSD = 64 * 72, N_HG = 64 * 72 * 2, N_MLC = 32 * 72;
    for (int it = gw; it < N_ML + N_SSD + N_HG + N_MLC; it += NGW) {
        if (it >= N_ML + N_SSD + N_HG) {
            const int q = it - (N_ML + N_SSD + N_HG), cg = q % 72, bh = q / 72, b = bh >> 2, h = bh & 3;
            GAS bf16_t* dst = WSP(bf16_t, WS_MLC) + ((size_t)bh * 2304 + 32 * cg) * 384;
#pragma unroll 1
            for (int ib = 0; ib < 3; ++ib) { u32x4 v[8];
#pragma unroll
                for (int i = 0; i < 8; ++i) { const int piece = (ib * 8 + i) * 64 + lane, rr = piece / 48, pc = piece % 48, ci = 32 * cg + rr;
                    const int trow = ci < CTXL ? ML + b * CTXL + ci : b * SEQ + (ci - CTXL);
                    v[i] = *(const GAS u32x4*)(U + (size_t)trow * NU + (pc >> 4) * 512 + h * 128 + (pc & 15) * 8); }
#pragma unroll
                for (int i = 0; i < 8; ++i) { const int piece = (ib * 8 + i) * 64 + lane; *(GAS u32x4*)(dst + (size_t)piece * 8) = v[i]; } }
            continue;
        }
        if (it < N_ML) {
            const int c = it % 72, task = it / 72, b = task >> 3, h = (task >> 1) & 3, dir = task & 1, cg = U_MLG + dir * 8 + h;
            const float fbias = INP(I_MLFB)[l * 8 + dir * 4 + h];
            const GAS bf16_t* gp = U + (size_t)prow(b, dir, 32 * c + r32) * NU + cg; const float gi = bf2f(gp[0]), gf = bf2f(gp[4]);
            const float x_ = gf + fbias, flog = fminf(x_, 0.f) - log1pf(__expf(-fabsf(x_)));
            const float Fl = scn::scan_add32(flog, r32), bl = gi - Fl, Ml = scn::scan_max32(bl, r32);
            if (hi == 0) *(GAS f32x4*)(WSP(float, WS_MLS) + ((size_t)task * 2304 + 32 * c + r32) * 8) = (f32x4){Fl, bl, Ml, 0.f};
        } else if (it < N_ML + N_SSD) {
            const int q = it - N_ML, c = q % 72, t3 = q / 72, b = t3 >> 3, hp = (t3 >> 1) & 3, dir = t3 & 1, hd = 2 * hp + hi;
            const float dtb = INP(I_DTB)[l * 16 + dir * 8 + hd], aneg = -__expf(INP(I_ALOG)[l * 16 + dir * 8 + hd]);
            const float xr_ = bf2f(U[(size_t)prow(b, dir, 32 * c + r32) * NU + U_DT + dir * 8 + hd]) + dtb;
            const float dt_ = fmaxf(xr_, 0.f) + log1pf(__expf(-fabsf(xr_))), at = scn::scan_add32(dt_ * aneg, r32), ae = __shfl(at, 31, 32);
            GAS float* rp = WSP(float, WS_SSDS) + ((size_t)((b * 2 + dir) * 8 + hd) * 2304 + 32 * c + r32) * 8;
            *(GAS f32x4*)rp = (f32x4){dt_, at, __expf(at), __expf(ae - at)}; *(GAS f32x4*)(rp + 4) = (f32x4){__expf(ae), 0.f, 0.f, 0.f};
        } else {
            const int q = it - N_ML - N_SSD, half = q & 1, c = (q >> 1) % 72, task = (q >> 1) / 72, b = task >> 3, h = (task >> 1) & 3, dir = task & 1, r16 = lane >> 2, ch0 = half * 64 + 16 * (lane & 3);
            GAS unsigned char* item = F.ws + WS_HGP + (size_t)(task * 72 + c) * HGP_ITEM;
            const GAS float* lbp = WSP(float, WS_TAB) + 2048 + l * 512 + h * 128 + ch0;
            float lb[16], cc[16], ee[16];
            u32x4 raw[2][4];
#pragma unroll
            for (int rb = 0; rb < 2; ++rb) { const GAS bf16_t* up = U + (size_t)prow(b, dir, 32 * c + rb * 16 + r16) * NU;
                raw[rb][0] = *(const GAS u32x4*)(up + U_HGF + dir * 512 + h * 128 + ch0); raw[rb][1] = *(const GAS u32x4*)(up + U_HGF + dir * 512 + h * 128 + ch0 + 8);
                raw[rb][2] = *(const GAS u32x4*)(up + U_HGQ + h * 128 + ch0); raw[rb][3] = *(const GAS u32x4*)(up + U_HGQ + h * 128 + ch0 + 8); }
#pragma unroll
            for (int j = 0; j < 16; ++j) { lb[j] = lbp[j]; cc[j] = 0.f; ee[j] = 0.f; }
#pragma unroll
            for (int rb = 0; rb < 2; ++rb) {
                const int rloc = rb * 16 + r16;
                float fa[8], fb[8], qa[8], qb[8], q1[16], k1[16];
                unpk8(fa, raw[rb][0]); unpk8(fb, raw[rb][1]); unpk8(qa, raw[rb][2]); unpk8(qb, raw[rb][3]);
#pragma unroll
                for (int j = 0; j < 16; ++j) {
                    const float fr_ = j < 8 ? fa[j & 7] : fb[j & 7], qr_ = j < 8 ? qa[j & 7] : qb[j & 7];
                    const float f_ = lb[j] + (1.f - lb[j]) * __builtin_amdgcn_rcpf(1.f + __expf(-fr_)); float x_ = __logf(f_);
                    { const float o = __shfl_up(x_, 4); if (lane >= 4) x_ += o; } { const float o = __shfl_up(x_, 8); if (lane >= 8) x_ += o; }
                    { const float o = __shfl_up(x_, 16); if (lane >= 16) x_ += o; } { const float o = __shfl_up(x_, 32); if (lane >= 32) x_ += o; }
                    const float tot = __shfl(x_, 60 + (lane & 3));
                    float g_;
                    if (rb == 0) { cc[j] = tot; g_ = x_; } else { g_ = cc[j] + x_; ee[j] = cc[j] + tot; }
                    const float e1 = __expf(g_ - cc[j]);
                    q1[j] = qr_ * __builtin_amdgcn_rcpf(1.f + __expf(-qr_)) * e1; k1[j] = (1.f - f_) * __builtin_amdgcn_rcpf(e1);
                }
                float t8[8];
#pragma unroll
                for (int j = 0; j < 8; ++j) t8[j] = q1[j]; st8bf((GAS bf16_t*)(item + scn::rowl(rloc, ch0 * 2)), t8);
#pragma unroll
                for (int j = 0; j < 8; ++j) t8[j] = q1[8 + j]; st8bf((GAS bf16_t*)(item + scn::rowl(rloc, ch0 * 2 + 16)), t8);
#pragma unroll
                for (int j = 0; j < 8; ++j) t8[j] = k1[j]; st8bf((GAS bf16_t*)(item + 8192 + scn::rowl(rloc, ch0 * 2)), t8);
#pragma unroll
                for (int j = 0; j < 8; ++j) t8[j] = k1[8 + j]; st8bf((GAS bf16_t*)(item + 8192 + scn::rowl(rloc, ch0 * 2 + 16)), t8);
            }
            if (r16 == 0) { GAS float* vv = (GAS float*)(item + 16384) + ch0;
#pragma unroll
                for (int j = 0; j < 16; ++j) { vv[j] = __expf(cc[j]); vv[128 + j] = __expf(ee[j] - cc[j]); } }
        }
    }
}
constexpr size_t CTL_CNTB = 131072;
__device__ __forceinline__ void phase_route(Frame& F, int l, int mrows, const XcdBarrier& bar) {
    unsigned* cnt = F.ctl + CW_CNT + l * 64;
    GAS int* list = WSP(int, WS_LIST); GAS float* wl = WSP(float, WS_WL);
    GAS int* cntb = (GAS int*)(F.ws + WS_CTL + CTL_CNTB) + (size_t)l * 1024 * 32;
    LAS int* ch = (LAS int*)F.lds;
    LAS int* off = ch + 1024;
    LAS int* part = ch + 2048;
    LAS int* base = ch + 2048 + 1024;
    const int t = F.tid, bx = F.vcu, G = F.G;
    const int rpb = (mrows + G - 1) / G, r = bx * rpb + t; const bool act = t < rpb && r < mrows;
    int ea = -1, eb = -1; float wa = 0.f, wb = 0.f;
    if (act) {
        const GAS float* lg0 = WSP(float, WS_LOG) + (size_t)r * 64;
        f32x4 lgv[9];
#pragma unroll
        for (int q = 0; q < 9; ++q) { lgv[q] = *(const GAS f32x4*)(lg0 + 4 * q);
#pragma unroll
            for (int ks = 1; ks < 4; ++ks) lgv[q] += *(const GAS f32x4*)(lg0 + (size_t)ks * MT * 64 + 4 * q); }
        const f32x4 g = lgv[0]; int gi = 0; float gm = g[0];
#pragma unroll
        for (int i = 1; i < 4; ++i) if (g[i] > gm) { gm = g[i]; gi = i; }
        float gs = 0.f;
#pragma unroll
        for (int i = 0; i < 4; ++i) gs += __expf(g[i] - gm);
        const float gp = 1.f / gs;
        f32x4 e0 = lgv[1], e1 = lgv[2];
        if (gi == 1) { e0 = lgv[3]; e1 = lgv[4]; } else if (gi == 2) { e0 = lgv[5]; e1 = lgv[6]; } else if (gi == 3) { e0 = lgv[7]; e1 = lgv[8]; }
        float ev[8] = {e0[0], e0[1], e0[2], e0[3], e1[0], e1[1], e1[2], e1[3]};
        int i1 = 0; float v1 = ev[0];
#pragma unroll
        for (int i = 1; i < 8; ++i) if (ev[i] > v1) { v1 = ev[i]; i1 = i; }
        int i2 = -1; float v2 = -3.4e38f;
#pragma unroll
        for (int i = 0; i < 8; ++i) if (i != i1 && ev[i] > v2) { v2 = ev[i]; i2 = i; }
        const float w1 = 1.f / (1.f + __expf(v2 - v1)), w2 = 1.f - w1;
        ea = gi * 8 + i1; eb = gi * 8 + i2; wa = w1 * gp; wb = w2 * gp;
    }
    ch[2 * t] = ea; ch[2 * t + 1] = eb;
    __syncthreads();
    if (t < 32) {
        int c = 0; const int n2 = 2 * (rpb < 512 ? rpb : 512);
#pragma unroll 8
        for (int i = 0; i < n2; ++i) { if (ch[i] == t) { off[i] = c; ++c; } }
        cntb[bx * 32 + t] = c;
    }
    xcd_barrier(bar);
    { const int e = t & 31, p = t >> 5; int sp = 0, sa = 0;
      for (int b2 = p; b2 < G; b2 += 16) { const int c = cntb[b2 * 32 + e]; sa += c; sp += b2 < bx ? c : 0; }
      part[p * 32 + e] = sp; part[512 + p * 32 + e] = sa; }
    __syncthreads();
    if (t < 32) { int sp = 0, sa = 0;
#pragma unroll
        for (int p = 0; p < 16; ++p) { sp += part[p * 32 + t]; sa += part[512 + p * 32 + t]; }
        base[t] = sp; if (bx == 0) cnt[t] = (unsigned)sa; }
    __syncthreads();
    if (act) { const int pa = base[ea] + off[2 * t], pb = base[eb] + off[2 * t + 1];
        list[(size_t)ea * MT + pa] = r * 2; wl[(size_t)ea * MT + pa] = wa;
        list[(size_t)eb * MT + pb] = r * 2 + 1; wl[(size_t)eb * MT + pb] = wb; }
    __syncthreads();
}
__device__ __forceinline__ void moe_tables(Frame& F, int l) {
    __syncthreads();
    if (F.tid < 32) F.MISC[64 + F.tid] = __hip_atomic_load(F.ctl + CW_CNT + l * 64 + F.tid, __ATOMIC_RELAXED, __HIP_MEMORY_SCOPE_AGENT);
    __syncthreads();
    if (F.tid == 0) { int s = 0; for (int e = 0; e < 32; ++e) { F.MISC[16 + e] = s; s += ((int)F.MISC[64 + e] + 255) >> 8; } F.MISC[48] = s; }
    __syncthreads();
}

constexpr int NSTEP = CTXL + SEQ;
namespace scn {
enum { K_ML = 0, K_HG = 1, K_SSD = 2 };
constexpr int GRP_BYTES = 65536, O_QT = 0, O_KT = 8192, O_QH = 16384, O_KH = 24576, O_VT = 34816, O_VH = 45056, O_SC = 55296, O_N = 59392, O_TOT = 60416;
constexpr int NCH = (CTXL + SEQ) / 32;
__device__ __forceinline__ int crow(int r, int hi) { return (r & 3) + 8 * (r >> 2) + 4 * hi; }
template <int OFF> __device__ __forceinline__ s16x4 trr(int base) { s16x4 r; asm volatile("ds_read_b64_tr_b16 %0, %1 offset:%2" : "=&v"(r) : "v"(base), "i"(OFF) : "memory"); return r; }
#define SCN_PK(L, H) (bf16x8){L[0], L[1], L[2], L[3], H[0], H[1], H[2], H[3]}
template <int S1, int CB> __device__ __forceinline__ bf16x8 trfrag(int base) { const s16x4 lo = trr<S1 * 5120 + CB * 2>(base), hi_ = trr<S1 * 5120 + 2560 + CB * 2>(base); return SCN_PK(lo, hi_); }
__device__ __forceinline__ void unpack8(float (&o)[8], u32x4 w) { o[0] = bflo(w.x); o[1] = bfhi(w.x); o[2] = bflo(w.y); o[3] = bfhi(w.y); o[4] = bflo(w.z); o[5] = bfhi(w.z); o[6] = bflo(w.w); o[7] = bfhi(w.w); }
__device__ __forceinline__ u32x4 pack8(const float (&v)[8]) { u32x4 w; w.x = cvt_pk_bf16(v[0], v[1]); w.y = cvt_pk_bf16(v[2], v[3]); w.z = cvt_pk_bf16(v[4], v[5]); w.w = cvt_pk_bf16(v[6], v[7]); return w; }

template <int KIND>
__device__ __forceinline__ void scan_block(Frame& F, int l, int task) {
    const int tid = F.tid, wave = F.wave, lane = tid & 63, grp = wave >> 2, vb = wave & 3, gt = tid & 255, r32 = lane & 31, hi = lane >> 5;
    LAS char* L = (LAS char*)F.lds + grp * GRP_BYTES;
    const int Lb = (int)(uintptr_t)L;
    const int b = task >> 3, hx = (task >> 1) & 3, dir = task & 1;
    const int srow = gt >> 3, sp = gt & 7;
    const GAS bf16_t* U = WSP(bf16_t, WS_RA); const GAS bf16_t* X2 = WSP(bf16_t, WS_XBC);
    GAS bf16_t* YO = WSP(bf16_t, WS_YFB) + (size_t)(KIND * 2 + dir) * MT * 512;
    LAS float* SC = (LAS float*)(L + O_SC);
    int cq = 0, ck = 0, cv = 0;
    const GAS float* recA = nullptr; const GAS float* recB = nullptr; const GAS unsigned char* hgp = nullptr; const GAS bf16_t* mlc = nullptr;
    if constexpr (KIND == K_ML) { cq = U_MLQ + hx * 128 + 16 * sp; ck = U_MLK + hx * 128 + 16 * sp; cv = U_MLV + hx * 128 + 16 * sp;
        recA = WSP(float, WS_MLS) + (size_t)task * 2304 * 8; recB = recA; mlc = WSP(bf16_t, WS_MLC) + (size_t)(b * 4 + hx) * 2304 * 384; }
    if constexpr (KIND == K_HG) { cv = U_HGI + hx * 128 + 16 * sp; hgp = F.ws + WS_HGP + (size_t)task * 72 * HGP_ITEM; }
    if constexpr (KIND == K_SSD) { const int g = hx >> 1; cq = 768 + g * 128 + 16 * sp; ck = 512 + g * 128 + 16 * sp; cv = hx * 128 + 16 * sp;
        recA = WSP(float, WS_SSDS) + (size_t)((b * 2 + dir) * 8 + 2 * hx + (sp >> 2)) * 2304 * 8;
        recB = WSP(float, WS_SSDS) + (size_t)((b * 2 + dir) * 8 + 2 * hx + hi) * 2304 * 8; }
    f32x16 S[4];
#pragma unroll
    for (int k = 0; k < 4; ++k)
#pragma unroll
        for (int r = 0; r < 16; ++r) S[k][r] = 0.f;
    if (KIND == K_ML) { LAS float* nn = (LAS float*)(L + O_N); nn[gt] = 0.f; }
    float Fs = 0.f, Bp = -INFINITY;
    const int i16 = lane & 15, g4 = lane >> 4;
    const int trb = Lb + (4 * hi + (i16 >> 2)) * 320 + (16 * (g4 & 1) + 4 * (i16 & 3)) * 2;
    struct Pre { u32x4 a0, a1, b0, b1, c0, c1; f32x4 sA, sB; float g1; }; Pre P0;
#define SCN_LOAD(P, c_) do { const int c__ = (c_); const int row_ = prow(b, dir, 32 * c__ + srow); \
        if constexpr (KIND == K_SSD) { const GAS bf16_t* xp = X2 + (size_t)row_ * 1024; P.a0 = *(const GAS u32x4*)(xp + cq); P.a1 = *(const GAS u32x4*)(xp + cq + 8); P.b0 = *(const GAS u32x4*)(xp + ck); P.b1 = *(const GAS u32x4*)(xp + ck + 8); P.c0 = *(const GAS u32x4*)(xp + cv); P.c1 = *(const GAS u32x4*)(xp + cv + 8); \
            P.sA = *(const GAS f32x4*)(recA + (size_t)(32 * c__ + srow) * 8); P.sB = *(const GAS f32x4*)(recB + (size_t)(32 * c__ + r32) * 8); P.g1 = recB[(size_t)(32 * c__ + r32) * 8 + 4]; } \
        else if constexpr (KIND == K_ML) { const int p__ = 32 * c__ + srow; const int ci_ = p__ < CTXL ? (dir ? CTXL - 1 - p__ : p__) : CTXL + (dir ? SEQ - 1 - (p__ - CTXL) : p__ - CTXL); \
            const GAS bf16_t* up = mlc + (size_t)ci_ * 384 + 16 * sp; P.a0 = *(const GAS u32x4*)(up); P.a1 = *(const GAS u32x4*)(up + 8); P.b0 = *(const GAS u32x4*)(up + 128); P.b1 = *(const GAS u32x4*)(up + 136); P.c0 = *(const GAS u32x4*)(up + 256); P.c1 = *(const GAS u32x4*)(up + 264); \
            P.sA = *(const GAS f32x4*)(recA + (size_t)(32 * c__ + srow) * 8); P.sB = *(const GAS f32x4*)(recB + (size_t)(32 * c__ + r32) * 8); } \
        else { const GAS unsigned char* it_ = hgp + (size_t)c__ * HGP_ITEM; const int ra_ = rowl(srow, 32 * sp), rb_ = rowl(srow, 32 * sp + 16); \
            P.a0 = *(const GAS u32x4*)(it_ + ra_); P.a1 = *(const GAS u32x4*)(it_ + rb_); P.b0 = *(const GAS u32x4*)(it_ + 8192 + ra_); P.b1 = *(const GAS u32x4*)(it_ + 8192 + rb_); \
            const GAS bf16_t* up = U + (size_t)row_ * NU; P.c0 = *(const GAS u32x4*)(up + cv); P.c1 = *(const GAS u32x4*)(up + cv + 8); \
            if (gt < 64) P.sA = *(const GAS f32x4*)((const GAS float*)(it_ + 16384) + 4 * gt); } } while (0)
#define SCN_STAGE(P, NPAR) do { \
        const int ra = rowl(srow, 32 * sp), rb = rowl(srow, 32 * sp + 16), ta = srow * 320 + 32 * sp; \
        *(LAS u32x4*)(L + O_QT + ra) = P.a0; *(LAS u32x4*)(L + O_QT + rb) = P.a1; *(LAS u32x4*)(L + O_KT + ra) = P.b0; *(LAS u32x4*)(L + O_KT + rb) = P.b1; \
        if constexpr (KIND == K_ML) { \
            const float Fle = __shfl(P.sB[0], 31, 32), Mle = __shfl(P.sB[2], 31, 32);         \
            const float bt = P.sB[1] - Fs, Bt = fmaxf(Bp, P.sB[2] - Fs), Be = fmaxf(Bp, Mle - Fs); \
            if (vb == 0 && hi == 0) { SC[r32] = bt; SC[32 + r32] = Bt; SC[64 + r32] = __expf(Bp - Bt); SC[96 + r32] = __expf(-(Fs + P.sB[0] + Bt)); if (r32 == 0) SC[128] = __expf(Bp - Be); } \
            const float win = __expf(P.sA[1] - Fs - Be); Fs += Fle; Bp = Be; \
            { LAS const float* nq = (LAS const float*)(L + O_N) + (NPAR) * 128 + 16 * sp;        \
              const f32x4 n0 = *(const LAS f32x4*)(nq), n1 = *(const LAS f32x4*)(nq + 4), n2 = *(const LAS f32x4*)(nq + 8), n3 = *(const LAS f32x4*)(nq + 12); \
              float qa[8], qb[8]; unpack8(qa, P.a0); unpack8(qb, P.a1); \
              float d = ((qa[0] * n0[0] + qa[1] * n0[1]) + (qa[2] * n0[2] + qa[3] * n0[3])) + ((qa[4] * n1[0] + qa[5] * n1[1]) + (qa[6] * n1[2] + qa[7] * n1[3])) \
                      + ((qb[0] * n2[0] + qb[1] * n2[1]) + (qb[2] * n2[2] + qb[3] * n2[3])) + ((qb[4] * n3[0] + qb[5] * n3[1]) + (qb[6] * n3[2] + qb[7] * n3[3])); \
              d += __shfl_xor(d, 1); d += __shfl_xor(d, 2); d += __shfl_xor(d, 4); \
              if (sp == 0) SC[160 + srow] = d; } \
            float ka[8], kb_[8]; unpack8(ka, P.b0); unpack8(kb_, P.b1); \
            _Pragma("unroll") for (int j = 0; j < 8; ++j) { ka[j] *= win; kb_[j] *= win; } \
            *(LAS u32x4*)(L + O_KH + ta) = pack8(ka); *(LAS u32x4*)(L + O_KH + ta + 16) = pack8(kb_); *(LAS u32x4*)(L + O_VT + ta) = P.c0; *(LAS u32x4*)(L + O_VT + ta + 16) = P.c1; \
        } else if constexpr (KIND == K_SSD) { \
            if (vb == 0) { SC[hi * 32 + r32] = P.sB[1]; SC[64 + hi * 32 + r32] = P.sB[2]; if (r32 == 0) SC[128 + hi] = P.g1; } \
            const float dts = P.sA[0], vsc = P.sA[3]; float va[8], vb_[8]; unpack8(va, P.c0); unpack8(vb_, P.c1); \
            *(LAS u32x4*)(L + O_KH + ta) = P.b0; *(LAS u32x4*)(L + O_KH + ta + 16) = P.b1; \
            _Pragma("unroll") for (int j = 0; j < 8; ++j) { va[j] *= dts; vb_[j] *= dts; } \
            *(LAS u32x4*)(L + O_VT + ta) = pack8(va); *(LAS u32x4*)(L + O_VT + ta + 16) = pack8(vb_); \
            _Pragma("unroll") for (int j = 0; j < 8; ++j) { va[j] *= vsc; vb_[j] *= vsc; } \
            *(LAS u32x4*)(L + O_VH + ta) = pack8(va); *(LAS u32x4*)(L + O_VH + ta + 16) = pack8(vb_); \
        } else { \
            *(LAS u32x4*)(L + O_KH + ta) = P.b0; *(LAS u32x4*)(L + O_KH + ta + 16) = P.b1; *(LAS u32x4*)(L + O_VT + ta) = P.c0; *(LAS u32x4*)(L + O_VT + ta + 16) = P.c1; \
            if (gt < 64) *(LAS f32x4*)(SC + 4 * gt) = P.sA; \
        } } while (0)
    constexpr int OQH = O_QT, OVH = (KIND == K_SSD) ? O_VH : O_VT;
    auto compute = [&](const int c) __attribute__((always_inline)) {
        const int hh = vb >> 1;
        if constexpr (KIND == K_HG) {
#pragma unroll
            for (int kb = 0; kb < 4; ++kb)
#pragma unroll
                for (int r = 0; r < 16; ++r) S[kb][r] *= SC[32 * kb + crow(r, hi)];
        }
        f32x16 acc;
#pragma unroll
        for (int r = 0; r < 16; ++r) acc[r] = 0.f;
        if (c > 0) {
#pragma unroll
            for (int kb = 0; kb < 4; ++kb)
#pragma unroll
                for (int s1 = 0; s1 < 2; ++s1) {
                    u32x4 aw; aw.x = cvt_pk_bf16(S[kb][8 * s1 + 0], S[kb][8 * s1 + 1]); aw.y = cvt_pk_bf16(S[kb][8 * s1 + 2], S[kb][8 * s1 + 3]); aw.z = cvt_pk_bf16(S[kb][8 * s1 + 4], S[kb][8 * s1 + 5]); aw.w = cvt_pk_bf16(S[kb][8 * s1 + 6], S[kb][8 * s1 + 7]);
                    const int cb0 = (32 * kb + 16 * s1 + 4 * hi) * 2;
                    const u32x2 lo = *(const LAS u32x2*)(L + OQH + rowl(r32, cb0)), hi2 = *(const LAS u32x2*)(L + OQH + rowl(r32, cb0 + 16));
                    const u32x4 bw = {lo.x, lo.y, hi2.x, hi2.y};
                    acc = __builtin_amdgcn_mfma_f32_32x32x16_bf16(__builtin_bit_cast(bf16x8, aw), __builtin_bit_cast(bf16x8, bw), acc, 0, 0, 0);
                }
            if constexpr (KIND == K_ML) { const float w = SC[64 + r32];
#pragma unroll
                for (int r = 0; r < 16; ++r) acc[r] *= w; }
            if constexpr (KIND == K_SSD) { const float w = SC[64 + hh * 32 + r32];
#pragma unroll
                for (int r = 0; r < 16; ++r) acc[r] *= w; }
        }
        f32x16 p;
#pragma unroll
        for (int r = 0; r < 16; ++r) p[r] = 0.f;
#pragma unroll
        for (int kk = 0; kk < 8; ++kk) { const int cb0 = (16 * kk + 8 * hi) * 2;
            const bf16x8 a = *(const LAS bf16x8*)(L + O_KT + rowl(r32, cb0)), bq = *(const LAS bf16x8*)(L + O_QT + rowl(r32, cb0));
            p = __builtin_amdgcn_mfma_f32_32x32x16_bf16(a, bq, p, 0, 0, 0); }
        float den = 0.f;
        if constexpr (KIND == K_ML) { const float Bt = SC[32 + r32];
            f32x4 bs4[4];
#pragma unroll
            for (int q = 0; q < 4; ++q) bs4[q] = *(const LAS f32x4*)(SC + 8 * q + 4 * hi);
#pragma unroll
            for (int r = 0; r < 16; ++r) { const int s_ = crow(r, hi); float w = __expf(fminf(bs4[r >> 2][r & 3] - Bt, 0.f)); w = s_ <= r32 ? w : 0.f; p[r] *= w; den += p[r]; }
            { auto rr = __builtin_amdgcn_permlane32_swap(__float_as_uint(den), __float_as_uint(den), false, false); den = __uint_as_float(rr[0]) + __uint_as_float(rr[1]); }
        } else if constexpr (KIND == K_SSD) { const float at = SC[hh * 32 + r32];
            f32x4 as_[4];
#pragma unroll
            for (int q = 0; q < 4; ++q) as_[q] = *(const LAS f32x4*)(SC + hh * 32 + 8 * q + 4 * hi);
#pragma unroll
            for (int r = 0; r < 16; ++r) { const int s_ = crow(r, hi); float w = __expf(fminf(at - as_[r >> 2][r & 3], 0.f)); p[r] *= s_ <= r32 ? w : 0.f; }
        } else {
#pragma unroll
            for (int r = 0; r < 16; ++r) { if (crow(r, hi) > r32) p[r] = 0.f; }
        }
        {
            u32x4 w0, w1; w0.x = cvt_pk_bf16(p[0], p[1]); w0.y = cvt_pk_bf16(p[2], p[3]); w0.z = cvt_pk_bf16(p[4], p[5]); w0.w = cvt_pk_bf16(p[6], p[7]);
            w1.x = cvt_pk_bf16(p[8], p[9]); w1.y = cvt_pk_bf16(p[10], p[11]); w1.z = cvt_pk_bf16(p[12], p[13]); w1.w = cvt_pk_bf16(p[14], p[15]);
            const int vbase = trb + O_VT + vb * 64;
            const bf16x8 v0 = trfrag<0, 0>(vbase), v1 = trfrag<1, 0>(vbase);
            asm volatile("s_waitcnt lgkmcnt(0)" ::: "memory"); __builtin_amdgcn_sched_barrier(0);
            acc = __builtin_amdgcn_mfma_f32_32x32x16_bf16(v0, __builtin_bit_cast(bf16x8, w0), acc, 0, 0, 0);
            acc = __builtin_amdgcn_mfma_f32_32x32x16_bf16(v1, __builtin_bit_cast(bf16x8, w1), acc, 0, 0, 0);
        }
        float oscale = 1.f;
        if constexpr (KIND == K_ML) {
            LAS const float* nn = (LAS const float*)(L + O_N) + (c & 1) * 128;
            const float ds = SC[160 + r32] * SC[64 + r32];
            oscale = __builtin_amdgcn_rcpf(fmaxf(fabsf(den + ds), SC[96 + r32]));
            { const int k = 32 * vb + r32; float sm = 0.f;
#pragma unroll
              for (int s_ = 0; s_ < 16; ++s_) sm += bf2f(*(const LAS bf16_t*)(L + O_KH + (16 * hi + s_) * 320 + k * 2));
              { auto rr = __builtin_amdgcn_permlane32_swap(__float_as_uint(sm), __float_as_uint(sm), false, false); sm = __uint_as_float(rr[0]) + __uint_as_float(rr[1]); }
              LAS float* n2 = (LAS float*)(L + O_N) + ((c + 1) & 1) * 128;
              if (hi == 0) n2[k] = SC[128] * nn[k] + sm; }
        }
        { const int orow = prow(b, dir, 32 * c + r32); GAS bf16_t* yp = YO + (size_t)orow * 512 + hx * 128 + 32 * vb + 4 * hi;
#pragma unroll
          for (int q = 0; q < 4; ++q) { u32x2 w; w.x = cvt_pk_bf16(acc[4 * q] * oscale, acc[4 * q + 1] * oscale); w.y = cvt_pk_bf16(acc[4 * q + 2] * oscale, acc[4 * q + 3] * oscale); *(GAS u32x2*)(yp + 8 * q) = w; } }
        {
            const int kbase = trb + O_KH, vbase = trb + OVH + vb * 64;
            const bf16x8 vh0 = trfrag<0, 0>(vbase), vh1 = trfrag<1, 0>(vbase);
            const bf16x8 k00 = trfrag<0, 0>(kbase), k01 = trfrag<1, 0>(kbase), k10 = trfrag<0, 32>(kbase), k11 = trfrag<1, 32>(kbase);
            const bf16x8 k20 = trfrag<0, 64>(kbase), k21 = trfrag<1, 64>(kbase), k30 = trfrag<0, 96>(kbase), k31 = trfrag<1, 96>(kbase);
            if constexpr (KIND != K_HG) { const float rd = KIND == K_ML ? SC[128] : SC[128 + hh];
#pragma unroll
                for (int kb = 0; kb < 4; ++kb)
#pragma unroll
                    for (int r = 0; r < 16; ++r) S[kb][r] *= rd; }
            asm volatile("s_waitcnt lgkmcnt(0)" ::: "memory"); __builtin_amdgcn_sched_barrier(0);
            S[0] = __builtin_amdgcn_mfma_f32_32x32x16_bf16(k00, vh0, S[0], 0, 0, 0); S[0] = __builtin_amdgcn_mfma_f32_32x32x16_bf16(k01, vh1, S[0], 0, 0, 0);
            S[1] = __builtin_amdgcn_mfma_f32_32x32x16_bf16(k10, vh0, S[1], 0, 0, 0); S[1] = __builtin_amdgcn_mfma_f32_32x32x16_bf16(k11, vh1, S[1], 0, 0, 0);
            S[2] = __builtin_amdgcn_mfma_f32_32x32x16_bf16(k20, vh0, S[2], 0, 0, 0); S[2] = __builtin_amdgcn_mfma_f32_32x32x16_bf16(k21, vh1, S[2], 0, 0, 0);
            S[3] = __builtin_amdgcn_mfma_f32_32x32x16_bf16(k30, vh0, S[3], 0, 0, 0); S[3] = __builtin_amdgcn_mfma_f32_32x32x16_bf16(k31, vh1, S[3], 0, 0, 0);
            if constexpr (KIND == K_HG) {
#pragma unroll
                for (int kb = 0; kb < 4; ++kb)
#pragma unroll
                    for (int r = 0; r < 16; ++r) S[kb][r] *= SC[128 + 32 * kb + crow(r, hi)];
            }
        }
    };
    {
        SCN_LOAD(P0, 0);
        __syncthreads();
        SCN_STAGE(P0, 0);
        __syncthreads();
        for (int c = 0; c < NCH; ++c) {
            if (c + 1 < NCH) SCN_LOAD(P0, c + 1);
            compute(c);
            __syncthreads();
            if (c + 1 < NCH) { SCN_STAGE(P0, (c + 1) & 1); }
            __syncthreads();
        }
    }
#undef SCN_LOAD
#undef SCN_STAGE
}
}

namespace att {
constexpr int KVBLK = 64, SHM_V = 64 * 128 * 2, SHM_K = 64 * 192 * 2;
constexpr float THRL = 11.5f;
#define AKSWZ(row, colB) ((row) * 384 + ((colB) ^ (((row) & 7) << 4)))
#define ASBAR() __builtin_amdgcn_sched_barrier(0)
__device__ __forceinline__ int crow(int r, int hi) { return (r & 3) + 8 * (r >> 2) + 4 * hi; }
__device__ __forceinline__ void partialSM(f32x16& p0, f32x16& p1, float& m_reg, float& mn, float& alpha) {
    float pmax = p0[0];
#pragma unroll
    for (int r = 1; r < 16; ++r) pmax = fmaxf(pmax, p0[r]);
#pragma unroll
    for (int r = 0; r < 16; ++r) pmax = fmaxf(pmax, p1[r]);
    { auto rr = __builtin_amdgcn_permlane32_swap(__float_as_uint(pmax), __float_as_uint(pmax), false, false); pmax = fmaxf(__uint_as_float(rr[0]), __uint_as_float(rr[1])); }
    if (__builtin_expect(__all(pmax - m_reg <= THRL), 1)) { mn = m_reg; alpha = 1.f; }
    else { mn = fmaxf(m_reg, pmax); alpha = __builtin_amdgcn_exp2f(m_reg - mn); m_reg = mn; }
#pragma unroll
    for (int r = 0; r < 16; ++r) p0[r] = __builtin_amdgcn_exp2f(p0[r] - mn);
#pragma unroll
    for (int r = 0; r < 16; ++r) p1[r] = p1[r] - mn;
}
__device__ __forceinline__ void finishSM(f32x16& p0, f32x16& p1, float alpha, float& l_reg, bf16x8& pa0, bf16x8& pa1, bf16x8& pa2, bf16x8& pa3) {
#pragma unroll
    for (int r = 0; r < 16; ++r) p1[r] = __builtin_amdgcn_exp2f(p1[r]);
    float ps = 0;
#pragma unroll
    for (int r = 0; r < 16; ++r) ps += p0[r];
#pragma unroll
    for (int r = 0; r < 16; ++r) ps += p1[r];
    { auto rr = __builtin_amdgcn_permlane32_swap(__float_as_uint(ps), __float_as_uint(ps), false, false); ps = __uint_as_float(rr[0]) + __uint_as_float(rr[1]); }
    l_reg = l_reg * alpha + ps;
#define APK4(P, BASE, OUT) do { unsigned a0 = cvt_pk_bf16(P[BASE + 0], P[BASE + 1]), a1 = cvt_pk_bf16(P[BASE + 2], P[BASE + 3]);   \
    unsigned b0 = cvt_pk_bf16(P[BASE + 4], P[BASE + 5]), b1 = cvt_pk_bf16(P[BASE + 6], P[BASE + 7]);                              \
    auto r0 = __builtin_amdgcn_permlane32_swap(a0, b0, false, false); auto r1 = __builtin_amdgcn_permlane32_swap(a1, b1, false, false); \
    u32x4 w = {r0[0], r1[0], r0[1], r1[1]}; OUT = __builtin_bit_cast(bf16x8, w); } while (0)
    APK4(p0, 0, pa0); APK4(p0, 8, pa1); APK4(p1, 0, pa2); APK4(p1, 8, pa3);
#undef APK4
}
__device__ __forceinline__ void qkt(f32x16& p0, f32x16& p1, const LAS char* Ks, const bf16x8* qr, int r32, int hi) {
    p0 = f32x16{}; p1 = f32x16{};
#pragma unroll
    for (int d0 = 0; d0 < 12; ++d0) { const int cb = (d0 * 16 + hi * 8) * 2;
        const bf16x8 b0 = *(const LAS bf16x8*)(Ks + AKSWZ(r32, cb));
        const bf16x8 b1 = *(const LAS bf16x8*)(Ks + AKSWZ(32 + r32, cb));
        p0 = __builtin_amdgcn_mfma_f32_32x32x16_bf16(b0, qr[d0], p0, 0, 0, 0);
        p1 = __builtin_amdgcn_mfma_f32_32x32x16_bf16(b1, qr[d0], p1, 0, 0, 0); }
}
__device__ __forceinline__ int v_st(int k, int c) { const int kk = (k & ~0xC) | ((k & 4) << 1) | ((k & 8) >> 1); return ((kk >> 3) * 4 + (c >> 5)) * 512 + ((kk & 7) * 32 + (c & 31)) * 2; }
__device__ __forceinline__ int v_rd_base(int lane) { return ((lane & 3) << 3) | (((lane >> 2) & 3) << 6) | (((lane >> 4) & 1) << 5) | (((lane >> 5) & 1) << 8); }
constexpr int v_rd_off(int d0, int ks, int half) { return d0 * 512 + ks * 4096 + half * 2048; }
template <int OFF> __device__ __forceinline__ s16x4 tr_read(int vb) { s16x4 r; asm volatile("ds_read_b64_tr_b16 %0, %1 offset:%2" : "=&v"(r) : "v"(vb), "i"(OFF) : "memory"); return r; }
template <int D0> __device__ __forceinline__ void pv_one(f32x16& od, int vb, bf16x8 pa0, bf16x8 pa1, bf16x8 pa2, bf16x8 pa3) {
    const s16x4 l0 = tr_read<v_rd_off(D0, 0, 0)>(vb), h0 = tr_read<v_rd_off(D0, 0, 1)>(vb), l1 = tr_read<v_rd_off(D0, 1, 0)>(vb), h1 = tr_read<v_rd_off(D0, 1, 1)>(vb);
    const s16x4 l2 = tr_read<v_rd_off(D0, 2, 0)>(vb), h2 = tr_read<v_rd_off(D0, 2, 1)>(vb), l3 = tr_read<v_rd_off(D0, 3, 0)>(vb), h3 = tr_read<v_rd_off(D0, 3, 1)>(vb);
    asm volatile("s_waitcnt lgkmcnt(0)" ::: "memory"); ASBAR();
#define APK(L, H) (bf16x8){L[0], L[1], L[2], L[3], H[0], H[1], H[2], H[3]}
    od = __builtin_amdgcn_mfma_f32_32x32x16_bf16(pa0, APK(l0, h0), od, 0, 0, 0);
    od = __builtin_amdgcn_mfma_f32_32x32x16_bf16(pa1, APK(l1, h1), od, 0, 0, 0);
    od = __builtin_amdgcn_mfma_f32_32x32x16_bf16(pa2, APK(l2, h2), od, 0, 0, 0);
    od = __builtin_amdgcn_mfma_f32_32x32x16_bf16(pa3, APK(l3, h3), od, 0, 0, 0);
#undef APK
}
__device__ __forceinline__ void pv_d0(f32x16* o, int vb, bf16x8 pa0, bf16x8 pa1, bf16x8 pa2, bf16x8 pa3) {
    pv_one<0>(o[0], vb, pa0, pa1, pa2, pa3); pv_one<1>(o[1], vb, pa0, pa1, pa2, pa3); pv_one<2>(o[2], vb, pa0, pa1, pa2, pa3); pv_one<3>(o[3], vb, pa0, pa1, pa2, pa3);
}
__device__ __forceinline__ void attn_unit(const GAS bf16_t* __restrict__ QB, const GAS bf16_t* __restrict__ KVB, const GAS bf16_t* __restrict__ U, GAS unsigned char* __restrict__ BR,
                                          int qrow0, int h, int kctx0, int klat0, int nct, int NT, LAS char* lds) {
    const int tid = opaque_tid(), wid = tid >> 6, lane = tid & 63, r32 = lane & 31, hi = lane >> 5;
    LAS char* V_lds = lds; LAS char* K_lds = lds + 2 * SHM_V;
    LAS float* ws = (LAS float*)(lds + 2 * SHM_V + 2 * SHM_K) + wid * 64; LAS float* li_l = ws; LAS float* al_l = ws + 32;
    float m_reg = -1e30f, l_reg = 0; f32x16 o[4] = {}; bf16x8 qr[12];
    const GAS bf16_t* Qw = QB + (size_t)(qrow0 + wid * 32 + r32) * 768;
#pragma unroll
    for (int d0 = 0; d0 < 8; ++d0) qr[d0] = *(const GAS bf16x8*)(Qw + h * 128 + d0 * 16 + hi * 8);
#pragma unroll
    for (int d0 = 8; d0 < 12; ++d0) qr[d0] = *(const GAS bf16x8*)(Qw + 512 + h * 64 + (d0 - 8) * 16 + hi * 8);
    const int sr = tid >> 4, sc = (tid & 15) * 8, vst0 = v_st(sr, sc), vst1 = v_st(32 + sr, sc), rr_ = tid >> 3, rc_ = (tid & 7) * 8;
    const int vb0 = (int)(uintptr_t)V_lds + v_rd_base(lane);
    struct { bf16x8 vs0, vs1, ks0, ks1, kr; } sr_[1];
#define ASLOAD(i, j_) do { const int j__ = (j_); const int k0 = j__ < nct ? kctx0 + 64 * j__ : klat0 + 64 * (j__ - nct); \
    sr_[i].vs0 = *(const GAS bf16x8*)(KVB + (size_t)(k0 + sr) * 1024 + 512 + h * 128 + sc); sr_[i].vs1 = *(const GAS bf16x8*)(KVB + (size_t)(k0 + 32 + sr) * 1024 + 512 + h * 128 + sc); \
    sr_[i].ks0 = *(const GAS bf16x8*)(KVB + (size_t)(k0 + sr) * 1024 + h * 128 + sc); sr_[i].ks1 = *(const GAS bf16x8*)(KVB + (size_t)(k0 + 32 + sr) * 1024 + h * 128 + sc); \
    sr_[i].kr = *(const GAS bf16x8*)(U + (size_t)(k0 + rr_) * NU + U_KR + rc_); } while (0)
#define ASWRITE(b, i) do { *(LAS bf16x8*)(V_lds + (b) * SHM_V + vst0) = sr_[i].vs0; *(LAS bf16x8*)(V_lds + (b) * SHM_V + vst1) = sr_[i].vs1; \
    *(LAS bf16x8*)(K_lds + (b) * SHM_K + AKSWZ(sr, sc * 2)) = sr_[i].ks0; *(LAS bf16x8*)(K_lds + (b) * SHM_K + AKSWZ(32 + sr, sc * 2)) = sr_[i].ks1; \
    *(LAS bf16x8*)(K_lds + (b) * SHM_K + AKSWZ(rr_, 256 + rc_ * 2)) = sr_[i].kr; } while (0)
#define ASWAIT() asm volatile("s_waitcnt vmcnt(0)" ::: "memory")
#define ARESC(a) do { if (__any((a) < 1.f)) { if (hi == 0) al_l[r32] = (a); asm volatile("s_waitcnt lgkmcnt(0)" ::: "memory"); \
    _Pragma("unroll") for (int d = 0; d < 4; ++d) _Pragma("unroll") for (int r = 0; r < 16; ++r) o[d][r] *= al_l[crow(r, hi)]; } } while (0)
    f32x16 pA0, pA1; float mnA, alA; bf16x8 pa0, pa1, pa2, pa3;
    ASLOAD(0, 0); asm volatile("s_waitcnt vmcnt(0)" ::: "memory"); ASWRITE(0, 0); __syncthreads();
    for (int j = 0; j < NT; ++j) {
        const int bsel = j & 1;
        if (j + 1 < NT) ASLOAD(0, j + 1);
        ASBAR(); qkt(pA0, pA1, K_lds + bsel * SHM_K, qr, r32, hi);
        partialSM(pA0, pA1, m_reg, mnA, alA);
        ARESC(alA);
        finishSM(pA0, pA1, alA, l_reg, pa0, pa1, pa2, pa3); ASBAR();
        pv_d0(o, vb0 + bsel * SHM_V, pa0, pa1, pa2, pa3);
        if (j + 1 < NT) { ASWAIT(); ASWRITE(bsel ^ 1, 0); }
        __syncthreads();
    }
    if (hi == 0) li_l[r32] = l_reg; asm volatile("s_waitcnt lgkmcnt(0)" ::: "memory");
    GAS unsigned char* Ow = BR + (size_t)(qrow0 + wid * 32) * DM + 1024 + h * 128;
#pragma unroll
    for (int r = 0; r < 16; ++r) { const int orow = crow(r, hi); const float rl = __builtin_amdgcn_rcpf(li_l[orow]);
#pragma unroll
        for (int d0 = 0; d0 < 4; ++d0) { const float v = __builtin_amdgcn_fmed3f(o[d0][r] * rl, -448.f, 448.f); Ow[(size_t)orow * DM + d0 * 32 + r32] = (unsigned char)(__builtin_amdgcn_cvt_pk_fp8_f32(v, 0.f, 0u, false) & 0xffu); } }
    __syncthreads();
#undef ASLOAD
#undef ASWRITE
#undef ASWAIT
#undef ARESC
}
}

constexpr int PH_PER_LAYER = 13, NPHASE = 2 + DEPTH * PH_PER_LAYER;
struct Args { const float* in[N_IN]; float* out; unsigned char* ws; int ph_lo, ph_hi; };
static_assert(sizeof(Args) == N_IN * 8 + 8 + 8 + 8, "Args has no padding");

#ifndef REP_G1
#define REP_G1 1
#endif
#ifndef REP_G2
#define REP_G2 1
#endif
#ifndef REP_G5
#define REP_G5 1
#endif
#ifndef REP_G6
#define REP_G6 1
#endif
#ifndef REP_G8
#define REP_G8 1
#endif
#ifndef REP_G10
#define REP_G10 1
#endif
#ifndef REP_G11
#define REP_G11 1
#endif
#ifndef REP_R4
#define REP_R4 1
#endif
#ifndef PH_MASK
#define PH_MASK 0xffffffffu
#endif
#define IN(k) (lo <= (k) && (k) < hi)
#define EN(j) ((PH_MASK >> (j)) & 1u)
#ifndef SUBMASK
#define SUBMASK 7
#endif
#define REFRESH() do { F.tid = opaque_tid(); F.lane = F.tid & 63; F.wave = __builtin_amdgcn_readfirstlane(F.tid >> 6); \
    F.ws = (GAS unsigned char*)opaque_ptr(args.ws); F.ctl = (unsigned*)opaque_ptr(args.ws + WS_CTL); F.out = (GAS float*)opaque_ptr(args.out); } while (0)
#ifdef PROBE_MASK
#define STAMP(k) do { if (blockIdx.x == 0 && threadIdx.x == 0) ((volatile unsigned long long*)(args.ws + WS_CTL + 65536))[16 + (k)] = __builtin_amdgcn_s_memrealtime(); } while (0)
#else
#define STAMP(k) do { } while (0)
#endif
#define SEAM(k) do { if (IN(k) && IN((k) + 1)) xcd_barrier(bar); STAMP((k) + 1); } while (0)
template <int l> __device__ __forceinline__ void layer_phases(Frame& F, const Args& args, const XcdBarrier& bar, const int lo, const int hi, char* ldsg) {
        const int pb = 2 + l * PH_PER_LAYER;
        const int mrows = (l + 1 < DEPTH) ? MT : ML;
        GAS bf16_t* const Hb = WSP(bf16_t, WS_H); GAS bf16_t* const Ub = WSP(bf16_t, WS_RA);
        if (IN(pb + 0) && EN(0) && l == 0) { REFRESH(); phase_rwA(F, l); }
        if (l == 0) SEAM(pb + 0);
        if (IN(pb + 1) && EN(1)) for (int rp_ = 0; rp_ < REP_G1; ++rp_) { REFRESH();
            EpiWin E{Ub, WSP(float, WS_SSQ), WSP(float, WS_TAB)};
            { Gemm g{WSP(bf16_t, WS_HIN), WSP(bf16_t, WS_WIN) + (size_t)l * NU * DM, DM, DM, DM};
              WinSched S; S.gs.init(MT / 256, 5, F.G, (int)blockIdx.x, (size_t)256 * DM * 2, (size_t)256 * DM * 2, 0, 0); S.mode = 1;
              pg8::gemm_phase<EpiWin, WinSched, false>(F.lds, g, S, E); }
            { Gemm g{(const GAS bf16_t*)WSP(unsigned char, WS_H8), (const GAS bf16_t*)(WSP(unsigned char, WS_WIN8) + (size_t)l * NU * DM), DM / 2, DM / 2, DM / 2};
              WinSched S; S.gs.init(MT / 256, 23, F.G, (int)((blockIdx.x + 152) & 255), (size_t)256 * DM, (size_t)256 * DM, 0, 0); S.mode = 0;
              pg8::gemm_phase<EpiWin, WinSched, false, true>(F.lds, g, S, E); }
        }
        SEAM(pb + 1);
        if (IN(pb + 2) && EN(2)) for (int rp_ = 0; rp_ < REP_G2; ++rp_) { REFRESH();
            if (SUBMASK & 1) { Gemm g{Ub, WSP(bf16_t, WS_WUQ) + (size_t)l * 768 * 512, NU, 512, 512};
              GridSched S; S.init(MT / 256, 3, F.G, (int)blockIdx.x, (size_t)256 * NU * 2, (size_t)256 * 512 * 2, (size_t)U_CQ * 2, 0);
              EpiMlaQ E{WSP(bf16_t, WS_QB), WSP(float, WS_SSQ), WSP(float, WS_TAB)};
              pg8::gemm_phase<EpiMlaQ, GridSched, false>(F.lds, g, S, E); }
            if (SUBMASK & 2) { Gemm g{Ub, WSP(bf16_t, WS_WUKV) + (size_t)l * 1024 * 256, NU, 256, 256};
              GridSched S; S.init(MT / 256, 4, F.G, (int)((blockIdx.x + 40u) % (unsigned)F.G), (size_t)256 * NU * 2, (size_t)256 * 256 * 2, (size_t)U_CKV * 2, 0);
              EpiMlaKV E{WSP(bf16_t, WS_KVB), WSP(float, WS_SSQ)};
              pg8::gemm_phase<EpiMlaKV, GridSched, false>(F.lds, g, S, E); }
            if (SUBMASK & 4) { Gemm g{(const GAS bf16_t*)WSP(unsigned char, WS_H8), (const GAS bf16_t*)(WSP(unsigned char, WS_WG) + (size_t)l * 8192 * DM), DM / 2, DM / 2, DM / 2};
              GridSched S; S.init(mrows / 256, 32, F.G, (int)blockIdx.x, (size_t)256 * DM, (size_t)256 * DM, 0, 0);
              EpiGate E{WSP(unsigned char, WS_RB)};
              pg8::gemm_phase<EpiGate, GridSched, false, true>(F.lds, g, S, E); }
            phase_ssdconv(F, l);
            phase_scanprep(F, l);
        }
        SEAM(pb + 2);
#ifndef REP_MIX
#define REP_MIX 1
#endif
        if (IN(pb + 3) && EN(3)) for (int rep_ = 0; rep_ < REP_MIX; ++rep_) { REFRESH();
            const int bx = blockIdx.x;
#ifndef REPMASK
#define REPMASK 15
#endif
#ifdef ONLYK
            const int SCANMASK = ONLYK;
#else
            const int SCANMASK = rep_ == 0 ? 15 : REPMASK;
#endif
            if (bx < 64) {
                if (__builtin_amdgcn_readfirstlane(F.wave) < 4) scn::scan_block<scn::K_ML>(F, l, bx); else scn::scan_block<scn::K_HG>(F, l, bx); }
            else if (bx < 96) { scn::scan_block<scn::K_SSD>(F, l, (bx - 64) * 2 + (F.wave >> 2)); }
            else if (SCANMASK & 8) {
                const int natt = 256 + (l + 1 < DEPTH ? 32 : 0), nab = F.G - 96;
                for (int ua = bx - 96; ua < natt; ua += nab) {
                    if (ua < 256) { const int b = ua >> 5, h = (ua >> 3) & 3, qb = ua & 7;
                        att::attn_unit(WSP(bf16_t, WS_QB), WSP(bf16_t, WS_KVB), Ub, WSP(unsigned char, WS_BR), b * SEQ + qb * 256, h, ML + b * CTXL, b * SEQ, 4, 36, (LAS char*)F.lds); }
                    else { const int uc = ua - 256, b = uc >> 2, h = uc & 3;
                        att::attn_unit(WSP(bf16_t, WS_QB), WSP(bf16_t, WS_KVB), Ub, WSP(unsigned char, WS_BR), ML + b * CTXL, h, ML + b * CTXL, 0, 4, 4, (LAS char*)F.lds); }
                }
                if (rep_ == 0) {
                    LAS float* scr = (LAS float*)(F.lds + F.wave * 16384);
                    if (l + 1 == DEPTH) { for (int it = (bx - 96) * 8 + F.wave; it < IT_MOE; it += (F.G - 96) * 8) cvt_moe_item(F, l, it, scr); }
                    else { for (int it = (bx - 96) * 8 + F.wave; it < IT_LAYER + IT_MOE / 2; it += (F.G - 96) * 8) { if (it < IT_LAYER) cvt_layer_item(F, l + 1, it, scr); else cvt_moe_item(F, l, it - IT_LAYER, scr); } }
                }
            }
        }
        SEAM(pb + 3);
        if (IN(pb + 4) && EN(4)) for (int rp_ = 0; rp_ < REP_R4; ++rp_) { REFRESH(); phase_finish(F, l, mrows); }
        SEAM(pb + 4);
        if (IN(pb + 5) && EN(5)) for (int rp_ = 0; rp_ < REP_G5; ++rp_) { REFRESH();
            Gemm g{(const GAS bf16_t*)WSP(unsigned char, WS_BR), (const GAS bf16_t*)(WSP(unsigned char, WS_WBR) + (size_t)l * 4 * DM * 512), DM / 2, 256, 256};
            MergeSched S; S.gs.init(mrows / 256, 8, F.G, (int)blockIdx.x, 0, 0, 0, 0);
            EpiMerge E{WSP(unsigned char, WS_RB), WSP(unsigned char, WS_RA + RA_ACC), WSP(float, WS_RSSD)};
            pg8::gemm_phase<EpiMerge, MergeSched, false, true, true>(F.lds, g, S, E);
            if (l == 0 && blockIdx.x >= 128) {
                LAS float* scr = (LAS float*)(F.lds + F.wave * 16384);
                for (int it = IT_MOE / 2 + ((int)blockIdx.x - 128) * 8 + F.wave; it < IT_MOE / 2 + 16384; it += 128 * 8) cvt_moe_item(F, 0, it, scr);
            }
        }
        SEAM(pb + 5);
        if (IN(pb + 6) && EN(6)) for (int rp_ = 0; rp_ < REP_G6; ++rp_) { REFRESH();
            Gemm g{(const GAS bf16_t*)WSP(unsigned char, WS_RA + RA_ACC), (const GAS bf16_t*)(WSP(unsigned char, WS_WOUT) + (size_t)l * DM * DM), DM / 2, DM / 2, DM / 2};
            GridSched S; S.init(mrows / 256, 8, F.G, (int)blockIdx.x, (size_t)256 * DM, (size_t)256 * DM, 0, 0);
            EpiBf16 E{WSP(bf16_t, WS_RB + RB_Y), DM};
            pg8::gemm_phase<EpiBf16, GridSched, false, true>(F.lds, g, S, E);
            if (l == 0 && blockIdx.x >= 64) {
                LAS float* scr = (LAS float*)(F.lds + F.wave * 16384);
                for (int it = IT_MOE / 2 + 16384 + ((int)blockIdx.x - 64) * 8 + F.wave; it < IT_MOE; it += 192 * 8) cvt_moe_item(F, 0, it, scr);
            }
        }
        SEAM(pb + 6);
        if (IN(pb + 7) && EN(7)) { REFRESH(); phase_rwB(F, l, mrows); }
        SEAM(pb + 7);
        if (IN(pb + 8) && EN(8)) for (int rp_ = 0; rp_ < REP_G8; ++rp_) { REFRESH();
            Gemm g{Hb, WSP(bf16_t, WS_WR) + (size_t)l * 256 * DM, DM, DM, 512};
            RouterSched S{mrows / 256, F.G, (int)blockIdx.x};
            EpiRouter E{WSP(float, WS_LOG)};
            pg8::gemm_phase<EpiRouter, RouterSched, false>(F.lds, g, S, E);
        }
        SEAM(pb + 8);
        if (IN(pb + 9) && EN(9)) { REFRESH(); phase_route(F, l, mrows, bar); }
        SEAM(pb + 9);
        if (IN(pb + 10) && EN(10)) for (int rp_ = 0; rp_ < REP_G10; ++rp_) { REFRESH();
            moe_tables(F, l);
            Gemm g{(const GAS bf16_t*)WSP(unsigned char, WS_H8), (const GAS bf16_t*)WSP(unsigned char, WS_W13), DM / 2, DM / 2, DM / 2};
            MoeSched S{(const volatile LAS int*)(F.MISC + 16), (const volatile LAS int*)(F.MISC + 64), WSP(int, WS_LIST), 4, F.G, (int)blockIdx.x, 1};
            EpiMoe1 E{WSP(unsigned char, WS_RA + RA_H1)};
            pg8::gemm_phase<EpiMoe1, MoeSched, true, true>(F.lds, g, S, E);
        }
        SEAM(pb + 10);
        if (IN(pb + 11) && EN(11)) for (int rp_ = 0; rp_ < REP_G11; ++rp_) { REFRESH();
            moe_tables(F, l);
            Gemm g{(const GAS bf16_t*)WSP(unsigned char, WS_RA + RA_H1), (const GAS bf16_t*)WSP(unsigned char, WS_W2), DEXP / 2, DEXP / 2, DEXP / 2};
            MoeSched S{(const volatile LAS int*)(F.MISC + 16), (const volatile LAS int*)(F.MISC + 64), WSP(int, WS_LIST), 8, F.G, (int)blockIdx.x, 2};
            EpiMoe2 E{WSP(bf16_t, WS_RB + RB_Y2), WSP(int, WS_LIST), WSP(float, WS_WL), (const volatile LAS int*)(F.MISC + 64)};
            pg8::gemm_phase<EpiMoe2, MoeSched, false, true>(F.lds, g, S, E);
        }
        SEAM(pb + 11);
        if (IN(pb + 12) && EN(12)) { REFRESH(); phase_rwC(F, l, mrows); }
        SEAM(pb + 12);
    }

__global__ void __launch_bounds__(512, 2) fwd_kernel(Args args) {
    extern __shared__ __attribute__((aligned(16))) unsigned char lds_raw[];
    Frame F;
    F.lds = (LAS unsigned char*)lds_raw;
    F.MISC = (volatile LAS unsigned*)(F.lds + MISC_OFF);
    F.tid = threadIdx.x; F.lane = F.tid & 63; F.wave = __builtin_amdgcn_readfirstlane(F.tid >> 6);
    F.G = gridDim.x; { const int bx = blockIdx.x; F.vcu = (F.G % 8 == 0) ? (bx % 8) * (F.G / 8) + bx / 8 : bx; }
    F.ws = (GAS unsigned char*)args.ws; F.ctl = (unsigned*)(args.ws + WS_CTL); F.out = (GAS float*)args.out;
    F.inp = args.in;
    for (int u = F.tid; u < (LDS_BYTES - MISC_OFF) / 4; u += 512) F.MISC[u] = 0u;
    __syncthreads();
    const int lo = args.ph_lo, hi = args.ph_hi;
    XcdBarrier bar; bar.bar = F.ctl + CW_BAR; bar.x = 0; bar.st = nullptr;
    if (hi - lo > 1) bar = xcd_barrier_post(F.ctl + CW_BAR, F.MISC + 8);
    char* ldsg = (char*)lds_raw;

#ifndef REP_PRO
#define REP_PRO 1
#endif
    STAMP(0);
    if (IN(0) && EN(13)) for (int rep_ = 0; rep_ < REP_PRO; ++rep_) { phase_prologue(F); } SEAM(0);
    if (IN(1) && EN(14)) { phase_modfin(F); } SEAM(1);

    layer_phases<0>(F, args, bar, lo, hi, ldsg);
    layer_phases<1>(F, args, bar, lo, hi, ldsg);
#ifdef PROBE_MASK
    __syncthreads();
    if (blockIdx.x == 0 && threadIdx.x == 0) {
        STAMP(NPHASE);
        volatile unsigned long long* T = (volatile unsigned long long*)(args.ws + WS_CTL + 65536) + 16; unsigned long long acc_ = 0;
        for (int k = 0; k < NPHASE; ++k) if ((PROBE_MASK >> k) & 1ull) { const unsigned long long a_ = T[k], b_ = T[k + 1]; if (a_ && b_ > a_) acc_ += b_ - a_; }
        args.out[0] = 3.0f + (float)acc_ * 0.001f;
    }
#endif
#undef IN
#undef SEAM
}


#ifdef DUMP_OFF
__global__ void dump_kernel(GAS float* out, const unsigned char* ws) {
    const size_t OUTN = (size_t)ML * DM; const size_t i0 = (size_t)blockIdx.x * blockDim.x + threadIdx.x, st = (size_t)gridDim.x * blockDim.x;
    for (size_t i = i0; i < OUTN; i += st) { float a = 0.f;
#if DUMP_F32
        const GAS float* src = (const GAS float*)(ws + (size_t)DUMP_OFF); for (size_t j = i; j < (size_t)DUMP_ELEMS; j += OUTN) a += src[j];
#else
        const GAS bf16_t* src = (const GAS bf16_t*)(ws + (size_t)DUMP_OFF); for (size_t j = i; j < (size_t)DUMP_ELEMS; j += OUTN) a += bf2f(src[j]);
#endif
        out[i] = a; }
}
#endif
extern "C" void kernel_launch(void* const* d_in, const int* in_sizes, int n_in, void* d_out, int out_size, void* d_ws, size_t ws_size, hipStream_t stream) {
    static int grid = 0;
    if (grid == 0) {
        if (n_in != N_IN || out_size != ML * DM || ws_size < WS_END) { fprintf(stderr, "kernel_launch: unexpected shapes: n_in %d out %d ws %zu (need %zu)\n", n_in, out_size, ws_size, (size_t)WS_END); grid = -1; return; }
        int dev = 0, cus = 0, per_cu = 0;
        if (hipGetDevice(&dev) != hipSuccess || hipDeviceGetAttribute(&cus, hipDeviceAttributeMultiprocessorCount, dev) != hipSuccess) { grid = -1; return; }
        if (hipFuncSetAttribute((const void*)fwd_kernel, hipFuncAttributeMaxDynamicSharedMemorySize, LDS_BYTES) != hipSuccess) { fprintf(stderr, "kernel_launch: hipFuncSetAttribute failed\n"); grid = -1; return; }
        if (hipOccupancyMaxActiveBlocksPerMultiprocessor(&per_cu, (const void*)fwd_kernel, 512, LDS_BYTES) != hipSuccess || per_cu < 1) { fprintf(stderr, "kernel_launch: occupancy query says %d\n", per_cu); }
        (void)hipGetLastError();
        grid = cus;
    }
    if (grid < 0) return;
    if (hipMemsetAsync((char*)d_ws + WS_CTL, 0, CTL_BYTES, stream) != hipSuccess) return;
    Args a{};
    for (int i = 0; i < N_IN; ++i) a.in[i] = (const float*)d_in[i];
    a.out = (float*)d_out; a.ws = (unsigned char*)d_ws;
#if MK_SINGLE
    a.ph_lo = 0; a.ph_hi = NPHASE;
    hipLaunchKernelGGL(fwd_kernel, dim3(grid), dim3(512), LDS_BYTES, stream, a);
#else
#ifndef MK_STOP
#define MK_STOP NPHASE
#endif
    for (int ph = 0; ph < MK_STOP; ++ph) {
        if (ph == 2 + PH_PER_LAYER) continue;
        a.ph_lo = ph; a.ph_hi = ph + 1;
        hipLaunchKernelGGL(fwd_kernel, dim3(grid), dim3(512), LDS_BYTES, stream, a);
    }
#endif
#ifdef DUMP_OFF
    hipLaunchKernelGGL(dump_kernel, dim3(2048), dim3(256), 0, stream, (float*)d_out, (const unsigned char*)d_ws);
#endif
    const hipError_t le = hipPeekAtLastError();
    if (le != hipSuccess) fprintf(stderr, "kernel_launch: launch failed: %s\n", hipGetErrorName(le));
}
```

```cpp
#include <hip/hip_runtime.h>
#include <cstdio>
#include <cstdint>

#ifndef MK_SINGLE
#define MK_SINGLE 1
#endif

constexpr int DM = 2048, NBATCH = 8, SEQ = 2048, CTXL = 256, DEPTH = 2;
constexpr int ML = NBATCH * SEQ;
constexpr int MC = NBATCH * CTXL;
constexpr int MT = ML + MC;
constexpr int DIN = 7008, NU = 7168;
constexpr int U_MLQ = 0, U_MLK = 512, U_MLV = 1024, U_MLO = 1536, U_HGQ = 2048, U_HGI = 2560, U_HGG = 3072, U_HGF = 3584,
              U_CQ = 4608, U_CKV = 5120, U_KR = 5376, U_MLG = 5440, U_DT = 5456, U_Z = 5632, U_XBC = 6144;
constexpr float EPS = 1e-6f;
constexpr int NEXP = 32, DEXP = 512;
constexpr int MOE_ROWS = 2 * MT + NEXP * 256;

enum { I_X = 0, I_C, I_CTX, I_CCTX, I_WADA, I_BADA, I_NORMG, I_WIN, I_MLFB, I_HGLB, I_HGNG, I_MLAGQ, I_MLAGKV, I_WUQ, I_WUKV,
       I_CONVW, I_CONVB, I_ALOG, I_DTB, I_SSDD, I_SSDNG, I_WGATE, I_WBR, I_WOUT, I_WGRP, I_WEXP, I_W1, I_W3, I_W2, N_IN };

constexpr size_t al256(size_t x) { return (x + 255) / 256 * 256; }
constexpr size_t WS_CTL = 0, CTL_BYTES = 1u << 20;
constexpr size_t WS_WIN = WS_CTL + CTL_BYTES;
constexpr size_t WS_WUQ = WS_WIN + (size_t)2 * NU * DM * 2;
constexpr size_t WS_WUKV = WS_WUQ + (size_t)2 * 768 * 512 * 2;
constexpr size_t WS_WG = WS_WUKV + (size_t)2 * 1024 * 256 * 2;
constexpr size_t WS_WBR = WS_WG + (size_t)2 * 8192 * DM;
constexpr size_t WS_WOUT = WS_WBR + (size_t)2 * 4 * DM * 512 * 2;
constexpr size_t WS_WR = WS_WOUT + (size_t)2 * DM * DM;
constexpr size_t WS_WIN8 = WS_WR + (size_t)2 * 256 * DM * 2;
constexpr size_t WS_W13 = WS_WIN8 + (size_t)2 * NU * DM;
constexpr size_t WS_W2 = WS_W13 + (size_t)NEXP * 1024 * DM * 2;
constexpr size_t WS_MODP = WS_W2 + (size_t)NEXP * DM * 512 * 2;
constexpr size_t WS_MOD = WS_MODP + (size_t)2 * 16 * 9 * 12288 * 4;
constexpr size_t WS_TAB = WS_MOD + (size_t)2 * 9 * 12288 * 4;
constexpr size_t WS_XC = WS_TAB + 16384;
constexpr size_t WS_H8 = WS_XC + (size_t)MC * DM * 4;
constexpr size_t WS_H = WS_H8 + (size_t)MT * DM;
constexpr size_t WS_HIN = WS_H;
constexpr size_t WS_QB = WS_H + (size_t)MT * DM * 2;
constexpr size_t WS_KVB = WS_QB + (size_t)MT * 768 * 2;
constexpr size_t WS_SSQ = WS_KVB + (size_t)MT * 1024 * 2;
constexpr size_t WS_BR = WS_SSQ + (size_t)MT * 12 * 4;
constexpr size_t WS_YFB = WS_BR + (size_t)MT * DM * 2;
constexpr size_t WS_RSSD = WS_YFB + (size_t)6 * MT * 512 * 2;
constexpr size_t WS_LOG = WS_RSSD + al256((size_t)MT * 4);
constexpr size_t WS_LIST = WS_LOG + (size_t)4 * MT * 64 * 4;
constexpr size_t WS_WL = WS_LIST + (size_t)NEXP * MT * 4;
constexpr size_t WS_XBC = WS_WL + (size_t)NEXP * MT * 4;
constexpr size_t HGP_ITEM = 8192 + 8192 + 1024;
constexpr size_t WS_HGP = WS_XBC + (size_t)MT * 1024 * 2;
constexpr size_t WS_MLS = WS_HGP + (size_t)64 * 72 * HGP_ITEM;
constexpr size_t WS_SSDS = WS_MLS + (size_t)64 * 2304 * 32;
constexpr size_t WS_MLC = WS_SSDS + (size_t)128 * 2304 * 32;
constexpr size_t WS_RA = WS_MLC + (size_t)32 * 2304 * 384 * 2;
constexpr size_t RA_BYTES = (size_t)MT * NU * 2;
constexpr size_t WS_RB = WS_RA + RA_BYTES;
constexpr size_t RB_BYTES = ((size_t)80 << 20) + (size_t)2 * MT * DM * 2;
constexpr size_t WS_END = WS_RB + RB_BYTES;
constexpr size_t RA_ACC = 0, RA_PART = (size_t)80 << 20, RA_H1 = (size_t)150 << 20;
constexpr size_t RB_Y = 0, RB_Y2 = (size_t)80 << 20;
static_assert(RA_PART >= (size_t)MT * DM * 2 && RA_H1 >= RA_PART + (size_t)256 * 65536 * 4 && RA_H1 + (size_t)MOE_ROWS * 512 * 2 <= RA_BYTES, "region A");
static_assert(RB_Y2 >= (size_t)MT * DM * 2 && RB_Y2 + (size_t)2 * MT * DM * 2 <= RB_BYTES && (size_t)MT * 8192 <= RB_BYTES, "region B");
constexpr int CW_CNT = 64;
constexpr int CW_BAR = 4096;

constexpr int RING_BYTES = 131072, MISC_OFF = RING_BYTES, LDS_BYTES = 147456;

#define GAS __attribute__((address_space(1)))
#define LAS __attribute__((address_space(3)))
typedef unsigned short bf16_t;
typedef short bf16x8 __attribute__((ext_vector_type(8)));
typedef short s16x4 __attribute__((ext_vector_type(4)));
typedef float f32x4 __attribute__((ext_vector_type(4)));
typedef float f32x2 __attribute__((ext_vector_type(2)));
typedef float f32x16 __attribute__((ext_vector_type(16)));
typedef unsigned u32x4 __attribute__((ext_vector_type(4)));
typedef unsigned u32x2 __attribute__((ext_vector_type(2)));
#define LDS_WAIT() asm volatile("s_waitcnt lgkmcnt(0)" ::: "memory")
#define VM_WAIT() asm volatile("s_waitcnt vmcnt(0)" ::: "memory")
typedef __bf16 bf16x2_t __attribute__((ext_vector_type(2)));
__device__ __forceinline__ unsigned cvt_pk_bf16(float lo, float hi) { const f32x2 v = {lo, hi}; return __builtin_bit_cast(unsigned, __builtin_convertvector(v, bf16x2_t)); }
__device__ __forceinline__ bf16_t f2bf(float f) { return (bf16_t)(cvt_pk_bf16(f, 0.f) & 0xffffu); }
__device__ __forceinline__ float bf2f(bf16_t b) { return __uint_as_float(((unsigned)b) << 16); }
__device__ __forceinline__ float bflo(unsigned w) { return __uint_as_float(w << 16); }
__device__ __forceinline__ float bfhi(unsigned w) { return __uint_as_float(w & 0xffff0000u); }
__device__ __forceinline__ float sigmoidf_(float x) { return 1.f / (1.f + __expf(-x)); }
__device__ __forceinline__ float siluf_(float x) { return x / (1.f + __expf(-x)); }
__device__ __forceinline__ int opaque_tid() { int t = threadIdx.x; asm volatile("" : "+v"(t)); return t; }
__device__ __forceinline__ const void* opaque_ptr(const void* p) {
    unsigned lo = (unsigned)(uintptr_t)p, hi = (unsigned)((uintptr_t)p >> 32); asm volatile("" : "+v"(lo), "+v"(hi));
    lo = __builtin_amdgcn_readfirstlane(lo); hi = __builtin_amdgcn_readfirstlane(hi); return (const void*)(((uintptr_t)hi << 32) | lo); }
__device__ __forceinline__ float wave_sum(float v) {
#pragma unroll
    for (int o = 1; o < 64; o <<= 1) v += __shfl_xor(v, o);
    return v;
}

__device__ __forceinline__ int prow(int b, int dir, int p) { if (p < CTXL) return ML + b * CTXL + (dir ? CTXL - 1 - p : p); const int q = p - CTXL; return b * SEQ + (dir ? SEQ - 1 - q : q); }
namespace scn {
__device__ __forceinline__ int rowl(int row, int colB) { return row * 256 + (colB ^ ((row & 7) << 4)); }
__device__ __forceinline__ float scan_add32(float v, int r32) {
#pragma unroll
    for (int d = 1; d < 32; d <<= 1) { const float o = __shfl_up(v, d, 32); if (r32 >= d) v += o; }
    return v;
}
__device__ __forceinline__ float scan_max32(float v, int r32) {
#pragma unroll
    for (int d = 1; d < 32; d <<= 1) { const float o = __shfl_up(v, d, 32); if (r32 >= d) v = fmaxf(v, o); }
    return v;
}
}

#define XB_TMO      128
#define XB_XCNT(j)  (256  + 64 * (j))
#define XB_XSUB(j)  (1280 + 64 * (j))
#define XB_XGEN(j)  (2304 + 64 * (j))
#define XB_TOP      3328
#define XB_TOPGEN   3392
#define XCD_BAR_WORDS 3456
#define XB_SPIN_CAP (1u << 18)
__device__ __forceinline__ unsigned xb_ld(unsigned* p)              { return __hip_atomic_load(p, __ATOMIC_RELAXED, __HIP_MEMORY_SCOPE_AGENT); }
__device__ __forceinline__ unsigned xb_add(unsigned* p, unsigned v) { return __hip_atomic_fetch_add(p, v, __ATOMIC_RELAXED, __HIP_MEMORY_SCOPE_AGENT); }
__device__ __forceinline__ unsigned xb_xcc_id() { return (unsigned)__builtin_amdgcn_s_getreg((3 << 11) | 20) & 0xFu; }
#define XB_SPIN(cond, bar) do { unsigned _sp = 0; while (cond) { __builtin_amdgcn_s_sleep(1); \
    if ((++_sp & 255u) == 0u) { if (xb_ld(&(bar)[XB_TMO])) break; if (_sp > XB_SPIN_CAP) { atomicAdd(&(bar)[XB_TMO], 1u); break; } } } } while (0)
struct XcdBarrier { unsigned* bar; unsigned x; volatile LAS unsigned* st; };
__device__ __forceinline__ XcdBarrier xcd_barrier_post(unsigned* bar, volatile LAS unsigned* st) {
    XcdBarrier b; b.bar = bar; b.x = xb_xcc_id(); b.st = st;
    if (threadIdx.x == 0) (void)xb_add(&bar[XB_XCNT(b.x)], 1u);
    return b;
}
__device__ __forceinline__ void xcd_barrier_complete(unsigned* bar, unsigned x, unsigned& nloc, unsigned& nx) {
    const unsigned G = gridDim.x * gridDim.y * gridDim.z;
    unsigned sum, cnt, mine, sp = 0u;
    for (;;) {
        sum = 0u; cnt = 0u; mine = 0u;
#pragma unroll
        for (unsigned j = 0; j < 16; ++j) { const unsigned c = xb_ld(&bar[XB_XCNT(j)]); sum += c; cnt += (c > 0u) ? 1u : 0u; mine = (j == x) ? c : mine; }
        if (sum == G) break;
        __builtin_amdgcn_s_sleep(1);
        if ((++sp & 255u) == 0u) { if (xb_ld(&bar[XB_TMO])) break; if (sp > XB_SPIN_CAP) { atomicAdd(&bar[XB_TMO], 1u); break; } }
    }
    nloc = mine > 0u ? mine : 1u; nx = cnt > 0u ? cnt : 1u;
}
__device__ __forceinline__ void xcd_barrier(const XcdBarrier& b) {
    asm volatile("s_waitcnt vmcnt(0)" ::: "memory");
    __syncthreads();
    if (threadIdx.x == 0) {
        unsigned* bar = b.bar;
        __builtin_amdgcn_s_waitcnt(0);
        unsigned nloc = b.st[0], nx = b.st[1];
        if (nloc == 0u) { xcd_barrier_complete(bar, b.x, nloc, nx); b.st[0] = nloc; b.st[1] = nx; }
        const unsigned old = xb_add(&bar[XB_XSUB(b.x)], 1u);
        const unsigned gen = old / nloc;
        if (old + 1u == (gen + 1u) * nloc) {
            __builtin_amdgcn_fence(__ATOMIC_RELEASE, "agent");
            asm volatile("s_waitcnt vmcnt(0)" ::: "memory");
            const unsigned og = xb_add(&bar[XB_TOP], 1u);
            const unsigned tg = og / nx;
            if (og + 1u == (tg + 1u) * nx) xb_add(&bar[XB_TOPGEN], 1u);
            else XB_SPIN(xb_ld(&bar[XB_TOPGEN]) == tg, bar);
            __builtin_amdgcn_fence(__ATOMIC_ACQUIRE, "agent");
            xb_add(&bar[XB_XGEN(b.x)], 1u);
            asm volatile("s_waitcnt vmcnt(0)" ::: "memory");
        } else {
            XB_SPIN(xb_ld(&bar[XB_XGEN(b.x)]) == gen, bar);
            __builtin_amdgcn_fence(__ATOMIC_ACQUIRE, "agent");
            asm volatile("s_waitcnt vmcnt(0)" ::: "memory");
        }
    }
    __syncthreads();
}

struct Frame {
    LAS unsigned char* lds;
    volatile LAS unsigned* MISC;
    unsigned* ctl;
    int tid, lane, wave, vcu, G;
    const float* const* inp;
    GAS float* out;
    GAS unsigned char* ws;
};
#define WSP(T, off) ((GAS T*)(F.ws + (off)))
#define INP(i) ((const GAS float*)F.inp[i])

namespace pg8 {
constexpr int BM = 256, BK = 64, HALF = 128, HTB = HALF * BK * 2, STAGE_BYTES = 8 * HTB, NXCD = 8, WGM = 8;
__host__ __device__ __forceinline__ int lds_byte(int r, int c) { const int st = (r >> 4) * 2 + (c >> 5), rr = r & 15, cc = c & 31, ob = rr * 64 + cc * 2; return st * 1024 + (ob ^ (((ob >> 9) & 1) << 5)); }
__host__ __device__ __forceinline__ void stage_rc(int b, int& R, int& C) { const int st = b / 1024, sb = b % 1024, swz = sb ^ (((sb >> 9) & 1) << 5); R = (st >> 1) * 16 + swz / 64; C = (st & 1) * 32 + (swz % 64) / 2; }

struct Unit { int pm, pn, aux, aux2; size_t aoff, boff; };
struct Gemm { const GAS bf16_t* A; const GAS bf16_t* Bt; int lda, ldb, K; };

struct GridSched {
    int nM, nN, nwg, G, c; size_t a_tile, b_tile, a0, b0;
    __device__ __forceinline__ void init(int nM_, int nN_, int G_, int c_, size_t a_tile_, size_t b_tile_, size_t a0_, size_t b0_) { nM = nM_; nN = nN_; nwg = nM * nN; G = G_; c = c_; a_tile = a_tile_; b_tile = b_tile_; a0 = a0_; b0 = b0_; }
    __device__ __forceinline__ void map(int L, int& pm, int& pn) const {
        int wgid = L; { const int q = nwg / NXCD, r = nwg % NXCD, xcd = wgid % NXCD, off = wgid / NXCD; wgid = (xcd < r ? xcd * (q + 1) : r * (q + 1) + (xcd - r) * q) + off; }
        const int nig = WGM * nN, gid = wgid / nig, fm = gid * WGM, gsz = (nM - fm) < WGM ? (nM - fm) : WGM;
        pm = fm + ((wgid % nig) % gsz); pn = (wgid % nig) / gsz;
    }
    __device__ __forceinline__ bool next(int i, Unit& u) const {
        const long L = (long)i * G + c; if (L >= nwg) return false;
        map((int)L, u.pm, u.pn); u.aux = 0; u.aux2 = 0; u.aoff = a0 + (size_t)u.pm * a_tile; u.boff = b0 + (size_t)u.pn * b_tile; return true;
    }
    __device__ __forceinline__ int arow(const Unit&, int) const { return 0; }
};

template <class Epi, class Sched, bool GATHER, bool FP8 = false, bool HM = false>
__device__ __forceinline__ void gemm_phase(LAS unsigned char* lds, const Gemm g, const Sched& S, const Epi& E) {
    const int tid = opaque_tid(), wid = __builtin_amdgcn_readfirstlane(tid >> 6), lane = tid & 63, wr = wid >> 2, wc = wid & 3, fr = lane & 15, fq = lane >> 4;
    int nt = g.K / BK; asm volatile("" : "+s"(nt));
    unsigned voffA[2], voffB[2];
#pragma unroll
    for (int i = 0; i < 2; ++i) { int R, C; stage_rc(tid * 16 + i * 8192, R, C);
        voffA[i] = (unsigned)(R * g.lda + C) * 2u; voffB[i] = (unsigned)(R * g.ldb + C) * 2u; }
    const size_t kstep = (size_t)(BK * 2);
    const size_t hstepA = (size_t)HALF * g.lda * 2, hstepB = (size_t)HALF * g.ldb * 2;
    const unsigned ldsw = (unsigned)wid * 1024u;
    const int aoff = lds_byte(wr * 64 + fr, fq * 8), boff = lds_byte(wc * 32 + fr, fq * 8);
#define PG8_SA(b, h) (((b) * 2 + (h)) * HTB)
#define PG8_SB(b, h) ((4 + (b) * 2 + (h)) * HTB)
#define PG8_STAGE(bufoff, gbase, voff) do { _Pragma("unroll") for (int _i = 0; _i < 2; ++_i) \
        __builtin_amdgcn_global_load_lds((const unsigned*)((const char*)(gbase) + (voff)[_i]), (LAS unsigned*)(lds + (bufoff) + ldsw + _i * 8192), 16, 0, 0); } while (0)
#define PG8_LDA(dst, b, h) do { _Pragma("unroll") for (int m = 0; m < 4; ++m) { dst[m].lo = *(const LAS v4i_t*)(lds + PG8_SA(b, h) + aoff + m * 2048); dst[m].hi = *(const LAS v4i_t*)(lds + PG8_SA(b, h) + aoff + m * 2048 + 1024); } } while (0)
#define PG8_LDB(dst, b, h) do { _Pragma("unroll") for (int n = 0; n < 2; ++n) { dst[n].lo = *(const LAS v4i_t*)(lds + PG8_SB(b, h) + boff + n * 2048); dst[n].hi = *(const LAS v4i_t*)(lds + PG8_SB(b, h) + boff + n * 2048 + 1024); } } while (0)
typedef int v8i_t __attribute__((ext_vector_type(8))); typedef int v4i_t __attribute__((ext_vector_type(4)));
#define PG8_MMA(ai, bj, At, Bt) do { __builtin_amdgcn_s_setprio(1); _Pragma("unroll") for (int m = 0; m < 4; ++m) _Pragma("unroll") for (int n = 0; n < 2; ++n) { \
        if constexpr (FP8) { asm volatile("v_mfma_scale_f32_16x16x128_f8f6f4 %0, %1, %2, %0, %3, %4 op_sel_hi:[0,0,0]" : "+v"(acc[ai][bj][m][n]) : "v"(Bt[n]), "v"(At[m]), "v"(scW), "v"(scA)); } \
        else { acc[ai][bj][m][n] = __builtin_amdgcn_mfma_f32_16x16x32_bf16(__builtin_bit_cast(bf16x8, (v4i_t)Bt[n].lo), __builtin_bit_cast(bf16x8, (v4i_t)At[m].lo), acc[ai][bj][m][n], 0, 0, 0); \
               acc[ai][bj][m][n] = __builtin_amdgcn_mfma_f32_16x16x32_bf16(__builtin_bit_cast(bf16x8, (v4i_t)Bt[n].hi), __builtin_bit_cast(bf16x8, (v4i_t)At[m].hi), acc[ai][bj][m][n], 0, 0, 0); } } \
        __builtin_amdgcn_s_setprio(0); } while (0)
#if GEMM_SAFE
#define PG8_WAIT_V(n) asm volatile("s_waitcnt vmcnt(0)" ::: "memory")
#else
#define PG8_WAIT_V(n) asm volatile("s_waitcnt vmcnt(" #n ")" ::: "memory")
#endif
#define PG8_WAIT_L(n) asm volatile("s_waitcnt lgkmcnt(" #n ")" ::: "memory")
#define PG8_BAR __builtin_amdgcn_s_barrier()
#define PG8_SCHED __builtin_amdgcn_sched_barrier(0)
    unsigned cvA[2][2], nvA[2][2];
#define PG8_GOFF(dst, u) do { if constexpr (GATHER) { const int ne_ = S.acnt(u); int gr_[2][2], gc_[2];        \
        _Pragma("unroll") for (int _i = 0; _i < 2; ++_i) { int R_; stage_rc(tid * 16 + _i * 8192, R_, gc_[_i]); _Pragma("unroll") for (int _h = 0; _h < 2; ++_h) gr_[_h][_i] = S.arow(u, _h * HALF + R_, ne_); } \
        _Pragma("unroll") for (int _i = 0; _i < 2; ++_i) _Pragma("unroll") for (int _h = 0; _h < 2; ++_h) dst[_h][_i] = (unsigned)(((size_t)gr_[_h][_i] * (size_t)g.lda + (size_t)gc_[_i]) * 2u); } } while (0)
#define PG8_STAGE_A(bufoff, base, half, vh) do { if constexpr (GATHER) { PG8_STAGE(bufoff, base, (vh)[half]); } else { PG8_STAGE(bufoff, (base) + (half) * hstepA, voffA); } } while (0)
    Unit cur, nxt; int ui = 0;
    if (!S.next(0, cur)) return;
    f32x4 acc[2][2][4][2];
#pragma unroll
    for (int a = 0; a < 2; ++a)
#pragma unroll
        for (int b = 0; b < 2; ++b)
#pragma unroll
            for (int m = 0; m < 4; ++m)
#pragma unroll
                for (int n = 0; n < 2; ++n) acc[a][b][m][n] = (f32x4){0.f, 0.f, 0.f, 0.f};
    int scW = 0x79797979, scA = 0x7f7f7f7f; asm volatile("" : "+v"(scW), "+v"(scA));
    v8i_t At[4], B0[2], B1[2];
    const char* cA = (const char*)g.A + cur.aoff; const char* cB = (const char*)g.Bt + cur.boff;
    PG8_GOFF(cvA, cur);
#pragma unroll
    for (int _h = 0; _h < 2; ++_h)
#pragma unroll
        for (int _i = 0; _i < 2; ++_i) nvA[_h][_i] = cvA[_h][_i];
    PG8_STAGE(PG8_SB(0, 0), cB, voffB); PG8_STAGE_A(PG8_SA(0, 0), cA, 0, cvA); PG8_STAGE(PG8_SB(0, 1), cB + hstepB, voffB); PG8_STAGE_A(PG8_SA(0, 1), cA, 1, cvA);
    if (wr == 1) PG8_BAR;
    PG8_WAIT_V(4); PG8_BAR;
    PG8_STAGE(PG8_SB(1, 0), cB + kstep, voffB); PG8_STAGE_A(PG8_SA(1, 0), cA + kstep, 0, cvA); PG8_STAGE(PG8_SB(1, 1), cB + hstepB + kstep, voffB);
    PG8_WAIT_V(6); PG8_BAR;
    for (;;) {
        const bool has_next = S.next(ui + 1, nxt);
        const char* nA = has_next ? (const char*)g.A + nxt.aoff : cA; const char* nB = has_next ? (const char*)g.Bt + nxt.boff : cB;
        for (int t = 0; t < nt; t += 2) {
            const bool last = (t == nt - 2);
            const char* a1 = cA + (size_t)(t + 1) * kstep;
            const char* a2 = last ? nA : cA + (size_t)(t + 2) * kstep; const char* b2 = last ? nB : cB + (size_t)(t + 2) * kstep;
            const char* a3 = a2 + kstep; const char* b3 = b2 + kstep;
            if constexpr (GATHER) { if (last && has_next) { PG8_GOFF(nvA, nxt); } }
            PG8_LDB(B0, 0, 0); PG8_SCHED; PG8_LDA(At, 0, 0); PG8_STAGE_A(PG8_SA(1, 1), a1, 1, cvA);
            PG8_WAIT_L(8); PG8_BAR; PG8_WAIT_L(0); PG8_MMA(0, 0, At, B0); PG8_BAR; PG8_SCHED;
            PG8_LDB(B1, 0, 1); PG8_STAGE(PG8_SB(0, 0), b2, voffB);
            PG8_BAR; PG8_WAIT_L(0); PG8_MMA(0, 1, At, B1); PG8_BAR;
            if constexpr (!HM) { PG8_LDA(At, 0, 1); } PG8_STAGE_A(PG8_SA(0, 0), a2, 0, nvA);
            PG8_BAR; PG8_WAIT_L(0); if constexpr (!HM) { PG8_MMA(1, 0, At, B0); } PG8_BAR; PG8_SCHED;
            PG8_STAGE(PG8_SB(0, 1), b2 + hstepB, voffB);
            PG8_WAIT_V(6); PG8_BAR; if constexpr (!HM) { PG8_MMA(1, 1, At, B1); } PG8_BAR;
            PG8_LDB(B0, 1, 0); PG8_SCHED; PG8_LDA(At, 1, 0); PG8_STAGE_A(PG8_SA(0, 1), a2, 1, nvA);
            PG8_WAIT_L(8); PG8_BAR; PG8_WAIT_L(0); PG8_MMA(0, 0, At, B0); PG8_BAR; PG8_SCHED;
            PG8_LDB(B1, 1, 1); PG8_STAGE(PG8_SB(1, 0), b3, voffB);
            PG8_BAR; PG8_WAIT_L(0); PG8_MMA(0, 1, At, B1); PG8_BAR;
            if constexpr (!HM) { PG8_LDA(At, 1, 1); } PG8_STAGE_A(PG8_SA(1, 0), a3, 0, nvA);
            PG8_BAR; PG8_WAIT_L(0); if constexpr (!HM) { PG8_MMA(1, 0, At, B0); } PG8_BAR; PG8_SCHED;
            PG8_STAGE(PG8_SB(1, 1), b3 + hstepB, voffB);
            PG8_WAIT_V(6); PG8_BAR; if constexpr (!HM) { PG8_MMA(1, 1, At, B1); } PG8_BAR;
        }
        if constexpr (FP8) { asm volatile("s_nop 15\n\ts_nop 15" ::: "memory"); }
        E(acc, cur, wr, wc, fr, fq);
        if (!has_next) break;
#pragma unroll
        for (int a = 0; a < (HM ? 1 : 2); ++a)
#pragma unroll
            for (int b = 0; b < 2; ++b)
#pragma unroll
                for (int m = 0; m < 4; ++m)
#pragma unroll
                    for (int n = 0; n < 2; ++n) acc[a][b][m][n] = (f32x4){0.f, 0.f, 0.f, 0.f};
        cur = nxt; cA = nA; cB = nB; ++ui;
        if constexpr (GATHER) {
#pragma unroll
            for (int _h = 0; _h < 2; ++_h)
#pragma unroll
                for (int _i = 0; _i < 2; ++_i) cvA[_h][_i] = nvA[_h][_i];
        }
    }
    PG8_WAIT_V(0);
    if (wr == 0) PG8_BAR;
    PG8_BAR;
#undef PG8_SA
#undef PG8_SB
#undef PG8_STAGE
#undef PG8_STAGE_A
#undef PG8_GOFF
#undef PG8_LDA
#undef PG8_LDB
#undef PG8_MMA
#undef PG8_WAIT_V
#undef PG8_WAIT_L
#undef PG8_BAR
#undef PG8_SCHED
}
}
using pg8::Unit;
using pg8::Gemm;
using pg8::GridSched;
#define EPI_ARGS f32x4 (&acc)[2][2][4][2], const Unit& u, int wr, int wc, int fr, int fq
#define EPI_FOR_ROWS for (int ai = 0; ai < 2; ++ai) for (int m = 0; m < 4; ++m)
#define EPI_FOR_COLS for (int bj = 0; bj < 2; ++bj) for (int n = 0; n < 2; ++n)
__device__ __forceinline__ void st_bf16x4(GAS bf16_t* p, f32x4 v) { u32x2 w; w.x = cvt_pk_bf16(v[0], v[1]); w.y = cvt_pk_bf16(v[2], v[3]); *(GAS u32x2*)p = w; }

struct EpiWin {
    GAS bf16_t* U; GAS float* ssq; const GAS float* rope;
    __device__ __forceinline__ void operator()(EPI_ARGS) const {
        const int row0 = u.pm * 256 + wr * 64 + fr, col0 = u.pn * 256 + wc * 32 + 4 * fq;
        if (u.pn == 21 && wc < 2 && u.pm < ML / 256) {
#pragma unroll
            for (int ai = 0; ai < 2; ++ai)
#pragma unroll
                for (int m = 0; m < 4; ++m) {
                    const int r = row0 + ai * 128 + m * 16, tok = r & (SEQ - 1), pos = wc == 0 ? (tok >> 6) : (tok & 63);
                    const f32x4 cs = *(const GAS f32x4*)(rope + pos * 16 + 4 * fq), sn = *(const GAS f32x4*)(rope + 1024 + pos * 16 + 4 * fq);
                    const f32x4 x1 = acc[ai][0][m][0], x2 = acc[ai][0][m][1];
                    acc[ai][0][m][0] = x1 * cs - x2 * sn; acc[ai][0][m][1] = x1 * sn + x2 * cs;
                }
        }
        if (u.pn >= 18 && u.pn <= 20) {
            const int slot = (u.pn - 18) * 4 + wc;
#pragma unroll
            for (int ai = 0; ai < 2; ++ai)
#pragma unroll
                for (int m = 0; m < 4; ++m) {
                    float s = 0.f;
#pragma unroll
                    for (int bj = 0; bj < 2; ++bj)
#pragma unroll
                        for (int n = 0; n < 2; ++n) { const f32x4 x = acc[ai][bj][m][n]; s += (x[0] * x[0] + x[1] * x[1]) + (x[2] * x[2] + x[3] * x[3]); }
                    s += __shfl_xor(s, 16); s += __shfl_xor(s, 32);
                    if (fq == 0) ssq[(size_t)(row0 + ai * 128 + m * 16) * 12 + slot] = s;
                }
        }
#pragma unroll
        for (int ai = 0; ai < 2; ++ai)
#pragma unroll
            for (int m = 0; m < 4; ++m) { GAS bf16_t* rowp = U + (size_t)(row0 + ai * 128 + m * 16) * NU + col0;
#pragma unroll
                for (int bj = 0; bj < 2; ++bj)
#pragma unroll
                    for (int n = 0; n < 2; ++n) st_bf16x4(rowp + bj * 128 + n * 16, acc[ai][bj][m][n]); }
    }
};
struct EpiMlaQ {
    GAS bf16_t* Q; const GAS float* ssq; const GAS float* rope;
    __device__ __forceinline__ void operator()(EPI_ARGS) const {
        const int row0 = u.pm * 256 + wr * 64 + fr, col0 = u.pn * 256 + wc * 32 + 4 * fq;
        float rstd[8];
        { f32x4 p0[8], p1[8];
#pragma unroll
          for (int i = 0; i < 8; ++i) { const int r = row0 + (i >> 2) * 128 + (i & 3) * 16; p0[i] = *(const GAS f32x4*)(ssq + (size_t)r * 12); p1[i] = *(const GAS f32x4*)(ssq + (size_t)r * 12 + 4); }
#pragma unroll
          for (int i = 0; i < 8; ++i) rstd[i] = rsqrtf(((p0[i][0] + p0[i][1]) + (p0[i][2] + p0[i][3]) + (p1[i][0] + p1[i][1]) + (p1[i][2] + p1[i][3])) * (1.f / 512.f) + EPS); }
        const bool rot = u.pn == 2 && u.pm < ML / 256;
#pragma unroll
        for (int ai = 0; ai < 2; ++ai) {
            f32x4 cs[4], sn[4];
#pragma unroll
            for (int m = 0; m < 4; ++m) { const int r = row0 + ai * 128 + m * 16; const int tok = r & (SEQ - 1), pos = rot ? ((wc & 1) == 0 ? (tok >> 6) : (tok & 63)) : 0;
                cs[m] = *(const GAS f32x4*)(rope + pos * 16 + 4 * fq); sn[m] = *(const GAS f32x4*)(rope + 1024 + pos * 16 + 4 * fq); }
#pragma unroll
            for (int m = 0; m < 4; ++m) {
                const int r = row0 + ai * 128 + m * 16, i = ai * 4 + m;
#pragma unroll
                for (int bj = 0; bj < 2; ++bj) {
                    f32x4 a = acc[ai][bj][m][0] * rstd[i], b = acc[ai][bj][m][1] * rstd[i];
                    if (rot) { const f32x4 x1 = a, x2 = b; a = x1 * cs[m] - x2 * sn[m]; b = x1 * sn[m] + x2 * cs[m]; }
                    GAS bf16_t* rowp = Q + (size_t)r * 768 + col0 + bj * 128;
                    st_bf16x4(rowp, a); st_bf16x4(rowp + 16, b);
                }
            }
        }
    }
};
struct EpiMlaKV {
    GAS bf16_t* KV; const GAS float* ssq;
    __device__ __forceinline__ void operator()(EPI_ARGS) const {
        const int row0 = u.pm * 256 + wr * 64 + fr, col0 = u.pn * 256 + wc * 32 + 4 * fq;
        f32x4 p0[8];
#pragma unroll
        for (int i = 0; i < 8; ++i) { const int r = row0 + (i >> 2) * 128 + (i & 3) * 16; p0[i] = *(const GAS f32x4*)(ssq + (size_t)r * 12 + 8); }
#pragma unroll
        for (int ai = 0; ai < 2; ++ai)
#pragma unroll
            for (int m = 0; m < 4; ++m) {
                const int r = row0 + ai * 128 + m * 16, i = ai * 4 + m;
                const float rstd = rsqrtf(((p0[i][0] + p0[i][1]) + (p0[i][2] + p0[i][3])) * (1.f / 256.f) + EPS);
                GAS bf16_t* rowp = KV + (size_t)r * 1024 + col0;
#pragma unroll
                for (int bj = 0; bj < 2; ++bj)
#pragma unroll
                    for (int n = 0; n < 2; ++n) st_bf16x4(rowp + bj * 128 + n * 16, acc[ai][bj][m][n] * rstd);
            }
    }
};
struct EpiGate {
    GAS unsigned char* G;
    __device__ __forceinline__ void operator()(EPI_ARGS) const {
        const __amdgpu_buffer_rsrc_t rsrc = __builtin_amdgcn_make_buffer_rsrc((void*)G, 0, 0x7fffffff, 0x00020000);
        const int voff = threadIdx.x * 8; const int tbase = (u.pm * 32 + u.pn) * 65536;
#pragma unroll
        for (int ai = 0; ai < 2; ++ai)
#pragma unroll
            for (int bj = 0; bj < 2; ++bj)
#pragma unroll
                for (int m = 0; m < 4; ++m) {
                    u32x2 w;
#pragma unroll
                    for (int n = 0; n < 2; ++n) { const f32x4 v = acc[ai][bj][m][n]; unsigned d = 0;
#pragma unroll
                        for (int j = 0; j < 4; ++j) { const float g = __builtin_amdgcn_rcpf(__builtin_fmaf(__builtin_amdgcn_exp2f(v[j]), 1.f / 255.f, 1.f / 255.f)); d = __builtin_amdgcn_cvt_pk_u8_f32(g, j, d); }
                        if (n == 0) w.x = d; else w.y = d; }
                    __builtin_amdgcn_raw_buffer_store_b64(w, rsrc, voff, tbase + ((ai * 2 + bj) * 4 + m) * 4096, 0);
                }
    }
};
struct EpiMerge {
    const GAS unsigned char* G; GAS unsigned char* ACC; const GAS float* rssd;
    __device__ __forceinline__ void operator()(EPI_ARGS) const {
        const int k = u.aux, hf = u.aux2;
        const int row0 = u.pm * 256 + hf * 128 + wr * 64 + fr, col0 = u.pn * 256 + wc * 32 + 4 * fq;
        const __amdgpu_buffer_rsrc_t rg = __builtin_amdgcn_make_buffer_rsrc((void*)G, 0, 0x7fffffff, 0x00020000);
        const int vg = threadIdx.x * 8; const int tbase = (u.pm * 32 + k * 8 + u.pn) * 65536 + hf * 32768;
        u32x2 gw[2][4]; float rsv[4];
#pragma unroll
        for (int m = 0; m < 4; ++m) { rsv[m] = (k == 3) ? rssd[row0 + m * 16] : 1.f;
#pragma unroll
            for (int bj = 0; bj < 2; ++bj) gw[bj][m] = __builtin_amdgcn_raw_buffer_load_b64(rg, vg, tbase + (bj * 4 + m) * 4096, 0); }
#pragma unroll
        for (int m = 0; m < 4; ++m) {
            const int r = row0 + m * 16; const float rs = rsv[m] * (1.f / 255.f);
#pragma unroll
            for (int bj = 0; bj < 2; ++bj) {
                const u32x2 g2 = gw[bj][m];
                f32x4 v0, v1;
                v0[0] = (float)(g2.x & 0xffu); v0[1] = (float)((g2.x >> 8) & 0xffu); v0[2] = (float)((g2.x >> 16) & 0xffu); v0[3] = (float)(g2.x >> 24);
                v1[0] = (float)(g2.y & 0xffu); v1[1] = (float)((g2.y >> 8) & 0xffu); v1[2] = (float)((g2.y >> 16) & 0xffu); v1[3] = (float)(g2.y >> 24);
                v0 = v0 * acc[0][bj][m][0] * rs; v1 = v1 * acc[0][bj][m][1] * rs;
                if (k > 0) { v0 += acc[1][bj][m][0]; v1 += acc[1][bj][m][1]; }
                if (k < 3) { acc[1][bj][m][0] = v0; acc[1][bj][m][1] = v1; }
                else { GAS unsigned char* op = ACC + (size_t)r * DM + col0 + bj * 128;
#pragma unroll
                    for (int j = 0; j < 4; ++j) { v0[j] = __builtin_amdgcn_fmed3f(v0[j], -448.f, 448.f); v1[j] = __builtin_amdgcn_fmed3f(v1[j], -448.f, 448.f); }
                    unsigned w0 = 0, w1 = 0; w0 = __builtin_amdgcn_cvt_pk_fp8_f32(v0[0], v0[1], w0, false); w0 = __builtin_amdgcn_cvt_pk_fp8_f32(v0[2], v0[3], w0, true);
                    w1 = __builtin_amdgcn_cvt_pk_fp8_f32(v1[0], v1[1], w1, false); w1 = __builtin_amdgcn_cvt_pk_fp8_f32(v1[2], v1[3], w1, true);
                    *(GAS unsigned*)op = w0; *(GAS unsigned*)(op + 16) = w1; }
            }
        }
    }
};
struct EpiBf16 {
    GAS bf16_t* O; int ld;
    __device__ __forceinline__ void operator()(EPI_ARGS) const {
        const int row0 = u.pm * 256 + wr * 64 + fr, col0 = u.pn * 256 + wc * 32 + 4 * fq;
#pragma unroll
        for (int ai = 0; ai < 2; ++ai)
#pragma unroll
            for (int m = 0; m < 4; ++m) { GAS bf16_t* rowp = O + (size_t)(row0 + ai * 128 + m * 16) * ld + col0;
#pragma unroll
                for (int bj = 0; bj < 2; ++bj)
#pragma unroll
                    for (int n = 0; n < 2; ++n) st_bf16x4(rowp + bj * 128 + n * 16, acc[ai][bj][m][n]); }
    }
};
struct EpiRouter {
    GAS float* LOG;
    __device__ __forceinline__ void operator()(EPI_ARGS) const {
        if (wc >= 2) return;
        const int row0 = u.pm * 256 + wr * 64 + fr, col0 = wc * 32 + 4 * fq;
#pragma unroll
        for (int ai = 0; ai < 2; ++ai)
#pragma unroll
            for (int m = 0; m < 4; ++m) { GAS float* rowp = LOG + ((size_t)u.aux * MT + (row0 + ai * 128 + m * 16)) * 64 + col0;
#pragma unroll
                for (int n = 0; n < 2; ++n) *(GAS f32x4*)(rowp + n * 16) = acc[ai][0][m][n]; }
    }
};
struct RouterSched {
    int nM, G, c;
    __device__ __forceinline__ bool next(int i, Unit& u) const {
        const long L = (long)i * G + c; if (L >= (long)nM * 4) return false;
        u.pm = (int)(L >> 2); u.pn = 0; u.aux = (int)(L & 3); u.aux2 = 0;
        u.aoff = ((size_t)u.pm * 256 * DM + (size_t)u.aux * 512) * 2; u.boff = (size_t)u.aux * 512 * 2; return true;
    }
    __device__ __forceinline__ int arow(const Unit&, int) const { return 0; }
};
struct MoeSched {
    const volatile LAS int* tb; const volatile LAS int* cnt; const GAS int* list; int nN, G, c, mode;
    __device__ __forceinline__ bool next(int i, Unit& u) const {
        const long L = (long)i * G + c; const int NT = tb[32]; const int nwg = NT * nN;
        if (L >= nwg) return false;
        const int q8 = nwg / pg8::NXCD, r8 = nwg % pg8::NXCD, xcd = (int)(L % pg8::NXCD), off = (int)(L / pg8::NXCD);
        const int wgid = (xcd < r8 ? xcd * (q8 + 1) : r8 * (q8 + 1) + (xcd - r8) * q8) + off;
        const int ti = wgid / nN;
        u.pn = wgid % nN; int e = 0;
        while (e < 31 && ti >= tb[e + 1]) ++e;
        u.aux = e; u.aux2 = ti - tb[e]; u.pm = ti;
        if (mode == 1) { u.aoff = 0; u.boff = ((size_t)e * 1024 + (size_t)u.pn * 256) * DM; }
        else { u.aoff = (size_t)ti * 256 * DEXP; u.boff = ((size_t)e * DM + (size_t)u.pn * 256) * DEXP; }
        return true;
    }
    __device__ __forceinline__ int acnt(const Unit& u) const { return cnt[u.aux]; }
    __device__ __forceinline__ int arow(const Unit& u, int r, int n_e) const {
        const int pos = u.aux2 * 256 + r; const int e = u.aux;
        const bool in = pos < n_e; const int v = list[(size_t)e * MT + (in ? pos : 0)] >> 1;
        return in ? v : 0;
    }
};
struct EpiMoe1 {
    GAS unsigned char* H1;
    __device__ __forceinline__ void operator()(EPI_ARGS) const {
        const int row0 = u.pm * 256 + wr * 64 + fr, col0 = u.pn * 128 + wc * 32 + 4 * fq;
#pragma unroll
        for (int ai = 0; ai < 2; ++ai)
#pragma unroll
            for (int m = 0; m < 4; ++m) { GAS unsigned char* rowp = H1 + (size_t)(row0 + ai * 128 + m * 16) * DEXP + col0;
#pragma unroll
                for (int n = 0; n < 2; ++n) { const f32x4 a = acc[ai][0][m][n], b = acc[ai][1][m][n]; f32x4 v;
#pragma unroll
                    for (int j = 0; j < 4; ++j) v[j] = __builtin_amdgcn_fmed3f(a[j] * __builtin_amdgcn_rcpf(1.f + __builtin_amdgcn_exp2f(-1.4426950409f * a[j])) * b[j], -448.f, 448.f);
                    unsigned w = 0; w = __builtin_amdgcn_cvt_pk_fp8_f32(v[0], v[1], w, false); w = __builtin_amdgcn_cvt_pk_fp8_f32(v[2], v[3], w, true);
                    *(GAS unsigned*)(rowp + n * 16) = w; } }
    }
};
struct EpiMoe2 {
    GAS bf16_t* Y2; const GAS int* list; const GAS float* wl; const volatile LAS int* cnt;
    __device__ __forceinline__ void operator()(EPI_ARGS) const {
        const int e = u.aux, n_e = cnt[e], col0 = u.pn * 256 + wc * 32 + 4 * fq;
        int ts[8]; float w[8];
#pragma unroll
        for (int i = 0; i < 8; ++i) { const int pos = u.aux2 * 256 + (i >> 2) * 128 + wr * 64 + (i & 3) * 16 + fr; const bool ok = pos < n_e;
            const int pc = ok ? pos : 0; const int tv = list[(size_t)e * MT + pc]; const float wv = wl[(size_t)e * MT + pc];
            ts[i] = ok ? tv : -1; w[i] = ok ? wv : 0.f; }
#pragma unroll
        for (int ai = 0; ai < 2; ++ai)
#pragma unroll
            for (int m = 0; m < 4; ++m) { const int i = ai * 4 + m;
                if (ts[i] >= 0) {
                    GAS bf16_t* rowp = Y2 + (size_t)ts[i] * DM + col0;
#pragma unroll
                    for (int bj = 0; bj < 2; ++bj)
#pragma unroll
                        for (int n = 0; n < 2; ++n) st_bf16x4(rowp + bj * 128 + n * 16, acc[ai][bj][m][n] * w[i]);
                }
            }
    }
};

struct WinSched {
    GridSched gs; int mode;
    __device__ __forceinline__ bool next(int i, Unit& u) const {
        const long L = (long)i * gs.G + gs.c; if (L >= gs.nwg) return false;
        int j; gs.map((int)L, u.pm, j);
        u.pn = mode == 0 ? (j < 17 ? 4 + j : 5 + j) : (j < 4 ? j : 21);
        u.aux = 0; u.aux2 = 0; u.aoff = gs.a0 + (size_t)u.pm * gs.a_tile; u.boff = gs.b0 + (size_t)u.pn * gs.b_tile; return true;
    }
    __device__ __forceinline__ int arow(const Unit&, int) const { return 0; }
};
struct MergeSched {
    GridSched gs;
    __device__ __forceinline__ bool next(int i, Unit& u) const {
        const long H = (long)(i >> 2) * gs.G + gs.c; if (H >= 2 * (long)gs.nwg) return false;
        const int hf = H >= gs.nwg ? 1 : 0; gs.map((int)(H - (long)hf * gs.nwg), u.pm, u.pn); const int k = i & 3; u.aux = k; u.aux2 = hf;
        u.aoff = ((size_t)u.pm * 256 + (size_t)hf * 128) * DM + (size_t)k * 512; u.boff = ((size_t)k * DM + (size_t)u.pn * 256) * 512; return true;
    }
    __device__ __forceinline__ int arow(const Unit&, int) const { return 0; }
};

__device__ __forceinline__ void tr_block(const GAS float* colp, int ldw, float nscale, const GAS float* kscale, int k0, GAS bf16_t* WT, int K, int n0, LAS float* scr, int lane) {
    float v[32];
#pragma unroll
    for (int i = 0; i < 32; ++i) { const int kk = 2 * i + (lane >> 5); v[i] = colp[(size_t)(k0 + kk) * ldw]; }
    if (kscale) {
#pragma unroll
        for (int i = 0; i < 32; ++i) { const int kk = 2 * i + (lane >> 5); v[i] *= kscale[k0 + kk]; }
    }
#pragma unroll
    for (int i = 0; i < 32; ++i) { const int kk = 2 * i + (lane >> 5); scr[kk * 33 + (lane & 31)] = v[i] * nscale; }
    LDS_WAIT(); asm volatile("" ::: "memory");
    const int c = lane & 7;
#pragma unroll
    for (int j = 0; j < 4; ++j) { const int n = (lane >> 3) + 8 * j; const LAS float* s = scr + (8 * c) * 33 + n;
        u32x4 o; o.x = cvt_pk_bf16(s[0 * 33], s[1 * 33]); o.y = cvt_pk_bf16(s[2 * 33], s[3 * 33]); o.z = cvt_pk_bf16(s[4 * 33], s[5 * 33]); o.w = cvt_pk_bf16(s[6 * 33], s[7 * 33]);
        *(GAS u32x4*)(WT + (size_t)(n0 + n) * K + k0 + 8 * c) = o; }
    LDS_WAIT(); asm volatile("" ::: "memory");
}

__device__ __forceinline__ void tr_block8(const GAS float* colp, int ldw, float nscale, int k0, GAS unsigned char* WT, int K, int n0, LAS float* scr, int lane) {
    float v[32];
#pragma unroll
    for (int i = 0; i < 32; ++i) { const int kk = 2 * i + (lane >> 5); v[i] = colp[(size_t)(k0 + kk) * ldw]; }
#pragma unroll
    for (int i = 0; i < 32; ++i) { const int kk = 2 * i + (lane >> 5); scr[kk * 33 + (lane & 31)] = v[i] * nscale; }
    LDS_WAIT(); asm volatile("" ::: "memory");
    const int c = lane & 7;
#pragma unroll
    for (int j = 0; j < 4; ++j) { const int n = (lane >> 3) + 8 * j; const LAS float* s = scr + (8 * c) * 33 + n;
        u32x2 o; unsigned w = 0; w = __builtin_amdgcn_cvt_pk_fp8_f32(s[0 * 33], s[1 * 33], w, false); w = __builtin_amdgcn_cvt_pk_fp8_f32(s[2 * 33], s[3 * 33], w, true); o.x = w;
        w = 0; w = __builtin_amdgcn_cvt_pk_fp8_f32(s[4 * 33], s[5 * 33], w, false); w = __builtin_amdgcn_cvt_pk_fp8_f32(s[6 * 33], s[7 * 33], w, true); o.y = w;
        *(GAS u32x2*)(WT + (size_t)(n0 + n) * K + k0 + 8 * c) = o; }
    LDS_WAIT(); asm volatile("" ::: "memory");
}

__device__ __forceinline__ void tr_block8k(const GAS float* colp, int ldw, float nscale, const GAS float* kscale, int k0, GAS unsigned char* WT, int K, int n0, LAS float* scr, int lane) {
    float v[32];
#pragma unroll
    for (int i = 0; i < 32; ++i) { const int kk = 2 * i + (lane >> 5); v[i] = colp[(size_t)(k0 + kk) * ldw]; }
    if (kscale) {
#pragma unroll
        for (int i = 0; i < 32; ++i) { const int kk = 2 * i + (lane >> 5); v[i] *= kscale[k0 + kk]; }
    }
#pragma unroll
    for (int i = 0; i < 32; ++i) { const int kk = 2 * i + (lane >> 5); scr[kk * 33 + (lane & 31)] = v[i] * nscale; }
    LDS_WAIT(); asm volatile("" ::: "memory");
    const int c = lane & 7;
#pragma unroll
    for (int j = 0; j < 4; ++j) { const int n = (lane >> 3) + 8 * j; const LAS float* s = scr + (8 * c) * 33 + n;
        u32x2 o; unsigned w = 0; w = __builtin_amdgcn_cvt_pk_fp8_f32(s[0 * 33], s[1 * 33], w, false); w = __builtin_amdgcn_cvt_pk_fp8_f32(s[2 * 33], s[3 * 33], w, true); o.x = w;
        w = 0; w = __builtin_amdgcn_cvt_pk_fp8_f32(s[4 * 33], s[5 * 33], w, false); w = __builtin_amdgcn_cvt_pk_fp8_f32(s[6 * 33], s[7 * 33], w, true); o.y = w;
        *(GAS u32x2*)(WT + (size_t)(n0 + n) * K + k0 + 8 * c) = o; }
    LDS_WAIT(); asm volatile("" ::: "memory");
}
__device__ __forceinline__ int win_src(int n) {
    if (n < 2048) return n;
    if (n < 5440) return n + 16;
    if (n < 5456) return 2048 + (n - 5440);
    if (n < 5472) return 6992 + (n - 5456);
    if (n < 5632) return -1;
    if (n < 6144) return 5456 + (n - 5632);
    return 5968 + (n - 6144);
}
constexpr int IT_WIN = 32 * 224, IT_WUQ = 8 * 24, IT_WUKV = 4 * 32, IT_WG = 32 * 64, IT_WBR = 8 * 64, IT_WOUT = 32 * 64, IT_WR = 32 * 8, IT_W13 = 32 * 32, IT_W2 = 8 * 64;
constexpr int IT_LAYER = IT_WIN + IT_WUQ + IT_WUKV + 4 * IT_WG + 4 * IT_WBR + IT_WOUT + IT_WR;
constexpr int IT_MOE = NEXP * (IT_W13 + IT_W2);
__device__ __forceinline__ void cvt_layer_item(Frame& F, int l, int r, LAS float* scr) {
    const int lane = F.lane, nl = lane & 31;
    if (r < IT_WIN) { const int nb = r % 224, kb = r / 224, n = nb * 32 + nl, sc = win_src(n);
        const int ct = nb >> 3;
        if (ct >= 4 && ct != 21) tr_block8(INP(I_WIN) + (size_t)l * DM * DIN + (sc >= 0 ? sc : 0), DIN, sc >= 0 ? 64.f : 0.f, kb * 64, WSP(unsigned char, WS_WIN8) + (size_t)l * NU * DM, DM, nb * 32, scr, lane);
        else tr_block(INP(I_WIN) + (size_t)l * DM * DIN + (sc >= 0 ? sc : 0), DIN, sc < 0 ? 0.f : (n < 512 ? 0.08838834764831845f : 1.f), nullptr, kb * 64, WSP(bf16_t, WS_WIN) + (size_t)l * NU * DM, DM, nb * 32, scr, lane);
        return; }
    r -= IT_WIN;
    if (r < IT_WUQ) { const int nb = r % 24, kb = r / 24, n = nb * 32 + nl; const int sc = n < 512 ? (n >> 7) * 192 + (n & 127) : ((n - 512) >> 6) * 192 + 128 + ((n - 512) & 63);
        tr_block(INP(I_WUQ) + (size_t)l * 512 * 768 + sc, 768, 0.07216878364870323f * 1.4426950408889634f, INP(I_MLAGQ) + l * 512, kb * 64, WSP(bf16_t, WS_WUQ) + (size_t)l * 768 * 512, 512, nb * 32, scr, lane); return; }
    r -= IT_WUQ;
    if (r < IT_WUKV) { const int nb = r % 32, kb = r / 32, n = nb * 32 + nl; const int sc = n < 512 ? (n >> 7) * 256 + (n & 127) : ((n - 512) >> 7) * 256 + 128 + ((n - 512) & 127);
        tr_block(INP(I_WUKV) + (size_t)l * 256 * 1024 + sc, 1024, 1.f, INP(I_MLAGKV) + l * 256, kb * 64, WSP(bf16_t, WS_WUKV) + (size_t)l * 1024 * 256, 256, nb * 32, scr, lane); return; }
    r -= IT_WUKV;
    if (r < 4 * IT_WG) { const int k = r / IT_WG, q = r % IT_WG, nb = q % 64, kb = q / 64;
        tr_block8(INP(I_WGATE) + (size_t)(l * 4 + k) * DM * DM + nb * 32 + nl, DM, -92.33248261689366f  , kb * 64, WSP(unsigned char, WS_WG) + ((size_t)l * 8192 + (size_t)k * 2048) * DM, DM, nb * 32, scr, lane); return; }
    r -= 4 * IT_WG;
    if (r < 4 * IT_WBR) { const int k = r / IT_WBR, q = r % IT_WBR, nb = q % 64, kb = q / 64;
        const GAS float* ks = k == 1 ? INP(I_HGNG) + l * 512 : (k == 3 ? INP(I_SSDNG) + l * 512 : nullptr);
        tr_block8k(INP(I_WBR) + (size_t)(l * 4 + k) * 512 * DM + nb * 32 + nl, DM, 64.f, ks, kb * 64, WSP(unsigned char, WS_WBR) + (size_t)(l * 4 + k) * DM * 512, 512, nb * 32, scr, lane); return; }
    r -= 4 * IT_WBR;
    if (r < IT_WOUT) { const int nb = r % 64, kb = r / 64;
        tr_block8(INP(I_WOUT) + (size_t)l * DM * DM + nb * 32 + nl, DM, 64.f, kb * 64, WSP(unsigned char, WS_WOUT) + (size_t)l * DM * DM, DM, nb * 32, scr, lane); return; }
    r -= IT_WOUT;
    { const int nb = r % 8, kb = r / 8, n = nb * 32 + nl; const GAS float* cp = INP(I_WGRP) + (size_t)l * DM * 4; int ld = 4;
      if (n < 4) { cp += n; } else if (n < 36) { cp = INP(I_WEXP) + (size_t)l * DM * 32 + (n - 4); ld = 32; }
      tr_block(cp, ld, n < 36 ? 1.f : 0.f, nullptr, kb * 64, WSP(bf16_t, WS_WR) + (size_t)l * 256 * DM, DM, nb * 32, scr, lane); }
}
__device__ __forceinline__ void cvt_moe_item(Frame& F, int l, int r, LAS float* scr) {
    const int lane = F.lane, nl = lane & 31;
    if (r < NEXP * IT_W13) { const int e = r / IT_W13, q = r % IT_W13, nb = q % 32, kb = q / 32, n = nb * 32 + nl;
        const int c = (n >> 8) * 128 + (n & 127); const GAS float* src = ((n >> 7) & 1) ? INP(I_W3) : INP(I_W1);
        tr_block8(src + (size_t)(l * NEXP + e) * DM * DEXP + c, DEXP, 64.f, kb * 64, WSP(unsigned char, WS_W13) + (size_t)e * 1024 * DM, DM, nb * 32, scr, lane); return; }
    r -= NEXP * IT_W13;
    { const int e = r / IT_W2, q = r % IT_W2, nb = q % 64, kb = q / 64;
      tr_block8(INP(I_W2) + (size_t)(l * NEXP + e) * DEXP * DM + nb * 32 + nl, DM, 64.f, kb * 64, WSP(unsigned char, WS_W2) + (size_t)e * DM * DEXP, DEXP, nb * 32, scr, lane); }
}
__device__ __forceinline__ void ada_task(Frame& F, int task, LAS float* scr) {
    const int ks = task & 15, cg = (task >> 4) % 48, l = task / (16 * 48); const int col = cg * 256 + F.lane * 4;
    for (int i = F.lane; i < 9 * 128; i += 64) { const int r = i >> 7, kk = ks * 128 + (i & 127); const float c = r < 8 ? INP(I_C)[r * DM + kk] : INP(I_CCTX)[kk]; scr[i] = siluf_(c); }
    LDS_WAIT(); asm volatile("" ::: "memory");
    f32x4 a[9];
#pragma unroll
    for (int r = 0; r < 9; ++r) a[r] = (f32x4){0.f, 0.f, 0.f, 0.f};
    const GAS float* W = INP(I_WADA) + ((size_t)l * DM + ks * 128) * 12288 + col;
    for (int k = 0; k < 128; k += 8) {
        f32x4 w[8];
#pragma unroll
        for (int q = 0; q < 8; ++q) w[q] = *(const GAS f32x4*)(W + (size_t)(k + q) * 12288);
#pragma unroll
        for (int q = 0; q < 8; ++q) {
#pragma unroll
            for (int r = 0; r < 9; ++r) a[r] += scr[r * 128 + k + q] * w[q];
        }
    }
    GAS float* P = WSP(float, WS_MODP) + ((size_t)(l * 16 + ks) * 9) * 12288 + col;
#pragma unroll
    for (int r = 0; r < 9; ++r) *(GAS f32x4*)(P + (size_t)r * 12288) = a[r];
    LDS_WAIT(); asm volatile("" ::: "memory");
}
__device__ __forceinline__ void tables_task(Frame& F) {
    GAS float* T = WSP(float, WS_TAB); const int lane = F.lane;
    for (int i = 0; i < 16; ++i) { const float inv = expf(-(float)i * (9.210340371976184f / 16.f)); const float ang = (float)lane * inv; T[lane * 16 + i] = cosf(ang); T[1024 + lane * 16 + i] = sinf(ang); }
    for (int j = lane; j < 512; j += 64) { const float a0 = INP(I_HGLB)[j], a1 = INP(I_HGLB)[512 + j], a2 = INP(I_HGLB)[1024 + j];
        const float mx = fmaxf(a0, fmaxf(a1, a2)), e0 = expf(a0 - mx), e1 = expf(a1 - mx), e2 = expf(a2 - mx), s = e0 + e1 + e2;
        T[2048 + j] = e0 / s; T[2048 + 512 + j] = (e0 + e1) / s; }
}
constexpr int N_ADA = 2 * 48 * 16;
__device__ __forceinline__ void phase_prologue(Frame& F) {
    LAS float* scr = (LAS float*)(F.lds + F.wave * 16384);
    const int gw = F.vcu * 8 + F.wave, NGW = F.G * 8;
    constexpr int TOTAL = N_ADA + 1 + IT_LAYER;
    for (int it = gw; it < TOTAL; it += NGW) {
        int r = it;
        if (r < N_ADA) { ada_task(F, r, scr); continue; } r -= N_ADA;
        if (r == 0) { tables_task(F); continue; } r -= 1;
        cvt_layer_item(F, 0, r, scr);
    }
}
__device__ __forceinline__ void phase_modfin(Frame& F) {
    const int gt = F.vcu * 512 + F.tid, NT_ = F.G * 512;
    for (int i = gt; i < 2 * 9 * 12288; i += NT_) { const int l = i / (9 * 12288), rc = i % (9 * 12288), col = rc % 12288;
        float s = INP(I_BADA)[l * 12288 + col];
#pragma unroll
        for (int ks = 0; ks < 16; ++ks) s += WSP(float, WS_MODP)[((size_t)(l * 16 + ks) * 9) * 12288 + rc];
        WSP(float, WS_MOD)[i] = s; }
}

struct Row8 { f32x4 v[8]; };
__device__ __forceinline__ void ld_row_f32(Row8& R, const GAS float* p, int lane) {
#pragma unroll
    for (int j = 0; j < 8; ++j) R.v[j] = ((const GAS f32x4*)p)[64 * j + lane];
}
__device__ __forceinline__ void st_row_f32(const Row8& R, GAS float* p, int lane) {
#pragma unroll
    for (int j = 0; j < 8; ++j) ((GAS f32x4*)p)[64 * j + lane] = R.v[j];
}
__device__ __forceinline__ void ld_row_bf16(Row8& R, const GAS bf16_t* p, int lane) {
#pragma unroll
    for (int j = 0; j < 8; ++j) { const u32x2 w = ((const GAS u32x2*)p)[64 * j + lane]; R.v[j] = (f32x4){bflo(w.x), bfhi(w.x), bflo(w.y), bfhi(w.y)}; }
}
__device__ __forceinline__ void st_row_bf16(const Row8& R, GAS bf16_t* p, int lane) {
#pragma unroll
    for (int j = 0; j < 8; ++j) { u32x2 w; w.x = cvt_pk_bf16(R.v[j][0], R.v[j][1]); w.y = cvt_pk_bf16(R.v[j][2], R.v[j][3]); ((GAS u32x2*)p)[64 * j + lane] = w; }
}
__device__ __forceinline__ float row_rstd(const Row8& R) {
    float s = 0.f;
#pragma unroll
    for (int j = 0; j < 8; ++j) s += (R.v[j][0] * R.v[j][0] + R.v[j][1] * R.v[j][1]) + (R.v[j][2] * R.v[j][2] + R.v[j][3] * R.v[j][3]);
    return rsqrtf(wave_sum(s) * (1.f / DM) + EPS);
}
__device__ __forceinline__ void st_modnorm(const Row8& R, float rstd, const GAS float* g, const GAS float* shift, const GAS float* scale, GAS bf16_t* o, int lane) {
#pragma unroll
    for (int j = 0; j < 8; ++j) { const int c = 64 * j + lane; const f32x4 gg = ((const GAS f32x4*)g)[c], sh = ((const GAS f32x4*)shift)[c], sc = ((const GAS f32x4*)scale)[c];
        const f32x4 h = (R.v[j] * rstd * gg) * (sc + 1.f) + sh; u32x2 w; w.x = cvt_pk_bf16(h[0], h[1]); w.y = cvt_pk_bf16(h[2], h[3]); ((GAS u32x2*)o)[c] = w; }
}
__device__ __forceinline__ void st_modnorm8(const Row8& R, float rstd, const GAS float* g, const GAS float* shift, const GAS float* scale, GAS unsigned char* o, int lane) {
#pragma unroll
    for (int j = 0; j < 8; ++j) { const int c = 64 * j + lane; const f32x4 gg = ((const GAS f32x4*)g)[c], sh = ((const GAS f32x4*)shift)[c], sc = ((const GAS f32x4*)scale)[c];
        f32x4 h = (R.v[j] * rstd * gg) * (sc + 1.f) + sh;
#pragma unroll
        for (int q = 0; q < 4; ++q) h[q] = __builtin_amdgcn_fmed3f(h[q], -448.f, 448.f);
        unsigned w = 0; w = __builtin_amdgcn_cvt_pk_fp8_f32(h[0], h[1], w, false); w = __builtin_amdgcn_cvt_pk_fp8_f32(h[2], h[3], w, true); ((GAS unsigned*)o)[c] = w; }
}
__device__ __forceinline__ void st_modnorm2(const Row8& R, float rstd, const GAS float* g, const GAS float* shift, const GAS float* scale, GAS bf16_t* o16, GAS unsigned char* o8, int lane) {
#pragma unroll
    for (int j = 0; j < 8; ++j) { const int c = 64 * j + lane; const f32x4 gg = ((const GAS f32x4*)g)[c], sh = ((const GAS f32x4*)shift)[c], sc = ((const GAS f32x4*)scale)[c];
        f32x4 h = (R.v[j] * rstd * gg) * (sc + 1.f) + sh; u32x2 w; w.x = cvt_pk_bf16(h[0], h[1]); w.y = cvt_pk_bf16(h[2], h[3]); ((GAS u32x2*)o16)[c] = w;
#pragma unroll
        for (int q = 0; q < 4; ++q) h[q] = __builtin_amdgcn_fmed3f(h[q], -448.f, 448.f);
        unsigned w8 = 0; w8 = __builtin_amdgcn_cvt_pk_fp8_f32(h[0], h[1], w8, false); w8 = __builtin_amdgcn_cvt_pk_fp8_f32(h[2], h[3], w8, true); ((GAS unsigned*)o8)[c] = w8; }
}
__device__ __forceinline__ const GAS float* mod_row(Frame& F, int l, int r) { return WSP(float, WS_MOD) + (size_t)(l * 9 + (r < ML ? (r >> 11) : 8)) * 12288; }
struct RawX { f32x4 f[8]; };
__device__ __forceinline__ void ld_raw_f32(RawX& R, const GAS float* p, int lane) {
#pragma unroll
    for (int j = 0; j < 8; ++j) R.f[j] = ((const GAS f32x4*)p)[64 * j + lane];
}
__device__ __forceinline__ void ld_raw_bf16(RawX& R, const GAS bf16_t* p, int lane) {
#pragma unroll
    for (int j = 0; j < 8; ++j) { const u32x2 w = ((const GAS u32x2*)p)[64 * j + lane]; R.f[j] = (f32x4){__uint_as_float(w.x), __uint_as_float(w.y), 0.f, 0.f}; }
}
__device__ __forceinline__ void raw_to_row(Row8& X, const RawX& R, bool is_bf16) {
#pragma unroll
    for (int j = 0; j < 8; ++j) { if (is_bf16) { const unsigned a = __float_as_uint(R.f[j][0]), b = __float_as_uint(R.f[j][1]); X.v[j] = (f32x4){bflo(a), bfhi(a), bflo(b), bfhi(b)}; } else X.v[j] = R.f[j]; }
}
struct RawB { u32x2 w[8]; };
__device__ __forceinline__ void ld_rawb(RawB& R, const GAS bf16_t* p, int lane) {
#pragma unroll
    for (int j = 0; j < 8; ++j) R.w[j] = ((const GAS u32x2*)p)[64 * j + lane];
}
__device__ __forceinline__ void rawb_to_row(Row8& X, const RawB& R) {
#pragma unroll
    for (int j = 0; j < 8; ++j) X.v[j] = (f32x4){bflo(R.w[j].x), bfhi(R.w[j].x), bflo(R.w[j].y), bfhi(R.w[j].y)};
}
__device__ __forceinline__ int row_grp(int r) { return r < ML ? (r >> 11) : 8; }
__device__ __forceinline__ void stage_vec(Frame& F, LAS float* dst, const GAS float* src) { ((LAS f32x4*)dst)[F.tid] = ((const GAS f32x4*)src)[F.tid]; }
__device__ __forceinline__ void st_modnorm2_l(const Row8& R, float rstd, const LAS float* g, const LAS float* shift, const LAS float* scale, GAS bf16_t* o16, GAS unsigned char* o8, int lane) {
#pragma unroll
    for (int j = 0; j < 8; ++j) { const int c = 64 * j + lane; const f32x4 gg = ((const LAS f32x4*)g)[c], sh = ((const LAS f32x4*)shift)[c], sc = ((const LAS f32x4*)scale)[c];
        f32x4 h = (R.v[j] * rstd * gg) * (sc + 1.f) + sh; u32x2 w; w.x = cvt_pk_bf16(h[0], h[1]); w.y = cvt_pk_bf16(h[2], h[3]); ((GAS u32x2*)o16)[c] = w;
#pragma unroll
        for (int q = 0; q < 4; ++q) h[q] = __builtin_amdgcn_fmed3f(h[q], -448.f, 448.f);
        unsigned w8 = 0; w8 = __builtin_amdgcn_cvt_pk_fp8_f32(h[0], h[1], w8, false); w8 = __builtin_amdgcn_cvt_pk_fp8_f32(h[2], h[3], w8, true); ((GAS unsigned*)o8)[c] = w8; }
}
__device__ __forceinline__ void phase_rwA(Frame& F, int l) {
    const int rpb = (MT + F.G - 1) / F.G, rlo = F.vcu * rpb, rhi = (rlo + rpb < MT ? rlo + rpb : MT) - 1;
    if (rlo > rhi) return;
    LAS float* Lf = (LAS float*)F.lds; const int ga = row_grp(rlo), gb = row_grp(rhi);
    stage_vec(F, Lf, INP(I_NORMG) + (size_t)(l * 4 + 0) * DM);
#pragma unroll
    for (int v = 0; v < 2; ++v) { stage_vec(F, Lf + (1 + v) * 2048, WSP(float, WS_MOD) + (size_t)(l * 9 + ga) * 12288 + v * DM); stage_vec(F, Lf + (3 + v) * 2048, WSP(float, WS_MOD) + (size_t)(l * 9 + gb) * 12288 + v * DM); }
    __syncthreads();
    for (int i0 = F.wave; i0 < rpb; i0 += 16) {
        const int r0 = rlo + i0, r1 = r0 + 8; const bool two = i0 + 8 < rpb && r1 <= rhi;
        if (r0 > rhi) break;
        RawX Ra, Rb; ld_raw_f32(Ra, r0 < ML ? INP(I_X) + (size_t)r0 * DM : INP(I_CTX) + (size_t)(r0 - ML) * DM, F.lane);
        if (two) ld_raw_f32(Rb, r1 < ML ? INP(I_X) + (size_t)r1 * DM : INP(I_CTX) + (size_t)(r1 - ML) * DM, F.lane);
#pragma unroll
        for (int q = 0; q < 2; ++q) { if (q == 1 && !two) break; const int r = q ? r1 : r0;
            Row8 R; raw_to_row(R, q ? Rb : Ra, false);
            const float rstd = row_rstd(R); const LAS float* md = Lf + (row_grp(r) == ga ? 1 : 3) * 2048;
            st_modnorm2_l(R, rstd, Lf, md, md + 2048, WSP(bf16_t, WS_HIN) + (size_t)r * DM, WSP(unsigned char, WS_H8) + (size_t)r * DM, F.lane); }
    }
}
__device__ __forceinline__ void phase_rwB(Frame& F, int l, int mrows) {
    const int rpb = (mrows + F.G - 1) / F.G, rlo = F.vcu * rpb, rhi = (rlo + rpb < mrows ? rlo + rpb : mrows) - 1;
    if (rlo > rhi) return;
    LAS float* Lf = (LAS float*)F.lds; const int ga = row_grp(rlo), gb = row_grp(rhi);
    stage_vec(F, Lf, INP(I_NORMG) + (size_t)(l * 4 + 1) * DM); stage_vec(F, Lf + 2048, INP(I_NORMG) + (size_t)(l * 4 + 2) * DM);
#pragma unroll
    for (int v = 0; v < 3; ++v) { stage_vec(F, Lf + (2 + v) * 2048, WSP(float, WS_MOD) + (size_t)(l * 9 + ga) * 12288 + (2 + v) * DM); stage_vec(F, Lf + (5 + v) * 2048, WSP(float, WS_MOD) + (size_t)(l * 9 + gb) * 12288 + (2 + v) * DM); }
    __syncthreads();
    const LAS float* g1 = Lf; const LAS float* g2 = Lf + 2048;
    for (int i0 = F.wave; i0 < rpb; i0 += 16) {
        const int r0 = rlo + i0, r1 = r0 + 8; const bool two = i0 + 8 < rpb && r1 <= rhi;
        if (r0 > rhi) break;
        RawB Ya, Yb; RawX Xa, Xb;
#define RWB_LOAD(Y_, X_, r_) do { ld_rawb(Y_, WSP(bf16_t, WS_RB + RB_Y) + (size_t)(r_) * DM, F.lane); \
        if ((r_) < ML) { if (l == 0) ld_raw_f32(X_, INP(I_X) + (size_t)(r_) * DM, F.lane); else ld_raw_bf16(X_, (const GAS bf16_t*)(F.out + (size_t)(r_) * DM), F.lane); } \
        else ld_raw_f32(X_, l == 0 ? INP(I_CTX) + (size_t)((r_) - ML) * DM : WSP(float, WS_XC) + (size_t)((r_) - ML) * DM, F.lane); } while (0)
        RWB_LOAD(Ya, Xa, r0); if (two) RWB_LOAD(Yb, Xb, r1);
#undef RWB_LOAD
#pragma unroll
        for (int q = 0; q < 2; ++q) { if (q == 1 && !two) break; const int r = q ? r1 : r0;
            Row8 Y, X; rawb_to_row(Y, q ? Yb : Ya); raw_to_row(X, q ? Xb : Xa, r < ML && l != 0);
            const float ry = row_rstd(Y); const LAS float* md = Lf + (row_grp(r) == ga ? 2 : 5) * 2048;
#pragma unroll
            for (int j = 0; j < 8; ++j) { const int c = 64 * j + F.lane; X.v[j] += ((const LAS f32x4*)md)[c] * (Y.v[j] * ry * ((const LAS f32x4*)g1)[c]); }
            if (r < ML) st_row_bf16(X, (GAS bf16_t*)(F.out + (size_t)r * DM), F.lane); else st_row_f32(X, WSP(float, WS_XC) + (size_t)(r - ML) * DM, F.lane);
            const float rx = row_rstd(X);
            st_modnorm2_l(X, rx, g2, md + 2048, md + 4096, WSP(bf16_t, WS_H) + (size_t)r * DM, WSP(unsigned char, WS_H8) + (size_t)r * DM, F.lane); }
    }
}
__device__ __forceinline__ void phase_rwC(Frame& F, int l, int mrows) {
    const int rpb = (mrows + F.G - 1) / F.G, rlo = F.vcu * rpb, rhi = (rlo + rpb < mrows ? rlo + rpb : mrows) - 1;
    if (rlo > rhi) return;
    LAS float* Lf = (LAS float*)F.lds; const int ga = row_grp(rlo), gb = row_grp(rhi);
    stage_vec(F, Lf, INP(I_NORMG) + (size_t)(l * 4 + 3) * DM);
    stage_vec(F, Lf + 2 * 2048, WSP(float, WS_MOD) + (size_t)(l * 9 + ga) * 12288 + 5 * DM); stage_vec(F, Lf + 5 * 2048, WSP(float, WS_MOD) + (size_t)(l * 9 + gb) * 12288 + 5 * DM);
    if (l + 1 < DEPTH) { stage_vec(F, Lf + 2048, INP(I_NORMG) + (size_t)((l + 1) * 4 + 0) * DM);
#pragma unroll
        for (int v = 0; v < 2; ++v) { stage_vec(F, Lf + (3 + v) * 2048, WSP(float, WS_MOD) + (size_t)((l + 1) * 9 + ga) * 12288 + v * DM); stage_vec(F, Lf + (6 + v) * 2048, WSP(float, WS_MOD) + (size_t)((l + 1) * 9 + gb) * 12288 + v * DM); } }
    __syncthreads();
    const LAS float* g3 = Lf;
    for (int i0 = F.wave; i0 < rpb; i0 += 16) {
        const int r0 = rlo + i0, r1 = r0 + 8; const bool two = i0 + 8 < rpb && r1 <= rhi;
        if (r0 > rhi) break;
        RawB Aa, Ba, Ab, Bb; RawX Xa, Xb;
#define RWC_LOAD(A_, B_, X_, r_) do { ld_rawb(A_, WSP(bf16_t, WS_RB + RB_Y2) + (size_t)(2 * (r_)) * DM, F.lane); ld_rawb(B_, WSP(bf16_t, WS_RB + RB_Y2) + (size_t)(2 * (r_) + 1) * DM, F.lane); \
        if ((r_) < ML) ld_raw_bf16(X_, (const GAS bf16_t*)(F.out + (size_t)(r_) * DM), F.lane); else ld_raw_f32(X_, WSP(float, WS_XC) + (size_t)((r_) - ML) * DM, F.lane); } while (0)
        RWC_LOAD(Aa, Ba, Xa, r0); if (two) RWC_LOAD(Ab, Bb, Xb, r1);
#undef RWC_LOAD
#pragma unroll
        for (int q = 0; q < 2; ++q) { if (q == 1 && !two) break; const int r = q ? r1 : r0;
            Row8 A, B, X; rawb_to_row(A, q ? Ab : Aa); rawb_to_row(B, q ? Bb : Ba); raw_to_row(X, q ? Xb : Xa, r < ML);
#pragma unroll
            for (int j = 0; j < 8; ++j) A.v[j] += B.v[j];
            const float ry = row_rstd(A); const LAS float* md = Lf + (row_grp(r) == ga ? 2 : 5) * 2048;
#pragma unroll
            for (int j = 0; j < 8; ++j) { const int c = 64 * j + F.lane; X.v[j] += ((const LAS f32x4*)md)[c] * (A.v[j] * ry * ((const LAS f32x4*)g3)[c]); }
            if (r >= ML) st_row_f32(X, WSP(float, WS_XC) + (size_t)(r - ML) * DM, F.lane);
            else if (l + 1 < DEPTH) st_row_bf16(X, (GAS bf16_t*)(F.out + (size_t)r * DM), F.lane);
            else st_row_f32(X, F.out + (size_t)r * DM, F.lane);
            if (l + 1 < DEPTH) { const float rx = row_rstd(X);
                st_modnorm2_l(X, rx, Lf + 2048, md + 2048, md + 4096, WSP(bf16_t, WS_HIN) + (size_t)r * DM, WSP(unsigned char, WS_H8) + (size_t)r * DM, F.lane); } }
    }
}
__device__ __forceinline__ void ld8bf(float (&o)[8], const GAS bf16_t* p) { const u32x4 w = *(const GAS u32x4*)p; o[0] = bflo(w.x); o[1] = bfhi(w.x); o[2] = bflo(w.y); o[3] = bfhi(w.y); o[4] = bflo(w.z); o[5] = bfhi(w.z); o[6] = bflo(w.w); o[7] = bfhi(w.w); }
__device__ __forceinline__ void st8bf(GAS bf16_t* p, const float (&v)[8]) { u32x4 w; w.x = cvt_pk_bf16(v[0], v[1]); w.y = cvt_pk_bf16(v[2], v[3]); w.z = cvt_pk_bf16(v[4], v[5]); w.w = cvt_pk_bf16(v[6], v[7]); *(GAS u32x4*)p = w; }
__device__ __forceinline__ void st8fp8(GAS unsigned char* p, const float (&v)[8]) {
    float c[8];
#pragma unroll
    for (int j = 0; j < 8; ++j) c[j] = __builtin_amdgcn_fmed3f(v[j], -448.f, 448.f);
    u32x2 o; unsigned w = 0; w = __builtin_amdgcn_cvt_pk_fp8_f32(c[0], c[1], w, false); w = __builtin_amdgcn_cvt_pk_fp8_f32(c[2], c[3], w, true); o.x = w;
    w = 0; w = __builtin_amdgcn_cvt_pk_fp8_f32(c[4], c[5], w, false); w = __builtin_amdgcn_cvt_pk_fp8_f32(c[6], c[7], w, true); o.y = w; *(GAS u32x2*)p = o;
}
__device__ __forceinline__ void unpk8(float (&o)[8], u32x4 w) { o[0] = bflo(w.x); o[1] = bfhi(w.x); o[2] = bflo(w.y); o[3] = bfhi(w.y); o[4] = bflo(w.z); o[5] = bfhi(w.z); o[6] = bflo(w.w); o[7] = bfhi(w.w); }
__device__ __forceinline__ void phase_finish(Frame& F, int l, int mrows) {
    const int gw = F.vcu * 8 + F.wave, NGW = F.G * 8, c8 = F.lane * 8;
    const GAS bf16_t* Y = WSP(bf16_t, WS_YFB); const GAS bf16_t* U = WSP(bf16_t, WS_RA); GAS unsigned char* BR = WSP(unsigned char, WS_BR); const GAS float* dskip = INP(I_SSDD) + l * 8;
    const float dsk = dskip[F.lane >> 3];
    struct FinRow { u32x4 v[10]; };
#define FIN_LOAD(R_, r_) do { const size_t r__ = (size_t)(r_); \
        R_.v[0] = *(const GAS u32x4*)(Y + ((size_t)0 * MT + r__) * 512 + c8); R_.v[1] = *(const GAS u32x4*)(Y + ((size_t)1 * MT + r__) * 512 + c8); R_.v[2] = *(const GAS u32x4*)(U + r__ * NU + U_MLO + c8); \
        R_.v[3] = *(const GAS u32x4*)(Y + ((size_t)2 * MT + r__) * 512 + c8); R_.v[4] = *(const GAS u32x4*)(Y + ((size_t)3 * MT + r__) * 512 + c8); R_.v[5] = *(const GAS u32x4*)(U + r__ * NU + U_HGG + c8); \
        R_.v[6] = *(const GAS u32x4*)(Y + ((size_t)4 * MT + r__) * 512 + c8); R_.v[7] = *(const GAS u32x4*)(Y + ((size_t)5 * MT + r__) * 512 + c8); R_.v[8] = *(const GAS u32x4*)(U + r__ * NU + U_Z + c8); \
        R_.v[9] = *(const GAS u32x4*)(WSP(bf16_t, WS_XBC) + r__ * 1024 + c8); } while (0)
    for (int r0 = gw; r0 < mrows; r0 += 2 * NGW) {
        const int r1 = r0 + NGW; const bool two = r1 < mrows;
        FinRow Ra, Rb; FIN_LOAD(Ra, r0); if (two) FIN_LOAD(Rb, r1);
#pragma unroll
        for (int q = 0; q < 2; ++q) { if (q == 1 && !two) break; const int r = q ? r1 : r0; const FinRow& R = q ? Rb : Ra;
            float a[8], b[8], g[8], o[8];
            unpk8(a, R.v[0]); unpk8(b, R.v[1]); unpk8(g, R.v[2]);
#pragma unroll
            for (int j = 0; j < 8; ++j) o[j] = (a[j] + b[j]) * sigmoidf_(g[j]);
            st8fp8(BR + (size_t)r * DM + c8, o);
            unpk8(a, R.v[3]); unpk8(b, R.v[4]); unpk8(g, R.v[5]);
            float ss = 0.f;
#pragma unroll
            for (int j = 0; j < 8; ++j) { a[j] += b[j]; ss += a[j] * a[j]; }
            ss += __shfl_xor(ss, 1); ss += __shfl_xor(ss, 2); ss += __shfl_xor(ss, 4); ss += __shfl_xor(ss, 8);
            const float rh = rsqrtf(ss * (1.f / 128.f) + EPS);
#pragma unroll
            for (int j = 0; j < 8; ++j) o[j] = a[j] * rh * sigmoidf_(g[j]);
            st8fp8(BR + (size_t)r * DM + 512 + c8, o);
            unpk8(a, R.v[6]); unpk8(b, R.v[7]); unpk8(g, R.v[8]);
            float s2 = 0.f, xh[8]; unpk8(xh, R.v[9]);
#pragma unroll
            for (int j = 0; j < 8; ++j) { o[j] = (a[j] + b[j] + dsk * xh[j]) * siluf_(g[j]); s2 += o[j] * o[j]; }
            s2 = wave_sum(s2);
            if (F.lane == 0) WSP(float, WS_RSSD)[r] = rsqrtf(s2 * (1.f / 512.f) + EPS);
            st8fp8(BR + (size_t)r * DM + 1536 + c8, o);
        }
    }
#undef FIN_LOAD
}

__device__ __forceinline__ void phase_ssdconv(Frame& F, int l) {
    const int gw = F.vcu * 8 + F.wave, NGW = F.G * 8, c16 = F.lane * 16;
    const GAS bf16_t* U = WSP(bf16_t, WS_RA); GAS bf16_t* X2 = WSP(bf16_t, WS_XBC);
    float w0[16], w1[16], w2[16], cb[16];
    { const GAS float* cw = INP(I_CONVW) + (size_t)l * 3 * 1024 + c16; const GAS float* bb = INP(I_CONVB) + l * 1024 + c16;
#pragma unroll
      for (int j = 0; j < 16; ++j) { w0[j] = cw[j]; w1[j] = cw[1024 + j]; w2[j] = cw[2048 + j]; cb[j] = bb[j]; } }
    for (int r = gw; r < MT; r += NGW) {
        const int t = r < ML ? (r & (SEQ - 1)) : ((r - ML) & (CTXL - 1)), tn = r < ML ? SEQ : CTXL;
        const GAS bf16_t* up = U + (size_t)r * NU + U_XBC + c16;
        float a[16], p_[16], n_[16];
        { const bool hp = t > 0, hn = t + 1 < tn; const GAS bf16_t* pp = hp ? up - NU : up; const GAS bf16_t* np = hn ? up + NU : up; const float pf = hp ? 1.f : 0.f, nf = hn ? 1.f : 0.f;
          const u32x4 ra0 = *(const GAS u32x4*)up, ra1 = *(const GAS u32x4*)(up + 8), rp0 = *(const GAS u32x4*)pp, rp1 = *(const GAS u32x4*)(pp + 8), rn0 = *(const GAS u32x4*)np, rn1 = *(const GAS u32x4*)(np + 8);
          float t8[8];
          unpk8(t8, ra0);
#pragma unroll
          for (int j = 0; j < 8; ++j) a[j] = t8[j]; unpk8(t8, ra1);
#pragma unroll
          for (int j = 0; j < 8; ++j) a[8 + j] = t8[j]; unpk8(t8, rp0);
#pragma unroll
          for (int j = 0; j < 8; ++j) p_[j] = t8[j] * pf; unpk8(t8, rp1);
#pragma unroll
          for (int j = 0; j < 8; ++j) p_[8 + j] = t8[j] * pf; unpk8(t8, rn0);
#pragma unroll
          for (int j = 0; j < 8; ++j) n_[j] = t8[j] * nf; unpk8(t8, rn1);
#pragma unroll
          for (int j = 0; j < 8; ++j) n_[8 + j] = t8[j] * nf; }
        float o[8];
#pragma unroll
        for (int j = 0; j < 8; ++j) o[j] = siluf_(w0[j] * p_[j] + w1[j] * a[j] + w2[j] * n_[j] + cb[j]);
        st8bf(X2 + (size_t)r * 1024 + c16, o);
#pragma unroll
        for (int j = 0; j < 8; ++j) o[j] = siluf_(w0[8 + j] * p_[8 + j] + w1[8 + j] * a[8 + j] + w2[8 + j] * n_[8 + j] + cb[8 + j]);
        st8bf(X2 + (size_t)r * 1024 + c16 + 8, o);
    }
}

__device__ __forceinline__ void phase_scanprep(Frame& F, int l) {
    const int gw = F.vcu * 8 + F.wave, NGW = F.G * 8, lane = F.lane, r32 = lane & 31, hi = lane >> 5;
    const GAS bf16_t* U = WSP(bf16_t, WS_RA);
    constexpr int N_ML = 64 * 72, N_SSD = 64 * 72, N_HG = 64 * 72 * 2, N_MLC = 32 * 72;
    for (int it = gw; it < N_ML + N_SSD + N_HG + N_MLC; it += NGW) {
        if (it >= N_ML + N_SSD + N_HG) {
            const int q = it - (N_ML + N_SSD + N_HG), cg = q % 72, bh = q / 72, b = bh >> 2, h = bh & 3;
            GAS bf16_t* dst = WSP(bf16_t, WS_MLC) + ((size_t)bh * 2304 + 32 * cg) * 384;
#pragma unroll 1
            for (int ib = 0; ib < 3; ++ib) { u32x4 v[8];
#pragma unroll
                for (int i = 0; i < 8; ++i) { const int piece = (ib * 8 + i) * 64 + lane, rr = piece / 48, pc = piece % 48, ci = 32 * cg + rr;
                    const int trow = ci < CTXL ? ML + b * CTXL + ci : b * SEQ + (ci - CTXL);
                    v[i] = *(const GAS u32x4*)(U + (size_t)trow * NU + (pc >> 4) * 512 + h * 128 + (pc & 15) * 8); }
#pragma unroll
                for (int i = 0; i < 8; ++i) { const int piece = (ib * 8 + i) * 64 + lane; *(GAS u32x4*)(dst + (size_t)piece * 8) = v[i]; } }
            continue;
        }
        if (it < N_ML) {
            const int c = it % 72, task = it / 72, b = task >> 3, h = (task >> 1) & 3, dir = task & 1, cg = U_MLG + dir * 8 + h;
            const float fbias = INP(I_MLFB)[l * 8 + dir * 4 + h];
            const GAS bf16_t* gp = U + (size_t)prow(b, dir, 32 * c + r32) * NU + cg; const float gi = bf2f(gp[0]), gf = bf2f(gp[4]);
            const float x_ = gf + fbias, flog = fminf(x_, 0.f) - log1pf(__expf(-fabsf(x_)));
            const float Fl = scn::scan_add32(flog, r32), bl = gi - Fl, Ml = scn::scan_max32(bl, r32);
            if (hi == 0) *(GAS f32x4*)(WSP(float, WS_MLS) + ((size_t)task * 2304 + 32 * c + r32) * 8) = (f32x4){Fl, bl, Ml, 0.f};
        } else if (it < N_ML + N_SSD) {
            const int q = it - N_ML, c = q % 72, t3 = q / 72, b = t3 >> 3, hp = (t3 >> 1) & 3, dir = t3 & 1, hd = 2 * hp + hi;
            const float dtb = INP(I_DTB)[l * 16 + dir * 8 + hd], aneg = -__expf(INP(I_ALOG)[l * 16 + dir * 8 + hd]);
            const float xr_ = bf2f(U[(size_t)prow(b, dir, 32 * c + r32) * NU + U_DT + dir * 8 + hd]) + dtb;
            const float dt_ = fmaxf(xr_, 0.f) + log1pf(__expf(-fabsf(xr_))), at = scn::scan_add32(dt_ * aneg, r32), ae = __shfl(at, 31, 32);
            GAS float* rp = WSP(float, WS_SSDS) + ((size_t)((b * 2 + dir) * 8 + hd) * 2304 + 32 * c + r32) * 8;
            *(GAS f32x4*)rp = (f32x4){dt_, at, __expf(at), __expf(ae - at)}; *(GAS f32x4*)(rp + 4) = (f32x4){__expf(ae), 0.f, 0.f, 0.f};
        } else {
            const int q = it - N_ML - N_SSD, half = q & 1, c = (q >> 1) % 72, task = (q >> 1) / 72, b = task >> 3, h = (task >> 1) & 3, dir = task & 1, r16 = lane >> 2, ch0 = half * 64 + 16 * (lane & 3);
            GAS unsigned char* item = F.ws + WS_HGP + (size_t)(task * 72 + c) * HGP_ITEM;
            const GAS float* lbp = WSP(float, WS_TAB) + 2048 + l * 512 + h * 128 + ch0;
            float lb[16], cc[16], ee[16];
            u32x4 raw[2][4];
#pragma unroll
            for (int rb = 0; rb < 2; ++rb) { const GAS bf16_t* up = U + (size_t)prow(b, dir, 32 * c + rb * 16 + r16) * NU;
                raw[rb][0] = *(const GAS u32x4*)(up + U_HGF + dir * 512 + h * 128 + ch0); raw[rb][1] = *(const GAS u32x4*)(up + U_HGF + dir * 512 + h * 128 + ch0 + 8);
                raw[rb][2] = *(const GAS u32x4*)(up + U_HGQ + h * 128 + ch0); raw[rb][3] = *(const GAS u32x4*)(up + U_HGQ + h * 128 + ch0 + 8); }
#pragma unroll
            for (int j = 0; j < 16; ++j) { lb[j] = lbp[j]; cc[j] = 0.f; ee[j] = 0.f; }
#pragma unroll
            for (int rb = 0; rb < 2; ++rb) {
                const int rloc = rb * 16 + r16;
                float fa[8], fb[8], qa[8], qb[8], q1[16], k1[16];
                unpk8(fa, raw[rb][0]); unpk8(fb, raw[rb][1]); unpk8(qa, raw[rb][2]); unpk8(qb, raw[rb][3]);
#pragma unroll
                for (int j = 0; j < 16; ++j) {
                    const float fr_ = j < 8 ? fa[j & 7] : fb[j & 7], qr_ = j < 8 ? qa[j & 7] : qb[j & 7];
                    const float f_ = lb[j] + (1.f - lb[j]) * __builtin_amdgcn_rcpf(1.f + __expf(-fr_)); float x_ = __logf(f_);
                    { const float o = __shfl_up(x_, 4); if (lane >= 4) x_ += o; } { const float o = __shfl_up(x_, 8); if (lane >= 8) x_ += o; }
                    { const float o = __shfl_up(x_, 16); if (lane >= 16) x_ += o; } { const float o = __shfl_up(x_, 32); if (lane >= 32) x_ += o; }
                    const float tot = __shfl(x_, 60 + (lane & 3));
                    float g_;
                    if (rb == 0) { cc[j] = tot; g_ = x_; } else { g_ = cc[j] + x_; ee[j] = cc[j] + tot; }
                    const float e1 = __expf(g_ - cc[j]);
                    q1[j] = qr_ * __builtin_amdgcn_rcpf(1.f + __expf(-qr_)) * e1; k1[j] = (1.f - f_) * __builtin_amdgcn_rcpf(e1);
                }
                float t8[8];
#pragma unroll
                for (int j = 0; j < 8; ++j) t8[j] = q1[j]; st8bf((GAS bf16_t*)(item + scn::rowl(rloc, ch0 * 2)), t8);
#pragma unroll
                for (int j = 0; j < 8; ++j) t8[j] = q1[8 + j]; st8bf((GAS bf16_t*)(item + scn::rowl(rloc, ch0 * 2 + 16)), t8);
#pragma unroll
                for (int j = 0; j < 8; ++j) t8[j] = k1[j]; st8bf((GAS bf16_t*)(item + 8192 + scn::rowl(rloc, ch0 * 2)), t8);
#pragma unroll
                for (int j = 0; j < 8; ++j) t8[j] = k1[8 + j]; st8bf((GAS bf16_t*)(item + 8192 + scn::rowl(rloc, ch0 * 2 + 16)), t8);
            }
            if (r16 == 0) { GAS float* vv = (GAS float*)(item + 16384) + ch0;
#pragma unroll
                for (int j = 0; j < 16; ++j) { vv[j] = __expf(cc[j]); vv[128 + j] = __expf(ee[j] - cc[j]); } }
        }
    }
}
constexpr size_t CTL_CNTB = 131072;
__device__ __forceinline__ void phase_route(Frame& F, int l, int mrows, const XcdBarrier& bar) {
    unsigned* cnt = F.ctl + CW_CNT + l * 64;
    GAS int* list = WSP(int, WS_LIST); GAS float* wl = WSP(float, WS_WL);
    GAS int* cntb = (GAS int*)(F.ws + WS_CTL + CTL_CNTB) + (size_t)l * 1024 * 32;
    LAS int* ch = (LAS int*)F.lds;
    LAS int* off = ch + 1024;
    LAS int* part = ch + 2048;
    LAS int* base = ch + 2048 + 1024;
    const int t = F.tid, bx = F.vcu, G = F.G;
    const int rpb = (mrows + G - 1) / G, r = bx * rpb + t; const bool act = t < rpb && r < mrows;
    int ea = -1, eb = -1; float wa = 0.f, wb = 0.f;
    if (act) {
        const GAS float* lg0 = WSP(float, WS_LOG) + (size_t)r * 64;
        f32x4 lgv[9];
#pragma unroll
        for (int q = 0; q < 9; ++q) { lgv[q] = *(const GAS f32x4*)(lg0 + 4 * q);
#pragma unroll
            for (int ks = 1; ks < 4; ++ks) lgv[q] += *(const GAS f32x4*)(lg0 + (size_t)ks * MT * 64 + 4 * q); }
        const f32x4 g = lgv[0]; int gi = 0; float gm = g[0];
#pragma unroll
        for (int i = 1; i < 4; ++i) if (g[i] > gm) { gm = g[i]; gi = i; }
        float gs = 0.f;
#pragma unroll
        for (int i = 0; i < 4; ++i) gs += __expf(g[i] - gm);
        const float gp = 1.f / gs;
        f32x4 e0 = lgv[1], e1 = lgv[2];
        if (gi == 1) { e0 = lgv[3]; e1 = lgv[4]; } else if (gi == 2) { e0 = lgv[5]; e1 = lgv[6]; } else if (gi == 3) { e0 = lgv[7]; e1 = lgv[8]; }
        float ev[8] = {e0[0], e0[1], e0[2], e0[3], e1[0], e1[1], e1[2], e1[3]};
        int i1 = 0; float v1 = ev[0];
#pragma unroll
        for (int i = 1; i < 8; ++i) if (ev[i] > v1) { v1 = ev[i]; i1 = i; }
        int i2 = -1; float v2 = -3.4e38f;
#pragma unroll
        for (int i = 0; i < 8; ++i) if (i != i1 && ev[i] > v2) { v2 = ev[i]; i2 = i; }
        const float w1 = 1.f / (1.f + __expf(v2 - v1)), w2 = 1.f - w1;
        ea = gi * 8 + i1; eb = gi * 8 + i2; wa = w1 * gp; wb = w2 * gp;
    }
    ch[2 * t] = ea; ch[2 * t + 1] = eb;
    __syncthreads();
    if (t < 32) {
        int c = 0; const int n2 = 2 * (rpb < 512 ? rpb : 512);
#pragma unroll 8
        for (int i = 0; i < n2; ++i) { if (ch[i] == t) { off[i] = c; ++c; } }
        cntb[bx * 32 + t] = c;
    }
    xcd_barrier(bar);
    { const int e = t & 31, p = t >> 5; int sp = 0, sa = 0;
      for (int b2 = p; b2 < G; b2 += 16) { const int c = cntb[b2 * 32 + e]; sa += c; sp += b2 < bx ? c : 0; }
      part[p * 32 + e] = sp; part[512 + p * 32 + e] = sa; }
    __syncthreads();
    if (t < 32) { int sp = 0, sa = 0;
#pragma unroll
        for (int p = 0; p < 16; ++p) { sp += part[p * 32 + t]; sa += part[512 + p * 32 + t]; }
        base[t] = sp; if (bx == 0) cnt[t] = (unsigned)sa; }
    __syncthreads();
    if (act) { const int pa = base[ea] + off[2 * t], pb = base[eb] + off[2 * t + 1];
        list[(size_t)ea * MT + pa] = r * 2; wl[(size_t)ea * MT + pa] = wa;
        list[(size_t)eb * MT + pb] = r * 2 + 1; wl[(size_t)eb * MT + pb] = wb; }
    __syncthreads();
}
__device__ __forceinline__ void moe_tables(Frame& F, int l) {
    __syncthreads();
    if (F.tid < 32) F.MISC[64 + F.tid] = __hip_atomic_load(F.ctl + CW_CNT + l * 64 + F.tid, __ATOMIC_RELAXED, __HIP_MEMORY_SCOPE_AGENT);
    __syncthreads();
    if (F.tid == 0) { int s = 0; for (int e = 0; e < 32; ++e) { F.MISC[16 + e] = s; s += ((int)F.MISC[64 + e] + 255) >> 8; } F.MISC[48] = s; }
    __syncthreads();
}

constexpr int NSTEP = CTXL + SEQ;
namespace scn {
enum { K_ML = 0, K_HG = 1, K_SSD = 2 };
constexpr int GRP_BYTES = 65536, O_QT = 0, O_KT = 8192, O_QH = 16384, O_KH = 24576, O_VT = 34816, O_VH = 45056, O_SC = 55296, O_N = 59392, O_TOT = 60416;
constexpr int NCH = (CTXL + SEQ) / 32;
__device__ __forceinline__ int crow(int r, int hi) { return (r & 3) + 8 * (r >> 2) + 4 * hi; }
template <int OFF> __device__ __forceinline__ s16x4 trr(int base) { s16x4 r; asm volatile("ds_read_b64_tr_b16 %0, %1 offset:%2" : "=&v"(r) : "v"(base), "i"(OFF) : "memory"); return r; }
#define SCN_PK(L, H) (bf16x8){L[0], L[1], L[2], L[3], H[0], H[1], H[2], H[3]}
template <int S1, int CB> __device__ __forceinline__ bf16x8 trfrag(int base) { const s16x4 lo = trr<S1 * 5120 + CB * 2>(base), hi_ = trr<S1 * 5120 + 2560 + CB * 2>(base); return SCN_PK(lo, hi_); }
__device__ __forceinline__ void unpack8(float (&o)[8], u32x4 w) { o[0] = bflo(w.x); o[1] = bfhi(w.x); o[2] = bflo(w.y); o[3] = bfhi(w.y); o[4] = bflo(w.z); o[5] = bfhi(w.z); o[6] = bflo(w.w); o[7] = bfhi(w.w); }
__device__ __forceinline__ u32x4 pack8(const float (&v)[8]) { u32x4 w; w.x = cvt_pk_bf16(v[0], v[1]); w.y = cvt_pk_bf16(v[2], v[3]); w.z = cvt_pk_bf16(v[4], v[5]); w.w = cvt_pk_bf16(v[6], v[7]); return w; }

template <int KIND>
__device__ __forceinline__ void scan_block(Frame& F, int l, int task) {
    const int tid = F.tid, wave = F.wave, lane = tid & 63, grp = wave >> 2, vb = wave & 3, gt = tid & 255, r32 = lane & 31, hi = lane >> 5;
    LAS char* L = (LAS char*)F.lds + grp * GRP_BYTES;
    const int Lb = (int)(uintptr_t)L;
    const int b = task >> 3, hx = (task >> 1) & 3, dir = task & 1;
    const int srow = gt >> 3, sp = gt & 7;
    const GAS bf16_t* U = WSP(bf16_t, WS_RA); const GAS bf16_t* X2 = WSP(bf16_t, WS_XBC);
    GAS bf16_t* YO = WSP(bf16_t, WS_YFB) + (size_t)(KIND * 2 + dir) * MT * 512;
    LAS float* SC = (LAS float*)(L + O_SC);
    int cq = 0, ck = 0, cv = 0;
    const GAS float* recA = nullptr; const GAS float* recB = nullptr; const GAS unsigned char* hgp = nullptr; const GAS bf16_t* mlc = nullptr;
    if constexpr (KIND == K_ML) { cq = U_MLQ + hx * 128 + 16 * sp; ck = U_MLK + hx * 128 + 16 * sp; cv = U_MLV + hx * 128 + 16 * sp;
        recA = WSP(float, WS_MLS) + (size_t)task * 2304 * 8; recB = recA; mlc = WSP(bf16_t, WS_MLC) + (size_t)(b * 4 + hx) * 2304 * 384; }
    if constexpr (KIND == K_HG) { cv = U_HGI + hx * 128 + 16 * sp; hgp = F.ws + WS_HGP + (size_t)task * 72 * HGP_ITEM; }
    if constexpr (KIND == K_SSD) { const int g = hx >> 1; cq = 768 + g * 128 + 16 * sp; ck = 512 + g * 128 + 16 * sp; cv = hx * 128 + 16 * sp;
        recA = WSP(float, WS_SSDS) + (size_t)((b * 2 + dir) * 8 + 2 * hx + (sp >> 2)) * 2304 * 8;
        recB = WSP(float, WS_SSDS) + (size_t)((b * 2 + dir) * 8 + 2 * hx + hi) * 2304 * 8; }
    f32x16 S[4];
#pragma unroll
    for (int k = 0; k < 4; ++k)
#pragma unroll
        for (int r = 0; r < 16; ++r) S[k][r] = 0.f;
    if (KIND == K_ML) { LAS float* nn = (LAS float*)(L + O_N); nn[gt] = 0.f; }
    float Fs = 0.f, Bp = -INFINITY;
    const int i16 = lane & 15, g4 = lane >> 4;
    const int trb = Lb + (4 * hi + (i16 >> 2)) * 320 + (16 * (g4 & 1) + 4 * (i16 & 3)) * 2;
    struct Pre { u32x4 a0, a1, b0, b1, c0, c1; f32x4 sA, sB; float g1; }; Pre P0;
#define SCN_LOAD(P, c_) do { const int c__ = (c_); const int row_ = prow(b, dir, 32 * c__ + srow); \
        if constexpr (KIND == K_SSD) { const GAS bf16_t* xp = X2 + (size_t)row_ * 1024; P.a0 = *(const GAS u32x4*)(xp + cq); P.a1 = *(const GAS u32x4*)(xp + cq + 8); P.b0 = *(const GAS u32x4*)(xp + ck); P.b1 = *(const GAS u32x4*)(xp + ck + 8); P.c0 = *(const GAS u32x4*)(xp + cv); P.c1 = *(const GAS u32x4*)(xp + cv + 8); \
            P.sA = *(const GAS f32x4*)(recA + (size_t)(32 * c__ + srow) * 8); P.sB = *(const GAS f32x4*)(recB + (size_t)(32 * c__ + r32) * 8); P.g1 = recB[(size_t)(32 * c__ + r32) * 8 + 4]; } \
        else if constexpr (KIND == K_ML) { const int p__ = 32 * c__ + srow; const int ci_ = p__ < CTXL ? (dir ? CTXL - 1 - p__ : p__) : CTXL + (dir ? SEQ - 1 - (p__ - CTXL) : p__ - CTXL); \
            const GAS bf16_t* up = mlc + (size_t)ci_ * 384 + 16 * sp; P.a0 = *(const GAS u32x4*)(up); P.a1 = *(const GAS u32x4*)(up + 8); P.b0 = *(const GAS u32x4*)(up + 128); P.b1 = *(const GAS u32x4*)(up + 136); P.c0 = *(const GAS u32x4*)(up + 256); P.c1 = *(const GAS u32x4*)(up + 264); \
            P.sA = *(const GAS f32x4*)(recA + (size_t)(32 * c__ + srow) * 8); P.sB = *(const GAS f32x4*)(recB + (size_t)(32 * c__ + r32) * 8); } \
        else { const GAS unsigned char* it_ = hgp + (size_t)c__ * HGP_ITEM; const int ra_ = rowl(srow, 32 * sp), rb_ = rowl(srow, 32 * sp + 16); \
            P.a0 = *(const GAS u32x4*)(it_ + ra_); P.a1 = *(const GAS u32x4*)(it_ + rb_); P.b0 = *(const GAS u32x4*)(it_ + 8192 + ra_); P.b1 = *(const GAS u32x4*)(it_ + 8192 + rb_); \
            const GAS bf16_t* up = U + (size_t)row_ * NU; P.c0 = *(const GAS u32x4*)(up + cv); P.c1 = *(const GAS u32x4*)(up + cv + 8); \
            if (gt < 64) P.sA = *(const GAS f32x4*)((const GAS float*)(it_ + 16384) + 4 * gt); } } while (0)
#define SCN_STAGE(P, NPAR) do { \
        const int ra = rowl(srow, 32 * sp), rb = rowl(srow, 32 * sp + 16), ta = srow * 320 + 32 * sp; \
        *(LAS u32x4*)(L + O_QT + ra) = P.a0; *(LAS u32x4*)(L + O_QT + rb) = P.a1; *(LAS u32x4*)(L + O_KT + ra) = P.b0; *(LAS u32x4*)(L + O_KT + rb) = P.b1; \
        if constexpr (KIND == K_ML) { \
            const float Fle = __shfl(P.sB[0], 31, 32), Mle = __shfl(P.sB[2], 31, 32);         \
            const float bt = P.sB[1] - Fs, Bt = fmaxf(Bp, P.sB[2] - Fs), Be = fmaxf(Bp, Mle - Fs); \
            if (vb == 0 && hi == 0) { SC[r32] = bt; SC[32 + r32] = Bt; SC[64 + r32] = __expf(Bp - Bt); SC[96 + r32] = __expf(-(Fs + P.sB[0] + Bt)); if (r32 == 0) SC[128] = __expf(Bp - Be); } \
            const float win = __expf(P.sA[1] - Fs - Be); Fs += Fle; Bp = Be; \
            { LAS const float* nq = (LAS const float*)(L + O_N) + (NPAR) * 128 + 16 * sp;        \
              const f32x4 n0 = *(const LAS f32x4*)(nq), n1 = *(const LAS f32x4*)(nq + 4), n2 = *(const LAS f32x4*)(nq + 8), n3 = *(const LAS f32x4*)(nq + 12); \
              float qa[8], qb[8]; unpack8(qa, P.a0); unpack8(qb, P.a1); \
              float d = ((qa[0] * n0[0] + qa[1] * n0[1]) + (qa[2] * n0[2] + qa[3] * n0[3])) + ((qa[4] * n1[0] + qa[5] * n1[1]) + (qa[6] * n1[2] + qa[7] * n1[3])) \
                      + ((qb[0] * n2[0] + qb[1] * n2[1]) + (qb[2] * n2[2] + qb[3] * n2[3])) + ((qb[4] * n3[0] + qb[5] * n3[1]) + (qb[6] * n3[2] + qb[7] * n3[3])); \
              d += __shfl_xor(d, 1); d += __shfl_xor(d, 2); d += __shfl_xor(d, 4); \
              if (sp == 0) SC[160 + srow] = d; } \
            float ka[8], kb_[8]; unpack8(ka, P.b0); unpack8(kb_, P.b1); \
            _Pragma("unroll") for (int j = 0; j < 8; ++j) { ka[j] *= win; kb_[j] *= win; } \
            *(LAS u32x4*)(L + O_KH + ta) = pack8(ka); *(LAS u32x4*)(L + O_KH + ta + 16) = pack8(kb_); *(LAS u32x4*)(L + O_VT + ta) = P.c0; *(LAS u32x4*)(L + O_VT + ta + 16) = P.c1; \
        } else if constexpr (KIND == K_SSD) { \
            if (vb == 0) { SC[hi * 32 + r32] = P.sB[1]; SC[64 + hi * 32 + r32] = P.sB[2]; if (r32 == 0) SC[128 + hi] = P.g1; } \
            const float dts = P.sA[0], vsc = P.sA[3]; float va[8], vb_[8]; unpack8(va, P.c0); unpack8(vb_, P.c1); \
            *(LAS u32x4*)(L + O_KH + ta) = P.b0; *(LAS u32x4*)(L + O_KH + ta + 16) = P.b1; \
            _Pragma("unroll") for (int j = 0; j < 8; ++j) { va[j] *= dts; vb_[j] *= dts; } \
            *(LAS u32x4*)(L + O_VT + ta) = pack8(va); *(LAS u32x4*)(L + O_VT + ta + 16) = pack8(vb_); \
            _Pragma("unroll") for (int j = 0; j < 8; ++j) { va[j] *= vsc; vb_[j] *= vsc; } \
            *(LAS u32x4*)(L + O_VH + ta) = pack8(va); *(LAS u32x4*)(L + O_VH + ta + 16) = pack8(vb_); \
        } else { \
            *(LAS u32x4*)(L + O_KH + ta) = P.b0; *(LAS u32x4*)(L + O_KH + ta + 16) = P.b1; *(LAS u32x4*)(L + O_VT + ta) = P.c0; *(LAS u32x4*)(L + O_VT + ta + 16) = P.c1; \
            if (gt < 64) *(LAS f32x4*)(SC + 4 * gt) = P.sA; \
        } } while (0)
    constexpr int OQH = O_QT, OVH = (KIND == K_SSD) ? O_VH : O_VT;
    auto compute = [&](const int c) __attribute__((always_inline)) {
        const int hh = vb >> 1;
        if constexpr (KIND == K_HG) {
#pragma unroll
            for (int kb = 0; kb < 4; ++kb)
#pragma unroll
                for (int r = 0; r < 16; ++r) S[kb][r] *= SC[32 * kb + crow(r, hi)];
        }
        f32x16 acc;
#pragma unroll
        for (int r = 0; r < 16; ++r) acc[r] = 0.f;
        if (c > 0) {
#pragma unroll
            for (int kb = 0; kb < 4; ++kb)
#pragma unroll
                for (int s1 = 0; s1 < 2; ++s1) {
                    u32x4 aw; aw.x = cvt_pk_bf16(S[kb][8 * s1 + 0], S[kb][8 * s1 + 1]); aw.y = cvt_pk_bf16(S[kb][8 * s1 + 2], S[kb][8 * s1 + 3]); aw.z = cvt_pk_bf16(S[kb][8 * s1 + 4], S[kb][8 * s1 + 5]); aw.w = cvt_pk_bf16(S[kb][8 * s1 + 6], S[kb][8 * s1 + 7]);
                    const int cb0 = (32 * kb + 16 * s1 + 4 * hi) * 2;
                    const u32x2 lo = *(const LAS u32x2*)(L + OQH + rowl(r32, cb0)), hi2 = *(const LAS u32x2*)(L + OQH + rowl(r32, cb0 + 16));
                    const u32x4 bw = {lo.x, lo.y, hi2.x, hi2.y};
                    acc = __builtin_amdgcn_mfma_f32_32x32x16_bf16(__builtin_bit_cast(bf16x8, aw), __builtin_bit_cast(bf16x8, bw), acc, 0, 0, 0);
                }
            if constexpr (KIND == K_ML) { const float w = SC[64 + r32];
#pragma unroll
                for (int r = 0; r < 16; ++r) acc[r] *= w; }
            if constexpr (KIND == K_SSD) { const float w = SC[64 + hh * 32 + r32];
#pragma unroll
                for (int r = 0; r < 16; ++r) acc[r] *= w; }
        }
        f32x16 p;
#pragma unroll
        for (int r = 0; r < 16; ++r) p[r] = 0.f;
#pragma unroll
        for (int kk = 0; kk < 8; ++kk) { const int cb0 = (16 * kk + 8 * hi) * 2;
            const bf16x8 a = *(const LAS bf16x8*)(L + O_KT + rowl(r32, cb0)), bq = *(const LAS bf16x8*)(L + O_QT + rowl(r32, cb0));
            p = __builtin_amdgcn_mfma_f32_32x32x16_bf16(a, bq, p, 0, 0, 0); }
        float den = 0.f;
        if constexpr (KIND == K_ML) { const float Bt = SC[32 + r32];
            f32x4 bs4[4];
#pragma unroll
            for (int q = 0; q < 4; ++q) bs4[q] = *(const LAS f32x4*)(SC + 8 * q + 4 * hi);
#pragma unroll
            for (int r = 0; r < 16; ++r) { const int s_ = crow(r, hi); float w = __expf(fminf(bs4[r >> 2][r & 3] - Bt, 0.f)); w = s_ <= r32 ? w : 0.f; p[r] *= w; den += p[r]; }
            { auto rr = __builtin_amdgcn_permlane32_swap(__float_as_uint(den), __float_as_uint(den), false, false); den = __uint_as_float(rr[0]) + __uint_as_float(rr[1]); }
        } else if constexpr (KIND == K_SSD) { const float at = SC[hh * 32 + r32];
            f32x4 as_[4];
#pragma unroll
            for (int q = 0; q < 4; ++q) as_[q] = *(const LAS f32x4*)(SC + hh * 32 + 8 * q + 4 * hi);
#pragma unroll
            for (int r = 0; r < 16; ++r) { const int s_ = crow(r, hi); float w = __expf(fminf(at - as_[r >> 2][r & 3], 0.f)); p[r] *= s_ <= r32 ? w : 0.f; }
        } else {
#pragma unroll
            for (int r = 0; r < 16; ++r) { if (crow(r, hi) > r32) p[r] = 0.f; }
        }
        {
            u32x4 w0, w1; w0.x = cvt_pk_bf16(p[0], p[1]); w0.y = cvt_pk_bf16(p[2], p[3]); w0.z = cvt_pk_bf16(p[4], p[5]); w0.w = cvt_pk_bf16(p[6], p[7]);
            w1.x = cvt_pk_bf16(p[8], p[9]); w1.y = cvt_pk_bf16(p[10], p[11]); w1.z = cvt_pk_bf16(p[12], p[13]); w1.w = cvt_pk_bf16(p[14], p[15]);
            const int vbase = trb + O_VT + vb * 64;
            const bf16x8 v0 = trfrag<0, 0>(vbase), v1 = trfrag<1, 0>(vbase);
            asm volatile("s_waitcnt lgkmcnt(0)" ::: "memory"); __builtin_amdgcn_sched_barrier(0);
            acc = __builtin_amdgcn_mfma_f32_32x32x16_bf16(v0, __builtin_bit_cast(bf16x8, w0), acc, 0, 0, 0);
            acc = __builtin_amdgcn_mfma_f32_32x32x16_bf16(v1, __builtin_bit_cast(bf16x8, w1), acc, 0, 0, 0);
        }
        float oscale = 1.f;
        if constexpr (KIND == K_ML) {
            LAS const float* nn = (LAS const float*)(L + O_N) + (c & 1) * 128;
            const float ds = SC[160 + r32] * SC[64 + r32];
            oscale = __builtin_amdgcn_rcpf(fmaxf(fabsf(den + ds), SC[96 + r32]));
            { const int k = 32 * vb + r32; float sm = 0.f;
#pragma unroll
              for (int s_ = 0; s_ < 16; ++s_) sm += bf2f(*(const LAS bf16_t*)(L + O_KH + (16 * hi + s_) * 320 + k * 2));
              { auto rr = __builtin_amdgcn_permlane32_swap(__float_as_uint(sm), __float_as_uint(sm), false, false); sm = __uint_as_float(rr[0]) + __uint_as_float(rr[1]); }
              LAS float* n2 = (LAS float*)(L + O_N) + ((c + 1) & 1) * 128;
              if (hi == 0) n2[k] = SC[128] * nn[k] + sm; }
        }
        { const int orow = prow(b, dir, 32 * c + r32); GAS bf16_t* yp = YO + (size_t)orow * 512 + hx * 128 + 32 * vb + 4 * hi;
#pragma unroll
          for (int q = 0; q < 4; ++q) { u32x2 w; w.x = cvt_pk_bf16(acc[4 * q] * oscale, acc[4 * q + 1] * oscale); w.y = cvt_pk_bf16(acc[4 * q + 2] * oscale, acc[4 * q + 3] * oscale); *(GAS u32x2*)(yp + 8 * q) = w; } }
        {
            const int kbase = trb + O_KH, vbase = trb + OVH + vb * 64;
            const bf16x8 vh0 = trfrag<0, 0>(vbase), vh1 = trfrag<1, 0>(vbase);
            const bf16x8 k00 = trfrag<0, 0>(kbase), k01 = trfrag<1, 0>(kbase), k10 = trfrag<0, 32>(kbase), k11 = trfrag<1, 32>(kbase);
            const bf16x8 k20 = trfrag<0, 64>(kbase), k21 = trfrag<1, 64>(kbase), k30 = trfrag<0, 96>(kbase), k31 = trfrag<1, 96>(kbase);
            if constexpr (KIND != K_HG) { const float rd = KIND == K_ML ? SC[128] : SC[128 + hh];
#pragma unroll
                for (int kb = 0; kb < 4; ++kb)
#pragma unroll
                    for (int r = 0; r < 16; ++r) S[kb][r] *= rd; }
            asm volatile("s_waitcnt lgkmcnt(0)" ::: "memory"); __builtin_amdgcn_sched_barrier(0);
            S[0] = __builtin_amdgcn_mfma_f32_32x32x16_bf16(k00, vh0, S[0], 0, 0, 0); S[0] = __builtin_amdgcn_mfma_f32_32x32x16_bf16(k01, vh1, S[0], 0, 0, 0);
            S[1] = __builtin_amdgcn_mfma_f32_32x32x16_bf16(k10, vh0, S[1], 0, 0, 0); S[1] = __builtin_amdgcn_mfma_f32_32x32x16_bf16(k11, vh1, S[1], 0, 0, 0);
            S[2] = __builtin_amdgcn_mfma_f32_32x32x16_bf16(k20, vh0, S[2], 0, 0, 0); S[2] = __builtin_amdgcn_mfma_f32_32x32x16_bf16(k21, vh1, S[2], 0, 0, 0);
            S[3] = __builtin_amdgcn_mfma_f32_32x32x16_bf16(k30, vh0, S[3], 0, 0, 0); S[3] = __builtin_amdgcn_mfma_f32_32x32x16_bf16(k31, vh1, S[3], 0, 0, 0);
            if constexpr (KIND == K_HG) {
#pragma unroll
                for (int kb = 0; kb < 4; ++kb)
#pragma unroll
                    for (int r = 0; r < 16; ++r) S[kb][r] *= SC[128 + 32 * kb + crow(r, hi)];
            }
        }
    };
    {
        SCN_LOAD(P0, 0);
        __syncthreads();
        SCN_STAGE(P0, 0);
        __syncthreads();
        for (int c = 0; c < NCH; ++c) {
            if (c + 1 < NCH) SCN_LOAD(P0, c + 1);
            compute(c);
            __syncthreads();
            if (c + 1 < NCH) { SCN_STAGE(P0, (c + 1) & 1); }
            __syncthreads();
        }
    }
#undef SCN_LOAD
#undef SCN_STAGE
}
}

namespace att {
constexpr int KVBLK = 64, SHM_V = 64 * 128 * 2, SHM_K = 64 * 192 * 2;
constexpr float THRL = 11.5f;
#define AKSWZ(row, colB) ((row) * 384 + ((colB) ^ (((row) & 7) << 4)))
#define ASBAR() __builtin_amdgcn_sched_barrier(0)
__device__ __forceinline__ int crow(int r, int hi) { return (r & 3) + 8 * (r >> 2) + 4 * hi; }
__device__ __forceinline__ void partialSM(f32x16& p0, f32x16& p1, float& m_reg, float& mn, float& alpha) {
    float pmax = p0[0];
#pragma unroll
    for (int r = 1; r < 16; ++r) pmax = fmaxf(pmax, p0[r]);
#pragma unroll
    for (int r = 0; r < 16; ++r) pmax = fmaxf(pmax, p1[r]);
    { auto rr = __builtin_amdgcn_permlane32_swap(__float_as_uint(pmax), __float_as_uint(pmax), false, false); pmax = fmaxf(__uint_as_float(rr[0]), __uint_as_float(rr[1])); }
    if (__builtin_expect(__all(pmax - m_reg <= THRL), 1)) { mn = m_reg; alpha = 1.f; }
    else { mn = fmaxf(m_reg, pmax); alpha = __builtin_amdgcn_exp2f(m_reg - mn); m_reg = mn; }
#pragma unroll
    for (int r = 0; r < 16; ++r) p0[r] = __builtin_amdgcn_exp2f(p0[r] - mn);
#pragma unroll
    for (int r = 0; r < 16; ++r) p1[r] = p1[r] - mn;
}
__device__ __forceinline__ void finishSM(f32x16& p0, f32x16& p1, float alpha, float& l_reg, bf16x8& pa0, bf16x8& pa1, bf16x8& pa2, bf16x8& pa3) {
#pragma unroll
    for (int r = 0; r < 16; ++r) p1[r] = __builtin_amdgcn_exp2f(p1[r]);
    float ps = 0;
#pragma unroll
    for (int r = 0; r < 16; ++r) ps += p0[r];
#pragma unroll
    for (int r = 0; r < 16; ++r) ps += p1[r];
    { auto rr = __builtin_amdgcn_permlane32_swap(__float_as_uint(ps), __float_as_uint(ps), false, false); ps = __uint_as_float(rr[0]) + __uint_as_float(rr[1]); }
    l_reg = l_reg * alpha + ps;
#define APK4(P, BASE, OUT) do { unsigned a0 = cvt_pk_bf16(P[BASE + 0], P[BASE + 1]), a1 = cvt_pk_bf16(P[BASE + 2], P[BASE + 3]);   \
    unsigned b0 = cvt_pk_bf16(P[BASE + 4], P[BASE + 5]), b1 = cvt_pk_bf16(P[BASE + 6], P[BASE + 7]);                              \
    auto r0 = __builtin_amdgcn_permlane32_swap(a0, b0, false, false); auto r1 = __builtin_amdgcn_permlane32_swap(a1, b1, false, false); \
    u32x4 w = {r0[0], r1[0], r0[1], r1[1]}; OUT = __builtin_bit_cast(bf16x8, w); } while (0)
    APK4(p0, 0, pa0); APK4(p0, 8, pa1); APK4(p1, 0, pa2); APK4(p1, 8, pa3);
#undef APK4
}
__device__ __forceinline__ void qkt(f32x16& p0, f32x16& p1, const LAS char* Ks, const bf16x8* qr, int r32, int hi) {
    p0 = f32x16{}; p1 = f32x16{};
#pragma unroll
    for (int d0 = 0; d0 < 12; ++d0) { const int cb = (d0 * 16 + hi * 8) * 2;
        const bf16x8 b0 = *(const LAS bf16x8*)(Ks + AKSWZ(r32, cb));
        const bf16x8 b1 = *(const LAS bf16x8*)(Ks + AKSWZ(32 + r32, cb));
        p0 = __builtin_amdgcn_mfma_f32_32x32x16_bf16(b0, qr[d0], p0, 0, 0, 0);
        p1 = __builtin_amdgcn_mfma_f32_32x32x16_bf16(b1, qr[d0], p1, 0, 0, 0); }
}
__device__ __forceinline__ int v_st(int k, int c) { const int kk = (k & ~0xC) | ((k & 4) << 1) | ((k & 8) >> 1); return ((kk >> 3) * 4 + (c >> 5)) * 512 + ((kk & 7) * 32 + (c & 31)) * 2; }
__device__ __forceinline__ int v_rd_base(int lane) { return ((lane & 3) << 3) | (((lane >> 2) & 3) << 6) | (((lane >> 4) & 1) << 5) | (((lane >> 5) & 1) << 8); }
constexpr int v_rd_off(int d0, int ks, int half) { return d0 * 512 + ks * 4096 + half * 2048; }
template <int OFF> __device__ __forceinline__ s16x4 tr_read(int vb) { s16x4 r; asm volatile("ds_read_b64_tr_b16 %0, %1 offset:%2" : "=&v"(r) : "v"(vb), "i"(OFF) : "memory"); return r; }
template <int D0> __device__ __forceinline__ void pv_one(f32x16& od, int vb, bf16x8 pa0, bf16x8 pa1, bf16x8 pa2, bf16x8 pa3) {
    const s16x4 l0 = tr_read<v_rd_off(D0, 0, 0)>(vb), h0 = tr_read<v_rd_off(D0, 0, 1)>(vb), l1 = tr_read<v_rd_off(D0, 1, 0)>(vb), h1 = tr_read<v_rd_off(D0, 1, 1)>(vb);
    const s16x4 l2 = tr_read<v_rd_off(D0, 2, 0)>(vb), h2 = tr_read<v_rd_off(D0, 2, 1)>(vb), l3 = tr_read<v_rd_off(D0, 3, 0)>(vb), h3 = tr_read<v_rd_off(D0, 3, 1)>(vb);
    asm volatile("s_waitcnt lgkmcnt(0)" ::: "memory"); ASBAR();
#define APK(L, H) (bf16x8){L[0], L[1], L[2], L[3], H[0], H[1], H[2], H[3]}
    od = __builtin_amdgcn_mfma_f32_32x32x16_bf16(pa0, APK(l0, h0), od, 0, 0, 0);
    od = __builtin_amdgcn_mfma_f32_32x32x16_bf16(pa1, APK(l1, h1), od, 0, 0, 0);
    od = __builtin_amdgcn_mfma_f32_32x32x16_bf16(pa2, APK(l2, h2), od, 0, 0, 0);
    od = __builtin_amdgcn_mfma_f32_32x32x16_bf16(pa3, APK(l3, h3), od, 0, 0, 0);
#undef APK
}
__device__ __forceinline__ void pv_d0(f32x16* o, int vb, bf16x8 pa0, bf16x8 pa1, bf16x8 pa2, bf16x8 pa3) {
    pv_one<0>(o[0], vb, pa0, pa1, pa2, pa3); pv_one<1>(o[1], vb, pa0, pa1, pa2, pa3); pv_one<2>(o[2], vb, pa0, pa1, pa2, pa3); pv_one<3>(o[3], vb, pa0, pa1, pa2, pa3);
}
__device__ __forceinline__ void attn_unit(const GAS bf16_t* __restrict__ QB, const GAS bf16_t* __restrict__ KVB, const GAS bf16_t* __restrict__ U, GAS unsigned char* __restrict__ BR,
                                          int qrow0, int h, int kctx0, int klat0, int nct, int NT, LAS char* lds) {
    const int tid = opaque_tid(), wid = tid >> 6, lane = tid & 63, r32 = lane & 31, hi = lane >> 5;
    LAS char* V_lds = lds; LAS char* K_lds = lds + 2 * SHM_V;
    LAS float* ws = (LAS float*)(lds + 2 * SHM_V + 2 * SHM_K) + wid * 64; LAS float* li_l = ws; LAS float* al_l = ws + 32;
    float m_reg = -1e30f, l_reg = 0; f32x16 o[4] = {}; bf16x8 qr[12];
    const GAS bf16_t* Qw = QB + (size_t)(qrow0 + wid * 32 + r32) * 768;
#pragma unroll
    for (int d0 = 0; d0 < 8; ++d0) qr[d0] = *(const GAS bf16x8*)(Qw + h * 128 + d0 * 16 + hi * 8);
#pragma unroll
    for (int d0 = 8; d0 < 12; ++d0) qr[d0] = *(const GAS bf16x8*)(Qw + 512 + h * 64 + (d0 - 8) * 16 + hi * 8);
    const int sr = tid >> 4, sc = (tid & 15) * 8, vst0 = v_st(sr, sc), vst1 = v_st(32 + sr, sc), rr_ = tid >> 3, rc_ = (tid & 7) * 8;
    const int vb0 = (int)(uintptr_t)V_lds + v_rd_base(lane);
    struct { bf16x8 vs0, vs1, ks0, ks1, kr; } sr_[1];
#define ASLOAD(i, j_) do { const int j__ = (j_); const int k0 = j__ < nct ? kctx0 + 64 * j__ : klat0 + 64 * (j__ - nct); \
    sr_[i].vs0 = *(const GAS bf16x8*)(KVB + (size_t)(k0 + sr) * 1024 + 512 + h * 128 + sc); sr_[i].vs1 = *(const GAS bf16x8*)(KVB + (size_t)(k0 + 32 + sr) * 1024 + 512 + h * 128 + sc); \
    sr_[i].ks0 = *(const GAS bf16x8*)(KVB + (size_t)(k0 + sr) * 1024 + h * 128 + sc); sr_[i].ks1 = *(const GAS bf16x8*)(KVB + (size_t)(k0 + 32 + sr) * 1024 + h * 128 + sc); \
    sr_[i].kr = *(const GAS bf16x8*)(U + (size_t)(k0 + rr_) * NU + U_KR + rc_); } while (0)
#define ASWRITE(b, i) do { *(LAS bf16x8*)(V_lds + (b) * SHM_V + vst0) = sr_[i].vs0; *(LAS bf16x8*)(V_lds + (b) * SHM_V + vst1) = sr_[i].vs1; \
    *(LAS bf16x8*)(K_lds + (b) * SHM_K + AKSWZ(sr, sc * 2)) = sr_[i].ks0; *(LAS bf16x8*)(K_lds + (b) * SHM_K + AKSWZ(32 + sr, sc * 2)) = sr_[i].ks1; \
    *(LAS bf16x8*)(K_lds + (b) * SHM_K + AKSWZ(rr_, 256 + rc_ * 2)) = sr_[i].kr; } while (0)
#define ASWAIT() asm volatile("s_waitcnt vmcnt(0)" ::: "memory")
#define ARESC(a) do { if (__any((a) < 1.f)) { if (hi == 0) al_l[r32] = (a); asm volatile("s_waitcnt lgkmcnt(0)" ::: "memory"); \
    _Pragma("unroll") for (int d = 0; d < 4; ++d) _Pragma("unroll") for (int r = 0; r < 16; ++r) o[d][r] *= al_l[crow(r, hi)]; } } while (0)
    f32x16 pA0, pA1; float mnA, alA; bf16x8 pa0, pa1, pa2, pa3;
    ASLOAD(0, 0); asm volatile("s_waitcnt vmcnt(0)" ::: "memory"); ASWRITE(0, 0); __syncthreads();
    for (int j = 0; j < NT; ++j) {
        const int bsel = j & 1;
        if (j + 1 < NT) ASLOAD(0, j + 1);
        ASBAR(); qkt(pA0, pA1, K_lds + bsel * SHM_K, qr, r32, hi);
        partialSM(pA0, pA1, m_reg, mnA, alA);
        ARESC(alA);
        finishSM(pA0, pA1, alA, l_reg, pa0, pa1, pa2, pa3); ASBAR();
        pv_d0(o, vb0 + bsel * SHM_V, pa0, pa1, pa2, pa3);
        if (j + 1 < NT) { ASWAIT(); ASWRITE(bsel ^ 1, 0); }
        __syncthreads();
    }
    if (hi == 0) li_l[r32] = l_reg; asm volatile("s_waitcnt lgkmcnt(0)" ::: "memory");
    GAS unsigned char* Ow = BR + (size_t)(qrow0 + wid * 32) * DM + 1024 + h * 128;
#pragma unroll
    for (int r = 0; r < 16; ++r) { const int orow = crow(r, hi); const float rl = __builtin_amdgcn_rcpf(li_l[orow]);
#pragma unroll
        for (int d0 = 0; d0 < 4; ++d0) { const float v = __builtin_amdgcn_fmed3f(o[d0][r] * rl, -448.f, 448.f); Ow[(size_t)orow * DM + d0 * 32 + r32] = (unsigned char)(__builtin_amdgcn_cvt_pk_fp8_f32(v, 0.f, 0u, false) & 0xffu); } }
    __syncthreads();
#undef ASLOAD
#undef ASWRITE
#undef ASWAIT
#undef ARESC
}
}

constexpr int PH_PER_LAYER = 13, NPHASE = 2 + DEPTH * PH_PER_LAYER;
struct Args { const float* in[N_IN]; float* out; unsigned char* ws; int ph_lo, ph_hi; };
static_assert(sizeof(Args) == N_IN * 8 + 8 + 8 + 8, "Args has no padding");

#ifndef REP_G1
#define REP_G1 1
#endif
#ifndef REP_G2
#define REP_G2 1
#endif
#ifndef REP_G5
#define REP_G5 1
#endif
#ifndef REP_G6
#define REP_G6 1
#endif
#ifndef REP_G8
#define REP_G8 1
#endif
#ifndef REP_G10
#define REP_G10 1
#endif
#ifndef REP_G11
#define REP_G11 1
#endif
#ifndef REP_R4
#define REP_R4 1
#endif
#ifndef PH_MASK
#define PH_MASK 0xffffffffu
#endif
#define IN(k) (lo <= (k) && (k) < hi)
#define EN(j) ((PH_MASK >> (j)) & 1u)
#ifndef SUBMASK
#define SUBMASK 7
#endif
#define REFRESH() do { F.tid = opaque_tid(); F.lane = F.tid & 63; F.wave = __builtin_amdgcn_readfirstlane(F.tid >> 6); \
    F.ws = (GAS unsigned char*)opaque_ptr(args.ws); F.ctl = (unsigned*)opaque_ptr(args.ws + WS_CTL); F.out = (GAS float*)opaque_ptr(args.out); } while (0)
#ifdef PROBE_MASK
#define STAMP(k) do { if (blockIdx.x == 0 && threadIdx.x == 0) ((volatile unsigned long long*)(args.ws + WS_CTL + 65536))[16 + (k)] = __builtin_amdgcn_s_memrealtime(); } while (0)
#else
#define STAMP(k) do { } while (0)
#endif
#define SEAM(k) do { if (IN(k) && IN((k) + 1)) xcd_barrier(bar); STAMP((k) + 1); } while (0)
template <int l> __device__ __forceinline__ void layer_phases(Frame& F, const Args& args, const XcdBarrier& bar, const int lo, const int hi, char* ldsg) {
        const int pb = 2 + l * PH_PER_LAYER;
        const int mrows = (l + 1 < DEPTH) ? MT : ML;
        GAS bf16_t* const Hb = WSP(bf16_t, WS_H); GAS bf16_t* const Ub = WSP(bf16_t, WS_RA);
        if (IN(pb + 0) && EN(0) && l == 0) { REFRESH(); phase_rwA(F, l); }
        if (l == 0) SEAM(pb + 0);
        if (IN(pb + 1) && EN(1)) for (int rp_ = 0; rp_ < REP_G1; ++rp_) { REFRESH();
            EpiWin E{Ub, WSP(float, WS_SSQ), WSP(float, WS_TAB)};
            { Gemm g{WSP(bf16_t, WS_HIN), WSP(bf16_t, WS_WIN) + (size_t)l * NU * DM, DM, DM, DM};
              WinSched S; S.gs.init(MT / 256, 5, F.G, (int)blockIdx.x, (size_t)256 * DM * 2, (size_t)256 * DM * 2, 0, 0); S.mode = 1;
              pg8::gemm_phase<EpiWin, WinSched, false>(F.lds, g, S, E); }
            { Gemm g{(const GAS bf16_t*)WSP(unsigned char, WS_H8), (const GAS bf16_t*)(WSP(unsigned char, WS_WIN8) + (size_t)l * NU * DM), DM / 2, DM / 2, DM / 2};
              WinSched S; S.gs.init(MT / 256, 23, F.G, (int)((blockIdx.x + 152) & 255), (size_t)256 * DM, (size_t)256 * DM, 0, 0); S.mode = 0;
              pg8::gemm_phase<EpiWin, WinSched, false, true>(F.lds, g, S, E); }
        }
        SEAM(pb + 1);
        if (IN(pb + 2) && EN(2)) for (int rp_ = 0; rp_ < REP_G2; ++rp_) { REFRESH();
            if (SUBMASK & 1) { Gemm g{Ub, WSP(bf16_t, WS_WUQ) + (size_t)l * 768 * 512, NU, 512, 512};
              GridSched S; S.init(MT / 256, 3, F.G, (int)blockIdx.x, (size_t)256 * NU * 2, (size_t)256 * 512 * 2, (size_t)U_CQ * 2, 0);
              EpiMlaQ E{WSP(bf16_t, WS_QB), WSP(float, WS_SSQ), WSP(float, WS_TAB)};
              pg8::gemm_phase<EpiMlaQ, GridSched, false>(F.lds, g, S, E); }
            if (SUBMASK & 2) { Gemm g{Ub, WSP(bf16_t, WS_WUKV) + (size_t)l * 1024 * 256, NU, 256, 256};
              GridSched S; S.init(MT / 256, 4, F.G, (int)((blockIdx.x + 40u) % (unsigned)F.G), (size_t)256 * NU * 2, (size_t)256 * 256 * 2, (size_t)U_CKV * 2, 0);
              EpiMlaKV E{WSP(bf16_t, WS_KVB), WSP(float, WS_SSQ)};
              pg8::gemm_phase<EpiMlaKV, GridSched, false>(F.lds, g, S, E); }
            if (SUBMASK & 4) { Gemm g{(const GAS bf16_t*)WSP(unsigned char, WS_H8), (const GAS bf16_t*)(WSP(unsigned char, WS_WG) + (size_t)l * 8192 * DM), DM / 2, DM / 2, DM / 2};
              GridSched S; S.init(mrows / 256, 32, F.G, (int)blockIdx.x, (size_t)256 * DM, (size_t)256 * DM, 0, 0);
              EpiGate E{WSP(unsigned char, WS_RB)};
              pg8::gemm_phase<EpiGate, GridSched, false, true>(F.lds, g, S, E); }
            phase_ssdconv(F, l);
            phase_scanprep(F, l);
        }
        SEAM(pb + 2);
#ifndef REP_MIX
#define REP_MIX 1
#endif
        if (IN(pb + 3) && EN(3)) for (int rep_ = 0; rep_ < REP_MIX; ++rep_) { REFRESH();
            const int bx = blockIdx.x;
#ifndef REPMASK
#define REPMASK 15
#endif
#ifdef ONLYK
            const int SCANMASK = ONLYK;
#else
            const int SCANMASK = rep_ == 0 ? 15 : REPMASK;
#endif
            if (bx < 64) {
                if (__builtin_amdgcn_readfirstlane(F.wave) < 4) scn::scan_block<scn::K_ML>(F, l, bx); else scn::scan_block<scn::K_HG>(F, l, bx); }
            else if (bx < 96) { scn::scan_block<scn::K_SSD>(F, l, (bx - 64) * 2 + (F.wave >> 2)); }
            else if (SCANMASK & 8) {
                const int natt = 256 + (l + 1 < DEPTH ? 32 : 0), nab = F.G - 96;
                for (int ua = bx - 96; ua < natt; ua += nab) {
                    if (ua < 256) { const int b = ua >> 5, h = (ua >> 3) & 3, qb = ua & 7;
                        att::attn_unit(WSP(bf16_t, WS_QB), WSP(bf16_t, WS_KVB), Ub, WSP(unsigned char, WS_BR), b * SEQ + qb * 256, h, ML + b * CTXL, b * SEQ, 4, 36, (LAS char*)F.lds); }
                    else { const int uc = ua - 256, b = uc >> 2, h = uc & 3;
                        att::attn_unit(WSP(bf16_t, WS_QB), WSP(bf16_t, WS_KVB), Ub, WSP(unsigned char, WS_BR), ML + b * CTXL, h, ML + b * CTXL, 0, 4, 4, (LAS char*)F.lds); }
                }
                if (rep_ == 0) {
                    LAS float* scr = (LAS float*)(F.lds + F.wave * 16384);
                    if (l + 1 == DEPTH) { for (int it = (bx - 96) * 8 + F.wave; it < IT_MOE; it += (F.G - 96) * 8) cvt_moe_item(F, l, it, scr); }
                    else { for (int it = (bx - 96) * 8 + F.wave; it < IT_LAYER + IT_MOE / 2; it += (F.G - 96) * 8) { if (it < IT_LAYER) cvt_layer_item(F, l + 1, it, scr); else cvt_moe_item(F, l, it - IT_LAYER, scr); } }
                }
            }
        }
        SEAM(pb + 3);
        if (IN(pb + 4) && EN(4)) for (int rp_ = 0; rp_ < REP_R4; ++rp_) { REFRESH(); phase_finish(F, l, mrows); }
        SEAM(pb + 4);
        if (IN(pb + 5) && EN(5)) for (int rp_ = 0; rp_ < REP_G5; ++rp_) { REFRESH();
            Gemm g{(const GAS bf16_t*)WSP(unsigned char, WS_BR), (const GAS bf16_t*)(WSP(unsigned char, WS_WBR) + (size_t)l * 4 * DM * 512), DM / 2, 256, 256};
            MergeSched S; S.gs.init(mrows / 256, 8, F.G, (int)blockIdx.x, 0, 0, 0, 0);
            EpiMerge E{WSP(unsigned char, WS_RB), WSP(unsigned char, WS_RA + RA_ACC), WSP(float, WS_RSSD)};
            pg8::gemm_phase<EpiMerge, MergeSched, false, true, true>(F.lds, g, S, E);
            if (l == 0 && blockIdx.x >= 128) {
                LAS float* scr = (LAS float*)(F.lds + F.wave * 16384);
                for (int it = IT_MOE / 2 + ((int)blockIdx.x - 128) * 8 + F.wave; it < IT_MOE / 2 + 16384; it += 128 * 8) cvt_moe_item(F, 0, it, scr);
            }
        }
        SEAM(pb + 5);
        if (IN(pb + 6) && EN(6)) for (int rp_ = 0; rp_ < REP_G6; ++rp_) { REFRESH();
            Gemm g{(const GAS bf16_t*)WSP(unsigned char, WS_RA + RA_ACC), (const GAS bf16_t*)(WSP(unsigned char, WS_WOUT) + (size_t)l * DM * DM), DM / 2, DM / 2, DM / 2};
            GridSched S; S.init(mrows / 256, 8, F.G, (int)blockIdx.x, (size_t)256 * DM, (size_t)256 * DM, 0, 0);
            EpiBf16 E{WSP(bf16_t, WS_RB + RB_Y), DM};
            pg8::gemm_phase<EpiBf16, GridSched, false, true>(F.lds, g, S, E);
            if (l == 0 && blockIdx.x >= 64) {
                LAS float* scr = (LAS float*)(F.lds + F.wave * 16384);
                for (int it = IT_MOE / 2 + 16384 + ((int)blockIdx.x - 64) * 8 + F.wave; it < IT_MOE; it += 192 * 8) cvt_moe_item(F, 0, it, scr);
            }
        }
        SEAM(pb + 6);
        if (IN(pb + 7) && EN(7)) { REFRESH(); phase_rwB(F, l, mrows); }
        SEAM(pb + 7);
        if (IN(pb + 8) && EN(8)) for (int rp_ = 0; rp_ < REP_G8; ++rp_) { REFRESH();
            Gemm g{Hb, WSP(bf16_t, WS_WR) + (size_t)l * 256 * DM, DM, DM, 512};
            RouterSched S{mrows / 256, F.G, (int)blockIdx.x};
            EpiRouter E{WSP(float, WS_LOG)};
            pg8::gemm_phase<EpiRouter, RouterSched, false>(F.lds, g, S, E);
        }
        SEAM(pb + 8);
        if (IN(pb + 9) && EN(9)) { REFRESH(); phase_route(F, l, mrows, bar); }
        SEAM(pb + 9);
        if (IN(pb + 10) && EN(10)) for (int rp_ = 0; rp_ < REP_G10; ++rp_) { REFRESH();
            moe_tables(F, l);
            Gemm g{(const GAS bf16_t*)WSP(unsigned char, WS_H8), (const GAS bf16_t*)WSP(unsigned char, WS_W13), DM / 2, DM / 2, DM / 2};
            MoeSched S{(const volatile LAS int*)(F.MISC + 16), (const volatile LAS int*)(F.MISC + 64), WSP(int, WS_LIST), 4, F.G, (int)blockIdx.x, 1};
            EpiMoe1 E{WSP(unsigned char, WS_RA + RA_H1)};
            pg8::gemm_phase<EpiMoe1, MoeSched, true, true>(F.lds, g, S, E);
        }
        SEAM(pb + 10);
        if (IN(pb + 11) && EN(11)) for (int rp_ = 0; rp_ < REP_G11; ++rp_) { REFRESH();
            moe_tables(F, l);
            Gemm g{(const GAS bf16_t*)WSP(unsigned char, WS_RA + RA_H1), (const GAS bf16_t*)WSP(unsigned char, WS_W2), DEXP / 2, DEXP / 2, DEXP / 2};
            MoeSched S{(const volatile LAS int*)(F.MISC + 16), (const volatile LAS int*)(F.MISC + 64), WSP(int, WS_LIST), 8, F.G, (int)blockIdx.x, 2};
            EpiMoe2 E{WSP(bf16_t, WS_RB + RB_Y2), WSP(int, WS_LIST), WSP(float, WS_WL), (const volatile LAS int*)(F.MISC + 64)};
            pg8::gemm_phase<EpiMoe2, MoeSched, false, true>(F.lds, g, S, E);
        }
        SEAM(pb + 11);
        if (IN(pb + 12) && EN(12)) { REFRESH(); phase_rwC(F, l, mrows); }
        SEAM(pb + 12);
    }

__global__ void __launch_bounds__(512, 2) fwd_kernel(Args args) {
    extern __shared__ __attribute__((aligned(16))) unsigned char lds_raw[];
    Frame F;
    F.lds = (LAS unsigned char*)lds_raw;
    F.MISC = (volatile LAS unsigned*)(F.lds + MISC_OFF);
    F.tid = threadIdx.x; F.lane = F.tid & 63; F.wave = __builtin_amdgcn_readfirstlane(F.tid >> 6);
    F.G = gridDim.x; { const int bx = blockIdx.x; F.vcu = (F.G % 8 == 0) ? (bx % 8) * (F.G / 8) + bx / 8 : bx; }
    F.ws = (GAS unsigned char*)args.ws; F.ctl = (unsigned*)(args.ws + WS_CTL); F.out = (GAS float*)args.out;
    F.inp = args.in;
    for (int u = F.tid; u < (LDS_BYTES - MISC_OFF) / 4; u += 512) F.MISC[u] = 0u;
    __syncthreads();
    const int lo = args.ph_lo, hi = args.ph_hi;
    XcdBarrier bar; bar.bar = F.ctl + CW_BAR; bar.x = 0; bar.st = nullptr;
    if (hi - lo > 1) bar = xcd_barrier_post(F.ctl + CW_BAR, F.MISC + 8);
    char* ldsg = (char*)lds_raw;

#ifndef REP_PRO
#define REP_PRO 1
#endif
    STAMP(0);
    if (IN(0) && EN(13)) for (int rep_ = 0; rep_ < REP_PRO; ++rep_) { phase_prologue(F); } SEAM(0);
    if (IN(1) && EN(14)) { phase_modfin(F); } SEAM(1);

    layer_phases<0>(F, args, bar, lo, hi, ldsg);
    layer_phases<1>(F, args, bar, lo, hi, ldsg);
#ifdef PROBE_MASK
    __syncthreads();
    if (blockIdx.x == 0 && threadIdx.x == 0) {
        STAMP(NPHASE);
        volatile unsigned long long* T = (volatile unsigned long long*)(args.ws + WS_CTL + 65536) + 16; unsigned long long acc_ = 0;
        for (int k = 0; k < NPHASE; ++k) if ((PROBE_MASK >> k) & 1ull) { const unsigned long long a_ = T[k], b_ = T[k + 1]; if (a_ && b_ > a_) acc_ += b_ - a_; }
        args.out[0] = 3.0f + (float)acc_ * 0.001f;
    }
#endif
#undef IN
#undef SEAM
}


#ifdef DUMP_OFF
__global__ void dump_kernel(GAS float* out, const unsigned char* ws) {
    const size_t OUTN = (size_t)ML * DM; const size_t i0 = (size_t)blockIdx.x * blockDim.x + threadIdx.x, st = (size_t)gridDim.x * blockDim.x;
    for (size_t i = i0; i < OUTN; i += st) { float a = 0.f;
#if DUMP_F32
        const GAS float* src = (const GAS float*)(ws + (size_t)DUMP_OFF); for (size_t j = i; j < (size_t)DUMP_ELEMS; j += OUTN) a += src[j];
#else
        const GAS bf16_t* src = (const GAS bf16_t*)(ws + (size_t)DUMP_OFF); for (size_t j = i; j < (size_t)DUMP_ELEMS; j += OUTN) a += bf2f(src[j]);
#endif
        out[i] = a; }
}
#endif
extern "C" void kernel_launch(void* const* d_in, const int* in_sizes, int n_in, void* d_out, int out_size, void* d_ws, size_t ws_size, hipStream_t stream) {
    static int grid = 0;
    if (grid == 0) {
        if (n_in != N_IN || out_size != ML * DM || ws_size < WS_END) { fprintf(stderr, "kernel_launch: unexpected shapes: n_in %d out %d ws %zu (need %zu)\n", n_in, out_size, ws_size, (size_t)WS_END); grid = -1; return; }
        int dev = 0, cus = 0, per_cu = 0;
        if (hipGetDevice(&dev) != hipSuccess || hipDeviceGetAttribute(&cus, hipDeviceAttributeMultiprocessorCount, dev) != hipSuccess) { grid = -1; return; }
        if (hipFuncSetAttribute((const void*)fwd_kernel, hipFuncAttributeMaxDynamicSharedMemorySize, LDS_BYTES) != hipSuccess) { fprintf(stderr, "kernel_launch: hipFuncSetAttribute failed\n"); grid = -1; return; }
        if (hipOccupancyMaxActiveBlocksPerMultiprocessor(&per_cu, (const void*)fwd_kernel, 512, LDS_BYTES) != hipSuccess || per_cu < 1) { fprintf(stderr, "kernel_launch: occupancy query says %d\n", per_cu); }
        (void)hipGetLastError();
        grid = cus;
    }
    if (grid < 0) return;
    if (hipMemsetAsync((char*)d_ws + WS_CTL, 0, CTL_BYTES, stream) != hipSuccess) return;
    Args a{};
    for (int i = 0; i < N_IN; ++i) a.in[i] = (const float*)d_in[i];
    a.out = (float*)d_out; a.ws = (unsigned char*)d_ws;
#if MK_SINGLE
    a.ph_lo = 0; a.ph_hi = NPHASE;
    hipLaunchKernelGGL(fwd_kernel, dim3(grid), dim3(512), LDS_BYTES, stream, a);
#else
#ifndef MK_STOP
#define MK_STOP NPHASE
#endif
    for (int ph = 0; ph < MK_STOP; ++ph) {
        if (ph == 2 + PH_PER_LAYER) continue;
        a.ph_lo = ph; a.ph_hi = ph + 1;
        hipLaunchKernelGGL(fwd_kernel, dim3(grid), dim3(512), LDS_BYTES, stream, a);
    }
#endif
#ifdef DUMP_OFF
    hipLaunchKernelGGL(dump_kernel, dim3(2048), dim3(256), 0, stream, (float*)d_out, (const unsigned char*)d_ws);
#endif
    const hipError_t le = hipPeekAtLastError();
    if (le != hipSuccess) fprintf(stderr, "kernel_launch: launch failed: %s\n", hipGetErrorName(le));
}
```

```cpp
#include <hip/hip_runtime.h>
#include <cstdio>
#include <cstdint>

#ifndef MK_SINGLE
#define MK_SINGLE 1
#endif

constexpr int DM = 2048, NBATCH = 8, SEQ = 2048, CTXL = 256, DEPTH = 2;
constexpr int ML = NBATCH * SEQ;
constexpr int MC = NBATCH * CTXL;
constexpr int MT = ML + MC;
constexpr int DIN = 7008, NU = 7168;
constexpr int U_MLQ = 0, U_MLK = 512, U_MLV = 1024, U_MLO = 1536, U_HGQ = 2048, U_HGI = 2560, U_HGG = 3072, U_HGF = 3584,
              U_CQ = 4608, U_CKV = 5120, U_KR = 5376, U_MLG = 5440, U_DT = 5456, U_Z = 5632, U_XBC = 6144;
constexpr float EPS = 1e-6f;
constexpr int NEXP = 32, DEXP = 512;
constexpr int MOE_ROWS = 2 * MT + NEXP * 256;

enum { I_X = 0, I_C, I_CTX, I_CCTX, I_WADA, I_BADA, I_NORMG, I_WIN, I_MLFB, I_HGLB, I_HGNG, I_MLAGQ, I_MLAGKV, I_WUQ, I_WUKV,
       I_CONVW, I_CONVB, I_ALOG, I_DTB, I_SSDD, I_SSDNG, I_WGATE, I_WBR, I_WOUT, I_WGRP, I_WEXP, I_W1, I_W3, I_W2, N_IN };

constexpr size_t al256(size_t x) { return (x + 255) / 256 * 256; }
constexpr size_t WS_CTL = 0, CTL_BYTES = 1u << 20;
constexpr size_t WS_WIN = WS_CTL + CTL_BYTES;
constexpr size_t WS_WUQ = WS_WIN + (size_t)2 * NU * DM * 2;
constexpr size_t WS_WUKV = WS_WUQ + (size_t)2 * 768 * 512 * 2;
constexpr size_t WS_WG = WS_WUKV + (size_t)2 * 1024 * 256 * 2;
constexpr size_t WS_WBR = WS_WG + (size_t)2 * 8192 * DM;
constexpr size_t WS_WOUT = WS_WBR + (size_t)2 * 4 * DM * 512 * 2;
constexpr size_t WS_WR = WS_WOUT + (size_t)2 * DM * DM;
constexpr size_t WS_WIN8 = WS_WR + (size_t)2 * 256 * DM * 2;
constexpr size_t WS_W13 = WS_WIN8 + (size_t)2 * NU * DM;
constexpr size_t WS_W2 = WS_W13 + (size_t)NEXP * 1024 * DM * 2;
constexpr size_t WS_MODP = WS_W2 + (size_t)NEXP * DM * 512 * 2;
constexpr size_t WS_MOD = WS_MODP + (size_t)2 * 16 * 9 * 12288 * 4;
constexpr size_t WS_TAB = WS_MOD + (size_t)2 * 9 * 12288 * 4;
constexpr size_t WS_XC = WS_TAB + 16384;
constexpr size_t WS_H8 = WS_XC + (size_t)MC * DM * 4;
constexpr size_t WS_H = WS_H8 + (size_t)MT * DM;
constexpr size_t WS_HIN = WS_H;
constexpr size_t WS_QB = WS_H + (size_t)MT * DM * 2;
constexpr size_t WS_KVB = WS_QB + (size_t)MT * 768 * 2;
constexpr size_t WS_SSQ = WS_KVB + (size_t)MT * 1024 * 2;
constexpr size_t WS_BR = WS_SSQ + (size_t)MT * 12 * 4;
constexpr size_t WS_YFB = WS_BR + (size_t)MT * DM * 2;
constexpr size_t WS_RSSD = WS_YFB + (size_t)6 * MT * 512 * 2;
constexpr size_t WS_LOG = WS_RSSD + al256((size_t)MT * 4);
constexpr size_t WS_LIST = WS_LOG + (size_t)4 * MT * 64 * 4;
constexpr size_t WS_WL = WS_LIST + (size_t)NEXP * MT * 4;
constexpr size_t WS_XBC = WS_WL + (size_t)NEXP * MT * 4;
constexpr size_t HGP_ITEM = 8192 + 8192 + 1024;
constexpr size_t WS_HGP = WS_XBC + (size_t)MT * 1024 * 2;
constexpr size_t WS_MLS = WS_HGP + (size_t)64 * 72 * HGP_ITEM;
constexpr size_t WS_SSDS = WS_MLS + (size_t)64 * 2304 * 32;
constexpr size_t WS_MLC = WS_SSDS + (size_t)128 * 2304 * 32;
constexpr size_t WS_RA = WS_MLC + (size_t)32 * 2304 * 384 * 2;
constexpr size_t RA_BYTES = (size_t)MT * NU * 2;
constexpr size_t WS_RB = WS_RA + RA_BYTES;
constexpr size_t RB_BYTES = ((size_t)80 << 20) + (size_t)2 * MT * DM * 2;
constexpr size_t WS_END = WS_RB + RB_BYTES;
constexpr size_t RA_ACC = 0, RA_PART = (size_t)80 << 20, RA_H1 = (size_t)150 << 20;
constexpr size_t RB_Y = 0, RB_Y2 = (size_t)80 << 20;
static_assert(RA_PART >= (size_t)MT * DM * 2 && RA_H1 >= RA_PART + (size_t)256 * 65536 * 4 && RA_H1 + (size_t)MOE_ROWS * 512 * 2 <= RA_BYTES, "region A");
static_assert(RB_Y2 >= (size_t)MT * DM * 2 && RB_Y2 + (size_t)2 * MT * DM * 2 <= RB_BYTES && (size_t)MT * 8192 <= RB_BYTES, "region B");
constexpr int CW_CNT = 64;
constexpr int CW_BAR = 4096;

constexpr int RING_BYTES = 131072, MISC_OFF = RING_BYTES, LDS_BYTES = 147456;

#define GAS __attribute__((address_space(1)))
#define LAS __attribute__((address_space(3)))
typedef unsigned short bf16_t;
typedef short bf16x8 __attribute__((ext_vector_type(8)));
typedef short s16x4 __attribute__((ext_vector_type(4)));
typedef float f32x4 __attribute__((ext_vector_type(4)));
typedef float f32x2 __attribute__((ext_vector_type(2)));
typedef float f32x16 __attribute__((ext_vector_type(16)));
typedef unsigned u32x4 __attribute__((ext_vector_type(4)));
typedef unsigned u32x2 __attribute__((ext_vector_type(2)));
#define LDS_WAIT() asm volatile("s_waitcnt lgkmcnt(0)" ::: "memory")
#define VM_WAIT() asm volatile("s_waitcnt vmcnt(0)" ::: "memory")
typedef __bf16 bf16x2_t __attribute__((ext_vector_type(2)));
__device__ __forceinline__ unsigned cvt_pk_bf16(float lo, float hi) { const f32x2 v = {lo, hi}; return __builtin_bit_cast(unsigned, __builtin_convertvector(v, bf16x2_t)); }
__device__ __forceinline__ bf16_t f2bf(float f) { return (bf16_t)(cvt_pk_bf16(f, 0.f) & 0xffffu); }
__device__ __forceinline__ float bf2f(bf16_t b) { return __uint_as_float(((unsigned)b) << 16); }
__device__ __forceinline__ float bflo(unsigned w) { return __uint_as_float(w << 16); }
__device__ __forceinline__ float bfhi(unsigned w) { return __uint_as_float(w & 0xffff0000u); }
__device__ __forceinline__ float sigmoidf_(float x) { return 1.f / (1.f + __expf(-x)); }
__device__ __forceinline__ float siluf_(float x) { return x / (1.f + __expf(-x)); }
__device__ __forceinline__ int opaque_tid() { int t = threadIdx.x; asm volatile("" : "+v"(t)); return t; }
__device__ __forceinline__ const void* opaque_ptr(const void* p) {
    unsigned lo = (unsigned)(uintptr_t)p, hi = (unsigned)((uintptr_t)p >> 32); asm volatile("" : "+v"(lo), "+v"(hi));
    lo = __builtin_amdgcn_readfirstlane(lo); hi = __builtin_amdgcn_readfirstlane(hi); return (const void*)(((uintptr_t)hi << 32) | lo); }
__device__ __forceinline__ float wave_sum(float v) {
#pragma unroll
    for (int o = 1; o < 64; o <<= 1) v += __shfl_xor(v, o);
    return v;
}

__device__ __forceinline__ int prow(int b, int dir, int p) { if (p < CTXL) return ML + b * CTXL + (dir ? CTXL - 1 - p : p); const int q = p - CTXL; return b * SEQ + (dir ? SEQ - 1 - q : q); }
namespace scn {
__device__ __forceinline__ int rowl(int row, int colB) { return row * 256 + (colB ^ ((row & 7) << 4)); }
__device__ __forceinline__ float scan_add32(float v, int r32) {
#pragma unroll
    for (int d = 1; d < 32; d <<= 1) { const float o = __shfl_up(v, d, 32); if (r32 >= d) v += o; }
    return v;
}
__device__ __forceinline__ float scan_max32(float v, int r32) {
#pragma unroll
    for (int d = 1; d < 32; d <<= 1) { const float o = __shfl_up(v, d, 32); if (r32 >= d) v = fmaxf(v, o); }
    return v;
}
}

#define XB_TMO      128
#define XB_XCNT(j)  (256  + 64 * (j))
#define XB_XSUB(j)  (1280 + 64 * (j))
#define XB_XGEN(j)  (2304 + 64 * (j))
#define XB_TOP      3328
#define XB_TOPGEN   3392
#define XCD_BAR_WORDS 3456
#define XB_SPIN_CAP (1u << 18)
__device__ __forceinline__ unsigned xb_ld(unsigned* p)              { return __hip_atomic_load(p, __ATOMIC_RELAXED, __HIP_MEMORY_SCOPE_AGENT); }
__device__ __forceinline__ unsigned xb_add(unsigned* p, unsigned v) { return __hip_atomic_fetch_add(p, v, __ATOMIC_RELAXED, __HIP_MEMORY_SCOPE_AGENT); }
__device__ __forceinline__ unsigned xb_xcc_id() { return (unsigned)__builtin_amdgcn_s_getreg((3 << 11) | 20) & 0xFu; }
#define XB_SPIN(cond, bar) do { unsigned _sp = 0; while (cond) { __builtin_amdgcn_s_sleep(1); \
    if ((++_sp & 255u) == 0u) { if (xb_ld(&(bar)[XB_TMO])) break; if (_sp > XB_SPIN_CAP) { atomicAdd(&(bar)[XB_TMO], 1u); break; } } } } while (0)
struct XcdBarrier { unsigned* bar; unsigned x; volatile LAS unsigned* st; };
__device__ __forceinline__ XcdBarrier xcd_barrier_post(unsigned* bar, volatile LAS unsigned* st) {
    XcdBarrier b; b.bar = bar; b.x = xb_xcc_id(); b.st = st;
    if (threadIdx.x == 0) (void)xb_add(&bar[XB_XCNT(b.x)], 1u);
    return b;
}
__device__ __forceinline__ void xcd_barrier_complete(unsigned* bar, unsigned x, unsigned& nloc, unsigned& nx) {
    const unsigned G = gridDim.x * gridDim.y * gridDim.z;
    unsigned sum, cnt, mine, sp = 0u;
    for (;;) {
        sum = 0u; cnt = 0u; mine = 0u;
#pragma unroll
        for (unsigned j = 0; j < 16; ++j) { const unsigned c = xb_ld(&bar[XB_XCNT(j)]); sum += c; cnt += (c > 0u) ? 1u : 0u; mine = (j == x) ? c : mine; }
        if (sum == G) break;
        __builtin_amdgcn_s_sleep(1);
        if ((++sp & 255u) == 0u) { if (xb_ld(&bar[XB_TMO])) break; if (sp > XB_SPIN_CAP) { atomicAdd(&bar[XB_TMO], 1u); break; } }
    }
    nloc = mine > 0u ? mine : 1u; nx = cnt > 0u ? cnt : 1u;
}
__device__ __forceinline__ void xcd_barrier(const XcdBarrier& b) {
    asm volatile("s_waitcnt vmcnt(0)" ::: "memory");
    __syncthreads();
    if (threadIdx.x == 0) {
        unsigned* bar = b.bar;
        __builtin_amdgcn_s_waitcnt(0);
        unsigned nloc = b.st[0], nx = b.st[1];
        if (nloc == 0u) { xcd_barrier_complete(bar, b.x, nloc, nx); b.st[0] = nloc; b.st[1] = nx; }
        const unsigned old = xb_add(&bar[XB_XSUB(b.x)], 1u);
        const unsigned gen = old / nloc;
        if (old + 1u == (gen + 1u) * nloc) {
            __builtin_amdgcn_fence(__ATOMIC_RELEASE, "agent");
            asm volatile("s_waitcnt vmcnt(0)" ::: "memory");
            const unsigned og = xb_add(&bar[XB_TOP], 1u);
            const unsigned tg = og / nx;
            if (og + 1u == (tg + 1u) * nx) xb_add(&bar[XB_TOPGEN], 1u);
            else XB_SPIN(xb_ld(&bar[XB_TOPGEN]) == tg, bar);
            __builtin_amdgcn_fence(__ATOMIC_ACQUIRE, "agent");
            xb_add(&bar[XB_XGEN(b.x)], 1u);
            asm volatile("s_waitcnt vmcnt(0)" ::: "memory");
        } else {
            XB_SPIN(xb_ld(&bar[XB_XGEN(b.x)]) == gen, bar);
            __builtin_amdgcn_fence(__ATOMIC_ACQUIRE, "agent");
            asm volatile("s_waitcnt vmcnt(0)" ::: "memory");
        }
    }
    __syncthreads();
}

struct Frame {
    LAS unsigned char* lds;
    volatile LAS unsigned* MISC;
    unsigned* ctl;
    int tid, lane, wave, vcu, G;
    const float* const* inp;
    GAS float* out;
    GAS unsigned char* ws;
};
#define WSP(T, off) ((GAS T*)(F.ws + (off)))
#define INP(i) ((const GAS float*)F.inp[i])

namespace pg8 {
constexpr int BM = 256, BK = 64, HALF = 128, HTB = HALF * BK * 2, STAGE_BYTES = 8 * HTB, NXCD = 8, WGM = 8;
__host__ __device__ __forceinline__ int lds_byte(int r, int c) { const int st = (r >> 4) * 2 + (c >> 5), rr = r & 15, cc = c & 31, ob = rr * 64 + cc * 2; return st * 1024 + (ob ^ (((ob >> 9) & 1) << 5)); }
__host__ __device__ __forceinline__ void stage_rc(int b, int& R, int& C) { const int st = b / 1024, sb = b % 1024, swz = sb ^ (((sb >> 9) & 1) << 5); R = (st >> 1) * 16 + swz / 64; C = (st & 1) * 32 + (swz % 64) / 2; }

struct Unit { int pm, pn, aux, aux2; size_t aoff, boff; };
struct Gemm { const GAS bf16_t* A; const GAS bf16_t* Bt; int lda, ldb, K; };

struct GridSched {
    int nM, nN, nwg, G, c; float rnig; size_t a_tile, b_tile, a0, b0;
    __device__ __forceinline__ void init(int nM_, int nN_, int G_, int c_, size_t a_tile_, size_t b_tile_, size_t a0_, size_t b0_) { nM = nM_; nN = nN_; nwg = nM * nN; G = G_; c = c_; rnig = 1.0f / (float)(WGM * nN_); a_tile = a_tile_; b_tile = b_tile_; a0 = a0_; b0 = b0_; }
    __device__ __forceinline__ void map(int L, int& pm, int& pn) const {
        unsigned wgid = (unsigned)L; { const unsigned q = (unsigned)nwg / NXCD, r = (unsigned)nwg % NXCD, xcd = wgid % NXCD, off = wgid / NXCD; wgid = (xcd < r ? xcd * (q + 1) : r * (q + 1) + (xcd - r) * q) + off; }
        const int nig = WGM * nN, gid = (int)(((float)wgid + 0.5f) * rnig), rem = (int)wgid - gid * nig, fm = gid * WGM, left = nM - fm;
        if (left >= WGM) { pm = fm + (rem & (WGM - 1)); pn = rem / WGM; }
        else { pm = fm + rem % left; pn = rem / left; }
    }
    __device__ __forceinline__ bool next(int i, Unit& u) const {
        const long L = (long)i * G + c; if (L >= nwg) return false;
        map((int)L, u.pm, u.pn); u.aux = 0; u.aux2 = 0; u.aoff = a0 + (size_t)u.pm * a_tile; u.boff = b0 + (size_t)u.pn * b_tile; return true;
    }
    __device__ __forceinline__ int arow(const Unit&, int) const { return 0; }
};

template <class Epi, class Sched, bool GATHER, bool FP8 = false, bool HM = false>
__device__ __forceinline__ void gemm_phase(LAS unsigned char* lds, const Gemm g, const Sched& S, const Epi& E) {
    const int tid = opaque_tid(), wid = __builtin_amdgcn_readfirstlane(tid >> 6), lane = tid & 63, wr = wid >> 2, wc = wid & 3, fr = lane & 15, fq = lane >> 4;
    int nt = g.K / BK; asm volatile("" : "+s"(nt));
    unsigned voffA[2], voffB[2];
#pragma unroll
    for (int i = 0; i < 2; ++i) { int R, C; stage_rc(tid * 16 + i * 8192, R, C);
        voffA[i] = (unsigned)(R * g.lda + C) * 2u; voffB[i] = (unsigned)(R * g.ldb + C) * 2u; }
    const size_t kstep = (size_t)(BK * 2);
    const size_t hstepA = (size_t)HALF * g.lda * 2, hstepB = (size_t)HALF * g.ldb * 2;
    const unsigned ldsw = (unsigned)wid * 1024u;
    const int aoff = lds_byte(wr * 64 + fr, fq * 8), boff = lds_byte(wc * 32 + fr, fq * 8);
#define PG8_SA(b, h) (((b) * 2 + (h)) * HTB)
#define PG8_SB(b, h) ((4 + (b) * 2 + (h)) * HTB)
#define PG8_STAGE(bufoff, gbase, voff) do { _Pragma("unroll") for (int _i = 0; _i < 2; ++_i) \
        __builtin_amdgcn_global_load_lds((const unsigned*)((const char*)(gbase) + (voff)[_i]), (LAS unsigned*)(lds + (bufoff) + ldsw + _i * 8192), 16, 0, 0); } while (0)
#define PG8_LDA(dst, b, h) do { _Pragma("unroll") for (int m = 0; m < 4; ++m) { dst[m].lo = *(const LAS v4i_t*)(lds + PG8_SA(b, h) + aoff + m * 2048); dst[m].hi = *(const LAS v4i_t*)(lds + PG8_SA(b, h) + aoff + m * 2048 + 1024); } } while (0)
#define PG8_LDB(dst, b, h) do { _Pragma("unroll") for (int n = 0; n < 2; ++n) { dst[n].lo = *(const LAS v4i_t*)(lds + PG8_SB(b, h) + boff + n * 2048); dst[n].hi = *(const LAS v4i_t*)(lds + PG8_SB(b, h) + boff + n * 2048 + 1024); } } while (0)
typedef int v8i_t __attribute__((ext_vector_type(8))); typedef int v4i_t __attribute__((ext_vector_type(4)));
#define PG8_MMA(ai, bj, At, Bt) do { __builtin_amdgcn_s_setprio(1); _Pragma("unroll") for (int m = 0; m < 4; ++m) _Pragma("unroll") for (int n = 0; n < 2; ++n) { \
        if constexpr (FP8) { asm volatile("v_mfma_scale_f32_16x16x128_f8f6f4 %0, %1, %2, %0, %3, %4 op_sel_hi:[0,0,0]" : "+v"(acc[ai][bj][m][n]) : "v"(Bt[n]), "v"(At[m]), "v"(scW), "v"(scA)); } \
        else { acc[ai][bj][m][n] = __builtin_amdgcn_mfma_f32_16x16x32_bf16(__builtin_bit_cast(bf16x8, (v4i_t)Bt[n].lo), __builtin_bit_cast(bf16x8, (v4i_t)At[m].lo), acc[ai][bj][m][n], 0, 0, 0); \
               acc[ai][bj][m][n] = __builtin_amdgcn_mfma_f32_16x16x32_bf16(__builtin_bit_cast(bf16x8, (v4i_t)Bt[n].hi), __builtin_bit_cast(bf16x8, (v4i_t)At[m].hi), acc[ai][bj][m][n], 0, 0, 0); } } \
        __builtin_amdgcn_s_setprio(0); } while (0)
#if GEMM_SAFE
#define PG8_WAIT_V(n) asm volatile("s_waitcnt vmcnt(0)" ::: "memory")
#else
#define PG8_WAIT_V(n) asm volatile("s_waitcnt vmcnt(" #n ")" ::: "memory")
#endif
#define PG8_WAIT_L(n) asm volatile("s_waitcnt lgkmcnt(" #n ")" ::: "memory")
#define PG8_BAR __builtin_amdgcn_s_barrier()
#define PG8_SCHED __builtin_amdgcn_sched_barrier(0)
    unsigned cvA[2][2], nvA[2][2];
#define PG8_GOFF(dst, u) do { if constexpr (GATHER) { const int ne_ = S.acnt(u); int gr_[2][2], gc_[2];        \
        _Pragma("unroll") for (int _i = 0; _i < 2; ++_i) { int R_; stage_rc(tid * 16 + _i * 8192, R_, gc_[_i]); _Pragma("unroll") for (int _h = 0; _h < 2; ++_h) gr_[_h][_i] = S.arow(u, _h * HALF + R_, ne_); } \
        _Pragma("unroll") for (int _i = 0; _i < 2; ++_i) _Pragma("unroll") for (int _h = 0; _h < 2; ++_h) dst[_h][_i] = (unsigned)(((size_t)gr_[_h][_i] * (size_t)g.lda + (size_t)gc_[_i]) * 2u); } } while (0)
#define PG8_STAGE_A(bufoff, base, half, vh) do { if constexpr (GATHER) { PG8_STAGE(bufoff, base, (vh)[half]); } else { PG8_STAGE(bufoff, (base) + (half) * hstepA, voffA); } } while (0)
    Unit cur, nxt; int ui = 0;
    if (!S.next(0, cur)) return;
    f32x4 acc[2][2][4][2];
#pragma unroll
    for (int a = 0; a < 2; ++a)
#pragma unroll
        for (int b = 0; b < 2; ++b)
#pragma unroll
            for (int m = 0; m < 4; ++m)
#pragma unroll
                for (int n = 0; n < 2; ++n) acc[a][b][m][n] = (f32x4){0.f, 0.f, 0.f, 0.f};
    int scW = 0x79797979, scA = 0x7f7f7f7f; asm volatile("" : "+v"(scW), "+v"(scA));
    v8i_t At[4], B0[2], B1[2];
    const char* cA = (const char*)g.A + cur.aoff; const char* cB = (const char*)g.Bt + cur.boff;
    PG8_GOFF(cvA, cur);
#pragma unroll
    for (int _h = 0; _h < 2; ++_h)
#pragma unroll
        for (int _i = 0; _i < 2; ++_i) nvA[_h][_i] = cvA[_h][_i];
    PG8_STAGE(PG8_SB(0, 0), cB, voffB); PG8_STAGE_A(PG8_SA(0, 0), cA, 0, cvA); PG8_STAGE(PG8_SB(0, 1), cB + hstepB, voffB); PG8_STAGE_A(PG8_SA(0, 1), cA, 1, cvA);
    if (wr == 1) PG8_BAR;
    PG8_WAIT_V(4); PG8_BAR;
    PG8_STAGE(PG8_SB(1, 0), cB + kstep, voffB); PG8_STAGE_A(PG8_SA(1, 0), cA + kstep, 0, cvA); PG8_STAGE(PG8_SB(1, 1), cB + hstepB + kstep, voffB);
    PG8_WAIT_V(6); PG8_BAR;
    for (;;) {
        const bool has_next = S.next(ui + 1, nxt);
        const char* nA = has_next ? (const char*)g.A + nxt.aoff : cA; const char* nB = has_next ? (const char*)g.Bt + nxt.boff : cB;
        for (int t = 0; t < nt; t += 2) {
            const bool last = (t == nt - 2);
            const char* a1 = cA + (size_t)(t + 1) * kstep;
            const char* a2 = last ? nA : cA + (size_t)(t + 2) * kstep; const char* b2 = last ? nB : cB + (size_t)(t + 2) * kstep;
            const char* a3 = a2 + kstep; const char* b3 = b2 + kstep;
            if constexpr (GATHER) { if (last && has_next) { PG8_GOFF(nvA, nxt); } }
            PG8_LDB(B0, 0, 0); PG8_SCHED; PG8_LDA(At, 0, 0); PG8_STAGE_A(PG8_SA(1, 1), a1, 1, cvA);
            PG8_WAIT_L(8); PG8_BAR; PG8_WAIT_L(0); PG8_MMA(0, 0, At, B0); PG8_BAR; PG8_SCHED;
            PG8_LDB(B1, 0, 1); PG8_STAGE(PG8_SB(0, 0), b2, voffB);
            PG8_BAR; PG8_WAIT_L(0); PG8_MMA(0, 1, At, B1); PG8_BAR;
            if constexpr (!HM) { PG8_LDA(At, 0, 1); } PG8_STAGE_A(PG8_SA(0, 0), a2, 0, nvA);
            PG8_BAR; PG8_WAIT_L(0); if constexpr (!HM) { PG8_MMA(1, 0, At, B0); } PG8_BAR; PG8_SCHED;
            PG8_STAGE(PG8_SB(0, 1), b2 + hstepB, voffB);
            PG8_WAIT_V(6); PG8_BAR; if constexpr (!HM) { PG8_MMA(1, 1, At, B1); } PG8_BAR;
            PG8_LDB(B0, 1, 0); PG8_SCHED; PG8_LDA(At, 1, 0); PG8_STAGE_A(PG8_SA(0, 1), a2, 1, nvA);
            PG8_WAIT_L(8); PG8_BAR; PG8_WAIT_L(0); PG8_MMA(0, 0, At, B0); PG8_BAR; PG8_SCHED;
            PG8_LDB(B1, 1, 1); PG8_STAGE(PG8_SB(1, 0), b3, voffB);
            PG8_BAR; PG8_WAIT_L(0); PG8_MMA(0, 1, At, B1); PG8_BAR;
            if constexpr (!HM) { PG8_LDA(At, 1, 1); } PG8_STAGE_A(PG8_SA(1, 0), a3, 0, nvA);
            PG8_BAR; PG8_WAIT_L(0); if constexpr (!HM) { PG8_MMA(1, 0, At, B0); } PG8_BAR; PG8_SCHED;
            PG8_STAGE(PG8_SB(1, 1), b3 + hstepB, voffB);
            PG8_WAIT_V(6); PG8_BAR; if constexpr (!HM) { PG8_MMA(1, 1, At, B1); } PG8_BAR;
        }
        if constexpr (FP8) { asm volatile("s_nop 15\n\ts_nop 15" ::: "memory"); }
        E(acc, cur, wr, wc, fr, fq);
        if (!has_next) break;
#pragma unroll
        for (int a = 0; a < (HM ? 1 : 2); ++a)
#pragma unroll
            for (int b = 0; b < 2; ++b)
#pragma unroll
                for (int m = 0; m < 4; ++m)
#pragma unroll
                    for (int n = 0; n < 2; ++n) acc[a][b][m][n] = (f32x4){0.f, 0.f, 0.f, 0.f};
        cur = nxt; cA = nA; cB = nB; ++ui;
        if constexpr (GATHER) {
#pragma unroll
            for (int _h = 0; _h < 2; ++_h)
#pragma unroll
                for (int _i = 0; _i < 2; ++_i) cvA[_h][_i] = nvA[_h][_i];
        }
    }
    PG8_WAIT_V(0);
    if (wr == 0) PG8_BAR;
    PG8_BAR;
#undef PG8_SA
#undef PG8_SB
#undef PG8_STAGE
#undef PG8_STAGE_A
#undef PG8_GOFF
#undef PG8_LDA
#undef PG8_LDB
#undef PG8_MMA
#undef PG8_WAIT_V
#undef PG8_WAIT_L
#undef PG8_BAR
#undef PG8_SCHED
}
}
using pg8::Unit;
using pg8::Gemm;
using pg8::GridSched;
#define EPI_ARGS f32x4 (&acc)[2][2][4][2], const Unit& u, int wr, int wc, int fr, int fq
#define EPI_FOR_ROWS for (int ai = 0; ai < 2; ++ai) for (int m = 0; m < 4; ++m)
#define EPI_FOR_COLS for (int bj = 0; bj < 2; ++bj) for (int n = 0; n < 2; ++n)
__device__ __forceinline__ void st_bf16x4(GAS bf16_t* p, f32x4 v) { u32x2 w; w.x = cvt_pk_bf16(v[0], v[1]); w.y = cvt_pk_bf16(v[2], v[3]); *(GAS u32x2*)p = w; }

struct EpiWin {
    GAS bf16_t* U; GAS float* ssq; const GAS float* rope; GAS bf16_t* MLC;
    __device__ __forceinline__ void operator()(EPI_ARGS) const {
        const int row0 = u.pm * 256 + wr * 64 + fr, col0 = u.pn * 256 + wc * 32 + 4 * fq;
        if (u.pn == 21 && wc < 2 && u.pm < ML / 256) {
#pragma unroll
            for (int ai = 0; ai < 2; ++ai)
#pragma unroll
                for (int m = 0; m < 4; ++m) {
                    const int r = row0 + ai * 128 + m * 16, tok = r & (SEQ - 1), pos = wc == 0 ? (tok >> 6) : (tok & 63);
                    const f32x4 cs = *(const GAS f32x4*)(rope + pos * 16 + 4 * fq), sn = *(const GAS f32x4*)(rope + 1024 + pos * 16 + 4 * fq);
                    const f32x4 x1 = acc[ai][0][m][0], x2 = acc[ai][0][m][1];
                    acc[ai][0][m][0] = x1 * cs - x2 * sn; acc[ai][0][m][1] = x1 * sn + x2 * cs;
                }
        }
        if (u.pn >= 18 && u.pn <= 20) {
            const int slot = (u.pn - 18) * 4 + wc;
#pragma unroll
            for (int ai = 0; ai < 2; ++ai)
#pragma unroll
                for (int m = 0; m < 4; ++m) {
                    float s = 0.f;
#pragma unroll
                    for (int bj = 0; bj < 2; ++bj)
#pragma unroll
                        for (int n = 0; n < 2; ++n) { const f32x4 x = acc[ai][bj][m][n]; s += (x[0] * x[0] + x[1] * x[1]) + (x[2] * x[2] + x[3] * x[3]); }
                    s += __shfl_xor(s, 16); s += __shfl_xor(s, 32);
                    if (fq == 0) ssq[(size_t)(row0 + ai * 128 + m * 16) * 12 + slot] = s;
                }
        }
#pragma unroll
        for (int ai = 0; ai < 2; ++ai)
#pragma unroll
            for (int m = 0; m < 4; ++m) { const int r_ = row0 + ai * 128 + m * 16;
                if (u.pn < 6) {
                    const int b_ = r_ < ML ? (r_ >> 11) : ((r_ - ML) >> 8), ci_ = r_ < ML ? CTXL + (r_ & (SEQ - 1)) : ((r_ - ML) & (CTXL - 1));
#pragma unroll
                    for (int bj = 0; bj < 2; ++bj) { GAS bf16_t* rp = MLC + ((size_t)(b_ * 4 + (u.pn & 1) * 2 + bj) * 2304 + ci_) * 384 + (u.pn >> 1) * 128 + wc * 32 + 4 * fq;
#pragma unroll
                        for (int n = 0; n < 2; ++n) st_bf16x4(rp + n * 16, acc[ai][bj][m][n]); }
                } else { GAS bf16_t* rowp = U + (size_t)r_ * NU + col0;
#pragma unroll
                    for (int bj = 0; bj < 2; ++bj)
#pragma unroll
                        for (int n = 0; n < 2; ++n) st_bf16x4(rowp + bj * 128 + n * 16, acc[ai][bj][m][n]); } }
    }
};
struct EpiMlaQ {
    GAS bf16_t* Q; const GAS float* ssq; const GAS float* rope;
    __device__ __forceinline__ void operator()(EPI_ARGS) const {
        const int row0 = u.pm * 256 + wr * 64 + fr, col0 = u.pn * 256 + wc * 32 + 4 * fq;
        float rstd[8];
        { f32x4 p0[8], p1[8];
#pragma unroll
          for (int i = 0; i < 8; ++i) { const int r = row0 + (i >> 2) * 128 + (i & 3) * 16; p0[i] = *(const GAS f32x4*)(ssq + (size_t)r * 12); p1[i] = *(const GAS f32x4*)(ssq + (size_t)r * 12 + 4); }
#pragma unroll
          for (int i = 0; i < 8; ++i) rstd[i] = rsqrtf(((p0[i][0] + p0[i][1]) + (p0[i][2] + p0[i][3]) + (p1[i][0] + p1[i][1]) + (p1[i][2] + p1[i][3])) * (1.f / 512.f) + EPS); }
        const bool rot = u.pn == 2 && u.pm < ML / 256;
#pragma unroll
        for (int ai = 0; ai < 2; ++ai) {
            f32x4 cs[4], sn[4];
#pragma unroll
            for (int m = 0; m < 4; ++m) { const int r = row0 + ai * 128 + m * 16; const int tok = r & (SEQ - 1), pos = rot ? ((wc & 1) == 0 ? (tok >> 6) : (tok & 63)) : 0;
                cs[m] = *(const GAS f32x4*)(rope + pos * 16 + 4 * fq); sn[m] = *(const GAS f32x4*)(rope + 1024 + pos * 16 + 4 * fq); }
#pragma unroll
            for (int m = 0; m < 4; ++m) {
                const int r = row0 + ai * 128 + m * 16, i = ai * 4 + m;
#pragma unroll
                for (int bj = 0; bj < 2; ++bj) {
                    f32x4 a = acc[ai][bj][m][0] * rstd[i], b = acc[ai][bj][m][1] * rstd[i];
                    if (rot) { const f32x4 x1 = a, x2 = b; a = x1 * cs[m] - x2 * sn[m]; b = x1 * sn[m] + x2 * cs[m]; }
                    GAS bf16_t* rowp = Q + (size_t)r * 768 + col0 + bj * 128;
                    st_bf16x4(rowp, a); st_bf16x4(rowp + 16, b);
                }
            }
        }
    }
};
struct EpiMlaKV {
    GAS bf16_t* KV; const GAS float* ssq;
    __device__ __forceinline__ void operator()(EPI_ARGS) const {
        const int row0 = u.pm * 256 + wr * 64 + fr, col0 = u.pn * 256 + wc * 32 + 4 * fq;
        f32x4 p0[8];
#pragma unroll
        for (int i = 0; i < 8; ++i) { const int r = row0 + (i >> 2) * 128 + (i & 3) * 16; p0[i] = *(const GAS f32x4*)(ssq + (size_t)r * 12 + 8); }
#pragma unroll
        for (int ai = 0; ai < 2; ++ai)
#pragma unroll
            for (int m = 0; m < 4; ++m) {
                const int r = row0 + ai * 128 + m * 16, i = ai * 4 + m;
                const float rstd = rsqrtf(((p0[i][0] + p0[i][1]) + (p0[i][2] + p0[i][3])) * (1.f / 256.f) + EPS);
                GAS bf16_t* rowp = KV + (size_t)r * 1024 + col0;
#pragma unroll
                for (int bj = 0; bj < 2; ++bj)
#pragma unroll
                    for (int n = 0; n < 2; ++n) st_bf16x4(rowp + bj * 128 + n * 16, acc[ai][bj][m][n] * rstd);
            }
    }
};
struct EpiGate {
    GAS unsigned char* G;
    __device__ __forceinline__ void operator()(EPI_ARGS) const {
        const __amdgpu_buffer_rsrc_t rsrc = __builtin_amdgcn_make_buffer_rsrc((void*)G, 0, 0x7fffffff, 0x00020000);
        const int voff = threadIdx.x * 8; const int tbase = (u.pm * 32 + u.pn) * 65536;
#pragma unroll
        for (int ai = 0; ai < 2; ++ai)
#pragma unroll
            for (int bj = 0; bj < 2; ++bj)
#pragma unroll
                for (int m = 0; m < 4; ++m) {
                    u32x2 w;
#pragma unroll
                    for (int n = 0; n < 2; ++n) { const f32x4 v = acc[ai][bj][m][n]; unsigned d = 0;
#pragma unroll
                        for (int j = 0; j < 4; ++j) { const float g = __builtin_amdgcn_rcpf(__builtin_fmaf(__builtin_amdgcn_exp2f(v[j]), 1.f / 255.f, 1.f / 255.f)); d = __builtin_amdgcn_cvt_pk_u8_f32(g, j, d); }
                        if (n == 0) w.x = d; else w.y = d; }
                    __builtin_amdgcn_raw_buffer_store_b64(w, rsrc, voff, tbase + ((ai * 2 + bj) * 4 + m) * 4096, 0);
                }
    }
};
struct EpiMerge {
    const GAS unsigned char* G; GAS unsigned char* ACC; const GAS float* rssd;
    __device__ __forceinline__ void operator()(EPI_ARGS) const {
        const int k = u.aux, hf = u.aux2;
        const int row0 = u.pm * 256 + hf * 128 + wr * 64 + fr, col0 = u.pn * 256 + wc * 32 + 4 * fq;
        const __amdgpu_buffer_rsrc_t rg = __builtin_amdgcn_make_buffer_rsrc((void*)G, 0, 0x7fffffff, 0x00020000);
        const int vg = threadIdx.x * 8; const int tbase = (u.pm * 32 + k * 8 + u.pn) * 65536 + hf * 32768;
        u32x2 gw[2][4]; float rsv[4];
#pragma unroll
        for (int m = 0; m < 4; ++m) { rsv[m] = (k == 3) ? rssd[row0 + m * 16] : 1.f;
#pragma unroll
            for (int bj = 0; bj < 2; ++bj) gw[bj][m] = __builtin_amdgcn_raw_buffer_load_b64(rg, vg, tbase + (bj * 4 + m) * 4096, 0); }
#pragma unroll
        for (int m = 0; m < 4; ++m) {
            const int r = row0 + m * 16; const float rs = rsv[m] * (1.f / 255.f);
#pragma unroll
            for (int bj = 0; bj < 2; ++bj) {
                const u32x2 g2 = gw[bj][m];
                f32x4 v0, v1;
                v0[0] = (float)(g2.x & 0xffu); v0[1] = (float)((g2.x >> 8) & 0xffu); v0[2] = (float)((g2.x >> 16) & 0xffu); v0[3] = (float)(g2.x >> 24);
                v1[0] = (float)(g2.y & 0xffu); v1[1] = (float)((g2.y >> 8) & 0xffu); v1[2] = (float)((g2.y >> 16) & 0xffu); v1[3] = (float)(g2.y >> 24);
                v0 = v0 * acc[0][bj][m][0] * rs; v1 = v1 * acc[0][bj][m][1] * rs;
                if (k > 0) { v0 += acc[1][bj][m][0]; v1 += acc[1][bj][m][1]; }
                if (k < 3) { acc[1][bj][m][0] = v0; acc[1][bj][m][1] = v1; }
                else { GAS unsigned char* op = ACC + (size_t)r * DM + col0 + bj * 128;
#pragma unroll
                    for (int j = 0; j < 4; ++j) { v0[j] = __builtin_amdgcn_fmed3f(v0[j], -448.f, 448.f); v1[j] = __builtin_amdgcn_fmed3f(v1[j], -448.f, 448.f); }
                    unsigned w0 = 0, w1 = 0; w0 = __builtin_amdgcn_cvt_pk_fp8_f32(v0[0], v0[1], w0, false); w0 = __builtin_amdgcn_cvt_pk_fp8_f32(v0[2], v0[3], w0, true);
                    w1 = __builtin_amdgcn_cvt_pk_fp8_f32(v1[0], v1[1], w1, false); w1 = __builtin_amdgcn_cvt_pk_fp8_f32(v1[2], v1[3], w1, true);
                    *(GAS unsigned*)op = w0; *(GAS unsigned*)(op + 16) = w1; }
            }
        }
    }
};
struct EpiBf16 {
    GAS bf16_t* O; int ld;
    __device__ __forceinline__ void operator()(EPI_ARGS) const {
        const int row0 = u.pm * 256 + wr * 64 + fr, col0 = u.pn * 256 + wc * 32 + 4 * fq;
#pragma unroll
        for (int ai = 0; ai < 2; ++ai)
#pragma unroll
            for (int m = 0; m < 4; ++m) { GAS bf16_t* rowp = O + (size_t)(row0 + ai * 128 + m * 16) * ld + col0;
#pragma unroll
                for (int bj = 0; bj < 2; ++bj)
#pragma unroll
                    for (int n = 0; n < 2; ++n) st_bf16x4(rowp + bj * 128 + n * 16, acc[ai][bj][m][n]); }
    }
};
struct EpiRouter {
    GAS float* LOG;
    __device__ __forceinline__ void operator()(EPI_ARGS) const {
        if (wc >= 2) return;
        const int row0 = u.pm * 256 + wr * 64 + fr, col0 = wc * 32 + 4 * fq;
#pragma unroll
        for (int ai = 0; ai < 2; ++ai)
#pragma unroll
            for (int m = 0; m < 4; ++m) { GAS float* rowp = LOG + ((size_t)u.aux * MT + (row0 + ai * 128 + m * 16)) * 64 + col0;
#pragma unroll
                for (int n = 0; n < 2; ++n) *(GAS f32x4*)(rowp + n * 16) = acc[ai][0][m][n]; }
    }
};
struct RouterSched {
    int nM, G, c;
    __device__ __forceinline__ bool next(int i, Unit& u) const {
        const long L = (long)i * G + c; if (L >= (long)nM * 4) return false;
        u.pm = (int)(L >> 2); u.pn = 0; u.aux = (int)(L & 3); u.aux2 = 0;
        u.aoff = ((size_t)u.pm * 256 * DM + (size_t)u.aux * 512) * 2; u.boff = (size_t)u.aux * 512 * 2; return true;
    }
    __device__ __forceinline__ int arow(const Unit&, int) const { return 0; }
};
struct MoeSched {
    const volatile LAS int* tb; const volatile LAS int* cnt; const GAS int* list; int nN, G, c, mode;
    __device__ __forceinline__ bool next(int i, Unit& u) const {
        const long L = (long)i * G + c; const int NT = tb[32]; const int nwg = NT * nN;
        if (L >= nwg) return false;
        const int q8 = (int)((unsigned)nwg / pg8::NXCD), r8 = (int)((unsigned)nwg % pg8::NXCD), xcd = (int)((unsigned)L % pg8::NXCD), off = (int)((unsigned)L / pg8::NXCD);
        const int wgid = (xcd < r8 ? xcd * (q8 + 1) : r8 * (q8 + 1) + (xcd - r8) * q8) + off;
        const int lgn = nN == 8 ? 3 : 2, ti = wgid >> lgn;
        u.pn = wgid & (nN - 1); int e = 0;
#pragma unroll
        for (int st = 16; st >= 1; st >>= 1) { if (ti >= tb[e + st]) e += st; }
        u.aux = e; u.aux2 = ti - tb[e]; u.pm = ti;
        if (mode == 1) { u.aoff = 0; u.boff = ((size_t)e * 1024 + (size_t)u.pn * 256) * DM; }
        else { u.aoff = (size_t)ti * 256 * DEXP; u.boff = ((size_t)e * DM + (size_t)u.pn * 256) * DEXP; }
        return true;
    }
    __device__ __forceinline__ int acnt(const Unit& u) const { return cnt[u.aux]; }
    __device__ __forceinline__ int arow(const Unit& u, int r, int n_e) const {
        const int pos = u.aux2 * 256 + r; const int e = u.aux;
        const bool in = pos < n_e; const int v = list[(size_t)e * MT + (in ? pos : 0)] >> 1;
        return in ? v : 0;
    }
};
struct EpiMoe1 {
    GAS unsigned char* H1;
    __device__ __forceinline__ void operator()(EPI_ARGS) const {
        const int row0 = u.pm * 256 + wr * 64 + fr, col0 = u.pn * 128 + wc * 32 + 4 * fq;
#pragma unroll
        for (int ai = 0; ai < 2; ++ai)
#pragma unroll
            for (int m = 0; m < 4; ++m) { GAS unsigned char* rowp = H1 + (size_t)(row0 + ai * 128 + m * 16) * DEXP + col0;
#pragma unroll
                for (int n = 0; n < 2; ++n) { const f32x4 a = acc[ai][0][m][n], b = acc[ai][1][m][n]; f32x4 v;
#pragma unroll
                    for (int j = 0; j < 4; ++j) v[j] = __builtin_amdgcn_fmed3f(a[j] * __builtin_amdgcn_rcpf(1.f + __builtin_amdgcn_exp2f(-1.4426950409f * a[j])) * b[j], -448.f, 448.f);
                    unsigned w = 0; w = __builtin_amdgcn_cvt_pk_fp8_f32(v[0], v[1], w, false); w = __builtin_amdgcn_cvt_pk_fp8_f32(v[2], v[3], w, true);
                    *(GAS unsigned*)(rowp + n * 16) = w; } }
    }
};
struct EpiMoe2 {
    GAS bf16_t* Y2; const GAS int* list; const GAS float* wl; const volatile LAS int* cnt;
    __device__ __forceinline__ void operator()(EPI_ARGS) const {
        const int e = u.aux, n_e = cnt[e], col0 = u.pn * 256 + wc * 32 + 4 * fq;
        int ts[8]; float w[8];
#pragma unroll
        for (int i = 0; i < 8; ++i) { const int pos = u.aux2 * 256 + (i >> 2) * 128 + wr * 64 + (i & 3) * 16 + fr; const bool ok = pos < n_e;
            const int pc = ok ? pos : 0; const int tv = list[(size_t)e * MT + pc]; const float wv = wl[(size_t)e * MT + pc];
            ts[i] = ok ? tv : -1; w[i] = ok ? wv : 0.f; }
#pragma unroll
        for (int ai = 0; ai < 2; ++ai)
#pragma unroll
            for (int m = 0; m < 4; ++m) { const int i = ai * 4 + m;
                if (ts[i] >= 0) {
                    GAS bf16_t* rowp = Y2 + (size_t)ts[i] * DM + col0;
#pragma unroll
                    for (int bj = 0; bj < 2; ++bj)
#pragma unroll
                        for (int n = 0; n < 2; ++n) st_bf16x4(rowp + bj * 128 + n * 16, acc[ai][bj][m][n] * w[i]);
                }
            }
    }
};

struct WinSched {
    GridSched gs; int mode;
    __device__ __forceinline__ bool next(int i, Unit& u) const {
        const long L = (long)i * gs.G + gs.c; if (L >= gs.nwg) return false;
        int j; gs.map((int)L, u.pm, j);
        u.pn = mode == 0 ? (j < 17 ? 4 + j : 5 + j) : (j < 4 ? j : 21);
        u.aux = 0; u.aux2 = 0; u.aoff = gs.a0 + (size_t)u.pm * gs.a_tile; u.boff = gs.b0 + (size_t)u.pn * gs.b_tile; return true;
    }
    __device__ __forceinline__ int arow(const Unit&, int) const { return 0; }
};
struct MergeSched {
    GridSched gs;
    __device__ __forceinline__ bool next(int i, Unit& u) const {
        const long H = (long)(i >> 2) * gs.G + gs.c; if (H >= 2 * (long)gs.nwg) return false;
        const int hf = H >= gs.nwg ? 1 : 0; gs.map((int)(H - (long)hf * gs.nwg), u.pm, u.pn); const int k = i & 3; u.aux = k; u.aux2 = hf;
        u.aoff = ((size_t)u.pm * 256 + (size_t)hf * 128) * DM + (size_t)k * 512; u.boff = ((size_t)k * DM + (size_t)u.pn * 256) * 512; return true;
    }
    __device__ __forceinline__ int arow(const Unit&, int) const { return 0; }
};

__device__ __forceinline__ void tr_block(const GAS float* colp, int ldw, float nscale, const GAS float* kscale, int k0, GAS bf16_t* WT, int K, int n0, LAS float* scr, int lane) {
    float v[32];
#pragma unroll
    for (int i = 0; i < 32; ++i) { const int kk = 2 * i + (lane >> 5); v[i] = colp[(size_t)(k0 + kk) * ldw]; }
    if (kscale) {
#pragma unroll
        for (int i = 0; i < 32; ++i) { const int kk = 2 * i + (lane >> 5); v[i] *= kscale[k0 + kk]; }
    }
#pragma unroll
    for (int i = 0; i < 32; ++i) { const int kk = 2 * i + (lane >> 5); scr[kk * 33 + (lane & 31)] = v[i] * nscale; }
    LDS_WAIT(); asm volatile("" ::: "memory");
    const int c = lane & 7;
#pragma unroll
    for (int j = 0; j < 4; ++j) { const int n = (lane >> 3) + 8 * j; const LAS float* s = scr + (8 * c) * 33 + n;
        u32x4 o; o.x = cvt_pk_bf16(s[0 * 33], s[1 * 33]); o.y = cvt_pk_bf16(s[2 * 33], s[3 * 33]); o.z = cvt_pk_bf16(s[4 * 33], s[5 * 33]); o.w = cvt_pk_bf16(s[6 * 33], s[7 * 33]);
        *(GAS u32x4*)(WT + (size_t)(n0 + n) * K + k0 + 8 * c) = o; }
    LDS_WAIT(); asm volatile("" ::: "memory");
}

__device__ __forceinline__ void tr_block8(const GAS float* colp, int ldw, float nscale, int k0, GAS unsigned char* WT, int K, int n0, LAS float* scr, int lane) {
    float v[32];
#pragma unroll
    for (int i = 0; i < 32; ++i) { const int kk = 2 * i + (lane >> 5); v[i] = colp[(size_t)(k0 + kk) * ldw]; }
#pragma unroll
    for (int i = 0; i < 32; ++i) { const int kk = 2 * i + (lane >> 5); scr[kk * 33 + (lane & 31)] = v[i] * nscale; }
    LDS_WAIT(); asm volatile("" ::: "memory");
    const int c = lane & 7;
#pragma unroll
    for (int j = 0; j < 4; ++j) { const int n = (lane >> 3) + 8 * j; const LAS float* s = scr + (8 * c) * 33 + n;
        u32x2 o; unsigned w = 0; w = __builtin_amdgcn_cvt_pk_fp8_f32(s[0 * 33], s[1 * 33], w, false); w = __builtin_amdgcn_cvt_pk_fp8_f32(s[2 * 33], s[3 * 33], w, true); o.x = w;
        w = 0; w = __builtin_amdgcn_cvt_pk_fp8_f32(s[4 * 33], s[5 * 33], w, false); w = __builtin_amdgcn_cvt_pk_fp8_f32(s[6 * 33], s[7 * 33], w, true); o.y = w;
        *(GAS u32x2*)(WT + (size_t)(n0 + n) * K + k0 + 8 * c) = o; }
    LDS_WAIT(); asm volatile("" ::: "memory");
}

__device__ __forceinline__ void tr_block8k(const GAS float* colp, int ldw, float nscale, const GAS float* kscale, int k0, GAS unsigned char* WT, int K, int n0, LAS float* scr, int lane) {
    float v[32];
#pragma unroll
    for (int i = 0; i < 32; ++i) { const int kk = 2 * i + (lane >> 5); v[i] = colp[(size_t)(k0 + kk) * ldw]; }
    if (kscale) {
#pragma unroll
        for (int i = 0; i < 32; ++i) { const int kk = 2 * i + (lane >> 5); v[i] *= kscale[k0 + kk]; }
    }
#pragma unroll
    for (int i = 0; i < 32; ++i) { const int kk = 2 * i + (lane >> 5); scr[kk * 33 + (lane & 31)] = v[i] * nscale; }
    LDS_WAIT(); asm volatile("" ::: "memory");
    const int c = lane & 7;
#pragma unroll
    for (int j = 0; j < 4; ++j) { const int n = (lane >> 3) + 8 * j; const LAS float* s = scr + (8 * c) * 33 + n;
        u32x2 o; unsigned w = 0; w = __builtin_amdgcn_cvt_pk_fp8_f32(s[0 * 33], s[1 * 33], w, false); w = __builtin_amdgcn_cvt_pk_fp8_f32(s[2 * 33], s[3 * 33], w, true); o.x = w;
        w = 0; w = __builtin_amdgcn_cvt_pk_fp8_f32(s[4 * 33], s[5 * 33], w, false); w = __builtin_amdgcn_cvt_pk_fp8_f32(s[6 * 33], s[7 * 33], w, true); o.y = w;
        *(GAS u32x2*)(WT + (size_t)(n0 + n) * K + k0 + 8 * c) = o; }
    LDS_WAIT(); asm volatile("" ::: "memory");
}
__device__ __forceinline__ int win_src(int n) {
    if (n < 2048) return n;
    if (n < 5440) return n + 16;
    if (n < 5456) return 2048 + (n - 5440);
    if (n < 5472) return 6992 + (n - 5456);
    if (n < 5632) return -1;
    if (n < 6144) return 5456 + (n - 5632);
    return 5968 + (n - 6144);
}
constexpr int IT_WIN = 32 * 224, IT_WUQ = 8 * 24, IT_WUKV = 4 * 32, IT_WG = 32 * 64, IT_WBR = 8 * 64, IT_WOUT = 32 * 64, IT_WR = 32 * 8, IT_W13 = 32 * 32, IT_W2 = 8 * 64;
constexpr int IT_LAYER = IT_WIN + IT_WUQ + IT_WUKV + 4 * IT_WG + 4 * IT_WBR + IT_WOUT + IT_WR;
constexpr int IT_MOE = NEXP * (IT_W13 + IT_W2);
__device__ __forceinline__ void cvt_layer_item(Frame& F, int l, int r, LAS float* scr) {
    const int lane = F.lane, nl = lane & 31;
    if (r < IT_WIN) { const int nb = r % 224, kb = r / 224, n = nb * 32 + nl, sc = win_src(n);
        const int ct = nb >> 3;
        if (ct >= 4 && ct != 21) tr_block8(INP(I_WIN) + (size_t)l * DM * DIN + (sc >= 0 ? sc : 0), DIN, sc >= 0 ? 64.f : 0.f, kb * 64, WSP(unsigned char, WS_WIN8) + (size_t)l * NU * DM, DM, nb * 32, scr, lane);
        else tr_block(INP(I_WIN) + (size_t)l * DM * DIN + (sc >= 0 ? sc : 0), DIN, sc < 0 ? 0.f : (n < 512 ? 0.08838834764831845f : 1.f), nullptr, kb * 64, WSP(bf16_t, WS_WIN) + (size_t)l * NU * DM, DM, nb * 32, scr, lane);
        return; }
    r -= IT_WIN;
    if (r < IT_WUQ) { const int nb = r % 24, kb = r / 24, n = nb * 32 + nl; const int sc = n < 512 ? (n >> 7) * 192 + (n & 127) : ((n - 512) >> 6) * 192 + 128 + ((n - 512) & 63);
        tr_block(INP(I_WUQ) + (size_t)l * 512 * 768 + sc, 768, 0.07216878364870323f * 1.4426950408889634f, INP(I_MLAGQ) + l * 512, kb * 64, WSP(bf16_t, WS_WUQ) + (size_t)l * 768 * 512, 512, nb * 32, scr, lane); return; }
    r -= IT_WUQ;
    if (r < IT_WUKV) { const int nb = r % 32, kb = r / 32, n = nb * 32 + nl; const int sc = n < 512 ? (n >> 7) * 256 + (n & 127) : ((n - 512) >> 7) * 256 + 128 + ((n - 512) & 127);
        tr_block(INP(I_WUKV) + (size_t)l * 256 * 1024 + sc, 1024, 1.f, INP(I_MLAGKV) + l * 256, kb * 64, WSP(bf16_t, WS_WUKV) + (size_t)l * 1024 * 256, 256, nb * 32, scr, lane); return; }
    r -= IT_WUKV;
    if (r < 4 * IT_WG) { const int k = r / IT_WG, q = r % IT_WG, nb = q % 64, kb = q / 64;
        tr_block8(INP(I_WGATE) + (size_t)(l * 4 + k) * DM * DM + nb * 32 + nl, DM, -92.33248261689366f  , kb * 64, WSP(unsigned char, WS_WG) + ((size_t)l * 8192 + (size_t)k * 2048) * DM, DM, nb * 32, scr, lane); return; }
    r -= 4 * IT_WG;
    if (r < 4 * IT_WBR) { const int k = r / IT_WBR, q = r % IT_WBR, nb = q % 64, kb = q / 64;
        const GAS float* ks = k == 1 ? INP(I_HGNG) + l * 512 : (k == 3 ? INP(I_SSDNG) + l * 512 : nullptr);
        tr_block8k(INP(I_WBR) + (size_t)(l * 4 + k) * 512 * DM + nb * 32 + nl, DM, 64.f, ks, kb * 64, WSP(unsigned char, WS_WBR) + (size_t)(l * 4 + k) * DM * 512, 512, nb * 32, scr, lane); return; }
    r -= 4 * IT_WBR;
    if (r < IT_WOUT) { const int nb = r % 64, kb = r / 64;
        tr_block8(INP(I_WOUT) + (size_t)l * DM * DM + nb * 32 + nl, DM, 64.f, kb * 64, WSP(unsigned char, WS_WOUT) + (size_t)l * DM * DM, DM, nb * 32, scr, lane); return; }
    r -= IT_WOUT;
    { const int nb = r % 8, kb = r / 8, n = nb * 32 + nl; const GAS float* cp = INP(I_WGRP) + (size_t)l * DM * 4; int ld = 4;
      if (n < 4) { cp += n; } else if (n < 36) { cp = INP(I_WEXP) + (size_t)l * DM * 32 + (n - 4); ld = 32; }
      tr_block(cp, ld, n < 36 ? 1.f : 0.f, nullptr, kb * 64, WSP(bf16_t, WS_WR) + (size_t)l * 256 * DM, DM, nb * 32, scr, lane); }
}
__device__ __forceinline__ void cvt_moe_item(Frame& F, int l, int r, LAS float* scr) {
    const int lane = F.lane, nl = lane & 31;
    if (r < NEXP * IT_W13) { const int e = r / IT_W13, q = r % IT_W13, nb = q % 32, kb = q / 32, n = nb * 32 + nl;
        const int c = (n >> 8) * 128 + (n & 127); const GAS float* src = ((n >> 7) & 1) ? INP(I_W3) : INP(I_W1);
        tr_block8(src + (size_t)(l * NEXP + e) * DM * DEXP + c, DEXP, 64.f, kb * 64, WSP(unsigned char, WS_W13) + (size_t)e * 1024 * DM, DM, nb * 32, scr, lane); return; }
    r -= NEXP * IT_W13;
    { const int e = r / IT_W2, q = r % IT_W2, nb = q % 64, kb = q / 64;
      tr_block8(INP(I_W2) + (size_t)(l * NEXP + e) * DEXP * DM + nb * 32 + nl, DM, 64.f, kb * 64, WSP(unsigned char, WS_W2) + (size_t)e * DM * DEXP, DEXP, nb * 32, scr, lane); }
}
__device__ __forceinline__ void ada_task(Frame& F, int task, LAS float* scr) {
    const int ks = task & 15, cg = (task >> 4) % 48, l = task / (16 * 48); const int col = cg * 256 + F.lane * 4;
    for (int i = F.lane; i < 9 * 128; i += 64) { const int r = i >> 7, kk = ks * 128 + (i & 127); const float c = r < 8 ? INP(I_C)[r * DM + kk] : INP(I_CCTX)[kk]; scr[i] = siluf_(c); }
    LDS_WAIT(); asm volatile("" ::: "memory");
    f32x4 a[9];
#pragma unroll
    for (int r = 0; r < 9; ++r) a[r] = (f32x4){0.f, 0.f, 0.f, 0.f};
    const GAS float* W = INP(I_WADA) + ((size_t)l * DM + ks * 128) * 12288 + col;
    for (int k = 0; k < 128; k += 8) {
        f32x4 w[8];
#pragma unroll
        for (int q = 0; q < 8; ++q) w[q] = *(const GAS f32x4*)(W + (size_t)(k + q) * 12288);
#pragma unroll
        for (int q = 0; q < 8; ++q) {
#pragma unroll
            for (int r = 0; r < 9; ++r) a[r] += scr[r * 128 + k + q] * w[q];
        }
    }
    GAS float* P = WSP(float, WS_MODP) + ((size_t)(l * 16 + ks) * 9) * 12288 + col;
#pragma unroll
    for (int r = 0; r < 9; ++r) *(GAS f32x4*)(P + (size_t)r * 12288) = a[r];
    LDS_WAIT(); asm volatile("" ::: "memory");
}
__device__ __forceinline__ void tables_task(Frame& F) {
    GAS float* T = WSP(float, WS_TAB); const int lane = F.lane;
    for (int i = 0; i < 16; ++i) { const float inv = expf(-(float)i * (9.210340371976184f / 16.f)); const float ang = (float)lane * inv; T[lane * 16 + i] = cosf(ang); T[1024 + lane * 16 + i] = sinf(ang); }
    for (int j = lane; j < 512; j += 64) { const float a0 = INP(I_HGLB)[j], a1 = INP(I_HGLB)[512 + j], a2 = INP(I_HGLB)[1024 + j];
        const float mx = fmaxf(a0, fmaxf(a1, a2)), e0 = expf(a0 - mx), e1 = expf(a1 - mx), e2 = expf(a2 - mx), s = e0 + e1 + e2;
        T[2048 + j] = e0 / s; T[2048 + 512 + j] = (e0 + e1) / s; }
}
constexpr int N_ADA = 2 * 48 * 16;
__device__ __forceinline__ void phase_prologue(Frame& F) {
    LAS float* scr = (LAS float*)(F.lds + F.wave * 16384);
    const int gw = F.vcu * 8 + F.wave, NGW = F.G * 8;
    constexpr int TOTAL = N_ADA + 1 + IT_LAYER;
    for (int it = gw; it < TOTAL; it += NGW) {
        int r = it;
        if (r < N_ADA) { ada_task(F, r, scr); continue; } r -= N_ADA;
        if (r == 0) { tables_task(F); continue; } r -= 1;
        cvt_layer_item(F, 0, r, scr);
    }
}
__device__ __forceinline__ void phase_modfin(Frame& F) {
    const int gt = F.vcu * 512 + F.tid, NT_ = F.G * 512;
    for (int i = gt; i < 2 * 9 * 12288; i += NT_) { const int l = i / (9 * 12288), rc = i % (9 * 12288), col = rc % 12288;
        float s = INP(I_BADA)[l * 12288 + col];
#pragma unroll
        for (int ks = 0; ks < 16; ++ks) s += WSP(float, WS_MODP)[((size_t)(l * 16 + ks) * 9) * 12288 + rc];
        WSP(float, WS_MOD)[i] = s; }
}

struct Row8 { f32x4 v[8]; };
__device__ __forceinline__ void ld_row_f32(Row8& R, const GAS float* p, int lane) {
#pragma unroll
    for (int j = 0; j < 8; ++j) R.v[j] = ((const GAS f32x4*)p)[64 * j + lane];
}
__device__ __forceinline__ void st_row_f32(const Row8& R, GAS float* p, int lane) {
#pragma unroll
    for (int j = 0; j < 8; ++j) ((GAS f32x4*)p)[64 * j + lane] = R.v[j];
}
__device__ __forceinline__ void ld_row_bf16(Row8& R, const GAS bf16_t* p, int lane) {
#pragma unroll
    for (int j = 0; j < 8; ++j) { const u32x2 w = ((const GAS u32x2*)p)[64 * j + lane]; R.v[j] = (f32x4){bflo(w.x), bfhi(w.x), bflo(w.y), bfhi(w.y)}; }
}
__device__ __forceinline__ void st_row_bf16(const Row8& R, GAS bf16_t* p, int lane) {
#pragma unroll
    for (int j = 0; j < 8; ++j) { u32x2 w; w.x = cvt_pk_bf16(R.v[j][0], R.v[j][1]); w.y = cvt_pk_bf16(R.v[j][2], R.v[j][3]); ((GAS u32x2*)p)[64 * j + lane] = w; }
}
__device__ __forceinline__ float row_rstd(const Row8& R) {
    float s = 0.f;
#pragma unroll
    for (int j = 0; j < 8; ++j) s += (R.v[j][0] * R.v[j][0] + R.v[j][1] * R.v[j][1]) + (R.v[j][2] * R.v[j][2] + R.v[j][3] * R.v[j][3]);
    return rsqrtf(wave_sum(s) * (1.f / DM) + EPS);
}
__device__ __forceinline__ void st_modnorm(const Row8& R, float rstd, const GAS float* g, const GAS float* shift, const GAS float* scale, GAS bf16_t* o, int lane) {
#pragma unroll
    for (int j = 0; j < 8; ++j) { const int c = 64 * j + lane; const f32x4 gg = ((const GAS f32x4*)g)[c], sh = ((const GAS f32x4*)shift)[c], sc = ((const GAS f32x4*)scale)[c];
        const f32x4 h = (R.v[j] * rstd * gg) * (sc + 1.f) + sh; u32x2 w; w.x = cvt_pk_bf16(h[0], h[1]); w.y = cvt_pk_bf16(h[2], h[3]); ((GAS u32x2*)o)[c] = w; }
}
__device__ __forceinline__ void st_modnorm8(const Row8& R, float rstd, const GAS float* g, const GAS float* shift, const GAS float* scale, GAS unsigned char* o, int lane) {
#pragma unroll
    for (int j = 0; j < 8; ++j) { const int c = 64 * j + lane; const f32x4 gg = ((const GAS f32x4*)g)[c], sh = ((const GAS f32x4*)shift)[c], sc = ((const GAS f32x4*)scale)[c];
        f32x4 h = (R.v[j] * rstd * gg) * (sc + 1.f) + sh;
#pragma unroll
        for (int q = 0; q < 4; ++q) h[q] = __builtin_amdgcn_fmed3f(h[q], -448.f, 448.f);
        unsigned w = 0; w = __builtin_amdgcn_cvt_pk_fp8_f32(h[0], h[1], w, false); w = __builtin_amdgcn_cvt_pk_fp8_f32(h[2], h[3], w, true); ((GAS unsigned*)o)[c] = w; }
}
__device__ __forceinline__ void st_modnorm2(const Row8& R, float rstd, const GAS float* g, const GAS float* shift, const GAS float* scale, GAS bf16_t* o16, GAS unsigned char* o8, int lane) {
#pragma unroll
    for (int j = 0; j < 8; ++j) { const int c = 64 * j + lane; const f32x4 gg = ((const GAS f32x4*)g)[c], sh = ((const GAS f32x4*)shift)[c], sc = ((const GAS f32x4*)scale)[c];
        f32x4 h = (R.v[j] * rstd * gg) * (sc + 1.f) + sh; u32x2 w; w.x = cvt_pk_bf16(h[0], h[1]); w.y = cvt_pk_bf16(h[2], h[3]); ((GAS u32x2*)o16)[c] = w;
#pragma unroll
        for (int q = 0; q < 4; ++q) h[q] = __builtin_amdgcn_fmed3f(h[q], -448.f, 448.f);
        unsigned w8 = 0; w8 = __builtin_amdgcn_cvt_pk_fp8_f32(h[0], h[1], w8, false); w8 = __builtin_amdgcn_cvt_pk_fp8_f32(h[2], h[3], w8, true); ((GAS unsigned*)o8)[c] = w8; }
}
__device__ __forceinline__ const GAS float* mod_row(Frame& F, int l, int r) { return WSP(float, WS_MOD) + (size_t)(l * 9 + (r < ML ? (r >> 11) : 8)) * 12288; }
struct RawX { f32x4 f[8]; };
__device__ __forceinline__ void ld_raw_f32(RawX& R, const GAS float* p, int lane) {
#pragma unroll
    for (int j = 0; j < 8; ++j) R.f[j] = ((const GAS f32x4*)p)[64 * j + lane];
}
__device__ __forceinline__ void ld_raw_bf16(RawX& R, const GAS bf16_t* p, int lane) {
#pragma unroll
    for (int j = 0; j < 8; ++j) { const u32x2 w = ((const GAS u32x2*)p)[64 * j + lane]; R.f[j] = (f32x4){__uint_as_float(w.x), __uint_as_float(w.y), 0.f, 0.f}; }
}
__device__ __forceinline__ void raw_to_row(Row8& X, const RawX& R, bool is_bf16) {
#pragma unroll
    for (int j = 0; j < 8; ++j) { if (is_bf16) { const unsigned a = __float_as_uint(R.f[j][0]), b = __float_as_uint(R.f[j][1]); X.v[j] = (f32x4){bflo(a), bfhi(a), bflo(b), bfhi(b)}; } else X.v[j] = R.f[j]; }
}
struct RawB { u32x2 w[8]; };
__device__ __forceinline__ void ld_rawb(RawB& R, const GAS bf16_t* p, int lane) {
#pragma unroll
    for (int j = 0; j < 8; ++j) R.w[j] = ((const GAS u32x2*)p)[64 * j + lane];
}
__device__ __forceinline__ void rawb_to_row(Row8& X, const RawB& R) {
#pragma unroll
    for (int j = 0; j < 8; ++j) X.v[j] = (f32x4){bflo(R.w[j].x), bfhi(R.w[j].x), bflo(R.w[j].y), bfhi(R.w[j].y)};
}
__device__ __forceinline__ int row_grp(int r) { return r < ML ? (r >> 11) : 8; }
__device__ __forceinline__ void stage_vec(Frame& F, LAS float* dst, const GAS float* src) { ((LAS f32x4*)dst)[F.tid] = ((const GAS f32x4*)src)[F.tid]; }
__device__ __forceinline__ void st_modnorm2_l(const Row8& R, float rstd, const LAS float* g, const LAS float* shift, const LAS float* scale, GAS bf16_t* o16, GAS unsigned char* o8, int lane) {
#pragma unroll
    for (int j = 0; j < 8; ++j) { const int c = 64 * j + lane; const f32x4 gg = ((const LAS f32x4*)g)[c], sh = ((const LAS f32x4*)shift)[c], sc = ((const LAS f32x4*)scale)[c];
        f32x4 h = (R.v[j] * rstd * gg) * (sc + 1.f) + sh; u32x2 w; w.x = cvt_pk_bf16(h[0], h[1]); w.y = cvt_pk_bf16(h[2], h[3]); ((GAS u32x2*)o16)[c] = w;
#pragma unroll
        for (int q = 0; q < 4; ++q) h[q] = __builtin_amdgcn_fmed3f(h[q], -448.f, 448.f);
        unsigned w8 = 0; w8 = __builtin_amdgcn_cvt_pk_fp8_f32(h[0], h[1], w8, false); w8 = __builtin_amdgcn_cvt_pk_fp8_f32(h[2], h[3], w8, true); ((GAS unsigned*)o8)[c] = w8; }
}
__device__ __forceinline__ void phase_rwA(Frame& F, int l) {
    const int rpb = (MT + F.G - 1) / F.G, rlo = F.vcu * rpb, rhi = (rlo + rpb < MT ? rlo + rpb : MT) - 1;
    if (rlo > rhi) return;
    LAS float* Lf = (LAS float*)F.lds; const int ga = row_grp(rlo), gb = row_grp(rhi);
    stage_vec(F, Lf, INP(I_NORMG) + (size_t)(l * 4 + 0) * DM);
#pragma unroll
    for (int v = 0; v < 2; ++v) { stage_vec(F, Lf + (1 + v) * 2048, WSP(float, WS_MOD) + (size_t)(l * 9 + ga) * 12288 + v * DM); stage_vec(F, Lf + (3 + v) * 2048, WSP(float, WS_MOD) + (size_t)(l * 9 + gb) * 12288 + v * DM); }
    __syncthreads();
    for (int i0 = F.wave; i0 < rpb; i0 += 16) {
        const int r0 = rlo + i0, r1 = r0 + 8; const bool two = i0 + 8 < rpb && r1 <= rhi;
        if (r0 > rhi) break;
        RawX Ra, Rb; ld_raw_f32(Ra, r0 < ML ? INP(I_X) + (size_t)r0 * DM : INP(I_CTX) + (size_t)(r0 - ML) * DM, F.lane);
        if (two) ld_raw_f32(Rb, r1 < ML ? INP(I_X) + (size_t)r1 * DM : INP(I_CTX) + (size_t)(r1 - ML) * DM, F.lane);
#pragma unroll
        for (int q = 0; q < 2; ++q) { if (q == 1 && !two) break; const int r = q ? r1 : r0;
            Row8 R; raw_to_row(R, q ? Rb : Ra, false);
            const float rstd = row_rstd(R); const LAS float* md = Lf + (row_grp(r) == ga ? 1 : 3) * 2048;
            st_modnorm2_l(R, rstd, Lf, md, md + 2048, WSP(bf16_t, WS_HIN) + (size_t)r * DM, WSP(unsigned char, WS_H8) + (size_t)r * DM, F.lane); }
    }
}
__device__ __forceinline__ void phase_rwB(Frame& F, int l, int mrows) {
    const int rpb = (mrows + F.G - 1) / F.G, rlo = F.vcu * rpb, rhi = (rlo + rpb < mrows ? rlo + rpb : mrows) - 1;
    if (rlo > rhi) return;
    LAS float* Lf = (LAS float*)F.lds; const int ga = row_grp(rlo), gb = row_grp(rhi);
    stage_vec(F, Lf, INP(I_NORMG) + (size_t)(l * 4 + 1) * DM); stage_vec(F, Lf + 2048, INP(I_NORMG) + (size_t)(l * 4 + 2) * DM);
#pragma unroll
    for (int v = 0; v < 3; ++v) { stage_vec(F, Lf + (2 + v) * 2048, WSP(float, WS_MOD) + (size_t)(l * 9 + ga) * 12288 + (2 + v) * DM); stage_vec(F, Lf + (5 + v) * 2048, WSP(float, WS_MOD) + (size_t)(l * 9 + gb) * 12288 + (2 + v) * DM); }
    __syncthreads();
    const LAS float* g1 = Lf; const LAS float* g2 = Lf + 2048;
    for (int i0 = F.wave; i0 < rpb; i0 += 16) {
        const int r0 = rlo + i0, r1 = r0 + 8; const bool two = i0 + 8 < rpb && r1 <= rhi;
        if (r0 > rhi) break;
        RawB Ya, Yb; RawX Xa, Xb;
#define RWB_LOAD(Y_, X_, r_) do { ld_rawb(Y_, WSP(bf16_t, WS_RB + RB_Y) + (size_t)(r_) * DM, F.lane); \
        if ((r_) < ML) { if (l == 0) ld_raw_f32(X_, INP(I_X) + (size_t)(r_) * DM, F.lane); else ld_raw_bf16(X_, (const GAS bf16_t*)(F.out + (size_t)(r_) * DM), F.lane); } \
        else ld_raw_f32(X_, l == 0 ? INP(I_CTX) + (size_t)((r_) - ML) * DM : WSP(float, WS_XC) + (size_t)((r_) - ML) * DM, F.lane); } while (0)
        RWB_LOAD(Ya, Xa, r0); if (two) RWB_LOAD(Yb, Xb, r1);
#undef RWB_LOAD
#pragma unroll
        for (int q = 0; q < 2; ++q) { if (q == 1 && !two) break; const int r = q ? r1 : r0;
            Row8 Y, X; rawb_to_row(Y, q ? Yb : Ya); raw_to_row(X, q ? Xb : Xa, r < ML && l != 0);
            const float ry = row_rstd(Y); const LAS float* md = Lf + (row_grp(r) == ga ? 2 : 5) * 2048;
#pragma unroll
            for (int j = 0; j < 8; ++j) { const int c = 64 * j + F.lane; X.v[j] += ((const LAS f32x4*)md)[c] * (Y.v[j] * ry * ((const LAS f32x4*)g1)[c]); }
            if (r < ML) st_row_bf16(X, (GAS bf16_t*)(F.out + (size_t)r * DM), F.lane); else st_row_f32(X, WSP(float, WS_XC) + (size_t)(r - ML) * DM, F.lane);
            const float rx = row_rstd(X);
            st_modnorm2_l(X, rx, g2, md + 2048, md + 4096, WSP(bf16_t, WS_H) + (size_t)r * DM, WSP(unsigned char, WS_H8) + (size_t)r * DM, F.lane); }
    }
}
__device__ __forceinline__ void phase_rwC(Frame& F, int l, int mrows) {
    const int rpb = (mrows + F.G - 1) / F.G, rlo = F.vcu * rpb, rhi = (rlo + rpb < mrows ? rlo + rpb : mrows) - 1;
    if (rlo > rhi) return;
    LAS float* Lf = (LAS float*)F.lds; const int ga = row_grp(rlo), gb = row_grp(rhi);
    stage_vec(F, Lf, INP(I_NORMG) + (size_t)(l * 4 + 3) * DM);
    stage_vec(F, Lf + 2 * 2048, WSP(float, WS_MOD) + (size_t)(l * 9 + ga) * 12288 + 5 * DM); stage_vec(F, Lf + 5 * 2048, WSP(float, WS_MOD) + (size_t)(l * 9 + gb) * 12288 + 5 * DM);
    if (l + 1 < DEPTH) { stage_vec(F, Lf + 2048, INP(I_NORMG) + (size_t)((l + 1) * 4 + 0) * DM);
#pragma unroll
        for (int v = 0; v < 2; ++v) { stage_vec(F, Lf + (3 + v) * 2048, WSP(float, WS_MOD) + (size_t)((l + 1) * 9 + ga) * 12288 + v * DM); stage_vec(F, Lf + (6 + v) * 2048, WSP(float, WS_MOD) + (size_t)((l + 1) * 9 + gb) * 12288 + v * DM); } }
    __syncthreads();
    const LAS float* g3 = Lf;
    for (int i0 = F.wave; i0 < rpb; i0 += 16) {
        const int r0 = rlo + i0, r1 = r0 + 8; const bool two = i0 + 8 < rpb && r1 <= rhi;
        if (r0 > rhi) break;
        RawB Aa, Ba, Ab, Bb; RawX Xa, Xb;
#define RWC_LOAD(A_, B_, X_, r_) do { ld_rawb(A_, WSP(bf16_t, WS_RB + RB_Y2) + (size_t)(2 * (r_)) * DM, F.lane); ld_rawb(B_, WSP(bf16_t, WS_RB + RB_Y2) + (size_t)(2 * (r_) + 1) * DM, F.lane); \
        if ((r_) < ML) ld_raw_bf16(X_, (const GAS bf16_t*)(F.out + (size_t)(r_) * DM), F.lane); else ld_raw_f32(X_, WSP(float, WS_XC) + (size_t)((r_) - ML) * DM, F.lane); } while (0)
        RWC_LOAD(Aa, Ba, Xa, r0); if (two) RWC_LOAD(Ab, Bb, Xb, r1);
#undef RWC_LOAD
#pragma unroll
        for (int q = 0; q < 2; ++q) { if (q == 1 && !two) break; const int r = q ? r1 : r0;
            Row8 A, B, X; rawb_to_row(A, q ? Ab : Aa); rawb_to_row(B, q ? Bb : Ba); raw_to_row(X, q ? Xb : Xa, r < ML);
#pragma unroll
            for (int j = 0; j < 8; ++j) A.v[j] += B.v[j];
            const float ry = row_rstd(A); const LAS float* md = Lf + (row_grp(r) == ga ? 2 : 5) * 2048;
#pragma unroll
            for (int j = 0; j < 8; ++j) { const int c = 64 * j + F.lane; X.v[j] += ((const LAS f32x4*)md)[c] * (A.v[j] * ry * ((const LAS f32x4*)g3)[c]); }
            if (r >= ML) st_row_f32(X, WSP(float, WS_XC) + (size_t)(r - ML) * DM, F.lane);
            else if (l + 1 < DEPTH) st_row_bf16(X, (GAS bf16_t*)(F.out + (size_t)r * DM), F.lane);
            else st_row_f32(X, F.out + (size_t)r * DM, F.lane);
            if (l + 1 < DEPTH) { const float rx = row_rstd(X);
                st_modnorm2_l(X, rx, Lf + 2048, md + 2048, md + 4096, WSP(bf16_t, WS_HIN) + (size_t)r * DM, WSP(unsigned char, WS_H8) + (size_t)r * DM, F.lane); } }
    }
}
__device__ __forceinline__ void ld8bf(float (&o)[8], const GAS bf16_t* p) { const u32x4 w = *(const GAS u32x4*)p; o[0] = bflo(w.x); o[1] = bfhi(w.x); o[2] = bflo(w.y); o[3] = bfhi(w.y); o[4] = bflo(w.z); o[5] = bfhi(w.z); o[6] = bflo(w.w); o[7] = bfhi(w.w); }
__device__ __forceinline__ void st8bf(GAS bf16_t* p, const float (&v)[8]) { u32x4 w; w.x = cvt_pk_bf16(v[0], v[1]); w.y = cvt_pk_bf16(v[2], v[3]); w.z = cvt_pk_bf16(v[4], v[5]); w.w = cvt_pk_bf16(v[6], v[7]); *(GAS u32x4*)p = w; }
__device__ __forceinline__ void st8fp8(GAS unsigned char* p, const float (&v)[8]) {
    float c[8];
#pragma unroll
    for (int j = 0; j < 8; ++j) c[j] = __builtin_amdgcn_fmed3f(v[j], -448.f, 448.f);
    u32x2 o; unsigned w = 0; w = __builtin_amdgcn_cvt_pk_fp8_f32(c[0], c[1], w, false); w = __builtin_amdgcn_cvt_pk_fp8_f32(c[2], c[3], w, true); o.x = w;
    w = 0; w = __builtin_amdgcn_cvt_pk_fp8_f32(c[4], c[5], w, false); w = __builtin_amdgcn_cvt_pk_fp8_f32(c[6], c[7], w, true); o.y = w; *(GAS u32x2*)p = o;
}
__device__ __forceinline__ void unpk8(float (&o)[8], u32x4 w) { o[0] = bflo(w.x); o[1] = bfhi(w.x); o[2] = bflo(w.y); o[3] = bfhi(w.y); o[4] = bflo(w.z); o[5] = bfhi(w.z); o[6] = bflo(w.w); o[7] = bfhi(w.w); }
__device__ __forceinline__ void phase_finish(Frame& F, int l, int mrows) {
    const int gw = F.vcu * 8 + F.wave, NGW = F.G * 8, c8 = F.lane * 8;
    const GAS bf16_t* Y = WSP(bf16_t, WS_YFB); const GAS bf16_t* U = WSP(bf16_t, WS_RA); GAS unsigned char* BR = WSP(unsigned char, WS_BR); const GAS float* dskip = INP(I_SSDD) + l * 8;
    const float dsk = dskip[F.lane >> 3];
    struct FinRow { u32x4 v[10]; };
#define FIN_LOAD(R_, r_) do { const size_t r__ = (size_t)(r_); \
        R_.v[0] = *(const GAS u32x4*)(Y + ((size_t)0 * MT + r__) * 512 + c8); R_.v[1] = *(const GAS u32x4*)(Y + ((size_t)1 * MT + r__) * 512 + c8); R_.v[2] = *(const GAS u32x4*)(U + r__ * NU + U_MLO + c8); \
        R_.v[3] = *(const GAS u32x4*)(Y + ((size_t)2 * MT + r__) * 512 + c8); R_.v[4] = *(const GAS u32x4*)(Y + ((size_t)3 * MT + r__) * 512 + c8); R_.v[5] = *(const GAS u32x4*)(U + r__ * NU + U_HGG + c8); \
        R_.v[6] = *(const GAS u32x4*)(Y + ((size_t)4 * MT + r__) * 512 + c8); R_.v[7] = *(const GAS u32x4*)(Y + ((size_t)5 * MT + r__) * 512 + c8); R_.v[8] = *(const GAS u32x4*)(U + r__ * NU + U_Z + c8); \
        R_.v[9] = *(const GAS u32x4*)(WSP(bf16_t, WS_XBC) + r__ * 1024 + c8); } while (0)
    for (int r0 = gw; r0 < mrows; r0 += 2 * NGW) {
        const int r1 = r0 + NGW; const bool two = r1 < mrows;
        FinRow Ra, Rb; FIN_LOAD(Ra, r0); if (two) FIN_LOAD(Rb, r1);
#pragma unroll
        for (int q = 0; q < 2; ++q) { if (q == 1 && !two) break; const int r = q ? r1 : r0; const FinRow& R = q ? Rb : Ra;
            float a[8], b[8], g[8], o[8];
            unpk8(a, R.v[0]); unpk8(b, R.v[1]); unpk8(g, R.v[2]);
#pragma unroll
            for (int j = 0; j < 8; ++j) o[j] = (a[j] + b[j]) * sigmoidf_(g[j]);
            st8fp8(BR + (size_t)r * DM + c8, o);
            unpk8(a, R.v[3]); unpk8(b, R.v[4]); unpk8(g, R.v[5]);
            float ss = 0.f;
#pragma unroll
            for (int j = 0; j < 8; ++j) { a[j] += b[j]; ss += a[j] * a[j]; }
            ss += __shfl_xor(ss, 1); ss += __shfl_xor(ss, 2); ss += __shfl_xor(ss, 4); ss += __shfl_xor(ss, 8);
            const float rh = rsqrtf(ss * (1.f / 128.f) + EPS);
#pragma unroll
            for (int j = 0; j < 8; ++j) o[j] = a[j] * rh * sigmoidf_(g[j]);
            st8fp8(BR + (size_t)r * DM + 512 + c8, o);
            unpk8(a, R.v[6]); unpk8(b, R.v[7]); unpk8(g, R.v[8]);
            float s2 = 0.f, xh[8]; unpk8(xh, R.v[9]);
#pragma unroll
            for (int j = 0; j < 8; ++j) { o[j] = (a[j] + b[j] + dsk * xh[j]) * siluf_(g[j]); s2 += o[j] * o[j]; }
            s2 = wave_sum(s2);
            if (F.lane == 0) WSP(float, WS_RSSD)[r] = rsqrtf(s2 * (1.f / 512.f) + EPS);
            st8fp8(BR + (size_t)r * DM + 1536 + c8, o);
        }
    }
#undef FIN_LOAD
}

__device__ __forceinline__ void phase_ssdconv(Frame& F, int l) {
    const int gw = F.vcu * 8 + F.wave, NGW = F.G * 8, c16 = F.lane * 16;
    const GAS bf16_t* U = WSP(bf16_t, WS_RA); GAS bf16_t* X2 = WSP(bf16_t, WS_XBC);
    float w0[16], w1[16], w2[16], cb[16];
    { const GAS float* cw = INP(I_CONVW) + (size_t)l * 3 * 1024 + c16; const GAS float* bb = INP(I_CONVB) + l * 1024 + c16;
#pragma unroll
      for (int j = 0; j < 16; ++j) { w0[j] = cw[j]; w1[j] = cw[1024 + j]; w2[j] = cw[2048 + j]; cb[j] = bb[j]; } }
    for (int r = gw; r < MT; r += NGW) {
        const int t = r < ML ? (r & (SEQ - 1)) : ((r - ML) & (CTXL - 1)), tn = r < ML ? SEQ : CTXL;
        const GAS bf16_t* up = U + (size_t)r * NU + U_XBC + c16;
        float a[16], p_[16], n_[16];
        { const bool hp = t > 0, hn = t + 1 < tn; const GAS bf16_t* pp = hp ? up - NU : up; const GAS bf16_t* np = hn ? up + NU : up; const float pf = hp ? 1.f : 0.f, nf = hn ? 1.f : 0.f;
          const u32x4 ra0 = *(const GAS u32x4*)up, ra1 = *(const GAS u32x4*)(up + 8), rp0 = *(const GAS u32x4*)pp, rp1 = *(const GAS u32x4*)(pp + 8), rn0 = *(const GAS u32x4*)np, rn1 = *(const GAS u32x4*)(np + 8);
          float t8[8];
          unpk8(t8, ra0);
#pragma unroll
          for (int j = 0; j < 8; ++j) a[j] = t8[j]; unpk8(t8, ra1);
#pragma unroll
          for (int j = 0; j < 8; ++j) a[8 + j] = t8[j]; unpk8(t8, rp0);
#pragma unroll
          for (int j = 0; j < 8; ++j) p_[j] = t8[j] * pf; unpk8(t8, rp1);
#pragma unroll
          for (int j = 0; j < 8; ++j) p_[8 + j] = t8[j] * pf; unpk8(t8, rn0);
#pragma unroll
          for (int j = 0; j < 8; ++j) n_[j] = t8[j] * nf; unpk8(t8, rn1);
#pragma unroll
          for (int j = 0; j < 8; ++j) n_[8 + j] = t8[j] * nf; }
        float o[8];
#pragma unroll
        for (int j = 0; j < 8; ++j) o[j] = siluf_(w0[j] * p_[j] + w1[j] * a[j] + w2[j] * n_[j] + cb[j]);
        st8bf(X2 + (size_t)r * 1024 + c16, o);
#pragma unroll
        for (int j = 0; j < 8; ++j) o[j] = siluf_(w0[8 + j] * p_[8 + j] + w1[8 + j] * a[8 + j] + w2[8 + j] * n_[8 + j] + cb[8 + j]);
        st8bf(X2 + (size_t)r * 1024 + c16 + 8, o);
    }
}

__device__ __forceinline__ void phase_scanprep(Frame& F, int l) {
    const int gw = F.vcu * 8 + F.wave, NGW = F.G * 8, lane = F.lane, r32 = lane & 31, hi = lane >> 5;
    const GAS bf16_t* U = WSP(bf16_t, WS_RA);
    constexpr int N_ML = 64 * 72, N_SSD = 64 * 72, N_HG = 64 * 72 * 2, N_MLC = 0;
    for (int it = gw; it < N_ML + N_SSD + N_HG + N_MLC; it += NGW) {
        if (it >= N_ML + N_SSD + N_HG) {
            const int q = it - (N_ML + N_SSD + N_HG), cg = q % 72, bh = q / 72, b = bh >> 2, h = bh & 3;
            GAS bf16_t* dst = WSP(bf16_t, WS_MLC) + ((size_t)bh * 2304 + 32 * cg) * 384;
#pragma unroll 1
            for (int ib = 0; ib < 3; ++ib) { u32x4 v[8];
#pragma unroll
                for (int i = 0; i < 8; ++i) { const int piece = (ib * 8 + i) * 64 + lane, rr = piece / 48, pc = piece % 48, ci = 32 * cg + rr;
                    const int trow = ci < CTXL ? ML + b * CTXL + ci : b * SEQ + (ci - CTXL);
                    v[i] = *(const GAS u32x4*)(U + (size_t)trow * NU + (pc >> 4) * 512 + h * 128 + (pc & 15) * 8); }
#pragma unroll
                for (int i = 0; i < 8; ++i) { const int piece = (ib * 8 + i) * 64 + lane; *(GAS u32x4*)(dst + (size_t)piece * 8) = v[i]; } }
            continue;
        }
        if (it < N_ML) {
            const int c = it % 72, task = it / 72, b = task >> 3, h = (task >> 1) & 3, dir = task & 1, cg = U_MLG + dir * 8 + h;
            const float fbias = INP(I_MLFB)[l * 8 + dir * 4 + h];
            const GAS bf16_t* gp = U + (size_t)prow(b, dir, 32 * c + r32) * NU + cg; const float gi = bf2f(gp[0]), gf = bf2f(gp[4]);
            const float x_ = gf + fbias, flog = fminf(x_, 0.f) - log1pf(__expf(-fabsf(x_)));
            const float Fl = scn::scan_add32(flog, r32), bl = gi - Fl, Ml = scn::scan_max32(bl, r32);
            if (hi == 0) *(GAS f32x4*)(WSP(float, WS_MLS) + ((size_t)task * 2304 + 32 * c + r32) * 8) = (f32x4){Fl, bl, Ml, 0.f};
        } else if (it < N_ML + N_SSD) {
            const int q = it - N_ML, c = q % 72, t3 = q / 72, b = t3 >> 3, hp = (t3 >> 1) & 3, dir = t3 & 1, hd = 2 * hp + hi;
            const float dtb = INP(I_DTB)[l * 16 + dir * 8 + hd], aneg = -__expf(INP(I_ALOG)[l * 16 + dir * 8 + hd]);
            const float xr_ = bf2f(U[(size_t)prow(b, dir, 32 * c + r32) * NU + U_DT + dir * 8 + hd]) + dtb;
            const float dt_ = fmaxf(xr_, 0.f) + log1pf(__expf(-fabsf(xr_))), at = scn::scan_add32(dt_ * aneg, r32), ae = __shfl(at, 31, 32);
            GAS float* rp = WSP(float, WS_SSDS) + ((size_t)((b * 2 + dir) * 8 + hd) * 2304 + 32 * c + r32) * 8;
            *(GAS f32x4*)rp = (f32x4){dt_, at, __expf(at), __expf(ae - at)}; *(GAS f32x4*)(rp + 4) = (f32x4){__expf(ae), 0.f, 0.f, 0.f};
        } else {
            const int q = it - N_ML - N_SSD, half = q & 1, c = (q >> 1) % 72, task = (q >> 1) / 72, b = task >> 3, h = (task >> 1) & 3, dir = task & 1, r16 = lane >> 2, ch0 = half * 64 + 16 * (lane & 3);
            GAS unsigned char* item = F.ws + WS_HGP + (size_t)(task * 72 + c) * HGP_ITEM;
            const GAS float* lbp = WSP(float, WS_TAB) + 2048 + l * 512 + h * 128 + ch0;
            float lb[16], cc[16], ee[16];
            u32x4 raw[2][4];
#pragma unroll
            for (int rb = 0; rb < 2; ++rb) { const GAS bf16_t* up = U + (size_t)prow(b, dir, 32 * c + rb * 16 + r16) * NU;
                raw[rb][0] = *(const GAS u32x4*)(up + U_HGF + dir * 512 + h * 128 + ch0); raw[rb][1] = *(const GAS u32x4*)(up + U_HGF + dir * 512 + h * 128 + ch0 + 8);
                raw[rb][2] = *(const GAS u32x4*)(up + U_HGQ + h * 128 + ch0); raw[rb][3] = *(const GAS u32x4*)(up + U_HGQ + h * 128 + ch0 + 8); }
#pragma unroll
            for (int j = 0; j < 16; ++j) { lb[j] = lbp[j]; cc[j] = 0.f; ee[j] = 0.f; }
#pragma unroll
            for (int rb = 0; rb < 2; ++rb) {
                const int rloc = rb * 16 + r16;
                float fa[8], fb[8], qa[8], qb[8], q1[16], k1[16];
                unpk8(fa, raw[rb][0]); unpk8(fb, raw[rb][1]); unpk8(qa, raw[rb][2]); unpk8(qb, raw[rb][3]);
#pragma unroll
                for (int j = 0; j < 16; ++j) {
                    const float fr_ = j < 8 ? fa[j & 7] : fb[j & 7], qr_ = j < 8 ? qa[j & 7] : qb[j & 7];
                    const float f_ = lb[j] + (1.f - lb[j]) * __builtin_amdgcn_rcpf(1.f + __expf(-fr_)); float x_ = __logf(f_);
                    { const float o = __shfl_up(x_, 4); if (lane >= 4) x_ += o; } { const float o = __shfl_up(x_, 8); if (lane >= 8) x_ += o; }
                    { const float o = __shfl_up(x_, 16); if (lane >= 16) x_ += o; } { const float o = __shfl_up(x_, 32); if (lane >= 32) x_ += o; }
                    const float tot = __shfl(x_, 60 + (lane & 3));
                    float g_;
                    if (rb == 0) { cc[j] = tot; g_ = x_; } else { g_ = cc[j] + x_; ee[j] = cc[j] + tot; }
                    const float e1 = __expf(g_ - cc[j]);
                    q1[j] = qr_ * __builtin_amdgcn_rcpf(1.f + __expf(-qr_)) * e1; k1[j] = (1.f - f_) * __builtin_amdgcn_rcpf(e1);
                }
                float t8[8];
#pragma unroll
                for (int j = 0; j < 8; ++j) t8[j] = q1[j]; st8bf((GAS bf16_t*)(item + scn::rowl(rloc, ch0 * 2)), t8);
#pragma unroll
                for (int j = 0; j < 8; ++j) t8[j] = q1[8 + j]; st8bf((GAS bf16_t*)(item + scn::rowl(rloc, ch0 * 2 + 16)), t8);
#pragma unroll
                for (int j = 0; j < 8; ++j) t8[j] = k1[j]; st8bf((GAS bf16_t*)(item + 8192 + scn::rowl(rloc, ch0 * 2)), t8);
#pragma unroll
                for (int j = 0; j < 8; ++j) t8[j] = k1[8 + j]; st8bf((GAS bf16_t*)(item + 8192 + scn::rowl(rloc, ch0 * 2 + 16)), t8);
            }
            if (r16 == 0) { GAS float* vv = (GAS float*)(item + 16384) + ch0;
#pragma unroll
                for (int j = 0; j < 16; ++j) { vv[j] = __expf(cc[j]); vv[128 + j] = __expf(ee[j] - cc[j]); } }
        }
    }
}
constexpr size_t CTL_CNTB = 131072;
__device__ __forceinline__ void phase_route(Frame& F, int l, int mrows, const XcdBarrier& bar) {
    unsigned* cnt = F.ctl + CW_CNT + l * 64;
    GAS int* list = WSP(int, WS_LIST); GAS float* wl = WSP(float, WS_WL);
    GAS int* cntb = (GAS int*)(F.ws + WS_CTL + CTL_CNTB) + (size_t)l * 1024 * 32;
    LAS int* ch = (LAS int*)F.lds;
    LAS int* off = ch + 1024;
    LAS int* part = ch + 2048;
    LAS int* base = ch + 2048 + 1024;
    const int t = F.tid, bx = F.vcu, G = F.G;
    const int rpb = (mrows + G - 1) / G, r = bx * rpb + t; const bool act = t < rpb && r < mrows;
    int ea = -1, eb = -1; float wa = 0.f, wb = 0.f;
    if (act) {
        const GAS float* lg0 = WSP(float, WS_LOG) + (size_t)r * 64;
        f32x4 lgv[9];
#pragma unroll
        for (int q = 0; q < 9; ++q) { lgv[q] = *(const GAS f32x4*)(lg0 + 4 * q);
#pragma unroll
            for (int ks = 1; ks < 4; ++ks) lgv[q] += *(const GAS f32x4*)(lg0 + (size_t)ks * MT * 64 + 4 * q); }
        const f32x4 g = lgv[0]; int gi = 0; float gm = g[0];
#pragma unroll
        for (int i = 1; i < 4; ++i) if (g[i] > gm) { gm = g[i]; gi = i; }
        float gs = 0.f;
#pragma unroll
        for (int i = 0; i < 4; ++i) gs += __expf(g[i] - gm);
        const float gp = 1.f / gs;
        f32x4 e0 = lgv[1], e1 = lgv[2];
        if (gi == 1) { e0 = lgv[3]; e1 = lgv[4]; } else if (gi == 2) { e0 = lgv[5]; e1 = lgv[6]; } else if (gi == 3) { e0 = lgv[7]; e1 = lgv[8]; }
        float ev[8] = {e0[0], e0[1], e0[2], e0[3], e1[0], e1[1], e1[2], e1[3]};
        int i1 = 0; float v1 = ev[0];
#pragma unroll
        for (int i = 1; i < 8; ++i) if (ev[i] > v1) { v1 = ev[i]; i1 = i; }
        int i2 = -1; float v2 = -3.4e38f;
#pragma unroll
        for (int i = 0; i < 8; ++i) if (i != i1 && ev[i] > v2) { v2 = ev[i]; i2 = i; }
        const float w1 = 1.f / (1.f + __expf(v2 - v1)), w2 = 1.f - w1;
        ea = gi * 8 + i1; eb = gi * 8 + i2; wa = w1 * gp; wb = w2 * gp;
    }
    ch[2 * t] = ea; ch[2 * t + 1] = eb;
    __syncthreads();
    if (t < 32) {
        int c = 0; const int n2 = 2 * (rpb < 512 ? rpb : 512);
#pragma unroll 8
        for (int i = 0; i < n2; ++i) { if (ch[i] == t) { off[i] = c; ++c; } }
        cntb[bx * 32 + t] = c;
    }
    xcd_barrier(bar);
    { const int e = t & 31, p = t >> 5; int sp = 0, sa = 0;
      for (int b2 = p; b2 < G; b2 += 16) { const int c = cntb[b2 * 32 + e]; sa += c; sp += b2 < bx ? c : 0; }
      part[p * 32 + e] = sp; part[512 + p * 32 + e] = sa; }
    __syncthreads();
    if (t < 32) { int sp = 0, sa = 0;
#pragma unroll
        for (int p = 0; p < 16; ++p) { sp += part[p * 32 + t]; sa += part[512 + p * 32 + t]; }
        base[t] = sp; if (bx == 0) cnt[t] = (unsigned)sa; }
    __syncthreads();
    if (act) { const int pa = base[ea] + off[2 * t], pb = base[eb] + off[2 * t + 1];
        list[(size_t)ea * MT + pa] = r * 2; wl[(size_t)ea * MT + pa] = wa;
        list[(size_t)eb * MT + pb] = r * 2 + 1; wl[(size_t)eb * MT + pb] = wb; }
    __syncthreads();
}
__device__ __forceinline__ void moe_tables(Frame& F, int l) {
    __syncthreads();
    if (F.tid < 32) {
        const int e = F.tid; const int c = (int)__hip_atomic_load(F.ctl + CW_CNT + l * 64 + e, __ATOMIC_RELAXED, __HIP_MEMORY_SCOPE_AGENT);
        const int t = (c + 255) >> 8; int incl = t;
#pragma unroll
        for (int d = 1; d < 32; d <<= 1) { const int o = __shfl_up(incl, d, 32); if (e >= d) incl += o; }
        F.MISC[64 + e] = (unsigned)c; F.MISC[16 + e] = (unsigned)(incl - t); if (e == 31) F.MISC[48] = (unsigned)incl;
    }
    __syncthreads();
}

constexpr int NSTEP = CTXL + SEQ;
namespace scn {
enum { K_ML = 0, K_HG = 1, K_SSD = 2 };
constexpr int GRP_BYTES = 65536, O_QT = 0, O_KT = 8192, O_QH = 16384, O_KH = 24576, O_VT = 34816, O_VH = 45056, O_SC = 55296, O_N = 59392, O_TOT = 60416;
constexpr int NCH = (CTXL + SEQ) / 32;
__device__ __forceinline__ int crow(int r, int hi) { return (r & 3) + 8 * (r >> 2) + 4 * hi; }
template <int OFF> __device__ __forceinline__ s16x4 trr(int base) { s16x4 r; asm volatile("ds_read_b64_tr_b16 %0, %1 offset:%2" : "=&v"(r) : "v"(base), "i"(OFF) : "memory"); return r; }
#define SCN_PK(L, H) (bf16x8){L[0], L[1], L[2], L[3], H[0], H[1], H[2], H[3]}
template <int S1, int CB> __device__ __forceinline__ bf16x8 trfrag(int base) { const s16x4 lo = trr<S1 * 5120 + CB * 2>(base), hi_ = trr<S1 * 5120 + 2560 + CB * 2>(base); return SCN_PK(lo, hi_); }
__device__ __forceinline__ void unpack8(float (&o)[8], u32x4 w) { o[0] = bflo(w.x); o[1] = bfhi(w.x); o[2] = bflo(w.y); o[3] = bfhi(w.y); o[4] = bflo(w.z); o[5] = bfhi(w.z); o[6] = bflo(w.w); o[7] = bfhi(w.w); }
__device__ __forceinline__ u32x4 pack8(const float (&v)[8]) { u32x4 w; w.x = cvt_pk_bf16(v[0], v[1]); w.y = cvt_pk_bf16(v[2], v[3]); w.z = cvt_pk_bf16(v[4], v[5]); w.w = cvt_pk_bf16(v[6], v[7]); return w; }

template <int KIND>
__device__ __forceinline__ void scan_block(Frame& F, int l, int task) {
    const int tid = F.tid, wave = F.wave, lane = tid & 63, grp = wave >> 2, vb = wave & 3, gt = tid & 255, r32 = lane & 31, hi = lane >> 5;
    LAS char* L = (LAS char*)F.lds + grp * GRP_BYTES;
    const int Lb = (int)(uintptr_t)L;
    const int b = task >> 3, hx = (task >> 1) & 3, dir = task & 1;
    const int srow = gt >> 3, sp = gt & 7;
    const GAS bf16_t* U = WSP(bf16_t, WS_RA); const GAS bf16_t* X2 = WSP(bf16_t, WS_XBC);
    GAS bf16_t* YO = WSP(bf16_t, WS_YFB) + (size_t)(KIND * 2 + dir) * MT * 512;
    LAS float* SC = (LAS float*)(L + O_SC);
    int cq = 0, ck = 0, cv = 0;
    const GAS float* recA = nullptr; const GAS float* recB = nullptr; const GAS unsigned char* hgp = nullptr; const GAS bf16_t* mlc = nullptr;
    if constexpr (KIND == K_ML) { cq = U_MLQ + hx * 128 + 16 * sp; ck = U_MLK + hx * 128 + 16 * sp; cv = U_MLV + hx * 128 + 16 * sp;
        recA = WSP(float, WS_MLS) + (size_t)task * 2304 * 8; recB = recA; mlc = WSP(bf16_t, WS_MLC) + (size_t)(b * 4 + hx) * 2304 * 384; }
    if constexpr (KIND == K_HG) { cv = U_HGI + hx * 128 + 16 * sp; hgp = F.ws + WS_HGP + (size_t)task * 72 * HGP_ITEM; }
    if constexpr (KIND == K_SSD) { const int g = hx >> 1; cq = 768 + g * 128 + 16 * sp; ck = 512 + g * 128 + 16 * sp; cv = hx * 128 + 16 * sp;
        recA = WSP(float, WS_SSDS) + (size_t)((b * 2 + dir) * 8 + 2 * hx + (sp >> 2)) * 2304 * 8;
        recB = WSP(float, WS_SSDS) + (size_t)((b * 2 + dir) * 8 + 2 * hx + hi) * 2304 * 8; }
    f32x16 S[4];
#pragma unroll
    for (int k = 0; k < 4; ++k)
#pragma unroll
        for (int r = 0; r < 16; ++r) S[k][r] = 0.f;
    if (KIND == K_ML) { LAS float* nn = (LAS float*)(L + O_N); nn[gt] = 0.f; }
    float Fs = 0.f, Bp = -INFINITY;
    const int i16 = lane & 15, g4 = lane >> 4;
    const int trb = Lb + (4 * hi + (i16 >> 2)) * 320 + (16 * (g4 & 1) + 4 * (i16 & 3)) * 2;
    struct Pre { u32x4 a0, a1, b0, b1, c0, c1; f32x4 sA, sB; float g1; }; Pre P0;
#define SCN_LOAD(P, c_) do { const int c__ = (c_); const int row_ = prow(b, dir, 32 * c__ + srow); \
        if constexpr (KIND == K_SSD) { const GAS bf16_t* xp = X2 + (size_t)row_ * 1024; P.a0 = *(const GAS u32x4*)(xp + cq); P.a1 = *(const GAS u32x4*)(xp + cq + 8); P.b0 = *(const GAS u32x4*)(xp + ck); P.b1 = *(const GAS u32x4*)(xp + ck + 8); P.c0 = *(const GAS u32x4*)(xp + cv); P.c1 = *(const GAS u32x4*)(xp + cv + 8); \
            P.sA = *(const GAS f32x4*)(recA + (size_t)(32 * c__ + srow) * 8); P.sB = *(const GAS f32x4*)(recB + (size_t)(32 * c__ + r32) * 8); P.g1 = recB[(size_t)(32 * c__ + r32) * 8 + 4]; } \
        else if constexpr (KIND == K_ML) { const int p__ = 32 * c__ + srow; const int ci_ = p__ < CTXL ? (dir ? CTXL - 1 - p__ : p__) : CTXL + (dir ? SEQ - 1 - (p__ - CTXL) : p__ - CTXL); \
            const GAS bf16_t* up = mlc + (size_t)ci_ * 384 + 16 * sp; P.a0 = *(const GAS u32x4*)(up); P.a1 = *(const GAS u32x4*)(up + 8); P.b0 = *(const GAS u32x4*)(up + 128); P.b1 = *(const GAS u32x4*)(up + 136); P.c0 = *(const GAS u32x4*)(up + 256); P.c1 = *(const GAS u32x4*)(up + 264); \
            P.sA = *(const GAS f32x4*)(recA + (size_t)(32 * c__ + srow) * 8); P.sB = *(const GAS f32x4*)(recB + (size_t)(32 * c__ + r32) * 8); } \
        else { const GAS unsigned char* it_ = hgp + (size_t)c__ * HGP_ITEM; const int ra_ = rowl(srow, 32 * sp), rb_ = rowl(srow, 32 * sp + 16); \
            P.a0 = *(const GAS u32x4*)(it_ + ra_); P.a1 = *(const GAS u32x4*)(it_ + rb_); P.b0 = *(const GAS u32x4*)(it_ + 8192 + ra_); P.b1 = *(const GAS u32x4*)(it_ + 8192 + rb_); \
            const GAS bf16_t* up = U + (size_t)row_ * NU; P.c0 = *(const GAS u32x4*)(up + cv); P.c1 = *(const GAS u32x4*)(up + cv + 8); \
            if (gt < 64) P.sA = *(const GAS f32x4*)((const GAS float*)(it_ + 16384) + 4 * gt); } } while (0)
#define SCN_STAGE(P, NPAR) do { \
        const int ra = rowl(srow, 32 * sp), rb = rowl(srow, 32 * sp + 16), ta = srow * 320 + 32 * sp; \
        *(LAS u32x4*)(L + O_QT + ra) = P.a0; *(LAS u32x4*)(L + O_QT + rb) = P.a1; *(LAS u32x4*)(L + O_KT + ra) = P.b0; *(LAS u32x4*)(L + O_KT + rb) = P.b1; \
        if constexpr (KIND == K_ML) { \
            const float Fle = __shfl(P.sB[0], 31, 32), Mle = __shfl(P.sB[2], 31, 32);         \
            const float bt = P.sB[1] - Fs, Bt = fmaxf(Bp, P.sB[2] - Fs), Be = fmaxf(Bp, Mle - Fs); \
            if (vb == 0 && hi == 0) { SC[r32] = bt; SC[32 + r32] = Bt; SC[64 + r32] = __expf(Bp - Bt); SC[96 + r32] = __expf(-(Fs + P.sB[0] + Bt)); if (r32 == 0) SC[128] = __expf(Bp - Be); } \
            const float win = __expf(P.sA[1] - Fs - Be); Fs += Fle; Bp = Be; \
            { LAS const float* nq = (LAS const float*)(L + O_N) + (NPAR) * 128 + 16 * sp;        \
              const f32x4 n0 = *(const LAS f32x4*)(nq), n1 = *(const LAS f32x4*)(nq + 4), n2 = *(const LAS f32x4*)(nq + 8), n3 = *(const LAS f32x4*)(nq + 12); \
              float qa[8], qb[8]; unpack8(qa, P.a0); unpack8(qb, P.a1); \
              float d = ((qa[0] * n0[0] + qa[1] * n0[1]) + (qa[2] * n0[2] + qa[3] * n0[3])) + ((qa[4] * n1[0] + qa[5] * n1[1]) + (qa[6] * n1[2] + qa[7] * n1[3])) \
                      + ((qb[0] * n2[0] + qb[1] * n2[1]) + (qb[2] * n2[2] + qb[3] * n2[3])) + ((qb[4] * n3[0] + qb[5] * n3[1]) + (qb[6] * n3[2] + qb[7] * n3[3])); \
              d += __shfl_xor(d, 1); d += __shfl_xor(d, 2); d += __shfl_xor(d, 4); \
              if (sp == 0) SC[160 + srow] = d; } \
            float ka[8], kb_[8]; unpack8(ka, P.b0); unpack8(kb_, P.b1); \
            _Pragma("unroll") for (int j = 0; j < 8; ++j) { ka[j] *= win; kb_[j] *= win; } \
            *(LAS u32x4*)(L + O_KH + ta) = pack8(ka); *(LAS u32x4*)(L + O_KH + ta + 16) = pack8(kb_); *(LAS u32x4*)(L + O_VT + ta) = P.c0; *(LAS u32x4*)(L + O_VT + ta + 16) = P.c1; \
        } else if constexpr (KIND == K_SSD) { \
            if (vb == 0) { SC[hi * 32 + r32] = P.sB[1]; SC[64 + hi * 32 + r32] = P.sB[2]; if (r32 == 0) SC[128 + hi] = P.g1; } \
            const float dts = P.sA[0], vsc = P.sA[3]; float va[8], vb_[8]; unpack8(va, P.c0); unpack8(vb_, P.c1); \
            *(LAS u32x4*)(L + O_KH + ta) = P.b0; *(LAS u32x4*)(L + O_KH + ta + 16) = P.b1; \
            _Pragma("unroll") for (int j = 0; j < 8; ++j) { va[j] *= dts; vb_[j] *= dts; } \
            *(LAS u32x4*)(L + O_VT + ta) = pack8(va); *(LAS u32x4*)(L + O_VT + ta + 16) = pack8(vb_); \
            _Pragma("unroll") for (int j = 0; j < 8; ++j) { va[j] *= vsc; vb_[j] *= vsc; } \
            *(LAS u32x4*)(L + O_VH + ta) = pack8(va); *(LAS u32x4*)(L + O_VH + ta + 16) = pack8(vb_); \
        } else { \
            *(LAS u32x4*)(L + O_KH + ta) = P.b0; *(LAS u32x4*)(L + O_KH + ta + 16) = P.b1; *(LAS u32x4*)(L + O_VT + ta) = P.c0; *(LAS u32x4*)(L + O_VT + ta + 16) = P.c1; \
            if (gt < 64) *(LAS f32x4*)(SC + 4 * gt) = P.sA; \
        } } while (0)
    constexpr int OQH = O_QT, OVH = (KIND == K_SSD) ? O_VH : O_VT;
    auto compute = [&](const int c) __attribute__((always_inline)) {
        const int hh = vb >> 1;
        if constexpr (KIND == K_HG) {
#pragma unroll
            for (int kb = 0; kb < 4; ++kb)
#pragma unroll
                for (int r = 0; r < 16; ++r) S[kb][r] *= SC[32 * kb + crow(r, hi)];
        }
        f32x16 acc;
#pragma unroll
        for (int r = 0; r < 16; ++r) acc[r] = 0.f;
        if (c > 0) {
#pragma unroll
            for (int kb = 0; kb < 4; ++kb)
#pragma unroll
                for (int s1 = 0; s1 < 2; ++s1) {
                    u32x4 aw; aw.x = cvt_pk_bf16(S[kb][8 * s1 + 0], S[kb][8 * s1 + 1]); aw.y = cvt_pk_bf16(S[kb][8 * s1 + 2], S[kb][8 * s1 + 3]); aw.z = cvt_pk_bf16(S[kb][8 * s1 + 4], S[kb][8 * s1 + 5]); aw.w = cvt_pk_bf16(S[kb][8 * s1 + 6], S[kb][8 * s1 + 7]);
                    const int cb0 = (32 * kb + 16 * s1 + 4 * hi) * 2;
                    const u32x2 lo = *(const LAS u32x2*)(L + OQH + rowl(r32, cb0)), hi2 = *(const LAS u32x2*)(L + OQH + rowl(r32, cb0 + 16));
                    const u32x4 bw = {lo.x, lo.y, hi2.x, hi2.y};
                    acc = __builtin_amdgcn_mfma_f32_32x32x16_bf16(__builtin_bit_cast(bf16x8, aw), __builtin_bit_cast(bf16x8, bw), acc, 0, 0, 0);
                }
            if constexpr (KIND == K_ML) { const float w = SC[64 + r32];
#pragma unroll
                for (int r = 0; r < 16; ++r) acc[r] *= w; }
            if constexpr (KIND == K_SSD) { const float w = SC[64 + hh * 32 + r32];
#pragma unroll
                for (int r = 0; r < 16; ++r) acc[r] *= w; }
        }
        f32x16 p;
#pragma unroll
        for (int r = 0; r < 16; ++r) p[r] = 0.f;
#pragma unroll
        for (int kk = 0; kk < 8; ++kk) { const int cb0 = (16 * kk + 8 * hi) * 2;
            const bf16x8 a = *(const LAS bf16x8*)(L + O_KT + rowl(r32, cb0)), bq = *(const LAS bf16x8*)(L + O_QT + rowl(r32, cb0));
            p = __builtin_amdgcn_mfma_f32_32x32x16_bf16(a, bq, p, 0, 0, 0); }
        float den = 0.f;
        if constexpr (KIND == K_ML) { const float Bt = SC[32 + r32];
            f32x4 bs4[4];
#pragma unroll
            for (int q = 0; q < 4; ++q) bs4[q] = *(const LAS f32x4*)(SC + 8 * q + 4 * hi);
#pragma unroll
            for (int r = 0; r < 16; ++r) { const int s_ = crow(r, hi); float w = __expf(fminf(bs4[r >> 2][r & 3] - Bt, 0.f)); w = s_ <= r32 ? w : 0.f; p[r] *= w; den += p[r]; }
            { auto rr = __builtin_amdgcn_permlane32_swap(__float_as_uint(den), __float_as_uint(den), false, false); den = __uint_as_float(rr[0]) + __uint_as_float(rr[1]); }
        } else if constexpr (KIND == K_SSD) { const float at = SC[hh * 32 + r32];
            f32x4 as_[4];
#pragma unroll
            for (int q = 0; q < 4; ++q) as_[q] = *(const LAS f32x4*)(SC + hh * 32 + 8 * q + 4 * hi);
#pragma unroll
            for (int r = 0; r < 16; ++r) { const int s_ = crow(r, hi); float w = __expf(fminf(at - as_[r >> 2][r & 3], 0.f)); p[r] *= s_ <= r32 ? w : 0.f; }
        } else {
#pragma unroll
            for (int r = 0; r < 16; ++r) { if (crow(r, hi) > r32) p[r] = 0.f; }
        }
        {
            u32x4 w0, w1; w0.x = cvt_pk_bf16(p[0], p[1]); w0.y = cvt_pk_bf16(p[2], p[3]); w0.z = cvt_pk_bf16(p[4], p[5]); w0.w = cvt_pk_bf16(p[6], p[7]);
            w1.x = cvt_pk_bf16(p[8], p[9]); w1.y = cvt_pk_bf16(p[10], p[11]); w1.z = cvt_pk_bf16(p[12], p[13]); w1.w = cvt_pk_bf16(p[14], p[15]);
            const int vbase = trb + O_VT + vb * 64;
            const bf16x8 v0 = trfrag<0, 0>(vbase), v1 = trfrag<1, 0>(vbase);
            asm volatile("s_waitcnt lgkmcnt(0)" ::: "memory"); __builtin_amdgcn_sched_barrier(0);
            acc = __builtin_amdgcn_mfma_f32_32x32x16_bf16(v0, __builtin_bit_cast(bf16x8, w0), acc, 0, 0, 0);
            acc = __builtin_amdgcn_mfma_f32_32x32x16_bf16(v1, __builtin_bit_cast(bf16x8, w1), acc, 0, 0, 0);
        }
        float oscale = 1.f;
        if constexpr (KIND == K_ML) {
            LAS const float* nn = (LAS const float*)(L + O_N) + (c & 1) * 128;
            const float ds = SC[160 + r32] * SC[64 + r32];
            oscale = __builtin_amdgcn_rcpf(fmaxf(fabsf(den + ds), SC[96 + r32]));
            { const int k = 32 * vb + r32; float sm = 0.f;
#pragma unroll
              for (int s_ = 0; s_ < 16; ++s_) sm += bf2f(*(const LAS bf16_t*)(L + O_KH + (16 * hi + s_) * 320 + k * 2));
              { auto rr = __builtin_amdgcn_permlane32_swap(__float_as_uint(sm), __float_as_uint(sm), false, false); sm = __uint_as_float(rr[0]) + __uint_as_float(rr[1]); }
              LAS float* n2 = (LAS float*)(L + O_N) + ((c + 1) & 1) * 128;
              if (hi == 0) n2[k] = SC[128] * nn[k] + sm; }
        }
        { const int orow = prow(b, dir, 32 * c + r32); GAS bf16_t* yp = YO + (size_t)orow * 512 + hx * 128 + 32 * vb + 4 * hi;
#pragma unroll
          for (int q = 0; q < 4; ++q) { u32x2 w; w.x = cvt_pk_bf16(acc[4 * q] * oscale, acc[4 * q + 1] * oscale); w.y = cvt_pk_bf16(acc[4 * q + 2] * oscale, acc[4 * q + 3] * oscale); *(GAS u32x2*)(yp + 8 * q) = w; } }
        {
            const int kbase = trb + O_KH, vbase = trb + OVH + vb * 64;
            const bf16x8 vh0 = trfrag<0, 0>(vbase), vh1 = trfrag<1, 0>(vbase);
            const bf16x8 k00 = trfrag<0, 0>(kbase), k01 = trfrag<1, 0>(kbase), k10 = trfrag<0, 32>(kbase), k11 = trfrag<1, 32>(kbase);
            const bf16x8 k20 = trfrag<0, 64>(kbase), k21 = trfrag<1, 64>(kbase), k30 = trfrag<0, 96>(kbase), k31 = trfrag<1, 96>(kbase);
            if constexpr (KIND != K_HG) { const float rd = KIND == K_ML ? SC[128] : SC[128 + hh];
#pragma unroll
                for (int kb = 0; kb < 4; ++kb)
#pragma unroll
                    for (int r = 0; r < 16; ++r) S[kb][r] *= rd; }
            asm volatile("s_waitcnt lgkmcnt(0)" ::: "memory"); __builtin_amdgcn_sched_barrier(0);
            S[0] = __builtin_amdgcn_mfma_f32_32x32x16_bf16(k00, vh0, S[0], 0, 0, 0); S[0] = __builtin_amdgcn_mfma_f32_32x32x16_bf16(k01, vh1, S[0], 0, 0, 0);
            S[1] = __builtin_amdgcn_mfma_f32_32x32x16_bf16(k10, vh0, S[1], 0, 0, 0); S[1] = __builtin_amdgcn_mfma_f32_32x32x16_bf16(k11, vh1, S[1], 0, 0, 0);
            S[2] = __builtin_amdgcn_mfma_f32_32x32x16_bf16(k20, vh0, S[2], 0, 0, 0); S[2] = __builtin_amdgcn_mfma_f32_32x32x16_bf16(k21, vh1, S[2], 0, 0, 0);
            S[3] = __builtin_amdgcn_mfma_f32_32x32x16_bf16(k30, vh0, S[3], 0, 0, 0); S[3] = __builtin_amdgcn_mfma_f32_32x32x16_bf16(k31, vh1, S[3], 0, 0, 0);
            if constexpr (KIND == K_HG) {
#pragma unroll
                for (int kb = 0; kb < 4; ++kb)
#pragma unroll
                    for (int r = 0; r < 16; ++r) S[kb][r] *= SC[128 + 32 * kb + crow(r, hi)];
            }
        }
    };
    {
        SCN_LOAD(P0, 0);
        __syncthreads();
        SCN_STAGE(P0, 0);
        __syncthreads();
        for (int c = 0; c < NCH; ++c) {
            if (c + 1 < NCH) SCN_LOAD(P0, c + 1);
            compute(c);
            __syncthreads();
            if (c + 1 < NCH) { SCN_STAGE(P0, (c + 1) & 1); }
            __syncthreads();
        }
    }
#undef SCN_LOAD
#undef SCN_STAGE
}
}

namespace att {
constexpr int KVBLK = 64, SHM_V = 64 * 128 * 2, SHM_K = 64 * 192 * 2;
constexpr float THRL = 11.5f;
#define AKSWZ(row, colB) ((row) * 384 + ((colB) ^ (((row) & 7) << 4)))
#define ASBAR() __builtin_amdgcn_sched_barrier(0)
__device__ __forceinline__ int crow(int r, int hi) { return (r & 3) + 8 * (r >> 2) + 4 * hi; }
__device__ __forceinline__ void partialSM(f32x16& p0, f32x16& p1, float& m_reg, float& mn, float& alpha) {
    float pmax = p0[0];
#pragma unroll
    for (int r = 1; r < 16; ++r) pmax = fmaxf(pmax, p0[r]);
#pragma unroll
    for (int r = 0; r < 16; ++r) pmax = fmaxf(pmax, p1[r]);
    { auto rr = __builtin_amdgcn_permlane32_swap(__float_as_uint(pmax), __float_as_uint(pmax), false, false); pmax = fmaxf(__uint_as_float(rr[0]), __uint_as_float(rr[1])); }
    if (__builtin_expect(__all(pmax - m_reg <= THRL), 1)) { mn = m_reg; alpha = 1.f; }
    else { mn = fmaxf(m_reg, pmax); alpha = __builtin_amdgcn_exp2f(m_reg - mn); m_reg = mn; }
#pragma unroll
    for (int r = 0; r < 16; ++r) p0[r] = __builtin_amdgcn_exp2f(p0[r] - mn);
#pragma unroll
    for (int r = 0; r < 16; ++r) p1[r] = p1[r] - mn;
}
__device__ __forceinline__ void finishSM(f32x16& p0, f32x16& p1, float alpha, float& l_reg, bf16x8& pa0, bf16x8& pa1, bf16x8& pa2, bf16x8& pa3) {
#pragma unroll
    for (int r = 0; r < 16; ++r) p1[r] = __builtin_amdgcn_exp2f(p1[r]);
    float ps = 0;
#pragma unroll
    for (int r = 0; r < 16; ++r) ps += p0[r];
#pragma unroll
    for (int r = 0; r < 16; ++r) ps += p1[r];
    { auto rr = __builtin_amdgcn_permlane32_swap(__float_as_uint(ps), __float_as_uint(ps), false, false); ps = __uint_as_float(rr[0]) + __uint_as_float(rr[1]); }
    l_reg = l_reg * alpha + ps;
#define APK4(P, BASE, OUT) do { unsigned a0 = cvt_pk_bf16(P[BASE + 0], P[BASE + 1]), a1 = cvt_pk_bf16(P[BASE + 2], P[BASE + 3]);   \
    unsigned b0 = cvt_pk_bf16(P[BASE + 4], P[BASE + 5]), b1 = cvt_pk_bf16(P[BASE + 6], P[BASE + 7]);                              \
    auto r0 = __builtin_amdgcn_permlane32_swap(a0, b0, false, false); auto r1 = __builtin_amdgcn_permlane32_swap(a1, b1, false, false); \
    u32x4 w = {r0[0], r1[0], r0[1], r1[1]}; OUT = __builtin_bit_cast(bf16x8, w); } while (0)
    APK4(p0, 0, pa0); APK4(p0, 8, pa1); APK4(p1, 0, pa2); APK4(p1, 8, pa3);
#undef APK4
}
__device__ __forceinline__ void qkt(f32x16& p0, f32x16& p1, const LAS char* Ks, const bf16x8* qr, int r32, int hi) {
    p0 = f32x16{}; p1 = f32x16{};
#pragma unroll
    for (int d0 = 0; d0 < 12; ++d0) { const int cb = (d0 * 16 + hi * 8) * 2;
        const bf16x8 b0 = *(const LAS bf16x8*)(Ks + AKSWZ(r32, cb));
        const bf16x8 b1 = *(const LAS bf16x8*)(Ks + AKSWZ(32 + r32, cb));
        p0 = __builtin_amdgcn_mfma_f32_32x32x16_bf16(b0, qr[d0], p0, 0, 0, 0);
        p1 = __builtin_amdgcn_mfma_f32_32x32x16_bf16(b1, qr[d0], p1, 0, 0, 0); }
}
__device__ __forceinline__ int v_st(int k, int c) { const int kk = (k & ~0xC) | ((k & 4) << 1) | ((k & 8) >> 1); return ((kk >> 3) * 4 + (c >> 5)) * 512 + ((kk & 7) * 32 + (c & 31)) * 2; }
__device__ __forceinline__ int v_rd_base(int lane) { return ((lane & 3) << 3) | (((lane >> 2) & 3) << 6) | (((lane >> 4) & 1) << 5) | (((lane >> 5) & 1) << 8); }
constexpr int v_rd_off(int d0, int ks, int half) { return d0 * 512 + ks * 4096 + half * 2048; }
template <int OFF> __device__ __forceinline__ s16x4 tr_read(int vb) { s16x4 r; asm volatile("ds_read_b64_tr_b16 %0, %1 offset:%2" : "=&v"(r) : "v"(vb), "i"(OFF) : "memory"); return r; }
template <int D0> __device__ __forceinline__ void pv_one(f32x16& od, int vb, bf16x8 pa0, bf16x8 pa1, bf16x8 pa2, bf16x8 pa3) {
    const s16x4 l0 = tr_read<v_rd_off(D0, 0, 0)>(vb), h0 = tr_read<v_rd_off(D0, 0, 1)>(vb), l1 = tr_read<v_rd_off(D0, 1, 0)>(vb), h1 = tr_read<v_rd_off(D0, 1, 1)>(vb);
    const s16x4 l2 = tr_read<v_rd_off(D0, 2, 0)>(vb), h2 = tr_read<v_rd_off(D0, 2, 1)>(vb), l3 = tr_read<v_rd_off(D0, 3, 0)>(vb), h3 = tr_read<v_rd_off(D0, 3, 1)>(vb);
    asm volatile("s_waitcnt lgkmcnt(0)" ::: "memory"); ASBAR();
#define APK(L, H) (bf16x8){L[0], L[1], L[2], L[3], H[0], H[1], H[2], H[3]}
    od = __builtin_amdgcn_mfma_f32_32x32x16_bf16(pa0, APK(l0, h0), od, 0, 0, 0);
    od = __builtin_amdgcn_mfma_f32_32x32x16_bf16(pa1, APK(l1, h1), od, 0, 0, 0);
    od = __builtin_amdgcn_mfma_f32_32x32x16_bf16(pa2, APK(l2, h2), od, 0, 0, 0);
    od = __builtin_amdgcn_mfma_f32_32x32x16_bf16(pa3, APK(l3, h3), od, 0, 0, 0);
#undef APK
}
__device__ __forceinline__ void pv_d0(f32x16* o, int vb, bf16x8 pa0, bf16x8 pa1, bf16x8 pa2, bf16x8 pa3) {
    pv_one<0>(o[0], vb, pa0, pa1, pa2, pa3); pv_one<1>(o[1], vb, pa0, pa1, pa2, pa3); pv_one<2>(o[2], vb, pa0, pa1, pa2, pa3); pv_one<3>(o[3], vb, pa0, pa1, pa2, pa3);
}
__device__ __forceinline__ void attn_unit(const GAS bf16_t* __restrict__ QB, const GAS bf16_t* __restrict__ KVB, const GAS bf16_t* __restrict__ U, GAS unsigned char* __restrict__ BR,
                                          int qrow0, int h, int kctx0, int klat0, int nct, int NT, LAS char* lds) {
    const int tid = opaque_tid(), wid = tid >> 6, lane = tid & 63, r32 = lane & 31, hi = lane >> 5;
    LAS char* V_lds = lds; LAS char* K_lds = lds + 2 * SHM_V;
    LAS float* ws = (LAS float*)(lds + 2 * SHM_V + 2 * SHM_K) + wid * 64; LAS float* li_l = ws; LAS float* al_l = ws + 32;
    float m_reg = -1e30f, l_reg = 0; f32x16 o[4] = {}; bf16x8 qr[12];
    const GAS bf16_t* Qw = QB + (size_t)(qrow0 + wid * 32 + r32) * 768;
#pragma unroll
    for (int d0 = 0; d0 < 8; ++d0) qr[d0] = *(const GAS bf16x8*)(Qw + h * 128 + d0 * 16 + hi * 8);
#pragma unroll
    for (int d0 = 8; d0 < 12; ++d0) qr[d0] = *(const GAS bf16x8*)(Qw + 512 + h * 64 + (d0 - 8) * 16 + hi * 8);
    const int sr = tid >> 4, sc = (tid & 15) * 8, vst0 = v_st(sr, sc), vst1 = v_st(32 + sr, sc), rr_ = tid >> 3, rc_ = (tid & 7) * 8;
    const int vb0 = (int)(uintptr_t)V_lds + v_rd_base(lane);
    struct { bf16x8 vs0, vs1, ks0, ks1, kr; } sr_[1];
#define ASLOAD(i, j_) do { const int j__ = (j_); const int k0 = j__ < nct ? kctx0 + 64 * j__ : klat0 + 64 * (j__ - nct); \
    sr_[i].vs0 = *(const GAS bf16x8*)(KVB + (size_t)(k0 + sr) * 1024 + 512 + h * 128 + sc); sr_[i].vs1 = *(const GAS bf16x8*)(KVB + (size_t)(k0 + 32 + sr) * 1024 + 512 + h * 128 + sc); \
    sr_[i].ks0 = *(const GAS bf16x8*)(KVB + (size_t)(k0 + sr) * 1024 + h * 128 + sc); sr_[i].ks1 = *(const GAS bf16x8*)(KVB + (size_t)(k0 + 32 + sr) * 1024 + h * 128 + sc); \
    sr_[i].kr = *(const GAS bf16x8*)(U + (size_t)(k0 + rr_) * NU + U_KR + rc_); } while (0)
#define ASWRITE(b, i) do { *(LAS bf16x8*)(V_lds + (b) * SHM_V + vst0) = sr_[i].vs0; *(LAS bf16x8*)(V_lds + (b) * SHM_V + vst1) = sr_[i].vs1; \
    *(LAS bf16x8*)(K_lds + (b) * SHM_K + AKSWZ(sr, sc * 2)) = sr_[i].ks0; *(LAS bf16x8*)(K_lds + (b) * SHM_K + AKSWZ(32 + sr, sc * 2)) = sr_[i].ks1; \
    *(LAS bf16x8*)(K_lds + (b) * SHM_K + AKSWZ(rr_, 256 + rc_ * 2)) = sr_[i].kr; } while (0)
#define ASWAIT() asm volatile("s_waitcnt vmcnt(0)" ::: "memory")
#define ARESC(a) do { if (__any((a) < 1.f)) { if (hi == 0) al_l[r32] = (a); asm volatile("s_waitcnt lgkmcnt(0)" ::: "memory"); \
    _Pragma("unroll") for (int d = 0; d < 4; ++d) _Pragma("unroll") for (int r = 0; r < 16; ++r) o[d][r] *= al_l[crow(r, hi)]; } } while (0)
    f32x16 pA0, pA1; float mnA, alA; bf16x8 pa0, pa1, pa2, pa3;
    ASLOAD(0, 0); asm volatile("s_waitcnt vmcnt(0)" ::: "memory"); ASWRITE(0, 0); __syncthreads();
    for (int j = 0; j < NT; ++j) {
        const int bsel = j & 1;
        if (j + 1 < NT) ASLOAD(0, j + 1);
        ASBAR(); qkt(pA0, pA1, K_lds + bsel * SHM_K, qr, r32, hi);
        partialSM(pA0, pA1, m_reg, mnA, alA);
        ARESC(alA);
        finishSM(pA0, pA1, alA, l_reg, pa0, pa1, pa2, pa3); ASBAR();
        pv_d0(o, vb0 + bsel * SHM_V, pa0, pa1, pa2, pa3);
        if (j + 1 < NT) { ASWAIT(); ASWRITE(bsel ^ 1, 0); }
        __syncthreads();
    }
    if (hi == 0) li_l[r32] = l_reg; asm volatile("s_waitcnt lgkmcnt(0)" ::: "memory");
    GAS unsigned char* Ow = BR + (size_t)(qrow0 + wid * 32) * DM + 1024 + h * 128;
#pragma unroll
    for (int r = 0; r < 16; ++r) { const int orow = crow(r, hi); const float rl = __builtin_amdgcn_rcpf(li_l[orow]);
#pragma unroll
        for (int d0 = 0; d0 < 4; ++d0) { const float v = __builtin_amdgcn_fmed3f(o[d0][r] * rl, -448.f, 448.f); Ow[(size_t)orow * DM + d0 * 32 + r32] = (unsigned char)(__builtin_amdgcn_cvt_pk_fp8_f32(v, 0.f, 0u, false) & 0xffu); } }
    __syncthreads();
#undef ASLOAD
#undef ASWRITE
#undef ASWAIT
#undef ARESC
}
}

constexpr int PH_PER_LAYER = 13, NPHASE = 2 + DEPTH * PH_PER_LAYER;
struct Args { const float* in[N_IN]; float* out; unsigned char* ws; int ph_lo, ph_hi; };
static_assert(sizeof(Args) == N_IN * 8 + 8 + 8 + 8, "Args has no padding");

#ifndef REP_G1
#define REP_G1 1
#endif
#ifndef REP_G2
#define REP_G2 1
#endif
#ifndef REP_G5
#define REP_G5 1
#endif
#ifndef REP_G6
#define REP_G6 1
#endif
#ifndef REP_G8
#define REP_G8 1
#endif
#ifndef REP_G10
#define REP_G10 1
#endif
#ifndef REP_G11
#define REP_G11 1
#endif
#ifndef REP_R4
#define REP_R4 1
#endif
#ifndef PH_MASK
#define PH_MASK 0xffffffffu
#endif
#define IN(k) (lo <= (k) && (k) < hi)
#define EN(j) ((PH_MASK >> (j)) & 1u)
#ifndef SUBMASK
#define SUBMASK 7
#endif
#define REFRESH() do { F.tid = opaque_tid(); F.lane = F.tid & 63; F.wave = __builtin_amdgcn_readfirstlane(F.tid >> 6); \
    F.ws = (GAS unsigned char*)opaque_ptr(args.ws); F.ctl = (unsigned*)opaque_ptr(args.ws + WS_CTL); F.out = (GAS float*)opaque_ptr(args.out); } while (0)
#ifdef PROBE_MASK
#define STAMP(k) do { if (blockIdx.x == 0 && threadIdx.x == 0) ((volatile unsigned long long*)(args.ws + WS_CTL + 65536))[16 + (k)] = __builtin_amdgcn_s_memrealtime(); } while (0)
#else
#define STAMP(k) do { } while (0)
#endif
#define SEAM(k) do { if (IN(k) && IN((k) + 1)) xcd_barrier(bar); STAMP((k) + 1); } while (0)
template <int l> __device__ __forceinline__ void layer_phases(Frame& F, const Args& args, const XcdBarrier& bar, const int lo, const int hi, char* ldsg) {
        const int pb = 2 + l * PH_PER_LAYER;
        const int mrows = (l + 1 < DEPTH) ? MT : ML;
        GAS bf16_t* const Hb = WSP(bf16_t, WS_H); GAS bf16_t* const Ub = WSP(bf16_t, WS_RA);
        if (IN(pb + 0) && EN(0) && l == 0) { REFRESH(); phase_rwA(F, l); }
        if (l == 0) SEAM(pb + 0);
        if (IN(pb + 1) && EN(1)) for (int rp_ = 0; rp_ < REP_G1; ++rp_) { REFRESH();
            EpiWin E{Ub, WSP(float, WS_SSQ), WSP(float, WS_TAB), WSP(bf16_t, WS_MLC)};
            { Gemm g{WSP(bf16_t, WS_HIN), WSP(bf16_t, WS_WIN) + (size_t)l * NU * DM, DM, DM, DM};
              WinSched S; S.gs.init(MT / 256, 5, F.G, (int)blockIdx.x, (size_t)256 * DM * 2, (size_t)256 * DM * 2, 0, 0); S.mode = 1;
              pg8::gemm_phase<EpiWin, WinSched, false>(F.lds, g, S, E); }
            { Gemm g{(const GAS bf16_t*)WSP(unsigned char, WS_H8), (const GAS bf16_t*)(WSP(unsigned char, WS_WIN8) + (size_t)l * NU * DM), DM / 2, DM / 2, DM / 2};
              WinSched S; S.gs.init(MT / 256, 23, F.G, (int)((blockIdx.x + 152) & 255), (size_t)256 * DM, (size_t)256 * DM, 0, 0); S.mode = 0;
              pg8::gemm_phase<EpiWin, WinSched, false, true>(F.lds, g, S, E); }
        }
        SEAM(pb + 1);
        if (IN(pb + 2) && EN(2)) for (int rp_ = 0; rp_ < REP_G2; ++rp_) { REFRESH();
            if (SUBMASK & 1) { Gemm g{Ub, WSP(bf16_t, WS_WUQ) + (size_t)l * 768 * 512, NU, 512, 512};
              GridSched S; S.init(MT / 256, 3, F.G, (int)blockIdx.x, (size_t)256 * NU * 2, (size_t)256 * 512 * 2, (size_t)U_CQ * 2, 0);
              EpiMlaQ E{WSP(bf16_t, WS_QB), WSP(float, WS_SSQ), WSP(float, WS_TAB)};
              pg8::gemm_phase<EpiMlaQ, GridSched, false>(F.lds, g, S, E); }
            if (SUBMASK & 2) { Gemm g{Ub, WSP(bf16_t, WS_WUKV) + (size_t)l * 1024 * 256, NU, 256, 256};
              GridSched S; S.init(MT / 256, 4, F.G, (int)((blockIdx.x + 40u) % (unsigned)F.G), (size_t)256 * NU * 2, (size_t)256 * 256 * 2, (size_t)U_CKV * 2, 0);
              EpiMlaKV E{WSP(bf16_t, WS_KVB), WSP(float, WS_SSQ)};
              pg8::gemm_phase<EpiMlaKV, GridSched, false>(F.lds, g, S, E); }
            if (SUBMASK & 4) { Gemm g{(const GAS bf16_t*)WSP(unsigned char, WS_H8), (const GAS bf16_t*)(WSP(unsigned char, WS_WG) + (size_t)l * 8192 * DM), DM / 2, DM / 2, DM / 2};
              GridSched S; S.init(mrows / 256, 32, F.G, (int)blockIdx.x, (size_t)256 * DM, (size_t)256 * DM, 0, 0);
              EpiGate E{WSP(unsigned char, WS_RB)};
              pg8::gemm_phase<EpiGate, GridSched, false, true>(F.lds, g, S, E); }
            phase_ssdconv(F, l);
            phase_scanprep(F, l);
        }
        SEAM(pb + 2);
#ifndef REP_MIX
#define REP_MIX 1
#endif
        if (IN(pb + 3) && EN(3)) for (int rep_ = 0; rep_ < REP_MIX; ++rep_) { REFRESH();
            const int bx = blockIdx.x;
#ifndef REPMASK
#define REPMASK 15
#endif
#ifdef ONLYK
            const int SCANMASK = ONLYK;
#else
            const int SCANMASK = rep_ == 0 ? 15 : REPMASK;
#endif
            if (bx < 64) {
                if (__builtin_amdgcn_readfirstlane(F.wave) < 4) scn::scan_block<scn::K_ML>(F, l, bx); else scn::scan_block<scn::K_HG>(F, l, bx); }
            else if (bx < 96) { scn::scan_block<scn::K_SSD>(F, l, (bx - 64) * 2 + (F.wave >> 2)); }
            else if (SCANMASK & 8) {
                const int natt = 256 + (l + 1 < DEPTH ? 32 : 0), nab = F.G - 96;
                for (int ua = bx - 96; ua < natt; ua += nab) {
                    if (ua < 256) { const int b = ua >> 5, h = (ua >> 3) & 3, qb = ua & 7;
                        att::attn_unit(WSP(bf16_t, WS_QB), WSP(bf16_t, WS_KVB), Ub, WSP(unsigned char, WS_BR), b * SEQ + qb * 256, h, ML + b * CTXL, b * SEQ, 4, 36, (LAS char*)F.lds); }
                    else { const int uc = ua - 256, b = uc >> 2, h = uc & 3;
                        att::attn_unit(WSP(bf16_t, WS_QB), WSP(bf16_t, WS_KVB), Ub, WSP(unsigned char, WS_BR), ML + b * CTXL, h, ML + b * CTXL, 0, 4, 4, (LAS char*)F.lds); }
                }
                if (rep_ == 0) {
                    LAS float* scr = (LAS float*)(F.lds + F.wave * 16384);
                    if (l + 1 == DEPTH) { for (int it = (bx - 96) * 8 + F.wave; it < IT_MOE; it += (F.G - 96) * 8) cvt_moe_item(F, l, it, scr); }
                    else { for (int it = (bx - 96) * 8 + F.wave; it < IT_LAYER + IT_MOE / 2; it += (F.G - 96) * 8) { if (it < IT_LAYER) cvt_layer_item(F, l + 1, it, scr); else cvt_moe_item(F, l, it - IT_LAYER, scr); } }
                }
            }
        }
        SEAM(pb + 3);
        if (IN(pb + 4) && EN(4)) for (int rp_ = 0; rp_ < REP_R4; ++rp_) { REFRESH(); phase_finish(F, l, mrows); }
        SEAM(pb + 4);
        if (IN(pb + 5) && EN(5)) for (int rp_ = 0; rp_ < REP_G5; ++rp_) { REFRESH();
            Gemm g{(const GAS bf16_t*)WSP(unsigned char, WS_BR), (const GAS bf16_t*)(WSP(unsigned char, WS_WBR) + (size_t)l * 4 * DM * 512), DM / 2, 256, 256};
            MergeSched S; S.gs.init(mrows / 256, 8, F.G, (int)blockIdx.x, 0, 0, 0, 0);
            EpiMerge E{WSP(unsigned char, WS_RB), WSP(unsigned char, WS_RA + RA_ACC), WSP(float, WS_RSSD)};
            pg8::gemm_phase<EpiMerge, MergeSched, false, true, true>(F.lds, g, S, E);
            if (l == 0 && blockIdx.x >= 128) {
                LAS float* scr = (LAS float*)(F.lds + F.wave * 16384);
                for (int it = IT_MOE / 2 + ((int)blockIdx.x - 128) * 8 + F.wave; it < IT_MOE / 2 + 16384; it += 128 * 8) cvt_moe_item(F, 0, it, scr);
            }
        }
        SEAM(pb + 5);
        if (IN(pb + 6) && EN(6)) for (int rp_ = 0; rp_ < REP_G6; ++rp_) { REFRESH();
            Gemm g{(const GAS bf16_t*)WSP(unsigned char, WS_RA + RA_ACC), (const GAS bf16_t*)(WSP(unsigned char, WS_WOUT) + (size_t)l * DM * DM), DM / 2, DM / 2, DM / 2};
            GridSched S; S.init(mrows / 256, 8, F.G, (int)blockIdx.x, (size_t)256 * DM, (size_t)256 * DM, 0, 0);
            EpiBf16 E{WSP(bf16_t, WS_RB + RB_Y), DM};
            pg8::gemm_phase<EpiBf16, GridSched, false, true>(F.lds, g, S, E);
            if (l == 0 && blockIdx.x >= 64) {
                LAS float* scr = (LAS float*)(F.lds + F.wave * 16384);
                for (int it = IT_MOE / 2 + 16384 + ((int)blockIdx.x - 64) * 8 + F.wave; it < IT_MOE; it += 192 * 8) cvt_moe_item(F, 0, it, scr);
            }
        }
        SEAM(pb + 6);
        if (IN(pb + 7) && EN(7)) { REFRESH(); phase_rwB(F, l, mrows); }
        SEAM(pb + 7);
        if (IN(pb + 8) && EN(8)) for (int rp_ = 0; rp_ < REP_G8; ++rp_) { REFRESH();
            Gemm g{Hb, WSP(bf16_t, WS_WR) + (size_t)l * 256 * DM, DM, DM, 512};
            RouterSched S{mrows / 256, F.G, (int)blockIdx.x};
            EpiRouter E{WSP(float, WS_LOG)};
            pg8::gemm_phase<EpiRouter, RouterSched, false>(F.lds, g, S, E);
        }
        SEAM(pb + 8);
        if (IN(pb + 9) && EN(9)) { REFRESH(); phase_route(F, l, mrows, bar); }
        SEAM(pb + 9);
        if (IN(pb + 10) && EN(10)) for (int rp_ = 0; rp_ < REP_G10; ++rp_) { REFRESH();
            moe_tables(F, l);
            Gemm g{(const GAS bf16_t*)WSP(unsigned char, WS_H8), (const GAS bf16_t*)WSP(unsigned char, WS_W13), DM / 2, DM / 2, DM / 2};
            MoeSched S{(const volatile LAS int*)(F.MISC + 16), (const volatile LAS int*)(F.MISC + 64), WSP(int, WS_LIST), 4, F.G, (int)blockIdx.x, 1};
            EpiMoe1 E{WSP(unsigned char, WS_RA + RA_H1)};
            pg8::gemm_phase<EpiMoe1, MoeSched, true, true>(F.lds, g, S, E);
        }
        SEAM(pb + 10);
        if (IN(pb + 11) && EN(11)) for (int rp_ = 0; rp_ < REP_G11; ++rp_) { REFRESH();
            moe_tables(F, l);
            Gemm g{(const GAS bf16_t*)WSP(unsigned char, WS_RA + RA_H1), (const GAS bf16_t*)WSP(unsigned char, WS_W2), DEXP / 2, DEXP / 2, DEXP / 2};
            MoeSched S{(const volatile LAS int*)(F.MISC + 16), (const volatile LAS int*)(F.MISC + 64), WSP(int, WS_LIST), 8, F.G, (int)blockIdx.x, 2};
            EpiMoe2 E{WSP(bf16_t, WS_RB + RB_Y2), WSP(int, WS_LIST), WSP(float, WS_WL), (const volatile LAS int*)(F.MISC + 64)};
            pg8::gemm_phase<EpiMoe2, MoeSched, false, true>(F.lds, g, S, E);
        }
        SEAM(pb + 11);
        if (IN(pb + 12) && EN(12)) { REFRESH(); phase_rwC(F, l, mrows); }
        SEAM(pb + 12);
    }

__global__ void __launch_bounds__(512, 2) fwd_kernel(Args args) {
    extern __shared__ __attribute__((aligned(16))) unsigned char lds_raw[];
    Frame F;
    F.lds = (LAS unsigned char*)lds_raw;
    F.MISC = (volatile LAS unsigned*)(F.lds + MISC_OFF);
    F.tid = threadIdx.x; F.lane = F.tid & 63; F.wave = __builtin_amdgcn_readfirstlane(F.tid >> 6);
    F.G = gridDim.x; { const int bx = blockIdx.x; F.vcu = (F.G % 8 == 0) ? (bx % 8) * (F.G / 8) + bx / 8 : bx; }
    F.ws = (GAS unsigned char*)args.ws; F.ctl = (unsigned*)(args.ws + WS_CTL); F.out = (GAS float*)args.out;
    F.inp = args.in;
    for (int u = F.tid; u < (LDS_BYTES - MISC_OFF) / 4; u += 512) F.MISC[u] = 0u;
    __syncthreads();
    const int lo = args.ph_lo, hi = args.ph_hi;
    XcdBarrier bar; bar.bar = F.ctl + CW_BAR; bar.x = 0; bar.st = nullptr;
    if (hi - lo > 1) bar = xcd_barrier_post(F.ctl + CW_BAR, F.MISC + 8);
    char* ldsg = (char*)lds_raw;

#ifndef REP_PRO
#define REP_PRO 1
#endif
    STAMP(0);
    if (IN(0) && EN(13)) for (int rep_ = 0; rep_ < REP_PRO; ++rep_) { phase_prologue(F); } SEAM(0);
    if (IN(1) && EN(14)) { phase_modfin(F); } SEAM(1);

    layer_phases<0>(F, args, bar, lo, hi, ldsg);
    layer_phases<1>(F, args, bar, lo, hi, ldsg);
#ifdef PROBE_MASK
    __syncthreads();
    if (blockIdx.x == 0 && threadIdx.x == 0) {
        STAMP(NPHASE);
        volatile unsigned long long* T = (volatile unsigned long long*)(args.ws + WS_CTL + 65536) + 16; unsigned long long acc_ = 0;
        for (int k = 0; k < NPHASE; ++k) if ((PROBE_MASK >> k) & 1ull) { const unsigned long long a_ = T[k], b_ = T[k + 1]; if (a_ && b_ > a_) acc_ += b_ - a_; }
        args.out[0] = 3.0f + (float)acc_ * 0.001f;
    }
#endif
#undef IN
#undef SEAM
}


#ifdef DUMP_OFF
__global__ void dump_kernel(GAS float* out, const unsigned char* ws) {
    const size_t OUTN = (size_t)ML * DM; const size_t i0 = (size_t)blockIdx.x * blockDim.x + threadIdx.x, st = (size_t)gridDim.x * blockDim.x;
    for (size_t i = i0; i < OUTN; i += st) { float a = 0.f;
#if DUMP_F32
        const GAS float* src = (const GAS float*)(ws + (size_t)DUMP_OFF); for (size_t j = i; j < (size_t)DUMP_ELEMS; j += OUTN) a += src[j];
#else
        const GAS bf16_t* src = (const GAS bf16_t*)(ws + (size_t)DUMP_OFF); for (size_t j = i; j < (size_t)DUMP_ELEMS; j += OUTN) a += bf2f(src[j]);
#endif
        out[i] = a; }
}
#endif
extern "C" void kernel_launch(void* const* d_in, const int* in_sizes, int n_in, void* d_out, int out_size, void* d_ws, size_t ws_size, hipStream_t stream) {
    static int grid = 0;
    if (grid == 0) {
        if (n_in != N_IN || out_size != ML * DM || ws_size < WS_END) { fprintf(stderr, "kernel_launch: unexpected shapes: n_in %d out %d ws %zu (need %zu)\n", n_in, out_size, ws_size, (size_t)WS_END); grid = -1; return; }
        int dev = 0, cus = 0, per_cu = 0;
        if (hipGetDevice(&dev) != hipSuccess || hipDeviceGetAttribute(&cus, hipDeviceAttributeMultiprocessorCount, dev) != hipSuccess) { grid = -1; return; }
        if (hipFuncSetAttribute((const void*)fwd_kernel, hipFuncAttributeMaxDynamicSharedMemorySize, LDS_BYTES) != hipSuccess) { fprintf(stderr, "kernel_launch: hipFuncSetAttribute failed\n"); grid = -1; return; }
        if (hipOccupancyMaxActiveBlocksPerMultiprocessor(&per_cu, (const void*)fwd_kernel, 512, LDS_BYTES) != hipSuccess || per_cu < 1) { fprintf(stderr, "kernel_launch: occupancy query says %d\n", per_cu); }
        (void)hipGetLastError();
        grid = cus;
    }
    if (grid < 0) return;
    if (hipMemsetAsync((char*)d_ws + WS_CTL, 0, CTL_BYTES, stream) != hipSuccess) return;
    Args a{};
    for (int i = 0; i < N_IN; ++i) a.in[i] = (const float*)d_in[i];
    a.out = (float*)d_out; a.ws = (unsigned char*)d_ws;
#if MK_SINGLE
    a.ph_lo = 0; a.ph_hi = NPHASE;
    hipLaunchKernelGGL(fwd_kernel, dim3(grid), dim3(512), LDS_BYTES, stream, a);
#else
#ifndef MK_STOP
#define MK_STOP NPHASE
#endif
    for (int ph = 0; ph < MK_STOP; ++ph) {
        if (ph == 2 + PH_PER_LAYER) continue;
        a.ph_lo = ph; a.ph_hi = ph + 1;
        hipLaunchKernelGGL(fwd_kernel, dim3(grid), dim3(512), LDS_BYTES, stream, a);
    }
#endif
#ifdef DUMP_OFF
    hipLaunchKernelGGL(dump_kernel, dim3(2048), dim3(256), 0, stream, (float*)d_out, (const unsigned char*)d_ws);
#endif
    const hipError_t le = hipPeekAtLastError();
    if (le != hipSuccess) fprintf(stderr, "kernel_launch: launch failed: %s\n", hipGetErrorName(le));
}
```
